# Optimizing an MI355X kernel written in HIP

```python
import jax
import jax.numpy as jnp
from jax import lax
import numpy as np

D_MODEL = 1024
BATCH = 4
SEQ = 8192
DEPTH = 1

PLE_DIM = 256
D_MIX = D_MODEL
RET_WIDTH = D_MIX // 2
RET_HEADS = 8
RET_HEAD_DIM = RET_WIDTH // RET_HEADS
ML_WIDTH = D_MIX - RET_WIDTH
ML_HEADS = 4
ML_HEAD_DIM = ML_WIDTH // ML_HEADS
N_PROJ = 4 * RET_WIDTH + 4 * ML_WIDTH + 2 * ML_HEADS
CHUNK = 128
CONV_W = 4
ROPE_BASE = 10000.0
N_GROUPS = 4
EXPERTS_PER_GROUP = 8
N_EXPERTS = N_GROUPS * EXPERTS_PER_GROUP
TOP_K = 2
D_EXPERT = D_MODEL // 2
MOE_BLOCK = 128
EPS = 1e-6

kernel_name = 'hymba_style_retention_mlstm_hmoe_ple'


def rms_norm(x, g):
    xf = x.astype(jnp.float32)
    y = xf * lax.rsqrt(jnp.mean(xf * xf, axis=-1, keepdims=True) + EPS)
    return (y * g.astype(jnp.float32)).astype(x.dtype)


def rotary(x, positions):
    half = x.shape[-1] // 2
    freqs = ROPE_BASE ** (-jnp.arange(half, dtype=jnp.float32) / half)
    ang = positions.astype(jnp.float32)[..., None] * freqs
    cos = jnp.cos(ang)[:, :, None, :]
    sin = jnp.sin(ang)[:, :, None, :]
    x1, x2 = x[..., :half], x[..., half:]
    return jnp.concatenate([x1 * cos - x2 * sin, x1 * sin + x2 * cos], axis=-1)


def _to_chunks(t):
    B, S, H, d = t.shape
    return t.reshape(B, S // CHUNK, CHUNK, H, d).transpose(0, 3, 1, 2, 4)


def _from_chunks(t):
    B, H, N, C, d = t.shape
    return t.transpose(0, 2, 3, 1, 4).reshape(B, N * C, H, d)


def retention(q, k, v, positions):
    B, S, H, dh = q.shape
    q = rotary(q, positions)
    k = rotary(k, positions) * (dh ** -0.5)
    qc, kc, vc = _to_chunks(q), _to_chunks(k), _to_chunks(v)
    log_gamma = jnp.log1p(-(2.0 ** (-5.0 - jnp.arange(H, dtype=jnp.float32))))
    idx = jnp.arange(CHUNK, dtype=jnp.float32)
    rel = idx[:, None] - idx[None, :]
    causal = rel >= 0
    decay = jnp.where(causal, jnp.exp(log_gamma[:, None, None] * jnp.where(causal, rel, 0.0)), 0.0)
    scores = jnp.einsum('bhncd,bhnmd->bhncm', qc, kc) * decay[:, None]
    intra = jnp.einsum('bhncm,bhnmd->bhncd', scores, vc)
    w_state = jnp.exp(log_gamma[:, None] * (CHUNK - 1 - idx))
    chunk_kv = jnp.einsum('bhncd,bhnce->bhnde', kc * w_state[:, None, :, None], vc)
    chunk_decay = jnp.exp(log_gamma * CHUNK)[:, None, None]

    def step(R, s):
        return chunk_decay * R + s, R

    R0 = jnp.zeros((B, H, dh, dh), jnp.float32)
    _, R_prev = lax.scan(step, R0, chunk_kv.transpose(2, 0, 1, 3, 4))
    R_prev = R_prev.transpose(1, 2, 0, 3, 4)
    w_query = jnp.exp(log_gamma[:, None] * (idx + 1.0))
    inter = jnp.einsum('bhncd,bhnde->bhnce', qc, R_prev) * w_query[:, None, :, None]
    return _from_chunks(intra + inter)


def mlstm(q, k, v, i_pre, f_pre):
    B, S, H, d = q.shape
    N = S // CHUNK
    k = k * (d ** -0.5)
    qc, kc, vc = _to_chunks(q), _to_chunks(k), _to_chunks(v)
    ig = i_pre.reshape(B, N, CHUNK, H).transpose(0, 3, 1, 2)
    logf = jax.nn.log_sigmoid(f_pre).reshape(B, N, CHUNK, H).transpose(0, 3, 1, 2)
    b = jnp.cumsum(logf, axis=-1)
    bL = b[..., -1]
    a = bL[..., None] - b + ig

    def step(carry, inp):
        S_, n_, m_ = carry
        k_, v_, a_, bL_ = inp
        m_new = jnp.maximum(bL_ + m_, jnp.max(a_, axis=-1))
        w = jnp.exp(a_ - m_new[..., None])
        dec = jnp.exp(bL_ + m_ - m_new)
        S_new = dec[..., None, None] * S_ + jnp.einsum('bhcd,bhce->bhde', k_ * w[..., None], v_)
        n_new = dec[..., None] * n_ + jnp.einsum('bhc,bhcd->bhd', w, k_)
        return (S_new, n_new, m_new), (S_, n_, m_)

    init = (jnp.zeros((B, H, d, d), jnp.float32), jnp.zeros((B, H, d), jnp.float32),
            jnp.zeros((B, H), jnp.float32))
    xs = (kc.transpose(2, 0, 1, 3, 4), vc.transpose(2, 0, 1, 3, 4),
          a.transpose(2, 0, 1, 3), bL.transpose(2, 0, 1))
    _, (S_prev, n_prev, m_prev) = lax.scan(step, init, xs)
    S_prev = S_prev.transpose(1, 2, 0, 3, 4)
    n_prev = n_prev.transpose(1, 2, 0, 3)
    m_prev = m_prev.transpose(1, 2, 0)

    causal = jnp.arange(CHUNK)[:, None] >= jnp.arange(CHUNK)[None, :]
    Dlog = jnp.where(causal, b[..., :, None] - b[..., None, :] + ig[..., None, :], -jnp.inf)
    inter_log = b + m_prev[..., None]
    m_row = jnp.maximum(jnp.max(Dlog, axis=-1), inter_log)
    P = jnp.exp(Dlog - m_row[..., None]) * jnp.einsum('bhncd,bhnmd->bhncm', qc, kc)
    w_inter = jnp.exp(inter_log - m_row)
    num = (jnp.einsum('bhncm,bhnmd->bhncd', P, vc)
           + w_inter[..., None] * jnp.einsum('bhncd,bhnde->bhnce', qc, S_prev))
    den = jnp.sum(P, axis=-1) + w_inter * jnp.einsum('bhncd,bhnd->bhnc', qc, n_prev)
    h = num / jnp.maximum(jnp.abs(den), jnp.exp(-m_row))[..., None]
    return _from_chunks(h)


def causal_conv(x, w, bias):
    C = x.shape[-1]
    y = lax.conv_general_dilated(x, w[:, None, :], window_strides=(1,),
                                 padding=((CONV_W - 1, 0),),
                                 dimension_numbers=('NWC', 'WIO', 'NWC'),
                                 feature_group_count=C)
    return y + bias


def mixer(xn, positions, w_in, conv_w, conv_b, b_igate, b_fgate, ret_gn, ml_gn, w_out):
    B, S, _ = xn.shape
    proj = xn @ w_in
    sizes = [RET_WIDTH] * 4 + [ML_WIDTH] * 4 + [ML_HEADS] * 2
    offs = np.cumsum(sizes)[:-1].tolist()
    rq, rk, rv, rg, mq, mk, mv, mo, mi, mf = jnp.split(proj, offs, axis=-1)
    f32 = jnp.float32
    rsh = (B, S, RET_HEADS, RET_HEAD_DIM)
    r = retention(rq.reshape(rsh).astype(f32), rk.reshape(rsh).astype(f32),
                  rv.reshape(rsh).astype(f32), positions)
    r = rms_norm(r, ret_gn.reshape(RET_HEADS, RET_HEAD_DIM)).reshape(B, S, RET_WIDTH)
    r = jax.nn.silu(rg.astype(f32)) * r
    qk = jax.nn.silu(causal_conv(jnp.concatenate([mq, mk], axis=-1), conv_w, conv_b))
    mq2, mk2 = jnp.split(qk, 2, axis=-1)
    msh = (B, S, ML_HEADS, ML_HEAD_DIM)
    i_pre = (mi + b_igate).astype(f32)
    f_pre = (mf + b_fgate).astype(f32)
    hm = mlstm(mq2.reshape(msh).astype(f32), mk2.reshape(msh).astype(f32),
               mv.reshape(msh).astype(f32), i_pre, f_pre)
    hm = jax.nn.sigmoid(mo.astype(f32)).reshape(msh) * hm
    hm = rms_norm(hm, ml_gn.reshape(ML_HEADS, ML_HEAD_DIM)).reshape(B, S, ML_WIDTH)
    y = jnp.concatenate([r, hm], axis=-1).astype(xn.dtype)
    return y @ w_out


def hier_moe(xn, w_group, b_group, w_router, b_router, w1, w3, w2):
    B, S, D = xn.shape
    T = B * S
    xf = xn.reshape(T, D)
    g_logits = (xf @ w_group).astype(jnp.float32) + b_group.astype(jnp.float32)
    g_prob = jax.nn.softmax(g_logits, axis=-1)
    g_sel = jnp.argmax(g_logits, axis=-1)
    p_g = jnp.take_along_axis(g_prob, g_sel[:, None], axis=-1)
    e_logits = ((xf @ w_router).astype(jnp.float32) + b_router.astype(jnp.float32)
                ).reshape(T, N_GROUPS, EXPERTS_PER_GROUP)
    e_in = jnp.take_along_axis(e_logits, g_sel[:, None, None], axis=1)[:, 0]
    top_p, top_i = lax.top_k(jax.nn.softmax(e_in, axis=-1), TOP_K)
    gates = p_g * top_p / jnp.sum(top_p, axis=-1, keepdims=True)
    expert_id = (g_sel[:, None] * EXPERTS_PER_GROUP + top_i).astype(jnp.int32)
    TK = T * TOP_K
    flat_e = expert_id.reshape(-1)
    order = jnp.argsort(flat_e).astype(jnp.int32)
    sorted_e = flat_e[order]
    counts = jnp.bincount(flat_e, length=N_EXPERTS).astype(jnp.int32)
    padded = (counts + MOE_BLOCK - 1) // MOE_BLOCK * MOE_BLOCK
    start = jnp.cumsum(counts) - counts
    pad_end = jnp.cumsum(padded)
    pad_start = pad_end - padded
    dest = pad_start[sorted_e] + jnp.arange(TK, dtype=jnp.int32) - start[sorted_e]
    n_blocks = TK // MOE_BLOCK + N_EXPERTS
    P = n_blocks * MOE_BLOCK
    row_token = jnp.full((P,), T, jnp.int32).at[dest].set(order // TOP_K)
    x_pad = jnp.concatenate([xf, jnp.zeros((1, D), xf.dtype)], axis=0)
    x_buf = x_pad[row_token].reshape(n_blocks, MOE_BLOCK, D)
    block_start = jnp.arange(n_blocks, dtype=jnp.int32) * MOE_BLOCK
    block_expert = jnp.clip(jnp.searchsorted(pad_end, block_start, side='right'),
                            0, N_EXPERTS - 1).astype(jnp.int32)

    def expert_block(args):
        xb, e = args
        hmid = jax.nn.silu(xb @ w1[e]) * (xb @ w3[e])
        return hmid @ w2[e]

    y_buf = lax.map(expert_block, (x_buf, block_expert)).reshape(P, D)
    slot_pos = jnp.zeros((TK,), jnp.int32).at[order].set(dest)
    y = y_buf[slot_pos].reshape(T, TOP_K, D)
    out = jnp.einsum('tk,tkd->td', gates.astype(y.dtype), y)
    return out.reshape(B, S, D)


def setup_inputs(seed: int = 0) -> dict:
    key = jax.random.key(seed)
    ks = jax.random.split(key, 26)
    f32 = jnp.float32
    nrm = lambda k, shape, scale: jax.random.normal(k, shape, f32) * scale
    L, D = DEPTH, D_MODEL
    x = jax.random.normal(ks[0], (BATCH, SEQ, D), f32)
    p = jax.random.normal(ks[1], (DEPTH, BATCH, SEQ, PLE_DIM), f32)
    positions = jnp.broadcast_to(jnp.arange(SEQ, dtype=jnp.int32)[None, :], (BATCH, SEQ))
    return {
        'x': x,
        'p': p,
        'positions': positions,
        'attn_norm': 1.0 + nrm(ks[2], (L, D), 0.02),
        'w_in': nrm(ks[3], (L, D, N_PROJ), D ** -0.5),
        'conv_w': nrm(ks[4], (L, CONV_W, 2 * ML_WIDTH), CONV_W ** -0.5),
        'conv_b': nrm(ks[5], (L, 2 * ML_WIDTH), 0.02),
        'b_igate': nrm(ks[6], (L, ML_HEADS), 0.1),
        'b_fgate': jnp.linspace(3.0, 6.0, ML_HEADS, dtype=f32)[None, :] + nrm(ks[7], (L, ML_HEADS), 0.02),
        'ret_gn': 1.0 + nrm(ks[8], (L, RET_WIDTH), 0.02),
        'ml_gn': 1.0 + nrm(ks[9], (L, ML_WIDTH), 0.02),
        'w_out': nrm(ks[10], (L, D_MIX, D), D_MIX ** -0.5),
        'moe_norm': 1.0 + nrm(ks[11], (L, D), 0.02),
        'w_group': nrm(ks[12], (L, D, N_GROUPS), D ** -0.5),
        'b_group': nrm(ks[13], (L, N_GROUPS), 0.01),
        'w_router': nrm(ks[14], (L, D, N_EXPERTS), D ** -0.5),
        'b_router': nrm(ks[15], (L, N_EXPERTS), 0.01),
        'w1': nrm(ks[16], (L, N_EXPERTS, D, D_EXPERT), D ** -0.5),
        'w3': nrm(ks[17], (L, N_EXPERTS, D, D_EXPERT), D ** -0.5),
        'w2': nrm(ks[18], (L, N_EXPERTS, D_EXPERT, D), D_EXPERT ** -0.5),
        'w_ple_up': nrm(ks[19], (L, PLE_DIM, D), PLE_DIM ** -0.5),
        'ple_norm': 1.0 + nrm(ks[20], (L, D), 0.02),
        'ple_gate_norm': 1.0 + nrm(ks[21], (L, D), 0.02),
        'w_ple_gate': nrm(ks[22], (L, D, D), D ** -0.5),
        'final_norm': 1.0 + nrm(ks[23], (D,), 0.02),
    }


def reference(x, p, positions, attn_norm, w_in, conv_w, conv_b, b_igate, b_fgate,
              ret_gn, ml_gn, w_out, moe_norm, w_group, b_group, w_router, b_router,
              w1, w3, w2, w_ple_up, ple_norm, ple_gate_norm, w_ple_gate, final_norm):
    h = x
    for l in range(DEPTH):
        xn = rms_norm(h, attn_norm[l])
        h = h + mixer(xn, positions, w_in[l], conv_w[l], conv_b[l], b_igate[l], b_fgate[l],
                      ret_gn[l], ml_gn[l], w_out[l])
        xn = rms_norm(h, moe_norm[l])
        h = h + hier_moe(xn, w_group[l], b_group[l], w_router[l], b_router[l],
                         w1[l], w3[l], w2[l])
        e = rms_norm(p[l] @ w_ple_up[l], ple_norm[l])
        gate = jax.nn.sigmoid(rms_norm(h, ple_gate_norm[l]) @ w_ple_gate[l])
        h = h + gate * e
    return rms_norm(h, final_norm)
```

```cpp
#include <hip/hip_runtime.h>
#include <cstdio>
#include <cstdint>

constexpr int D = 1024, BATCH = 4, SEQ = 8192, T = BATCH * SEQ, PLE = 256;
constexpr int NPROJ = 4104, NP = 4096;
constexpr int CH = 128, NCH = SEQ / CH;
constexpr int RH = 8, RD = 64, MH = 4, MD = 128;
constexpr int NE = 32, DE = 512;
constexpr float EPS = 1e-6f;
constexpr int C_RQ = 0, C_RK = 512, C_RV = 1024, C_RG = 1536, C_MQ = 2048, C_MK = 2560, C_MV = 3072, C_MO = 3584;

constexpr size_t MiB = 1u << 20;
constexpr size_t WS_CTL = 0;
constexpr size_t WS_RSTD1 = 1 * MiB;
constexpr size_t WS_GATES = WS_RSTD1 + 256 * 1024;
constexpr size_t WS_RSTDG = 3 * MiB;
constexpr size_t WS_RSTDE = WS_RSTDG + 256 * 1024;
constexpr size_t WS_EID = 4 * MiB;
constexpr size_t WS_POS = WS_EID + 256 * 1024;
constexpr size_t WS_GATE = WS_POS + 256 * 1024;
constexpr size_t WS_MN = 5 * MiB;
constexpr size_t WS_ML = WS_MN + 512 * 1024;
constexpr size_t WS_MBL = WS_ML + 4096;
constexpr size_t WS_MM = WS_MBL + 4096;
constexpr size_t WS_LIST = 8 * MiB;
constexpr size_t WS_WB = 16 * MiB;
constexpr size_t WS_PROJ = 128 * MiB;
constexpr size_t WS_HBUF = 128 * MiB;
constexpr size_t WS_YBUF = 200 * MiB;
constexpr size_t WS_PEB = 128 * MiB;
constexpr size_t WS_YREG = 384 * MiB;
constexpr size_t WS_END = 448 * MiB;
constexpr size_t OUT_RST = 0;
constexpr size_t OUT_MST = 32 * MiB;
constexpr int CW_CNT = 64;

constexpr int NTHREADS = 512, NWAVES = 8;
constexpr int LDS_BYTES = 147456;

typedef unsigned short bf16_t;
__device__ __forceinline__ float bf2f(bf16_t h) { return __uint_as_float((unsigned)h << 16); }
__device__ __forceinline__ bf16_t f2bf(float f) { unsigned u = __float_as_uint(f); return (bf16_t)((u + 0x7fffu + ((u >> 16) & 1u)) >> 16); }
__device__ __forceinline__ float wave_sum(float v) {
#pragma unroll
    for (int o = 1; o < 64; o <<= 1) v += __shfl_xor(v, o);
    return v;
}
__device__ __forceinline__ float sigmoidf_(float x) { return 1.0f / (1.0f + expf(-x)); }
__device__ __forceinline__ float siluf_(float x) { return x / (1.0f + expf(-x)); }
__device__ __forceinline__ float logsigmoidf_(float x) { return x >= 0.f ? -log1pf(expf(-x)) : x - log1pf(expf(x)); }

struct Params {
    const float *x, *p; const int* pos;
    const float *attn_norm, *w_in, *conv_w, *conv_b, *b_ig, *b_fg, *ret_gn, *ml_gn, *w_out, *moe_norm, *w_group, *b_group, *w_router, *b_router,
                *w1, *w3, *w2, *w_up, *ple_norm, *pg_norm, *w_gate, *final_norm;
    float* out; unsigned char* ws; int ph_lo, ph_hi;
};

__device__ __forceinline__ void load4(const float* p, float (&o)[4]) { const float4 v = *(const float4*)p; o[0] = v.x; o[1] = v.y; o[2] = v.z; o[3] = v.w; }
__device__ __forceinline__ void load4(const bf16_t* p, float (&o)[4]) { const uint2 v = *(const uint2*)p; o[0] = __uint_as_float(v.x << 16); o[1] = __uint_as_float(v.x & 0xffff0000u); o[2] = __uint_as_float(v.y << 16); o[3] = __uint_as_float(v.y & 0xffff0000u); }

template <typename TA, bool DUAL, class Epi>
__device__ __forceinline__ void gemm_naive(float* lds, const TA* A, int lda, const int* rowidx, int nvalid,
                                           const float* B, const float* B2, int ldb, int M, int N, int K, int tile0, const Epi& epi) {
    constexpr int BM = 128, BN = 64, BK = 16, LA = BM + 4, LB = BN + 4;
    float* As = lds; float* Bs = As + BK * LA; float* Bs2 = Bs + BK * LB;
    const int tid = threadIdx.x, tx = tid & 15, ty = tid >> 4;
    const int G = gridDim.x, b = blockIdx.x;
    const int ntn = N / BN, ntiles = (M / BM) * ntn;
    int start = (int)(((long)b - (long)tile0) % G); if (start < 0) start += G;
    for (int tt = start; tt < ntiles; tt += G) {
        const int tm = tt / ntn, tn = tt % ntn, row0 = tm * BM, col0 = tn * BN;
        float acc[4][4], acc2[4][4];
#pragma unroll
        for (int i = 0; i < 4; ++i)
#pragma unroll
            for (int j = 0; j < 4; ++j) { acc[i][j] = 0.f; acc2[i][j] = 0.f; }
        const int ar = tid >> 2, ak = (tid & 3) * 4;
        int arow = row0 + ar; if (rowidx) { const int i = arow < nvalid ? arow : nvalid - 1; arow = rowidx[i]; }
        const TA* ap = A + (size_t)arow * lda + ak;
        const int bk = tid >> 5, bc = (tid & 31) * 2;
        const float* bp = B + (size_t)bk * ldb + col0 + bc;
        const float* bp2 = DUAL ? B2 + (size_t)bk * ldb + col0 + bc : nullptr;
        for (int k0 = 0; k0 < K; k0 += BK) {
            float av[4]; load4(ap + k0, av);
            const float2 bv = *(const float2*)(bp + (size_t)k0 * ldb);
            float2 bv2 = make_float2(0.f, 0.f); if (DUAL) bv2 = *(const float2*)(bp2 + (size_t)k0 * ldb);
            __syncthreads();
#pragma unroll
            for (int i = 0; i < 4; ++i) As[(ak + i) * LA + ar] = av[i];
            Bs[bk * LB + bc] = bv.x; Bs[bk * LB + bc + 1] = bv.y;
            if (DUAL) { Bs2[bk * LB + bc] = bv2.x; Bs2[bk * LB + bc + 1] = bv2.y; }
            __syncthreads();
#pragma unroll
            for (int kk = 0; kk < BK; ++kk) {
                const float4 a = *(const float4*)&As[kk * LA + ty * 4];
                const float4 bb = *(const float4*)&Bs[kk * LB + tx * 4];
                const float aa[4] = {a.x, a.y, a.z, a.w}, bq[4] = {bb.x, bb.y, bb.z, bb.w};
#pragma unroll
                for (int i = 0; i < 4; ++i)
#pragma unroll
                    for (int j = 0; j < 4; ++j) acc[i][j] += aa[i] * bq[j];
                if (DUAL) {
                    const float4 b2 = *(const float4*)&Bs2[kk * LB + tx * 4];
                    const float bq2[4] = {b2.x, b2.y, b2.z, b2.w};
#pragma unroll
                    for (int i = 0; i < 4; ++i)
#pragma unroll
                        for (int j = 0; j < 4; ++j) acc2[i][j] += aa[i] * bq2[j];
                }
            }
        }
#pragma unroll
        for (int i = 0; i < 4; ++i) epi(row0 + ty * 4 + i, col0 + tx * 4, acc[i], acc2[i]);
    }
    __syncthreads();
}

template <int LO, int HI>
__global__ void __launch_bounds__(NTHREADS, 2) mk(Params P) {
    extern __shared__ __attribute__((aligned(16))) unsigned char lds_raw[];
    float* ldsf = (float*)lds_raw;
    const int tid = threadIdx.x, lane = tid & 63, wave = tid >> 6;
    const int G = gridDim.x, bid = blockIdx.x;
    const int gw = bid * NWAVES + wave, NGW = G * NWAVES;
    unsigned char* ws = P.ws;
    float* rstd1 = (float*)(ws + WS_RSTD1); float* gates = (float*)(ws + WS_GATES);
    float* rstdg = (float*)(ws + WS_RSTDG); float* rstde = (float*)(ws + WS_RSTDE);
    int* eid = (int*)(ws + WS_EID); int* posn = (int*)(ws + WS_POS); float* gate = (float*)(ws + WS_GATE);
    float* mn = (float*)(ws + WS_MN); float* ml = (float*)(ws + WS_ML); float* mbl = (float*)(ws + WS_MBL); float* mm = (float*)(ws + WS_MM);
    int* list = (int*)(ws + WS_LIST); int* cnt = (int*)(ws + WS_CTL) + CW_CNT;
    bf16_t* proj = (bf16_t*)(ws + WS_PROJ); bf16_t* hbuf = (bf16_t*)(ws + WS_HBUF); bf16_t* ybuf = (bf16_t*)(ws + WS_YBUF); bf16_t* peb = (bf16_t*)(ws + WS_PEB);
    bf16_t* yreg = (bf16_t*)(ws + WS_YREG);
    float* out = P.out;
    float* rst = (float*)((unsigned char*)out + OUT_RST); float* mst = (float*)((unsigned char*)out + OUT_MST);
#define IN(k) (LO <= (k) && (k) < HI)

    if constexpr (IN(0)) {
        for (int row = gw; row < T; row += NGW) {
            const float4* xr = (const float4*)(P.x + (size_t)row * D) + lane;
            float4 v[4]; float ss = 0.f;
#pragma unroll
            for (int j = 0; j < 4; ++j) { v[j] = xr[64 * j]; ss += v[j].x * v[j].x + v[j].y * v[j].y + v[j].z * v[j].z + v[j].w * v[j].w; }
            ss = wave_sum(ss);
            const float rstd = 1.0f / sqrtf(ss * (1.0f / D) + EPS);
            float g8[8];
#pragma unroll
            for (int i = 0; i < 8; ++i) g8[i] = 0.f;
#pragma unroll
            for (int j = 0; j < 4; ++j) {
                const int k0 = 4 * (lane + 64 * j);
                const float4 nv = *(const float4*)(P.attn_norm + k0);
                float4 xn; xn.x = v[j].x * nv.x * rstd; xn.y = v[j].y * nv.y * rstd; xn.z = v[j].z * nv.z * rstd; xn.w = v[j].w * nv.w * rstd;
                ((float4*)(out + (size_t)row * D))[lane + 64 * j] = xn;
                const float xs[4] = {xn.x, xn.y, xn.z, xn.w};
#pragma unroll
                for (int i = 0; i < 4; ++i) {
                    const float4* wr = (const float4*)(P.w_in + (size_t)(k0 + i) * NPROJ + NP);
                    const float4 w0 = wr[0], w1 = wr[1];
                    g8[0] += xs[i] * w0.x; g8[1] += xs[i] * w0.y; g8[2] += xs[i] * w0.z; g8[3] += xs[i] * w0.w;
                    g8[4] += xs[i] * w1.x; g8[5] += xs[i] * w1.y; g8[6] += xs[i] * w1.z; g8[7] += xs[i] * w1.w;
                }
            }
#pragma unroll
            for (int i = 0; i < 8; ++i) g8[i] = wave_sum(g8[i]);
            if (lane == 0) {
                rstd1[row] = rstd;
#pragma unroll
                for (int i = 0; i < 8; ++i) gates[(size_t)row * 8 + i] = g8[i];
            }
        }
    }
    if constexpr (IN(1)) {
        auto epi = [&](int row, int col, const float (&v)[4], const float (&)[4]) {
            uint2 o; o.x = (unsigned)f2bf(v[0]) | ((unsigned)f2bf(v[1]) << 16); o.y = (unsigned)f2bf(v[2]) | ((unsigned)f2bf(v[3]) << 16);
            *(uint2*)(proj + (size_t)row * NP + col) = o;
        };
        gemm_naive<float, false>(ldsf, (const float*)out, D, nullptr, 0, P.w_in, nullptr, NPROJ, T, NP, D, 0, epi);
    }
    if constexpr (IN(2)) {
        const int nitems = BATCH * NCH * (RH + MH);
        for (int it = bid; it < nitems; it += G) {
            const int bn = it / (RH + MH), hh = it % (RH + MH), b = bn / NCH, n = bn % NCH;
            const size_t t0 = (size_t)b * SEQ + (size_t)n * CH;
            __syncthreads();
            if (hh < RH) {
                const int h = hh;
                float* kk = ldsf; float* vv = ldsf + CH * RD;
                const float lg = log1pf(-exp2f(-5.0f - (float)h));
                for (int idx = tid; idx < CH * 32; idx += NTHREADS) {
                    const int c = idx >> 5, j = idx & 31; const size_t t = t0 + c;
                    const float ang = (float)P.pos[t] * powf(10000.0f, -(float)j / 32.0f);
                    float sn, cs; sincosf(ang, &sn, &cs);
                    const float x1 = bf2f(proj[t * NP + C_RK + h * RD + j]), x2 = bf2f(proj[t * NP + C_RK + h * RD + 32 + j]);
                    const float wst = expf(lg * (float)(CH - 1 - c)) * 0.125f;
                    kk[c * RD + j] = (x1 * cs - x2 * sn) * wst; kk[c * RD + 32 + j] = (x1 * sn + x2 * cs) * wst;
                }
                for (int idx = tid; idx < CH * RD; idx += NTHREADS) { const int c = idx >> 6, e = idx & 63; vv[idx] = bf2f(proj[(t0 + c) * NP + C_RV + h * RD + e]); }
                __syncthreads();
                const int d = tid >> 3, e0 = (tid & 7) * 8;
                float acc[8];
#pragma unroll
                for (int i = 0; i < 8; ++i) acc[i] = 0.f;
                for (int c = 0; c < CH; ++c) { const float kv = kk[c * RD + d];
#pragma unroll
                    for (int i = 0; i < 8; ++i) acc[i] += kv * vv[c * RD + e0 + i]; }
                float* dst = rst + ((size_t)(bn * RH + h) * RD + d) * RD + e0;
#pragma unroll
                for (int i = 0; i < 8; ++i) dst[i] = acc[i];
            } else {
                const int h = hh - RH;
                float* kk = ldsf; float* sw = ldsf + CH * MD; float* sb = sw + CH;
                if (tid < CH) {
                    const size_t t = t0 + tid;
                    sw[tid] = gates[t * 8 + h] + P.b_ig[h];
                    sb[tid] = logsigmoidf_(gates[t * 8 + 4 + h] + P.b_fg[h]);
                }
                __syncthreads();
                if (tid == 0) { float run = 0.f; for (int c = 0; c < CH; ++c) { run += sb[c]; sb[c] = run; } }
                __syncthreads();
                const float bL = sb[CH - 1];
                float mloc = -INFINITY;
                for (int c = 0; c < CH; ++c) mloc = fmaxf(mloc, bL - sb[c] + sw[c]);
                __syncthreads();
                if (tid < CH) sw[tid] = expf(bL - sb[tid] + sw[tid] - mloc);
                for (int idx = tid; idx < CH * MD; idx += NTHREADS) {
                    const int c = idx >> 7, d = idx & 127; const int s = n * CH + c; const int chn = 512 + h * MD + d;
                    float a = P.conv_b[chn];
#pragma unroll
                    for (int w = 0; w < 4; ++w) { const int ss = s - 3 + w; if (ss >= 0) a += bf2f(proj[((size_t)b * SEQ + ss) * NP + C_MK + h * MD + d]) * P.conv_w[w * 1024 + chn]; }
                    kk[idx] = siluf_(a) * 0.08838834764831845f;
                }
                __syncthreads();
                const int d = tid >> 2, e0 = (tid & 3) * 32;
                float acc[32]; float nacc = 0.f;
#pragma unroll
                for (int i = 0; i < 32; ++i) acc[i] = 0.f;
                for (int c = 0; c < CH; ++c) {
                    const float kv = kk[c * MD + d] * sw[c]; nacc += kv;
                    const bf16_t* vp = proj + (t0 + c) * NP + C_MV + h * MD + e0;
#pragma unroll
                    for (int i = 0; i < 32; ++i) acc[i] += kv * bf2f(vp[i]);
                }
                const int sidx = bn * MH + h;
                float* dst = mst + ((size_t)sidx * MD + d) * MD + e0;
#pragma unroll
                for (int i = 0; i < 32; ++i) dst[i] = acc[i];
                if ((tid & 3) == 0) mn[(size_t)sidx * MD + d] = nacc;
                if (tid == 0) { ml[sidx] = mloc; mbl[sidx] = bL; }
            }
        }
    }
    if constexpr (IN(3)) {
        const long NT = (long)G * NTHREADS; const long NR = (long)BATCH * RH * RD * RD, NM = (long)BATCH * MH * MD * MD, NN = (long)BATCH * MH * MD;
        for (long idx = (long)bid * NTHREADS + tid; idx < NR + NM + NN; idx += NT) {
            if (idx < NR) {
                const int el = (int)(idx % (RD * RD)); const int bh = (int)(idx / (RD * RD)); const int b = bh / RH, h = bh % RH;
                const float dec = expf(log1pf(-exp2f(-5.0f - (float)h)) * (float)CH);
                float R = 0.f;
                for (int n = 0; n < NCH; ++n) { float* ptr = rst + ((size_t)((b * NCH + n) * RH + h)) * (RD * RD) + el; const float tmp = *ptr; *ptr = R; R = dec * R + tmp; }
            } else {
                const long j = idx - NR; const bool isn = j >= NM;
                const long jj = isn ? j - NM : j; const int per = isn ? MD : MD * MD;
                const int el = (int)(jj % per); const int bh = (int)(jj / per); const int b = bh / MH, h = bh % MH;
                float S = 0.f, m = 0.f;
                for (int n = 0; n < NCH; ++n) {
                    const int sidx = (b * NCH + n) * MH + h;
                    const float bL = mbl[sidx], mloc = ml[sidx];
                    const float mnew = fmaxf(bL + m, mloc);
                    const float dec = expf(bL + m - mnew), sc = expf(mloc - mnew);
                    float* ptr = isn ? mn + (size_t)sidx * MD + el : mst + (size_t)sidx * (MD * MD) + el;
                    const float tmp = *ptr; *ptr = S; S = dec * S + sc * tmp;
                    if (isn && el == 0) mm[sidx] = m;
                    m = mnew;
                }
            }
        }
    }
    if constexpr (IN(4)) {
        const int nitems = BATCH * NCH * (RH + MH);
        for (int it = bid; it < nitems; it += G) {
            const int bn = it / (RH + MH), hh = it % (RH + MH), b = bn / NCH, n = bn % NCH;
            const size_t t0 = (size_t)b * SEQ + (size_t)n * CH;
            __syncthreads();
            if (hh < RH) {
                const int h = hh;
                float* qq = ldsf; float* kk = qq + CH * RD; float* vv = kk + CH * RD; float* Rp = vv + CH * RD;
                const float lg = log1pf(-exp2f(-5.0f - (float)h));
                for (int idx = tid; idx < CH * 32; idx += NTHREADS) {
                    const int c = idx >> 5, j = idx & 31; const size_t t = t0 + c;
                    const float ang = (float)P.pos[t] * powf(10000.0f, -(float)j / 32.0f);
                    float sn, cs; sincosf(ang, &sn, &cs);
                    float x1 = bf2f(proj[t * NP + C_RK + h * RD + j]), x2 = bf2f(proj[t * NP + C_RK + h * RD + 32 + j]);
                    kk[c * RD + j] = (x1 * cs - x2 * sn) * 0.125f; kk[c * RD + 32 + j] = (x1 * sn + x2 * cs) * 0.125f;
                    x1 = bf2f(proj[t * NP + C_RQ + h * RD + j]); x2 = bf2f(proj[t * NP + C_RQ + h * RD + 32 + j]);
                    qq[c * RD + j] = (x1 * cs - x2 * sn); qq[c * RD + 32 + j] = (x1 * sn + x2 * cs);
                }
                for (int idx = tid; idx < CH * RD; idx += NTHREADS) { const int c = idx >> 6, e = idx & 63; vv[idx] = bf2f(proj[(t0 + c) * NP + C_RV + h * RD + e]); }
                for (int idx = tid; idx < RD * RD; idx += NTHREADS) Rp[idx] = rst[(size_t)(bn * RH + h) * (RD * RD) + idx];
                __syncthreads();
                const int c = tid >> 2, e0 = (tid & 3) * 16;
                float acc[16];
#pragma unroll
                for (int i = 0; i < 16; ++i) acc[i] = 0.f;
                for (int j = 0; j <= c; ++j) {
                    float s = 0.f;
                    for (int d = 0; d < RD; ++d) s += qq[c * RD + d] * kk[j * RD + d];
                    s *= expf(lg * (float)(c - j));
#pragma unroll
                    for (int i = 0; i < 16; ++i) acc[i] += s * vv[j * RD + e0 + i];
                }
                const float wq = expf(lg * (float)(c + 1));
                for (int d = 0; d < RD; ++d) { const float qv = qq[c * RD + d] * wq;
#pragma unroll
                    for (int i = 0; i < 16; ++i) acc[i] += qv * Rp[d * RD + e0 + i]; }
                float ss = 0.f;
#pragma unroll
                for (int i = 0; i < 16; ++i) ss += acc[i] * acc[i];
                ss += __shfl_xor(ss, 1); ss += __shfl_xor(ss, 2);
                const float rn = 1.0f / sqrtf(ss * (1.0f / RD) + EPS);
                const size_t t = t0 + c;
#pragma unroll
                for (int i = 0; i < 16; ++i) {
                    const int e = e0 + i; const float g = bf2f(proj[t * NP + C_RG + h * RD + e]);
                    yreg[t * D + h * RD + e] = f2bf(siluf_(g) * acc[i] * rn * P.ret_gn[h * RD + e]);
                }
            } else {
                const int h = hh - RH; const int sidx = bn * MH + h;
                float* qq = ldsf; float* kk = qq + CH * MD; float* sb = kk + CH * MD; float* sg = sb + CH; float* spm = sg + CH;
                if (tid < CH) {
                    const size_t t = t0 + tid;
                    sg[tid] = gates[t * 8 + h] + P.b_ig[h];
                    sb[tid] = logsigmoidf_(gates[t * 8 + 4 + h] + P.b_fg[h]);
                }
                __syncthreads();
                if (tid == 0) { float run = 0.f, pm = -INFINITY; for (int c = 0; c < CH; ++c) { run += sb[c]; sb[c] = run; const float g = sg[c] - run; sg[c] = g; pm = fmaxf(pm, g); spm[c] = pm; } }
                for (int idx = tid; idx < CH * MD; idx += NTHREADS) {
                    const int c = idx >> 7, d = idx & 127; const int s = n * CH + c;
                    float aq = P.conv_b[h * MD + d], ak = P.conv_b[512 + h * MD + d];
#pragma unroll
                    for (int w = 0; w < 4; ++w) { const int ss = s - 3 + w; if (ss >= 0) { const size_t tt = (size_t)b * SEQ + ss;
                        aq += bf2f(proj[tt * NP + C_MQ + h * MD + d]) * P.conv_w[w * 1024 + h * MD + d];
                        ak += bf2f(proj[tt * NP + C_MK + h * MD + d]) * P.conv_w[w * 1024 + 512 + h * MD + d]; } }
                    qq[idx] = siluf_(aq); kk[idx] = siluf_(ak) * 0.08838834764831845f;
                }
                __syncthreads();
                const float mprev = mm[sidx];
                const int c = tid >> 2, e0 = (tid & 3) * 32;
                const float bc = sb[c], mrow = bc + fmaxf(spm[c], mprev);
                float acc[32]; float den = 0.f;
#pragma unroll
                for (int i = 0; i < 32; ++i) acc[i] = 0.f;
                for (int j = 0; j <= c; ++j) {
                    float s = 0.f;
                    for (int d = 0; d < MD; ++d) s += qq[c * MD + d] * kk[j * MD + d];
                    const float pj = expf(bc + sg[j] - mrow) * s; den += pj;
                    const bf16_t* vp = proj + (t0 + j) * NP + C_MV + h * MD + e0;
#pragma unroll
                    for (int i = 0; i < 32; ++i) acc[i] += pj * bf2f(vp[i]);
                }
                const float wi = expf(bc + mprev - mrow);
                const float* Sp = mst + (size_t)sidx * (MD * MD); const float* np_ = mn + (size_t)sidx * MD;
                for (int d = 0; d < MD; ++d) { const float qv = qq[c * MD + d] * wi; den += qv * np_[d];
#pragma unroll
                    for (int i = 0; i < 32; ++i) acc[i] += qv * Sp[d * MD + e0 + i]; }
                const float dn = fmaxf(fabsf(den), expf(-mrow));
                const size_t t = t0 + c; float ss = 0.f;
#pragma unroll
                for (int i = 0; i < 32; ++i) { const float o = bf2f(proj[t * NP + C_MO + h * MD + e0 + i]); acc[i] = sigmoidf_(o) * acc[i] / dn; ss += acc[i] * acc[i]; }
                ss += __shfl_xor(ss, 1); ss += __shfl_xor(ss, 2);
                const float rn = 1.0f / sqrtf(ss * (1.0f / MD) + EPS);
#pragma unroll
                for (int i = 0; i < 32; ++i) yreg[t * D + 512 + h * MD + e0 + i] = f2bf(acc[i] * rn * P.ml_gn[h * MD + e0 + i]);
            }
        }
    }
    if constexpr (IN(5)) {
        auto epi = [&](int row, int col, const float (&v)[4], const float (&)[4]) {
            const float4 xv = *(const float4*)(P.x + (size_t)row * D + col);
            float4 o; o.x = xv.x + v[0]; o.y = xv.y + v[1]; o.z = xv.z + v[2]; o.w = xv.w + v[3];
            *(float4*)(out + (size_t)row * D + col) = o;
        };
        gemm_naive<bf16_t, false>(ldsf, yreg, D, nullptr, 0, P.w_out, nullptr, D, T, D, D, 0, epi);
    }
    if constexpr (IN(6)) {
        for (int row = gw; row < T; row += NGW) {
            const float4* hr = (const float4*)(out + (size_t)row * D) + lane;
            float4 v[4]; float ss = 0.f;
#pragma unroll
            for (int j = 0; j < 4; ++j) { v[j] = hr[64 * j]; ss += v[j].x * v[j].x + v[j].y * v[j].y + v[j].z * v[j].z + v[j].w * v[j].w; }
            ss = wave_sum(ss);
            const float rstd = 1.0f / sqrtf(ss * (1.0f / D) + EPS);
            float lg[36];
#pragma unroll
            for (int i = 0; i < 36; ++i) lg[i] = 0.f;
#pragma unroll
            for (int j = 0; j < 4; ++j) {
                const int k0 = 4 * (lane + 64 * j);
                const float4 nv = *(const float4*)(P.moe_norm + k0);
                const float xs[4] = {v[j].x * nv.x * rstd, v[j].y * nv.y * rstd, v[j].z * nv.z * rstd, v[j].w * nv.w * rstd};
                uint2 o; o.x = (unsigned)f2bf(xs[0]) | ((unsigned)f2bf(xs[1]) << 16); o.y = (unsigned)f2bf(xs[2]) | ((unsigned)f2bf(xs[3]) << 16);
                *(uint2*)(yreg + (size_t)row * D + k0) = o;
#pragma unroll
                for (int i = 0; i < 4; ++i) {
                    const float4 wg = *(const float4*)(P.w_group + (size_t)(k0 + i) * 4);
                    lg[0] += xs[i] * wg.x; lg[1] += xs[i] * wg.y; lg[2] += xs[i] * wg.z; lg[3] += xs[i] * wg.w;
                    const float4* wr = (const float4*)(P.w_router + (size_t)(k0 + i) * 32);
#pragma unroll
                    for (int q = 0; q < 8; ++q) { const float4 w = wr[q]; lg[4 + 4 * q] += xs[i] * w.x; lg[5 + 4 * q] += xs[i] * w.y; lg[6 + 4 * q] += xs[i] * w.z; lg[7 + 4 * q] += xs[i] * w.w; }
                }
            }
#pragma unroll
            for (int i = 0; i < 36; ++i) lg[i] = wave_sum(lg[i]);
            float gl[4];
#pragma unroll
            for (int i = 0; i < 4; ++i) gl[i] = lg[i] + P.b_group[i];
            int gs = 0; float gmax = gl[0];
#pragma unroll
            for (int i = 1; i < 4; ++i) if (gl[i] > gmax) { gmax = gl[i]; gs = i; }
            float gsum = 0.f;
#pragma unroll
            for (int i = 0; i < 4; ++i) gsum += expf(gl[i] - gmax);
            const float pg = 1.0f / gsum;
            float el[8];
#pragma unroll
            for (int i = 0; i < 8; ++i) {
                float a = lg[4 + i] + P.b_router[i];
                if (gs == 1) a = lg[12 + i] + P.b_router[8 + i];
                if (gs == 2) a = lg[20 + i] + P.b_router[16 + i];
                if (gs == 3) a = lg[28 + i] + P.b_router[24 + i];
                el[i] = a;
            }
            int i0 = 0; float l0 = el[0];
#pragma unroll
            for (int i = 1; i < 8; ++i) if (el[i] > l0) { l0 = el[i]; i0 = i; }
            int i1 = -1; float l1 = -INFINITY;
#pragma unroll
            for (int i = 0; i < 8; ++i) if (i != i0 && el[i] > l1) { l1 = el[i]; i1 = i; }
            const float r = expf(l1 - l0);
            const float g0 = pg / (1.0f + r), g1 = pg * r / (1.0f + r);
            if (lane == 0) {
                const int e0 = gs * 8 + i0, e1 = gs * 8 + i1;
                const int p0 = atomicAdd(&cnt[e0], 1), p1 = atomicAdd(&cnt[e1], 1);
                list[(size_t)e0 * T + p0] = row; list[(size_t)e1 * T + p1] = row;
                eid[row * 2] = e0; eid[row * 2 + 1] = e1; posn[row * 2] = p0; posn[row * 2 + 1] = p1;
                gate[row * 2] = g0; gate[row * 2 + 1] = g1;
            }
        }
    }
    int* s_off = (int*)(lds_raw + LDS_BYTES - 512); int* s_cnt = s_off + 40;
    if constexpr (IN(7) || IN(8) || IN(9)) {
        __syncthreads();
        if (tid == 0) { int o = 0; for (int e = 0; e < NE; ++e) { const int c = cnt[e]; s_cnt[e] = c; s_off[e] = o; o += (c + 255) & ~255; } s_off[NE] = o; }
        __syncthreads();
    }
    if constexpr (IN(7)) {
        int tile0 = 0;
        for (int e = 0; e < NE; ++e) {
            const int c = s_cnt[e]; if (c == 0) continue;
            const int Mp = (c + 255) & ~255; const int off = s_off[e];
            auto epi = [&](int row, int col, const float (&v)[4], const float (&v2)[4]) {
                uint2 o; o.x = (unsigned)f2bf(siluf_(v[0]) * v2[0]) | ((unsigned)f2bf(siluf_(v[1]) * v2[1]) << 16);
                o.y = (unsigned)f2bf(siluf_(v[2]) * v2[2]) | ((unsigned)f2bf(siluf_(v[3]) * v2[3]) << 16);
                *(uint2*)(hbuf + (size_t)(off + row) * DE + col) = o;
            };
            gemm_naive<bf16_t, true>(ldsf, yreg, D, list + (size_t)e * T, c, P.w1 + (size_t)e * D * DE, P.w3 + (size_t)e * D * DE, DE, Mp, DE, D, tile0, epi);
            tile0 += (Mp / 128) * (DE / 64);
        }
    }
    if constexpr (IN(8)) {
        int tile0 = 0;
        for (int e = 0; e < NE; ++e) {
            const int c = s_cnt[e]; if (c == 0) continue;
            const int Mp = (c + 255) & ~255; const int off = s_off[e];
            auto epi = [&](int row, int col, const float (&v)[4], const float (&)[4]) {
                uint2 o; o.x = (unsigned)f2bf(v[0]) | ((unsigned)f2bf(v[1]) << 16); o.y = (unsigned)f2bf(v[2]) | ((unsigned)f2bf(v[3]) << 16);
                *(uint2*)(ybuf + (size_t)(off + row) * D + col) = o;
            };
            gemm_naive<bf16_t, false>(ldsf, hbuf + (size_t)off * DE, DE, nullptr, 0, P.w2 + (size_t)e * DE * D, nullptr, D, Mp, D, DE, tile0, epi);
            tile0 += (Mp / 128) * (D / 64);
        }
    }
    if constexpr (IN(9)) {
        for (int row = gw; row < T; row += NGW) {
            const int s0 = s_off[eid[row * 2]] + posn[row * 2], s1 = s_off[eid[row * 2 + 1]] + posn[row * 2 + 1];
            const float g0 = gate[row * 2], g1 = gate[row * 2 + 1];
            float ss = 0.f;
#pragma unroll
            for (int j = 0; j < 4; ++j) {
                const int k0 = 4 * (lane + 64 * j);
                float4 hv = *(const float4*)(out + (size_t)row * D + k0);
                float y0[4], y1[4]; load4(ybuf + (size_t)s0 * D + k0, y0); load4(ybuf + (size_t)s1 * D + k0, y1);
                hv.x += g0 * y0[0] + g1 * y1[0]; hv.y += g0 * y0[1] + g1 * y1[1]; hv.z += g0 * y0[2] + g1 * y1[2]; hv.w += g0 * y0[3] + g1 * y1[3];
                *(float4*)(out + (size_t)row * D + k0) = hv;
                ss += hv.x * hv.x + hv.y * hv.y + hv.z * hv.z + hv.w * hv.w;
                const float4 nv = *(const float4*)(P.pg_norm + k0);
                uint2 o; o.x = (unsigned)f2bf(hv.x * nv.x) | ((unsigned)f2bf(hv.y * nv.y) << 16); o.y = (unsigned)f2bf(hv.z * nv.z) | ((unsigned)f2bf(hv.w * nv.w) << 16);
                *(uint2*)(yreg + (size_t)row * D + k0) = o;
            }
            ss = wave_sum(ss);
            if (lane == 0) rstdg[row] = 1.0f / sqrtf(ss * (1.0f / D) + EPS);
        }
    }
    if constexpr (IN(10)) {
        auto epi = [&](int row, int col, const float (&v)[4], const float (&)[4]) {
            uint2 o; o.x = (unsigned)f2bf(v[0]) | ((unsigned)f2bf(v[1]) << 16); o.y = (unsigned)f2bf(v[2]) | ((unsigned)f2bf(v[3]) << 16);
            *(uint2*)(peb + (size_t)row * D + col) = o;
        };
        gemm_naive<float, false>(ldsf, P.p, PLE, nullptr, 0, P.w_up, nullptr, D, T, D, PLE, 0, epi);
    }
    if constexpr (IN(11)) {
        for (int row = gw; row < T; row += NGW) {
            float ss = 0.f;
#pragma unroll
            for (int j = 0; j < 4; ++j) { float y[4]; load4(peb + (size_t)row * D + 4 * (lane + 64 * j), y); ss += y[0] * y[0] + y[1] * y[1] + y[2] * y[2] + y[3] * y[3]; }
            ss = wave_sum(ss);
            if (lane == 0) rstde[row] = 1.0f / sqrtf(ss * (1.0f / D) + EPS);
        }
    }
    if constexpr (IN(12)) {
        auto epi = [&](int row, int col, const float (&v)[4], const float (&)[4]) {
            const float rg = rstdg[row], re = rstde[row];
            float pe[4]; load4(peb + (size_t)row * D + col, pe);
            const float4 pn = *(const float4*)(P.ple_norm + col);
            float4 hv = *(const float4*)(out + (size_t)row * D + col);
            hv.x += sigmoidf_(rg * v[0]) * (pe[0] * re * pn.x); hv.y += sigmoidf_(rg * v[1]) * (pe[1] * re * pn.y);
            hv.z += sigmoidf_(rg * v[2]) * (pe[2] * re * pn.z); hv.w += sigmoidf_(rg * v[3]) * (pe[3] * re * pn.w);
            *(float4*)(out + (size_t)row * D + col) = hv;
        };
        gemm_naive<bf16_t, false>(ldsf, yreg, D, nullptr, 0, P.w_gate, nullptr, D, T, D, D, 0, epi);
    }
    if constexpr (IN(13)) {
        for (int row = gw; row < T; row += NGW) {
            float4* hr = (float4*)(out + (size_t)row * D) + lane;
            float4 v[4]; float ss = 0.f;
#pragma unroll
            for (int j = 0; j < 4; ++j) { v[j] = hr[64 * j]; ss += v[j].x * v[j].x + v[j].y * v[j].y + v[j].z * v[j].z + v[j].w * v[j].w; }
            ss = wave_sum(ss);
            const float rstd = 1.0f / sqrtf(ss * (1.0f / D) + EPS);
#pragma unroll
            for (int j = 0; j < 4; ++j) {
                const float4 nv = *(const float4*)(P.final_norm + 4 * (lane + 64 * j));
                float4 o; o.x = v[j].x * rstd * nv.x; o.y = v[j].y * rstd * nv.y; o.z = v[j].z * rstd * nv.z; o.w = v[j].w * rstd * nv.w;
                hr[64 * j] = o;
            }
        }
    }
#undef IN
}

constexpr int NPHASES = 14;

template <int PH> static void launch_one(int grid, const Params& p, hipStream_t stream) {
    static bool attr_done = false;
    if (!attr_done) { (void)hipFuncSetAttribute((const void*)mk<PH, PH + 1>, hipFuncAttributeMaxDynamicSharedMemorySize, LDS_BYTES); attr_done = true; }
    hipLaunchKernelGGL((mk<PH, PH + 1>), dim3(grid), dim3(NTHREADS), LDS_BYTES, stream, p);
}
template <int PH> static void launch_all(int grid, const Params& p, hipStream_t stream) {
    if constexpr (PH < NPHASES) { launch_one<PH>(grid, p, stream); launch_all<PH + 1>(grid, p, stream); }
}

extern "C" void kernel_launch(void* const* d_in, const int* in_sizes, int n_in, void* d_out, int out_size, void* d_ws, size_t ws_size, hipStream_t stream) {
    static int grid = 0;
    if (grid == 0) {
        if (n_in != 25 || in_sizes[0] != T * D || out_size != T * D || ws_size < WS_END) {
            fprintf(stderr, "kernel_launch: unexpected shapes: n_in %d in0 %d out %d ws %zu\n", n_in, n_in > 0 ? in_sizes[0] : -1, out_size, ws_size); grid = -1; return; }
        int dev = 0, cus = 0;
        hipGetDevice(&dev); hipDeviceGetAttribute(&cus, hipDeviceAttributeMultiprocessorCount, dev);
        (void)hipGetLastError();
        grid = cus;
    }
    if (grid < 0) return;
    hipMemsetAsync((char*)d_ws + WS_CTL, 0, 1 * MiB, stream);
    Params p{};
    p.x = (const float*)d_in[0]; p.p = (const float*)d_in[1]; p.pos = (const int*)d_in[2];
    p.attn_norm = (const float*)d_in[3]; p.w_in = (const float*)d_in[4]; p.conv_w = (const float*)d_in[5]; p.conv_b = (const float*)d_in[6];
    p.b_ig = (const float*)d_in[7]; p.b_fg = (const float*)d_in[8]; p.ret_gn = (const float*)d_in[9]; p.ml_gn = (const float*)d_in[10];
    p.w_out = (const float*)d_in[11]; p.moe_norm = (const float*)d_in[12]; p.w_group = (const float*)d_in[13]; p.b_group = (const float*)d_in[14];
    p.w_router = (const float*)d_in[15]; p.b_router = (const float*)d_in[16]; p.w1 = (const float*)d_in[17]; p.w3 = (const float*)d_in[18]; p.w2 = (const float*)d_in[19];
    p.w_up = (const float*)d_in[20]; p.ple_norm = (const float*)d_in[21]; p.pg_norm = (const float*)d_in[22]; p.w_gate = (const float*)d_in[23]; p.final_norm = (const float*)d_in[24];
    p.out = (float*)d_out; p.ws = (unsigned char*)d_ws;
    launch_all<0>(grid, p, stream);
}
```

```cpp
#include <hip/hip_runtime.h>
#include <cstdio>
#include <cstdint>

constexpr int D = 1024, BATCH = 4, SEQ = 8192, T = BATCH * SEQ, PLE = 256;
constexpr int NPROJ = 4104, NP = 4096;
constexpr int CH = 128, NCH = SEQ / CH;
constexpr int RH = 8, RD = 64, MH = 4, MD = 128;
constexpr int NE = 32, DE = 512;
constexpr float EPS = 1e-6f;
constexpr int C_RQ = 0, C_RK = 512, C_RV = 1024, C_RG = 1536, C_MQ = 2048, C_MK = 2560, C_MV = 3072, C_MO = 3584;

constexpr size_t MiB = 1u << 20;
constexpr size_t WS_CTL = 0;
constexpr size_t WS_RSTD1 = 1 * MiB;
constexpr size_t WS_GATES = WS_RSTD1 + 256 * 1024;
constexpr size_t WS_RSTDG = 3 * MiB;
constexpr size_t WS_RSTDE = WS_RSTDG + 256 * 1024;
constexpr size_t WS_EID = 4 * MiB;
constexpr size_t WS_POS = WS_EID + 256 * 1024;
constexpr size_t WS_GATE = WS_POS + 256 * 1024;
constexpr size_t WS_MN = 5 * MiB;
constexpr size_t WS_ML = WS_MN + 512 * 1024;
constexpr size_t WS_MBL = WS_ML + 4096;
constexpr size_t WS_MM = WS_MBL + 4096;
constexpr size_t WS_LIST = 8 * MiB;
constexpr size_t WS_PART = 12 * MiB;
constexpr size_t WS_PART2 = 14 * MiB;
constexpr size_t WS_WIN = 16 * MiB;
constexpr size_t WS_WOUT = 24 * MiB;
constexpr size_t WS_W13 = 26 * MiB;
constexpr size_t WS_W2 = 90 * MiB;
constexpr size_t WS_WGATE = 122 * MiB;
constexpr size_t WS_WUP = 124 * MiB;
constexpr size_t WS_PROJ = 128 * MiB;
constexpr size_t WS_HBUF = 128 * MiB;
constexpr size_t WS_XS = 200 * MiB;
constexpr size_t WS_YBUF = 200 * MiB;
constexpr size_t WS_PEB = 128 * MiB;
constexpr size_t WS_YREG = 384 * MiB;
constexpr size_t WS_PB = 448 * MiB;
constexpr size_t WS_END = 464 * MiB;
constexpr size_t OUT_RST = 0;
constexpr size_t OUT_MST = 32 * MiB;
constexpr int CW_CNT = 64;
constexpr int CW_BAR = 4096;

constexpr int NTHREADS = 512, NWAVES = 8;
constexpr int RING_BYTES = 131072;
constexpr int LDSX_OFF = RING_BYTES;
constexpr int LDS_BYTES = 147456;

#define GAS __attribute__((address_space(1)))
#define LAS __attribute__((address_space(3)))
typedef unsigned short bf16_t;
typedef unsigned v4u __attribute__((ext_vector_type(4)));
__device__ __forceinline__ float bf2f(bf16_t h) { return __uint_as_float((unsigned)h << 16); }
__device__ __forceinline__ unsigned f2bf(float f) { unsigned u = __float_as_uint(f); return (u + 0x7fffu + ((u >> 16) & 1u)) >> 16; }
__device__ __forceinline__ unsigned pk2(float lo, float hi) { return f2bf(lo) | (f2bf(hi) << 16); }
__device__ __forceinline__ float wave_sum(float v) {
#pragma unroll
    for (int o = 1; o < 64; o <<= 1) v += __shfl_xor(v, o);
    return v;
}
__device__ __forceinline__ float sigmoidf_(float x) { return 1.0f / (1.0f + expf(-x)); }
__device__ __forceinline__ float siluf_(float x) { return x / (1.0f + expf(-x)); }
__device__ __forceinline__ float logsigmoidf_(float x) { return x >= 0.f ? -log1pf(expf(-x)) : x - log1pf(expf(x)); }
#define LDS_WAIT() asm volatile("s_waitcnt lgkmcnt(0)" ::: "memory")

namespace pg8 {
#define PG8_LAS __attribute__((address_space(3)))
typedef unsigned short bf16_t;
typedef short bf16x8 __attribute__((ext_vector_type(8)));
typedef float f32x4 __attribute__((ext_vector_type(4)));
typedef unsigned u32x4 __attribute__((ext_vector_type(4)));
constexpr int BM = 256, BK = 64, HALF = 128, HTB = HALF * BK * 2  , STAGE_BYTES = 8 * HTB, NXCD = 8, WGM = 8;

__host__ __device__ __forceinline__ int lds_byte(int r, int c) { const int st = (r >> 4) * 2 + (c >> 5), rr = r & 15, cc = c & 31, ob = rr * 64 + cc * 2; return st * 1024 + (ob ^ (((ob >> 9) & 1) << 5)); }
__host__ __device__ __forceinline__ void stage_rc(int b, int& R, int& C) { const int st = b / 1024, sb = b % 1024, swz = sb ^ (((sb >> 9) & 1) << 5); R = (st >> 1) * 16 + swz / 64; C = (st & 1) * 32 + (swz % 64) / 2; }
__host__ __device__ __forceinline__ int perm32(int rho) { const int n = rho >> 4, i = rho & 15; return 8 * (i >> 2) + 4 * n + (i & 3); }

struct Unit { int pm, pn; };
struct Gemm { const bf16_t* A; const bf16_t* Bt; int M, N, K; };

struct StaticOrder {
    int nM, nN, nwg, G, c;
    __host__ __device__ void init(int M, int N, int G_, int c_) { nM = M / BM; nN = N / BM; nwg = nM * nN; G = G_; c = c_; }
    __host__ __device__ bool next(int i, Unit& u) const {
        const long L = (long)i * G + c; if (L >= nwg) return false;
        int wgid = (int)L; { const int q = nwg / NXCD, r = nwg % NXCD, xcd = wgid % NXCD, off = wgid / NXCD; wgid = (xcd < r ? xcd * (q + 1) : r * (q + 1) + (xcd - r) * q) + off; }
        const int nig = WGM * nN, gid = wgid / nig, fm = gid * WGM, gsz = (nM - fm) < WGM ? (nM - fm) : WGM;
        u.pm = fm + ((wgid % nig) % gsz); u.pn = (wgid % nig) / gsz; return true;
    }
    __device__ __forceinline__ void a_ready(const Unit&) const {}
    __device__ __forceinline__ void done(const Unit&) const {}
};

__device__ __forceinline__ unsigned cvt_pk_bf16(float lo, float hi) { unsigned r; asm volatile("v_cvt_pk_bf16_f32 %0, %1, %2" : "=v"(r) : "v"(lo), "v"(hi)); return r; }
typedef float f32x2 __attribute__((ext_vector_type(2)));
struct GroupedOrder {
    int nM, nwg, G, c; const PG8_LAS int* t2e;
    __device__ void init(int nM_, int G_, int c_, const PG8_LAS int* t2e_) { nM = nM_; nwg = nM_ * 4; G = G_; c = c_; t2e = t2e_; }
    __device__ bool next(int i, Unit& u) const {
        const long L = (long)i * G + c; if (L >= nwg) return false;
        int wgid = (int)L; { const int q = nwg / NXCD, r = nwg % NXCD, xcd = wgid % NXCD, off = wgid / NXCD; wgid = (xcd < r ? xcd * (q + 1) : r * (q + 1) + (xcd - r) * q) + off; }
        const int nig = WGM * 4, gid = wgid / nig, fm = gid * WGM, gsz = (nM - fm) < WGM ? (nM - fm) : WGM;
        u.pm = fm + ((wgid % nig) % gsz); u.pn = (wgid % nig) / gsz + 4 * t2e[u.pm]; return true;
    }
    __device__ __forceinline__ void a_ready(const Unit&) const {}
    __device__ __forceinline__ void done(const Unit&) const {}
};
__device__ __forceinline__ float fast_sigmoid(float x) { return __builtin_amdgcn_rcpf(1.0f + __builtin_amdgcn_exp2f(-1.4426950408889634f * x)); }
struct EpiStoreBf16 {
    static constexpr bool PERM = true, AFTER_DRAIN = false;
    bf16_t* O; int ldc; int pn_mask; float* part;
    __device__ __forceinline__ void operator()(const f32x4 (&acc)[2][2][4][2], const Unit& u, int wr, int wc, int fr, int fq) const {
        const int pnl = u.pn & pn_mask; const int row0 = u.pm * BM + wr * 64 + fr, col0 = pnl * BM + wc * 32 + 8 * fq;
#pragma unroll
        for (int ai = 0; ai < 2; ++ai)
#pragma unroll
            for (int m = 0; m < 4; ++m) { const int row = row0 + ai * HALF + m * 16; bf16_t* rowp = O + (size_t)row * ldc + col0; float s = 0.f;
#pragma unroll
                for (int bj = 0; bj < 2; ++bj) { const f32x4 v0 = acc[ai][bj][m][0], v1 = acc[ai][bj][m][1];
                    u32x4 w; w.x = cvt_pk_bf16(v0[0], v0[1]); w.y = cvt_pk_bf16(v0[2], v0[3]); w.z = cvt_pk_bf16(v1[0], v1[1]); w.w = cvt_pk_bf16(v1[2], v1[3]);
                    *(u32x4*)(rowp + bj * HALF) = w;
                    s += (v0[0] * v0[0] + v0[1] * v0[1]) + (v0[2] * v0[2] + v0[3] * v0[3]) + (v1[0] * v1[0] + v1[1] * v1[1]) + (v1[2] * v1[2] + v1[3] * v1[3]); }
                if (part) { s += __shfl_xor(s, 16); s += __shfl_xor(s, 32); if (fq == 0) part[(size_t)row * 16 + pnl * 4 + wc] = s; } }
    }
};
struct EpiSwiglu {
    static constexpr bool PERM = true, AFTER_DRAIN = false;
    bf16_t* H;
    __device__ __forceinline__ void operator()(const f32x4 (&acc)[2][2][4][2], const Unit& u, int wr, int wc, int fr, int fq) const {
        const int pnl = u.pn & 3; const int row0 = u.pm * BM + wr * 64 + fr, col0 = pnl * HALF + wc * 32 + 8 * fq;
#pragma unroll
        for (int ai = 0; ai < 2; ++ai)
#pragma unroll
            for (int m = 0; m < 4; ++m) { bf16_t* rowp = H + (size_t)(row0 + ai * HALF + m * 16) * 512 + col0;
                f32x4 h[2];
#pragma unroll
                for (int n = 0; n < 2; ++n) { const f32x4 a = acc[ai][0][m][n], b = acc[ai][1][m][n];
#pragma unroll
                    for (int j = 0; j < 4; ++j) h[n][j] = a[j] * fast_sigmoid(a[j]) * b[j]; }
                u32x4 w; w.x = cvt_pk_bf16(h[0][0], h[0][1]); w.y = cvt_pk_bf16(h[0][2], h[0][3]); w.z = cvt_pk_bf16(h[1][0], h[1][1]); w.w = cvt_pk_bf16(h[1][2], h[1][3]);
                *(u32x4*)rowp = w; }
    }
};
struct EpiRes {
    static constexpr bool PERM = false, AFTER_DRAIN = false;
    const float* base; float* out;
    __device__ __forceinline__ void operator()(const f32x4 (&acc)[2][2][4][2], const Unit& u, int wr, int wc, int fr, int fq) const {
        const int row0 = u.pm * BM + wr * 64 + fr, col0 = u.pn * BM + wc * 32 + 4 * fq;
#pragma unroll
        for (int ai = 0; ai < 2; ++ai)
#pragma unroll
            for (int m = 0; m < 4; ++m) { const size_t off = (size_t)(row0 + ai * HALF + m * 16) * 1024 + col0;
#pragma unroll
                for (int bj = 0; bj < 2; ++bj)
#pragma unroll
                    for (int n = 0; n < 2; ++n) { const f32x4 bs = *(const f32x4*)(base + off + bj * HALF + n * 16); *(f32x4*)(out + off + bj * HALF + n * 16) = bs + acc[ai][bj][m][n]; }
                asm volatile("" ::: "memory"); }
    }
};
struct EpiGate {
    static constexpr bool PERM = false, AFTER_DRAIN = false;
    float* out; const bf16_t* peb; const float* rstdg; const float* rstde; const float* ple_norm; float* part;
    __device__ __forceinline__ void operator()(const f32x4 (&acc)[2][2][4][2], const Unit& u, int wr, int wc, int fr, int fq) const {
        const int row0 = u.pm * BM + wr * 64 + fr, col0 = u.pn * BM + wc * 32 + 4 * fq;
        f32x4 pn4[2][2];
#pragma unroll
        for (int bj = 0; bj < 2; ++bj)
#pragma unroll
            for (int n = 0; n < 2; ++n) pn4[bj][n] = *(const f32x4*)(ple_norm + col0 + bj * HALF + n * 16);
#pragma unroll
        for (int ai = 0; ai < 2; ++ai)
#pragma unroll
            for (int m = 0; m < 4; ++m) { const int row = row0 + ai * HALF + m * 16; const size_t off = (size_t)row * 1024 + col0; const float rg = rstdg[row], re = rstde[row]; float s = 0.f;
#pragma unroll
                for (int bj = 0; bj < 2; ++bj)
#pragma unroll
                    for (int n = 0; n < 2; ++n) { const size_t o = off + bj * HALF + n * 16;
                        const uint2 pe = *(const uint2*)(peb + o); f32x4 h = *(const f32x4*)(out + o); const f32x4 a = acc[ai][bj][m][n];
                        f32x4 e; e[0] = __uint_as_float(pe.x << 16); e[1] = __uint_as_float(pe.x & 0xffff0000u); e[2] = __uint_as_float(pe.y << 16); e[3] = __uint_as_float(pe.y & 0xffff0000u);
#pragma unroll
                        for (int j = 0; j < 4; ++j) { h[j] += fast_sigmoid(rg * a[j]) * (e[j] * re * pn4[bj][n][j]); s += h[j] * h[j]; }
                        *(f32x4*)(out + o) = h; }
                s += __shfl_xor(s, 16); s += __shfl_xor(s, 32); if (fq == 0) part[(size_t)row * 16 + u.pn * 4 + wc] = s;
                asm volatile("" ::: "memory"); }
    }
};

template <class Epi, class Sched, bool ALIGN_EPI = false, bool SP2 = false>
__device__ __forceinline__ void gemm_phase(PG8_LAS unsigned char* lds, const Gemm g, const Sched& S, const Epi& E) {
    const int tid = threadIdx.x, wid = __builtin_amdgcn_readfirstlane(tid >> 6), lane = tid & 63, wr = wid >> 2, wc = wid & 3, fr = lane & 15, fq = lane >> 4;
    const int K = g.K, nt = K / BK;
    unsigned voffA[2], voffB[2];
#pragma unroll
    for (int i = 0; i < 2; ++i) { int R, C; stage_rc(tid * 16 + i * 8192, R, C); const int Rb = Epi::PERM ? ((R & ~31) + perm32(R & 31)) : R;
        voffA[i] = (unsigned)(R * K + C) * 2u; voffB[i] = (unsigned)(Rb * K + C) * 2u; }
    const size_t kstep = (size_t)(BK * 2);
    const size_t hstep = (size_t)HALF * K * 2;
    const size_t tstep = 2 * hstep;
    const unsigned ldsw = (unsigned)wid * 1024u;
    const int aoff = lds_byte(wr * 64 + fr, fq * 8), boff = lds_byte(wc * 32 + fr, fq * 8);
#define PG8_SA(b, h) (((b) * 2 + (h)) * HTB)
#define PG8_SB(b, h) ((4 + (b) * 2 + (h)) * HTB)
#define PG8_STAGE(bufoff, gbase, voff) do { _Pragma("unroll") for (int _i = 0; _i < 2; ++_i) \
        __builtin_amdgcn_global_load_lds((const unsigned*)((const char*)(gbase) + (voff)[_i]), (PG8_LAS unsigned*)(lds + (bufoff) + ldsw + _i * 8192), 16, 0, 0); } while (0)
#define PG8_LDA(dst, b, h) do { _Pragma("unroll") for (int m = 0; m < 4; ++m) _Pragma("unroll") for (int k = 0; k < 2; ++k) dst[m][k] = *(const PG8_LAS bf16x8*)(lds + PG8_SA(b, h) + aoff + m * 2048 + k * 1024); } while (0)
#define PG8_LDB(dst, b, h) do { _Pragma("unroll") for (int n = 0; n < 2; ++n) _Pragma("unroll") for (int k = 0; k < 2; ++k) dst[n][k] = *(const PG8_LAS bf16x8*)(lds + PG8_SB(b, h) + boff + n * 2048 + k * 1024); } while (0)
#define PG8_MMA(ai, bj, At, Bt) do { __builtin_amdgcn_s_setprio(1); _Pragma("unroll") for (int m = 0; m < 4; ++m) _Pragma("unroll") for (int n = 0; n < 2; ++n) _Pragma("unroll") for (int k = 0; k < 2; ++k) \
        acc[ai][bj][m][n] = __builtin_amdgcn_mfma_f32_16x16x32_bf16(Bt[n][k], At[m][k], acc[ai][bj][m][n], 0, 0, 0); __builtin_amdgcn_s_setprio(0); } while (0)
#define PG8_WAIT_V(n) asm volatile("s_waitcnt vmcnt(" #n ")" ::: "memory")
#define PG8_WAIT_L(n) asm volatile("s_waitcnt lgkmcnt(" #n ")" ::: "memory")
#define PG8_BAR __builtin_amdgcn_s_barrier()
#define PG8_SCHED __builtin_amdgcn_sched_barrier(0)
    Unit cur, nxt; int ui = 0;
    if (!S.next(0, cur)) return;
    f32x4 acc[2][2][4][2];
#pragma unroll
    for (int a = 0; a < 2; ++a)
#pragma unroll
        for (int b = 0; b < 2; ++b)
#pragma unroll
            for (int m = 0; m < 4; ++m)
#pragma unroll
                for (int n = 0; n < 2; ++n) acc[a][b][m][n] = (f32x4){0.f, 0.f, 0.f, 0.f};
    bf16x8 At[4][2], B0[2][2], B1[2][2];
    const char* cA = (const char*)g.A + (size_t)cur.pm * tstep; const char* cB = (const char*)g.Bt + (size_t)cur.pn * tstep;
    S.a_ready(cur);
    if constexpr (SP2) {
        PG8_STAGE(PG8_SB(0, 0), cB, voffB); PG8_STAGE(PG8_SB(0, 1), cB + hstep, voffB); PG8_STAGE(PG8_SA(0, 0), cA, voffA); PG8_STAGE(PG8_SA(0, 1), cA + hstep, voffA);
        if (wr == 1) PG8_BAR;
        PG8_WAIT_V(2); PG8_BAR;
        PG8_STAGE(PG8_SB(1, 0), cB + kstep, voffB); PG8_STAGE(PG8_SA(1, 0), cA + kstep, voffA); PG8_STAGE(PG8_SB(1, 1), cB + hstep + kstep, voffB);
        PG8_WAIT_V(6); PG8_BAR;
    } else {
        PG8_STAGE(PG8_SB(0, 0), cB, voffB); PG8_STAGE(PG8_SA(0, 0), cA, voffA); PG8_STAGE(PG8_SB(0, 1), cB + hstep, voffB); PG8_STAGE(PG8_SA(0, 1), cA + hstep, voffA);
        if (wr == 1) PG8_BAR;
        PG8_WAIT_V(4); PG8_BAR;
        PG8_STAGE(PG8_SB(1, 0), cB + kstep, voffB); PG8_STAGE(PG8_SA(1, 0), cA + kstep, voffA); PG8_STAGE(PG8_SB(1, 1), cB + hstep + kstep, voffB);
        PG8_WAIT_V(6); PG8_BAR;
    }
    for (;;) {
        const bool has_next = S.next(ui + 1, nxt);
        const char* nA = has_next ? (const char*)g.A + (size_t)nxt.pm * tstep : cA; const char* nB = has_next ? (const char*)g.Bt + (size_t)nxt.pn * tstep : cB;
        for (int t = 0; t < nt; t += 2) {
            const bool last = (t == nt - 2);
            const char* a1 = cA + (size_t)(t + 1) * kstep;
            const char* a2 = last ? nA : cA + (size_t)(t + 2) * kstep; const char* b2 = last ? nB : cB + (size_t)(t + 2) * kstep;
            const char* a3 = a2 + kstep; const char* b3 = b2 + kstep;
            if (last && has_next) S.a_ready(nxt);
            if constexpr (SP2) {
            PG8_LDB(B0, 0, 0); PG8_LDB(B1, 0, 1); PG8_SCHED; PG8_LDA(At, 0, 0); PG8_STAGE(PG8_SA(1, 1), a1 + hstep, voffA);
            PG8_WAIT_V(8); PG8_WAIT_L(0); PG8_BAR; PG8_MMA(0, 0, At, B0); PG8_MMA(0, 1, At, B1); PG8_BAR; PG8_SCHED;
            PG8_LDA(At, 0, 1); PG8_STAGE(PG8_SB(0, 0), b2, voffB); PG8_STAGE(PG8_SB(0, 1), b2 + hstep, voffB); PG8_STAGE(PG8_SA(0, 0), a2, voffA);
            PG8_WAIT_V(8); PG8_WAIT_L(0); PG8_BAR; PG8_MMA(1, 0, At, B0); PG8_MMA(1, 1, At, B1); PG8_BAR; PG8_SCHED;
            PG8_LDB(B0, 1, 0); PG8_LDB(B1, 1, 1); PG8_SCHED; PG8_LDA(At, 1, 0); PG8_STAGE(PG8_SA(0, 1), a2 + hstep, voffA);
            PG8_WAIT_V(8); PG8_WAIT_L(0); PG8_BAR; PG8_MMA(0, 0, At, B0); PG8_MMA(0, 1, At, B1); PG8_BAR; PG8_SCHED;
            PG8_LDA(At, 1, 1); PG8_STAGE(PG8_SB(1, 0), b3, voffB); PG8_STAGE(PG8_SB(1, 1), b3 + hstep, voffB); PG8_STAGE(PG8_SA(1, 0), a3, voffA);
            PG8_WAIT_V(8); PG8_WAIT_L(0); PG8_BAR; PG8_MMA(1, 0, At, B0); PG8_MMA(1, 1, At, B1); PG8_BAR; PG8_SCHED;
            } else {
            PG8_LDB(B0, 0, 0); PG8_SCHED; PG8_LDA(At, 0, 0); PG8_STAGE(PG8_SA(1, 1), a1 + hstep, voffA);
            PG8_WAIT_L(8); PG8_BAR; PG8_WAIT_L(0); PG8_MMA(0, 0, At, B0); PG8_BAR; PG8_SCHED;
            PG8_LDB(B1, 0, 1); PG8_STAGE(PG8_SB(0, 0), b2, voffB);
            PG8_BAR; PG8_WAIT_L(0); PG8_MMA(0, 1, At, B1); PG8_BAR;
            PG8_LDA(At, 0, 1); PG8_STAGE(PG8_SA(0, 0), a2, voffA);
            PG8_BAR; PG8_WAIT_L(0); PG8_MMA(1, 0, At, B0); PG8_BAR; PG8_SCHED;
            PG8_STAGE(PG8_SB(0, 1), b2 + hstep, voffB);
            PG8_WAIT_V(6); PG8_BAR; PG8_MMA(1, 1, At, B1); PG8_BAR;
            PG8_LDB(B0, 1, 0); PG8_SCHED; PG8_LDA(At, 1, 0); PG8_STAGE(PG8_SA(0, 1), a2 + hstep, voffA);
            PG8_WAIT_L(8); PG8_BAR; PG8_WAIT_L(0); PG8_MMA(0, 0, At, B0); PG8_BAR; PG8_SCHED;
            PG8_LDB(B1, 1, 1); PG8_STAGE(PG8_SB(1, 0), b3, voffB);
            PG8_BAR; PG8_WAIT_L(0); PG8_MMA(0, 1, At, B1); PG8_BAR;
            PG8_LDA(At, 1, 1); PG8_STAGE(PG8_SA(1, 0), a3, voffA);
            PG8_BAR; PG8_WAIT_L(0); PG8_MMA(1, 0, At, B0); PG8_BAR; PG8_SCHED;
            PG8_STAGE(PG8_SB(1, 1), b3 + hstep, voffB);
            PG8_WAIT_V(6); PG8_BAR; PG8_MMA(1, 1, At, B1); PG8_BAR;
            }
        }
        if constexpr (ALIGN_EPI) { if (wr == 0) PG8_BAR; }
        if constexpr (!Epi::AFTER_DRAIN) { E(acc, cur, wr, wc, fr, fq); S.done(cur); }
        if (!has_next) break;
#pragma unroll
        for (int a = 0; a < 2; ++a)
#pragma unroll
            for (int b = 0; b < 2; ++b)
#pragma unroll
                for (int m = 0; m < 4; ++m)
#pragma unroll
                    for (int n = 0; n < 2; ++n) acc[a][b][m][n] = (f32x4){0.f, 0.f, 0.f, 0.f};
        cur = nxt; cA = nA; cB = nB; ++ui;
        if constexpr (ALIGN_EPI) { if (wr == 1) PG8_BAR; }
    }
    PG8_WAIT_V(0);
    if constexpr (!ALIGN_EPI) { if (wr == 0) PG8_BAR; }
    PG8_BAR;
    if constexpr (Epi::AFTER_DRAIN) { E.fused(acc, cur, wr, wc, fr, fq, lds, wid, lane); S.done(cur); }
#undef PG8_SA
#undef PG8_SB
#undef PG8_STAGE
#undef PG8_LDA
#undef PG8_LDB
#undef PG8_MMA
#undef PG8_WAIT_V
#undef PG8_WAIT_L
#undef PG8_BAR
#undef PG8_SCHED
}
}
typedef float f4v __attribute__((ext_vector_type(4)));
struct Params {
    const float *x, *p; const int* pos;
    const float *attn_norm, *w_in, *conv_w, *conv_b, *b_ig, *b_fg, *ret_gn, *ml_gn, *w_out, *moe_norm, *w_group, *b_group, *w_router, *b_router,
                *w1, *w3, *w2, *w_up, *ple_norm, *pg_norm, *w_gate, *final_norm;
    float* out; unsigned char* ws;
};

__device__ __forceinline__ void load4(const float* p, float (&o)[4]) { const float4 v = *(const float4*)p; o[0] = v.x; o[1] = v.y; o[2] = v.z; o[3] = v.w; }
__device__ __forceinline__ void load4(const bf16_t* p, float (&o)[4]) { const uint2 v = *(const uint2*)p; o[0] = __uint_as_float(v.x << 16); o[1] = __uint_as_float(v.x & 0xffff0000u); o[2] = __uint_as_float(v.y << 16); o[3] = __uint_as_float(v.y & 0xffff0000u); }

__device__ __forceinline__ void transpose_item(const float* W, int ldw, const float* gain, bf16_t* WT, int K, int kb, int n0, size_t drow0, LAS float* scr, int lane) {
    const int k0 = 64 * kb;
#pragma unroll 8
    for (int i = 0; i < 32; ++i) { const int kk = 2 * i + (lane >> 5); float w = W[(size_t)(k0 + kk) * ldw + n0 + (lane & 31)]; if (gain) w *= gain[k0 + kk]; scr[kk * 33 + (lane & 31)] = w; }
    LDS_WAIT(); asm volatile("" ::: "memory");
    const int c = lane & 7;
#pragma unroll
    for (int j = 0; j < 4; ++j) { const int n = (lane >> 3) + 8 * j; const LAS float* s = scr + (8 * c) * 33 + n;
        v4u o; o.x = pk2(s[0 * 33], s[1 * 33]); o.y = pk2(s[2 * 33], s[3 * 33]); o.z = pk2(s[4 * 33], s[5 * 33]); o.w = pk2(s[6 * 33], s[7 * 33]);
        *(GAS v4u*)(WT + (drow0 + n) * K + k0 + 8 * c) = o; }
    LDS_WAIT(); asm volatile("" ::: "memory");
}

constexpr int NPHASES = 14;
template <int LO, int HI>
__global__ void __launch_bounds__(NTHREADS, 2) mk(Params P) {
    extern __shared__ __attribute__((aligned(16))) unsigned char lds_raw[];
    float* ldsf = (float*)lds_raw;
    LAS unsigned char* ldsl = (LAS unsigned char*)lds_raw;
    const int tid = threadIdx.x, lane = tid & 63, wave = __builtin_amdgcn_readfirstlane(tid >> 6);
    const int G = gridDim.x, bid = blockIdx.x;
    const int gw = bid * NWAVES + wave, NGW = G * NWAVES;
    unsigned char* ws = P.ws;
    float* rstd1 = (float*)(ws + WS_RSTD1); float* gates = (float*)(ws + WS_GATES);
    float* rstdg = (float*)(ws + WS_RSTDG); float* rstde = (float*)(ws + WS_RSTDE);
    int* eid = (int*)(ws + WS_EID); int* posn = (int*)(ws + WS_POS); float* gate = (float*)(ws + WS_GATE);
    float* mn = (float*)(ws + WS_MN); float* ml = (float*)(ws + WS_ML); float* mbl = (float*)(ws + WS_MBL); float* mm = (float*)(ws + WS_MM);
    int* list = (int*)(ws + WS_LIST); int* cnt = (int*)(ws + WS_CTL) + CW_CNT;
    float* part = (float*)(ws + WS_PART); float* part2 = (float*)(ws + WS_PART2);
    bf16_t* win_t = (bf16_t*)(ws + WS_WIN); bf16_t* wout_t = (bf16_t*)(ws + WS_WOUT); bf16_t* w13_t = (bf16_t*)(ws + WS_W13); bf16_t* w2_t = (bf16_t*)(ws + WS_W2);
    bf16_t* wgate_t = (bf16_t*)(ws + WS_WGATE); bf16_t* wup_t = (bf16_t*)(ws + WS_WUP);
    bf16_t* proj = (bf16_t*)(ws + WS_PROJ); bf16_t* hbuf = (bf16_t*)(ws + WS_HBUF); bf16_t* xs = (bf16_t*)(ws + WS_XS); bf16_t* ybuf = (bf16_t*)(ws + WS_YBUF); bf16_t* peb = (bf16_t*)(ws + WS_PEB);
    bf16_t* yreg = (bf16_t*)(ws + WS_YREG); bf16_t* pb = (bf16_t*)(ws + WS_PB);
    float* out = P.out;
    float* rst = (float*)((unsigned char*)out + OUT_RST); float* mst = (float*)((unsigned char*)out + OUT_MST);
    LAS int* s_off = (LAS int*)(ldsl + LDSX_OFF + 256);
    LAS int* s_cnt = s_off + 40;
    LAS int* s_t2e = s_off + 80;
#define IN(k) (LO <= (k) && (k) < HI)

    if constexpr (IN(0)) {
        {
            LAS float* scr = (LAS float*)(ldsl + wave * 16384);
            constexpr int I0 = 16 * 128, I1 = 16 * 32, I2 = 64 * 256, I3 = 32 * 256, I4 = 16 * 32, I5 = 4 * 32;
            for (int it = gw; it < I0 + I1 + I2 + I3 + I4 + I5; it += NGW) {
                int r = it;
                if (r < I0) { transpose_item(P.w_in, NPROJ, P.attn_norm, win_t, D, r / 128, 32 * (r % 128), (size_t)(32 * (r % 128)), scr, lane); continue; } r -= I0;
                if (r < I1) { transpose_item(P.w_out, D, nullptr, wout_t, D, r / 32, 32 * (r % 32), (size_t)(32 * (r % 32)), scr, lane); continue; } r -= I1;
                if (r < I2) { const int mat = r >> 8, q = r & 255, e = mat >> 1, which = mat & 1, kb = q >> 4, n0 = 32 * (q & 15);
                    const float* W = (which ? P.w3 : P.w1) + (size_t)e * D * DE;
                    transpose_item(W, DE, nullptr, w13_t, D, kb, n0, (size_t)e * 1024 + (size_t)((n0 >> 7) * 256 + which * 128 + (n0 & 127)), scr, lane); continue; } r -= I2;
                if (r < I3) { const int e = r >> 8, q = r & 255, kb = q >> 5, n0 = 32 * (q & 31);
                    transpose_item(P.w2 + (size_t)e * DE * D, D, nullptr, w2_t, DE, kb, n0, (size_t)e * 1024 + n0, scr, lane); continue; } r -= I3;
                if (r < I4) { transpose_item(P.w_gate, D, P.pg_norm, wgate_t, D, r / 32, 32 * (r % 32), (size_t)(32 * (r % 32)), scr, lane); continue; } r -= I4;
                transpose_item(P.w_up, D, nullptr, wup_t, PLE, r / 32, 32 * (r % 32), (size_t)(32 * (r % 32)), scr, lane);
            }
        }
        __syncthreads();
        {
            LAS float* gwl = (LAS float*)ldsl;
            for (int idx = tid; idx < D * 8; idx += NTHREADS) { const int k = idx >> 3, j = idx & 7; gwl[idx] = P.w_in[(size_t)k * NPROJ + NP + j] * P.attn_norm[k]; }
            __syncthreads();
            for (int row = gw; row < T; row += NGW) {
                const float4* xr = (const float4*)(P.x + (size_t)row * D) + lane;
                float4 v[4]; float ss = 0.f;
#pragma unroll
                for (int j = 0; j < 4; ++j) { v[j] = xr[64 * j]; ss += v[j].x * v[j].x + v[j].y * v[j].y + v[j].z * v[j].z + v[j].w * v[j].w; }
                ss = wave_sum(ss);
                const float rstd = 1.0f / sqrtf(ss * (1.0f / D) + EPS);
                float g8[8];
#pragma unroll
                for (int i = 0; i < 8; ++i) g8[i] = 0.f;
#pragma unroll
                for (int j = 0; j < 4; ++j) {
                    const int k0 = 4 * (lane + 64 * j);
                    const float xs_[4] = {v[j].x * rstd, v[j].y * rstd, v[j].z * rstd, v[j].w * rstd};
                    uint2 o; o.x = pk2(xs_[0], xs_[1]); o.y = pk2(xs_[2], xs_[3]);
                    *(uint2*)(yreg + (size_t)row * D + k0) = o;
#pragma unroll
                    for (int i = 0; i < 4; ++i) {
                        const LAS f4v* wr = (const LAS f4v*)(gwl + (k0 + i) * 8);
                        const f4v w0 = wr[0], w1 = wr[1];
                        g8[0] += xs_[i] * w0.x; g8[1] += xs_[i] * w0.y; g8[2] += xs_[i] * w0.z; g8[3] += xs_[i] * w0.w;
                        g8[4] += xs_[i] * w1.x; g8[5] += xs_[i] * w1.y; g8[6] += xs_[i] * w1.z; g8[7] += xs_[i] * w1.w;
                    }
                }
#pragma unroll
                for (int i = 0; i < 8; ++i) g8[i] = wave_sum(g8[i]);
                if (lane == 0) {
                    rstd1[row] = rstd;
                    *(float4*)(gates + (size_t)row * 8) = make_float4(g8[0], g8[1], g8[2], g8[3]);
                    *(float4*)(gates + (size_t)row * 8 + 4) = make_float4(g8[4], g8[5], g8[6], g8[7]);
                }
            }
            for (int row = gw; row < T; row += NGW) {
                const float4 v = ((const float4*)(P.p + (size_t)row * PLE))[lane];
                uint2 o; o.x = pk2(v.x, v.y); o.y = pk2(v.z, v.w);
                ((uint2*)(pb + (size_t)row * PLE))[lane] = o;
            }
        }
        __syncthreads();
    }
    if constexpr (IN(1)) {
        pg8::Gemm g{yreg, win_t, T, NP, D}; pg8::StaticOrder S; S.init(T, NP, G, bid);
        pg8::EpiStoreBf16 E{proj, NP, 0xffff, nullptr};
        pg8::gemm_phase<pg8::EpiStoreBf16, pg8::StaticOrder, true, true>(ldsl, g, S, E);
    }
    if constexpr (IN(2)) {
        const int nitems = BATCH * NCH * (RH + MH);
        for (int it = bid; it < nitems; it += G) {
            const int bn = it / (RH + MH), hh = it % (RH + MH), b = bn / NCH, n = bn % NCH;
            const size_t t0 = (size_t)b * SEQ + (size_t)n * CH;
            __syncthreads();
            if (hh < RH) {
                const int h = hh;
                float* kk = ldsf; float* vv = ldsf + CH * RD;
                const float lg = log1pf(-exp2f(-5.0f - (float)h));
                for (int idx = tid; idx < CH * 32; idx += NTHREADS) {
                    const int c = idx >> 5, j = idx & 31; const size_t t = t0 + c;
                    const float ang = (float)P.pos[t] * powf(10000.0f, -(float)j / 32.0f);
                    float sn, cs; sincosf(ang, &sn, &cs);
                    const float x1 = bf2f(proj[t * NP + C_RK + h * RD + j]), x2 = bf2f(proj[t * NP + C_RK + h * RD + 32 + j]);
                    const float wst = expf(lg * (float)(CH - 1 - c)) * 0.125f;
                    kk[c * RD + j] = (x1 * cs - x2 * sn) * wst; kk[c * RD + 32 + j] = (x1 * sn + x2 * cs) * wst;
                }
                for (int idx = tid; idx < CH * RD; idx += NTHREADS) { const int c = idx >> 6, e = idx & 63; vv[idx] = bf2f(proj[(t0 + c) * NP + C_RV + h * RD + e]); }
                __syncthreads();
                const int d = tid >> 3, e0 = (tid & 7) * 8;
                float acc[8];
#pragma unroll
                for (int i = 0; i < 8; ++i) acc[i] = 0.f;
                for (int c = 0; c < CH; ++c) { const float kv = kk[c * RD + d];
#pragma unroll
                    for (int i = 0; i < 8; ++i) acc[i] += kv * vv[c * RD + e0 + i]; }
                float* dst = rst + ((size_t)(bn * RH + h) * RD + d) * RD + e0;
#pragma unroll
                for (int i = 0; i < 8; ++i) dst[i] = acc[i];
            } else {
                const int h = hh - RH;
                float* kk = ldsf; float* sw = ldsf + CH * MD; float* sb = sw + CH;
                if (tid < CH) {
                    const size_t t = t0 + tid;
                    sw[tid] = gates[t * 8 + h] + P.b_ig[h];
                    sb[tid] = logsigmoidf_(gates[t * 8 + 4 + h] + P.b_fg[h]);
                }
                __syncthreads();
                if (tid == 0) { float run = 0.f; for (int c = 0; c < CH; ++c) { run += sb[c]; sb[c] = run; } }
                __syncthreads();
                const float bL = sb[CH - 1];
                float mloc = -INFINITY;
                for (int c = 0; c < CH; ++c) mloc = fmaxf(mloc, bL - sb[c] + sw[c]);
                __syncthreads();
                if (tid < CH) sw[tid] = expf(bL - sb[tid] + sw[tid] - mloc);
                for (int idx = tid; idx < CH * MD; idx += NTHREADS) {
                    const int c = idx >> 7, d = idx & 127; const int s = n * CH + c; const int chn = 512 + h * MD + d;
                    float a = P.conv_b[chn];
#pragma unroll
                    for (int w = 0; w < 4; ++w) { const int ss = s - 3 + w; if (ss >= 0) a += bf2f(proj[((size_t)b * SEQ + ss) * NP + C_MK + h * MD + d]) * P.conv_w[w * 1024 + chn]; }
                    kk[idx] = siluf_(a) * 0.08838834764831845f;
                }
                __syncthreads();
                const int d = tid >> 2, e0 = (tid & 3) * 32;
                float acc[32]; float nacc = 0.f;
#pragma unroll
                for (int i = 0; i < 32; ++i) acc[i] = 0.f;
                for (int c = 0; c < CH; ++c) {
                    const float kv = kk[c * MD + d] * sw[c]; nacc += kv;
                    const bf16_t* vp = proj + (t0 + c) * NP + C_MV + h * MD + e0;
#pragma unroll
                    for (int i = 0; i < 32; ++i) acc[i] += kv * bf2f(vp[i]);
                }
                const int sidx = bn * MH + h;
                float* dst = mst + ((size_t)sidx * MD + d) * MD + e0;
#pragma unroll
                for (int i = 0; i < 32; ++i) dst[i] = acc[i];
                if ((tid & 3) == 0) mn[(size_t)sidx * MD + d] = nacc;
                if (tid == 0) { ml[sidx] = mloc; mbl[sidx] = bL; }
            }
        }
        __syncthreads();
    }
    if constexpr (IN(3)) {
        const long NT = (long)G * NTHREADS; const long NR = (long)BATCH * RH * RD * RD, NM = (long)BATCH * MH * MD * MD, NN = (long)BATCH * MH * MD;
        for (long idx = (long)bid * NTHREADS + tid; idx < NR + NM + NN; idx += NT) {
            if (idx < NR) {
                const int el = (int)(idx % (RD * RD)); const int bh = (int)(idx / (RD * RD)); const int b = bh / RH, h = bh % RH;
                const float dec = expf(log1pf(-exp2f(-5.0f - (float)h)) * (float)CH);
                float R = 0.f;
                for (int n = 0; n < NCH; ++n) { float* ptr = rst + ((size_t)((b * NCH + n) * RH + h)) * (RD * RD) + el; const float tmp = *ptr; *ptr = R; R = dec * R + tmp; }
            } else {
                const long j = idx - NR; const bool isn = j >= NM;
                const long jj = isn ? j - NM : j; const int per = isn ? MD : MD * MD;
                const int el = (int)(jj % per); const int bh = (int)(jj / per); const int b = bh / MH, h = bh % MH;
                float S = 0.f, m = 0.f;
                for (int n = 0; n < NCH; ++n) {
                    const int sidx = (b * NCH + n) * MH + h;
                    const float bL = mbl[sidx], mloc = ml[sidx];
                    const float mnew = fmaxf(bL + m, mloc);
                    const float dec = expf(bL + m - mnew), sc = expf(mloc - mnew);
                    float* ptr = isn ? mn + (size_t)sidx * MD + el : mst + (size_t)sidx * (MD * MD) + el;
                    const float tmp = *ptr; *ptr = S; S = dec * S + sc * tmp;
                    if (isn && el == 0) mm[sidx] = m;
                    m = mnew;
                }
            }
        }
    }
    if constexpr (IN(4)) {
        const int nitems = BATCH * NCH * (RH + MH);
        for (int it = bid; it < nitems; it += G) {
            const int bn = it / (RH + MH), hh = it % (RH + MH), b = bn / NCH, n = bn % NCH;
            const size_t t0 = (size_t)b * SEQ + (size_t)n * CH;
            __syncthreads();
            if (hh < RH) {
                const int h = hh;
                float* qq = ldsf; float* kk = qq + CH * RD; float* vv = kk + CH * RD; float* Rp = vv + CH * RD;
                const float lg = log1pf(-exp2f(-5.0f - (float)h));
                for (int idx = tid; idx < CH * 32; idx += NTHREADS) {
                    const int c = idx >> 5, j = idx & 31; const size_t t = t0 + c;
                    const float ang = (float)P.pos[t] * powf(10000.0f, -(float)j / 32.0f);
                    float sn, cs; sincosf(ang, &sn, &cs);
                    float x1 = bf2f(proj[t * NP + C_RK + h * RD + j]), x2 = bf2f(proj[t * NP + C_RK + h * RD + 32 + j]);
                    kk[c * RD + j] = (x1 * cs - x2 * sn) * 0.125f; kk[c * RD + 32 + j] = (x1 * sn + x2 * cs) * 0.125f;
                    x1 = bf2f(proj[t * NP + C_RQ + h * RD + j]); x2 = bf2f(proj[t * NP + C_RQ + h * RD + 32 + j]);
                    qq[c * RD + j] = (x1 * cs - x2 * sn); qq[c * RD + 32 + j] = (x1 * sn + x2 * cs);
                }
                for (int idx = tid; idx < CH * RD; idx += NTHREADS) { const int c = idx >> 6, e = idx & 63; vv[idx] = bf2f(proj[(t0 + c) * NP + C_RV + h * RD + e]); }
                for (int idx = tid; idx < RD * RD; idx += NTHREADS) Rp[idx] = rst[(size_t)(bn * RH + h) * (RD * RD) + idx];
                __syncthreads();
                const int c = tid >> 2, e0 = (tid & 3) * 16;
                float acc[16];
#pragma unroll
                for (int i = 0; i < 16; ++i) acc[i] = 0.f;
                for (int j = 0; j <= c; ++j) {
                    float s = 0.f;
                    for (int d = 0; d < RD; ++d) s += qq[c * RD + d] * kk[j * RD + d];
                    s *= expf(lg * (float)(c - j));
#pragma unroll
                    for (int i = 0; i < 16; ++i) acc[i] += s * vv[j * RD + e0 + i];
                }
                const float wq = expf(lg * (float)(c + 1));
                for (int d = 0; d < RD; ++d) { const float qv = qq[c * RD + d] * wq;
#pragma unroll
                    for (int i = 0; i < 16; ++i) acc[i] += qv * Rp[d * RD + e0 + i]; }
                float ss = 0.f;
#pragma unroll
                for (int i = 0; i < 16; ++i) ss += acc[i] * acc[i];
                ss += __shfl_xor(ss, 1); ss += __shfl_xor(ss, 2);
                const float rn = 1.0f / sqrtf(ss * (1.0f / RD) + EPS);
                const size_t t = t0 + c;
#pragma unroll
                for (int i = 0; i < 16; ++i) {
                    const int e = e0 + i; const float g = bf2f(proj[t * NP + C_RG + h * RD + e]);
                    yreg[t * D + h * RD + e] = (bf16_t)f2bf(siluf_(g) * acc[i] * rn * P.ret_gn[h * RD + e]);
                }
            } else {
                const int h = hh - RH; const int sidx = bn * MH + h;
                float* qq = ldsf; float* kk = qq + CH * MD; float* sb = kk + CH * MD; float* sg = sb + CH; float* spm = sg + CH;
                if (tid < CH) {
                    const size_t t = t0 + tid;
                    sg[tid] = gates[t * 8 + h] + P.b_ig[h];
                    sb[tid] = logsigmoidf_(gates[t * 8 + 4 + h] + P.b_fg[h]);
                }
                __syncthreads();
                if (tid == 0) { float run = 0.f, pm = -INFINITY; for (int c = 0; c < CH; ++c) { run += sb[c]; sb[c] = run; const float g = sg[c] - run; sg[c] = g; pm = fmaxf(pm, g); spm[c] = pm; } }
                for (int idx = tid; idx < CH * MD; idx += NTHREADS) {
                    const int c = idx >> 7, d = idx & 127; const int s = n * CH + c;
                    float aq = P.conv_b[h * MD + d], ak = P.conv_b[512 + h * MD + d];
#pragma unroll
                    for (int w = 0; w < 4; ++w) { const int ss = s - 3 + w; if (ss >= 0) { const size_t tt = (size_t)b * SEQ + ss;
                        aq += bf2f(proj[tt * NP + C_MQ + h * MD + d]) * P.conv_w[w * 1024 + h * MD + d];
                        ak += bf2f(proj[tt * NP + C_MK + h * MD + d]) * P.conv_w[w * 1024 + 512 + h * MD + d]; } }
                    qq[idx] = siluf_(aq); kk[idx] = siluf_(ak) * 0.08838834764831845f;
                }
                __syncthreads();
                const float mprev = mm[sidx];
                const int c = tid >> 2, e0 = (tid & 3) * 32;
                const float bc = sb[c], mrow = bc + fmaxf(spm[c], mprev);
                float acc[32]; float den = 0.f;
#pragma unroll
                for (int i = 0; i < 32; ++i) acc[i] = 0.f;
                for (int j = 0; j <= c; ++j) {
                    float s = 0.f;
                    for (int d = 0; d < MD; ++d) s += qq[c * MD + d] * kk[j * MD + d];
                    const float pj = expf(bc + sg[j] - mrow) * s; den += pj;
                    const bf16_t* vp = proj + (t0 + j) * NP + C_MV + h * MD + e0;
#pragma unroll
                    for (int i = 0; i < 32; ++i) acc[i] += pj * bf2f(vp[i]);
                }
                const float wi = expf(bc + mprev - mrow);
                const float* Sp = mst + (size_t)sidx * (MD * MD); const float* np_ = mn + (size_t)sidx * MD;
                for (int d = 0; d < MD; ++d) { const float qv = qq[c * MD + d] * wi; den += qv * np_[d];
#pragma unroll
                    for (int i = 0; i < 32; ++i) acc[i] += qv * Sp[d * MD + e0 + i]; }
                const float dn = fmaxf(fabsf(den), expf(-mrow));
                const size_t t = t0 + c; float ss = 0.f;
#pragma unroll
                for (int i = 0; i < 32; ++i) { const float o = bf2f(proj[t * NP + C_MO + h * MD + e0 + i]); acc[i] = sigmoidf_(o) * acc[i] / dn; ss += acc[i] * acc[i]; }
                ss += __shfl_xor(ss, 1); ss += __shfl_xor(ss, 2);
                const float rn = 1.0f / sqrtf(ss * (1.0f / MD) + EPS);
#pragma unroll
                for (int i = 0; i < 32; ++i) yreg[t * D + 512 + h * MD + e0 + i] = (bf16_t)f2bf(acc[i] * rn * P.ml_gn[h * MD + e0 + i]);
            }
        }
        __syncthreads();
    }
    if constexpr (IN(5)) {
        pg8::Gemm g{yreg, wout_t, T, D, D}; pg8::StaticOrder S; S.init(T, D, G, bid);
        pg8::EpiRes E{P.x, out};
        pg8::gemm_phase<pg8::EpiRes, pg8::StaticOrder, true, true>(ldsl, g, S, E);
    }
    if constexpr (IN(6)) {
        for (int row = gw; row < T; row += NGW) {
            const float4* hr = (const float4*)(out + (size_t)row * D) + lane;
            float4 v[4]; float ss = 0.f;
#pragma unroll
            for (int j = 0; j < 4; ++j) { v[j] = hr[64 * j]; ss += v[j].x * v[j].x + v[j].y * v[j].y + v[j].z * v[j].z + v[j].w * v[j].w; }
            ss = wave_sum(ss);
            const float rstd = 1.0f / sqrtf(ss * (1.0f / D) + EPS);
            float lg[36];
#pragma unroll
            for (int i = 0; i < 36; ++i) lg[i] = 0.f;
#pragma unroll
            for (int j = 0; j < 4; ++j) {
                const int k0 = 4 * (lane + 64 * j);
                const float4 nv = *(const float4*)(P.moe_norm + k0);
                const float xs_[4] = {v[j].x * nv.x * rstd, v[j].y * nv.y * rstd, v[j].z * nv.z * rstd, v[j].w * nv.w * rstd};
                uint2 o; o.x = pk2(xs_[0], xs_[1]); o.y = pk2(xs_[2], xs_[3]);
                *(uint2*)(yreg + (size_t)row * D + k0) = o;
#pragma unroll
                for (int i = 0; i < 4; ++i) {
                    const float4 wg = *(const float4*)(P.w_group + (size_t)(k0 + i) * 4);
                    lg[0] += xs_[i] * wg.x; lg[1] += xs_[i] * wg.y; lg[2] += xs_[i] * wg.z; lg[3] += xs_[i] * wg.w;
                    const float4* wr = (const float4*)(P.w_router + (size_t)(k0 + i) * 32);
#pragma unroll
                    for (int q = 0; q < 8; ++q) { const float4 w = wr[q]; lg[4 + 4 * q] += xs_[i] * w.x; lg[5 + 4 * q] += xs_[i] * w.y; lg[6 + 4 * q] += xs_[i] * w.z; lg[7 + 4 * q] += xs_[i] * w.w; }
                }
            }
#pragma unroll
            for (int i = 0; i < 36; ++i) lg[i] = wave_sum(lg[i]);
            float gl[4];
#pragma unroll
            for (int i = 0; i < 4; ++i) gl[i] = lg[i] + P.b_group[i];
            int gs = 0; float gmax = gl[0];
#pragma unroll
            for (int i = 1; i < 4; ++i) if (gl[i] > gmax) { gmax = gl[i]; gs = i; }
            float gsum = 0.f;
#pragma unroll
            for (int i = 0; i < 4; ++i) gsum += expf(gl[i] - gmax);
            const float pg = 1.0f / gsum;
            float el[8];
#pragma unroll
            for (int i = 0; i < 8; ++i) {
                float a = lg[4 + i] + P.b_router[i];
                if (gs == 1) a = lg[12 + i] + P.b_router[8 + i];
                if (gs == 2) a = lg[20 + i] + P.b_router[16 + i];
                if (gs == 3) a = lg[28 + i] + P.b_router[24 + i];
                el[i] = a;
            }
            int i0 = 0; float l0 = el[0];
#pragma unroll
            for (int i = 1; i < 8; ++i) if (el[i] > l0) { l0 = el[i]; i0 = i; }
            int i1 = -1; float l1 = -INFINITY;
#pragma unroll
            for (int i = 0; i < 8; ++i) if (i != i0 && el[i] > l1) { l1 = el[i]; i1 = i; }
            const float r = expf(l1 - l0);
            const float g0 = pg / (1.0f + r), g1 = pg * r / (1.0f + r);
            if (lane == 0) {
                const int e0 = gs * 8 + i0, e1 = gs * 8 + i1;
                const int p0 = atomicAdd(&cnt[e0], 1), p1 = atomicAdd(&cnt[e1], 1);
                list[(size_t)e0 * T + p0] = row; list[(size_t)e1 * T + p1] = row;
                eid[row * 2] = e0; eid[row * 2 + 1] = e1; posn[row * 2] = p0; posn[row * 2 + 1] = p1;
                gate[row * 2] = g0; gate[row * 2 + 1] = g1;
            }
        }
    }
    if constexpr (IN(7) || IN(8) || IN(9) || IN(11)) {
        __syncthreads();
        if (tid == 0) { int o = 0; for (int e = 0; e < NE; ++e) { const int c = cnt[e]; s_cnt[e] = c; s_off[e] = o; const int nt = (c + 255) >> 8; for (int i = 0; i < nt; ++i) s_t2e[(o >> 8) + i] = e; o += nt << 8; } s_off[NE] = o; }
        __syncthreads();
    }
    if constexpr (IN(7)) {
        const int NS = s_off[NE];
        for (int s = gw; s < NS; s += NGW) {
            const int e = s_t2e[s >> 8], i = s - s_off[e];
            v4u a = {0u, 0u, 0u, 0u}, b2 = {0u, 0u, 0u, 0u};
            if (i < s_cnt[e]) { const int tok = list[(size_t)e * T + i]; const v4u* src = (const v4u*)(yreg + (size_t)tok * D); a = src[lane]; b2 = src[lane + 64]; }
            v4u* dst = (v4u*)(xs + (size_t)s * D); dst[lane] = a; dst[lane + 64] = b2;
        }
    }
    if constexpr (IN(8)) {
        const int NS = s_off[NE];
        pg8::Gemm g{xs, w13_t, NS, NE * 1024, D}; pg8::GroupedOrder S; S.init(NS >> 8, G, bid, (const LAS int*)s_t2e);
        pg8::EpiSwiglu E{hbuf};
        pg8::gemm_phase<pg8::EpiSwiglu, pg8::GroupedOrder, true, true>(ldsl, g, S, E);
    }
    if constexpr (IN(9)) {
        const int NS = s_off[NE];
        pg8::Gemm g{hbuf, w2_t, NS, NE * 1024, DE}; pg8::GroupedOrder S; S.init(NS >> 8, G, bid, (const LAS int*)s_t2e);
        pg8::EpiStoreBf16 E{ybuf, D, 3, nullptr};
        pg8::gemm_phase<pg8::EpiStoreBf16, pg8::GroupedOrder, true, true>(ldsl, g, S, E);
    }
    if constexpr (IN(10)) {
        pg8::Gemm g{pb, wup_t, T, D, PLE}; pg8::StaticOrder S; S.init(T, D, G, bid);
        pg8::EpiStoreBf16 E{peb, D, 0xffff, part};
        pg8::gemm_phase<pg8::EpiStoreBf16, pg8::StaticOrder, true, true>(ldsl, g, S, E);
    }
    if constexpr (IN(11)) {
        for (int row = gw; row < T; row += NGW) {
            const int s0 = s_off[eid[row * 2]] + posn[row * 2], s1 = s_off[eid[row * 2 + 1]] + posn[row * 2 + 1];
            const float g0 = gate[row * 2], g1 = gate[row * 2 + 1];
            float ss = 0.f;
#pragma unroll
            for (int j = 0; j < 4; ++j) {
                const int k0 = 4 * (lane + 64 * j);
                float4 hv = *(const float4*)(out + (size_t)row * D + k0);
                float y0[4], y1[4]; load4(ybuf + (size_t)s0 * D + k0, y0); load4(ybuf + (size_t)s1 * D + k0, y1);
                hv.x += g0 * y0[0] + g1 * y1[0]; hv.y += g0 * y0[1] + g1 * y1[1]; hv.z += g0 * y0[2] + g1 * y1[2]; hv.w += g0 * y0[3] + g1 * y1[3];
                *(float4*)(out + (size_t)row * D + k0) = hv;
                ss += hv.x * hv.x + hv.y * hv.y + hv.z * hv.z + hv.w * hv.w;
                uint2 o; o.x = pk2(hv.x, hv.y); o.y = pk2(hv.z, hv.w);
                *(uint2*)(yreg + (size_t)row * D + k0) = o;
            }
            ss = wave_sum(ss);
            float pe = lane < 16 ? part[(size_t)row * 16 + lane] : 0.f;
            pe = wave_sum(pe);
            if (lane == 0) { rstdg[row] = 1.0f / sqrtf(ss * (1.0f / D) + EPS); rstde[row] = 1.0f / sqrtf(pe * (1.0f / D) + EPS); }
        }
    }
    if constexpr (IN(12)) {
        pg8::Gemm g{yreg, wgate_t, T, D, D}; pg8::StaticOrder S; S.init(T, D, G, bid);
        pg8::EpiGate E{out, peb, rstdg, rstde, P.ple_norm, part2};
        pg8::gemm_phase<pg8::EpiGate, pg8::StaticOrder, true, true>(ldsl, g, S, E);
    }
    if constexpr (IN(13)) {
        for (int row = gw; row < T; row += NGW) {
            float4* hr = (float4*)(out + (size_t)row * D) + lane;
            float4 v[4];
#pragma unroll
            for (int j = 0; j < 4; ++j) v[j] = hr[64 * j];
            float ss = lane < 16 ? part2[(size_t)row * 16 + lane] : 0.f;
            ss = wave_sum(ss);
            const float rstd = 1.0f / sqrtf(ss * (1.0f / D) + EPS);
#pragma unroll
            for (int j = 0; j < 4; ++j) {
                const float4 nv = *(const float4*)(P.final_norm + 4 * (lane + 64 * j));
                float4 o; o.x = v[j].x * rstd * nv.x; o.y = v[j].y * rstd * nv.y; o.z = v[j].z * rstd * nv.z; o.w = v[j].w * rstd * nv.w;
                hr[64 * j] = o;
            }
        }
    }
#undef IN
}

template <int PH> static void launch_one(int grid, const Params& p, hipStream_t stream) {
    static bool attr_done = false;
    if (!attr_done) { (void)hipFuncSetAttribute((const void*)mk<PH, PH + 1>, hipFuncAttributeMaxDynamicSharedMemorySize, LDS_BYTES); attr_done = true; }
    hipLaunchKernelGGL((mk<PH, PH + 1>), dim3(grid), dim3(NTHREADS), LDS_BYTES, stream, p);
}
template <int PH> static void launch_all(int grid, const Params& p, hipStream_t stream) {
    if constexpr (PH < NPHASES) { launch_one<PH>(grid, p, stream); launch_all<PH + 1>(grid, p, stream); }
}

extern "C" void kernel_launch(void* const* d_in, const int* in_sizes, int n_in, void* d_out, int out_size, void* d_ws, size_t ws_size, hipStream_t stream) {
    static int grid = 0;
    if (grid == 0) {
        if (n_in != 25 || in_sizes[0] != T * D || out_size != T * D || ws_size < WS_END) {
            fprintf(stderr, "kernel_launch: unexpected shapes: n_in %d in0 %d out %d ws %zu\n", n_in, n_in > 0 ? in_sizes[0] : -1, out_size, ws_size); grid = -1; return; }
        int dev = 0, cus = 0;
        (void)hipGetDevice(&dev); (void)hipDeviceGetAttribute(&cus, hipDeviceAttributeMultiprocessorCount, dev);
        (void)hipGetLastError();
        grid = cus;
    }
    if (grid < 0) return;
    (void)hipMemsetAsync((char*)d_ws + WS_CTL, 0, 1 * MiB, stream);
    Params p{};
    p.x = (const float*)d_in[0]; p.p = (const float*)d_in[1]; p.pos = (const int*)d_in[2];
    p.attn_norm = (const float*)d_in[3]; p.w_in = (const float*)d_in[4]; p.conv_w = (const float*)d_in[5]; p.conv_b = (const float*)d_in[6];
    p.b_ig = (const float*)d_in[7]; p.b_fg = (const float*)d_in[8]; p.ret_gn = (const float*)d_in[9]; p.ml_gn = (const float*)d_in[10];
    p.w_out = (const float*)d_in[11]; p.moe_norm = (const float*)d_in[12]; p.w_group = (const float*)d_in[13]; p.b_group = (const float*)d_in[14];
    p.w_router = (const float*)d_in[15]; p.b_router = (const float*)d_in[16]; p.w1 = (const float*)d_in[17]; p.w3 = (const float*)d_in[18]; p.w2 = (const float*)d_in[19];
    p.w_up = (const float*)d_in[20]; p.ple_norm = (const float*)d_in[21]; p.pg_norm = (const float*)d_in[22]; p.w_gate = (const float*)d_in[23]; p.final_norm = (const float*)d_in[24];
    p.out = (float*)d_out; p.ws = (unsigned char*)d_ws;
    launch_all<0>(grid, p, stream);
}
```

```cpp
#include <hip/hip_runtime.h>
#include <cstdio>
#include <cstdint>

constexpr int D = 1024, BATCH = 4, SEQ = 8192, T = BATCH * SEQ, PLE = 256;
constexpr int NPROJ = 4104, NP = 4096;
constexpr int CH = 128, NCH = SEQ / CH;
constexpr int RH = 8, RD = 64, MH = 4, MD = 128;
constexpr int NE = 32, DE = 512;
constexpr float EPS = 1e-6f;
constexpr int C_RQ = 0, C_RK = 512, C_RV = 1024, C_RG = 1536, C_MQ = 2048, C_MK = 2560, C_MV = 3072, C_MO = 3584;

constexpr size_t MiB = 1u << 20;
constexpr size_t WS_CTL = 0;
constexpr size_t WS_RSTD1 = 1 * MiB;
constexpr size_t WS_GATES = WS_RSTD1 + 256 * 1024;
constexpr size_t WS_RSTDG = 3 * MiB;
constexpr size_t WS_RSTDE = WS_RSTDG + 256 * 1024;
constexpr size_t WS_EID = 4 * MiB;
constexpr size_t WS_POS = WS_EID + 256 * 1024;
constexpr size_t WS_GATE = WS_POS + 256 * 1024;
constexpr size_t WS_MN = 5 * MiB;
constexpr size_t WS_ML = WS_MN + 512 * 1024;
constexpr size_t WS_MBL = WS_ML + 4096;
constexpr size_t WS_MM = WS_MBL + 4096;
constexpr size_t WS_LIST = 8 * MiB;
constexpr size_t WS_PART = 12 * MiB;
constexpr size_t WS_PART2 = 14 * MiB;
constexpr size_t WS_WIN = 16 * MiB;
constexpr size_t WS_WOUT = 24 * MiB;
constexpr size_t WS_W13 = 26 * MiB;
constexpr size_t WS_W2 = 90 * MiB;
constexpr size_t WS_WGATE = 122 * MiB;
constexpr size_t WS_WUP = 124 * MiB;
constexpr size_t WS_PROJ = 128 * MiB;
constexpr size_t WS_HBUF = 128 * MiB;
constexpr size_t WS_XS = 200 * MiB;
constexpr size_t WS_YBUF = 200 * MiB;
constexpr size_t WS_PEB = 128 * MiB;
constexpr size_t WS_YREG = 384 * MiB;
constexpr size_t WS_PB = 448 * MiB;
constexpr size_t WS_END = 464 * MiB;
constexpr size_t OUT_RST = 0;
constexpr size_t OUT_MST = 32 * MiB;
constexpr int CW_CNT = 64;
constexpr int CW_BAR = 4096;

constexpr int NTHREADS = 512, NWAVES = 8;
constexpr int RING_BYTES = 131072;
constexpr int LDSX_OFF = 143360;
constexpr int LDS_BYTES = 147456;

#define GAS __attribute__((address_space(1)))
#define LAS __attribute__((address_space(3)))
typedef unsigned short bf16_t;
typedef unsigned v4u __attribute__((ext_vector_type(4)));
__device__ __forceinline__ float bf2f(bf16_t h) { return __uint_as_float((unsigned)h << 16); }
__device__ __forceinline__ unsigned f2bf(float f) { unsigned u = __float_as_uint(f); return (u + 0x7fffu + ((u >> 16) & 1u)) >> 16; }
__device__ __forceinline__ unsigned pk2(float lo, float hi) { return f2bf(lo) | (f2bf(hi) << 16); }
__device__ __forceinline__ float wave_sum(float v) {
#pragma unroll
    for (int o = 1; o < 64; o <<= 1) v += __shfl_xor(v, o);
    return v;
}
__device__ __forceinline__ float sigmoidf_(float x) { return 1.0f / (1.0f + expf(-x)); }
__device__ __forceinline__ float siluf_(float x) { return x / (1.0f + expf(-x)); }
__device__ __forceinline__ float logsigmoidf_(float x) { return x >= 0.f ? -log1pf(expf(-x)) : x - log1pf(expf(x)); }
#define LDS_WAIT() asm volatile("s_waitcnt lgkmcnt(0)" ::: "memory")

namespace pg8 {
#define PG8_LAS __attribute__((address_space(3)))
typedef unsigned short bf16_t;
typedef short bf16x8 __attribute__((ext_vector_type(8)));
typedef float f32x4 __attribute__((ext_vector_type(4)));
typedef unsigned u32x4 __attribute__((ext_vector_type(4)));
constexpr int BM = 256, BK = 64, HALF = 128, HTB = HALF * BK * 2  , STAGE_BYTES = 8 * HTB, NXCD = 8, WGM = 8;

__host__ __device__ __forceinline__ int lds_byte(int r, int c) { const int st = (r >> 4) * 2 + (c >> 5), rr = r & 15, cc = c & 31, ob = rr * 64 + cc * 2; return st * 1024 + (ob ^ (((ob >> 9) & 1) << 5)); }
__host__ __device__ __forceinline__ void stage_rc(int b, int& R, int& C) { const int st = b / 1024, sb = b % 1024, swz = sb ^ (((sb >> 9) & 1) << 5); R = (st >> 1) * 16 + swz / 64; C = (st & 1) * 32 + (swz % 64) / 2; }
__host__ __device__ __forceinline__ int perm32(int rho) { const int n = rho >> 4, i = rho & 15; return 8 * (i >> 2) + 4 * n + (i & 3); }

struct Unit { int pm, pn; };
struct Gemm { const bf16_t* A; const bf16_t* Bt; int M, N, K; };

struct StaticOrder {
    int nM, nN, nwg, G, c;
    __host__ __device__ void init(int M, int N, int G_, int c_) { nM = M / BM; nN = N / BM; nwg = nM * nN; G = G_; c = c_; }
    __host__ __device__ bool next(int i, Unit& u) const {
        const long L = (long)i * G + c; if (L >= nwg) return false;
        int wgid = (int)L; { const int q = nwg / NXCD, r = nwg % NXCD, xcd = wgid % NXCD, off = wgid / NXCD; wgid = (xcd < r ? xcd * (q + 1) : r * (q + 1) + (xcd - r) * q) + off; }
        const int nig = WGM * nN, gid = wgid / nig, fm = gid * WGM, gsz = (nM - fm) < WGM ? (nM - fm) : WGM;
        u.pm = fm + ((wgid % nig) % gsz); u.pn = (wgid % nig) / gsz; return true;
    }
    __device__ __forceinline__ void a_ready(const Unit&) const {}
    __device__ __forceinline__ void done(const Unit&) const {}
};

__device__ __forceinline__ unsigned cvt_pk_bf16(float lo, float hi) { unsigned r; asm volatile("v_cvt_pk_bf16_f32 %0, %1, %2" : "=v"(r) : "v"(lo), "v"(hi)); return r; }
typedef float f32x2 __attribute__((ext_vector_type(2)));
struct GroupedOrder {
    int nM, nwg, G, c; const PG8_LAS int* t2e;
    __device__ void init(int nM_, int G_, int c_, const PG8_LAS int* t2e_) { nM = nM_; nwg = nM_ * 4; G = G_; c = c_; t2e = t2e_; }
    __device__ bool next(int i, Unit& u) const {
        const long L = (long)i * G + c; if (L >= nwg) return false;
        int wgid = (int)L; { const int q = nwg / NXCD, r = nwg % NXCD, xcd = wgid % NXCD, off = wgid / NXCD; wgid = (xcd < r ? xcd * (q + 1) : r * (q + 1) + (xcd - r) * q) + off; }
        const int nig = WGM * 4, gid = wgid / nig, fm = gid * WGM, gsz = (nM - fm) < WGM ? (nM - fm) : WGM;
        u.pm = fm + ((wgid % nig) % gsz); u.pn = (wgid % nig) / gsz + 4 * t2e[u.pm]; return true;
    }
    __device__ __forceinline__ void a_ready(const Unit&) const {}
    __device__ __forceinline__ void done(const Unit&) const {}
};
__device__ __forceinline__ float fast_sigmoid(float x) { return __builtin_amdgcn_rcpf(1.0f + __builtin_amdgcn_exp2f(-1.4426950408889634f * x)); }
struct EpiStoreBf16 {
    static constexpr bool PERM = true, AFTER_DRAIN = false;
    bf16_t* O; int ldc; int pn_mask; float* part;
    __device__ __forceinline__ void operator()(const f32x4 (&acc)[2][2][4][2], const Unit& u, int wr, int wc, int fr, int fq) const {
        const int pnl = u.pn & pn_mask; const int row0 = u.pm * BM + wr * 64 + fr, col0 = pnl * BM + wc * 32 + 8 * fq;
#pragma unroll
        for (int ai = 0; ai < 2; ++ai)
#pragma unroll
            for (int m = 0; m < 4; ++m) { const int row = row0 + ai * HALF + m * 16; bf16_t* rowp = O + (size_t)row * ldc + col0; float s = 0.f;
#pragma unroll
                for (int bj = 0; bj < 2; ++bj) { const f32x4 v0 = acc[ai][bj][m][0], v1 = acc[ai][bj][m][1];
                    u32x4 w; w.x = cvt_pk_bf16(v0[0], v0[1]); w.y = cvt_pk_bf16(v0[2], v0[3]); w.z = cvt_pk_bf16(v1[0], v1[1]); w.w = cvt_pk_bf16(v1[2], v1[3]);
                    *(u32x4*)(rowp + bj * HALF) = w;
                    s += (v0[0] * v0[0] + v0[1] * v0[1]) + (v0[2] * v0[2] + v0[3] * v0[3]) + (v1[0] * v1[0] + v1[1] * v1[1]) + (v1[2] * v1[2] + v1[3] * v1[3]); }
                if (part) { s += __shfl_xor(s, 16); s += __shfl_xor(s, 32); if (fq == 0) part[(size_t)row * 16 + pnl * 4 + wc] = s; } }
    }
};
struct EpiSwiglu {
    static constexpr bool PERM = true, AFTER_DRAIN = false;
    bf16_t* H;
    __device__ __forceinline__ void operator()(const f32x4 (&acc)[2][2][4][2], const Unit& u, int wr, int wc, int fr, int fq) const {
        const int pnl = u.pn & 3; const int row0 = u.pm * BM + wr * 64 + fr, col0 = pnl * HALF + wc * 32 + 8 * fq;
#pragma unroll
        for (int ai = 0; ai < 2; ++ai)
#pragma unroll
            for (int m = 0; m < 4; ++m) { bf16_t* rowp = H + (size_t)(row0 + ai * HALF + m * 16) * 512 + col0;
                f32x4 h[2];
#pragma unroll
                for (int n = 0; n < 2; ++n) { const f32x4 a = acc[ai][0][m][n], b = acc[ai][1][m][n];
#pragma unroll
                    for (int j = 0; j < 4; ++j) h[n][j] = a[j] * fast_sigmoid(a[j]) * b[j]; }
                u32x4 w; w.x = cvt_pk_bf16(h[0][0], h[0][1]); w.y = cvt_pk_bf16(h[0][2], h[0][3]); w.z = cvt_pk_bf16(h[1][0], h[1][1]); w.w = cvt_pk_bf16(h[1][2], h[1][3]);
                *(u32x4*)rowp = w; }
    }
};
struct EpiRes {
    static constexpr bool PERM = false, AFTER_DRAIN = false;
    const float* base; float* out;
    __device__ __forceinline__ void operator()(const f32x4 (&acc)[2][2][4][2], const Unit& u, int wr, int wc, int fr, int fq) const {
        const int row0 = u.pm * BM + wr * 64 + fr, col0 = u.pn * BM + wc * 32 + 4 * fq;
#pragma unroll
        for (int ai = 0; ai < 2; ++ai)
#pragma unroll
            for (int m = 0; m < 4; ++m) { const size_t off = (size_t)(row0 + ai * HALF + m * 16) * 1024 + col0;
#pragma unroll
                for (int bj = 0; bj < 2; ++bj)
#pragma unroll
                    for (int n = 0; n < 2; ++n) { const f32x4 bs = *(const f32x4*)(base + off + bj * HALF + n * 16); *(f32x4*)(out + off + bj * HALF + n * 16) = bs + acc[ai][bj][m][n]; }
                asm volatile("" ::: "memory"); }
    }
};
struct EpiGate {
    static constexpr bool PERM = false, AFTER_DRAIN = false;
    float* out; const bf16_t* peb; const float* rstdg; const float* rstde; const float* ple_norm; float* part;
    __device__ __forceinline__ void operator()(const f32x4 (&acc)[2][2][4][2], const Unit& u, int wr, int wc, int fr, int fq) const {
        const int row0 = u.pm * BM + wr * 64 + fr, col0 = u.pn * BM + wc * 32 + 4 * fq;
        f32x4 pn4[2][2];
#pragma unroll
        for (int bj = 0; bj < 2; ++bj)
#pragma unroll
            for (int n = 0; n < 2; ++n) pn4[bj][n] = *(const f32x4*)(ple_norm + col0 + bj * HALF + n * 16);
#pragma unroll
        for (int ai = 0; ai < 2; ++ai)
#pragma unroll
            for (int m = 0; m < 4; ++m) { const int row = row0 + ai * HALF + m * 16; const size_t off = (size_t)row * 1024 + col0; const float rg = rstdg[row], re = rstde[row]; float s = 0.f;
#pragma unroll
                for (int bj = 0; bj < 2; ++bj)
#pragma unroll
                    for (int n = 0; n < 2; ++n) { const size_t o = off + bj * HALF + n * 16;
                        const uint2 pe = *(const uint2*)(peb + o); f32x4 h = *(const f32x4*)(out + o); const f32x4 a = acc[ai][bj][m][n];
                        f32x4 e; e[0] = __uint_as_float(pe.x << 16); e[1] = __uint_as_float(pe.x & 0xffff0000u); e[2] = __uint_as_float(pe.y << 16); e[3] = __uint_as_float(pe.y & 0xffff0000u);
#pragma unroll
                        for (int j = 0; j < 4; ++j) { h[j] += fast_sigmoid(rg * a[j]) * (e[j] * re * pn4[bj][n][j]); s += h[j] * h[j]; }
                        *(f32x4*)(out + o) = h; }
                s += __shfl_xor(s, 16); s += __shfl_xor(s, 32); if (fq == 0) part[(size_t)row * 16 + u.pn * 4 + wc] = s;
                asm volatile("" ::: "memory"); }
    }
};

template <class Epi, class Sched, bool ALIGN_EPI = false, bool SP2 = false>
__device__ __forceinline__ void gemm_phase(PG8_LAS unsigned char* lds, const Gemm g, const Sched& S, const Epi& E) {
    int tid_l = threadIdx.x; asm volatile("" : "+v"(tid_l));
    const int tid = tid_l, wid = __builtin_amdgcn_readfirstlane(tid >> 6), lane = tid & 63, wr = wid >> 2, wc = wid & 3, fr = lane & 15, fq = lane >> 4;
    const int K = g.K, nt = K / BK;
    unsigned voffA[2], voffB[2];
#pragma unroll
    for (int i = 0; i < 2; ++i) { int R, C; stage_rc(tid * 16 + i * 8192, R, C); const int Rb = Epi::PERM ? ((R & ~31) + perm32(R & 31)) : R;
        voffA[i] = (unsigned)(R * K + C) * 2u; voffB[i] = (unsigned)(Rb * K + C) * 2u; }
    const size_t kstep = (size_t)(BK * 2);
    const size_t hstep = (size_t)HALF * K * 2;
    const size_t tstep = 2 * hstep;
    const unsigned ldsw = (unsigned)wid * 1024u;
    const int aoff = lds_byte(wr * 64 + fr, fq * 8), boff = lds_byte(wc * 32 + fr, fq * 8);
#define PG8_SA(b, h) (((b) * 2 + (h)) * HTB)
#define PG8_SB(b, h) ((4 + (b) * 2 + (h)) * HTB)
#define PG8_STAGE(bufoff, gbase, voff) do { _Pragma("unroll") for (int _i = 0; _i < 2; ++_i) \
        __builtin_amdgcn_global_load_lds((const unsigned*)((const char*)(gbase) + (voff)[_i]), (PG8_LAS unsigned*)(lds + (bufoff) + ldsw + _i * 8192), 16, 0, 0); } while (0)
#define PG8_LDA(dst, b, h) do { _Pragma("unroll") for (int m = 0; m < 4; ++m) _Pragma("unroll") for (int k = 0; k < 2; ++k) dst[m][k] = *(const PG8_LAS bf16x8*)(lds + PG8_SA(b, h) + aoff + m * 2048 + k * 1024); } while (0)
#define PG8_LDB(dst, b, h) do { _Pragma("unroll") for (int n = 0; n < 2; ++n) _Pragma("unroll") for (int k = 0; k < 2; ++k) dst[n][k] = *(const PG8_LAS bf16x8*)(lds + PG8_SB(b, h) + boff + n * 2048 + k * 1024); } while (0)
#define PG8_MMA(ai, bj, At, Bt) do { __builtin_amdgcn_s_setprio(1); _Pragma("unroll") for (int m = 0; m < 4; ++m) _Pragma("unroll") for (int n = 0; n < 2; ++n) _Pragma("unroll") for (int k = 0; k < 2; ++k) \
        acc[ai][bj][m][n] = __builtin_amdgcn_mfma_f32_16x16x32_bf16(Bt[n][k], At[m][k], acc[ai][bj][m][n], 0, 0, 0); __builtin_amdgcn_s_setprio(0); } while (0)
#define PG8_WAIT_V(n) asm volatile("s_waitcnt vmcnt(" #n ")" ::: "memory")
#define PG8_WAIT_L(n) asm volatile("s_waitcnt lgkmcnt(" #n ")" ::: "memory")
#define PG8_BAR __builtin_amdgcn_s_barrier()
#define PG8_SCHED __builtin_amdgcn_sched_barrier(0)
    Unit cur, nxt; int ui = 0;
    if (!S.next(0, cur)) return;
    f32x4 acc[2][2][4][2];
#pragma unroll
    for (int a = 0; a < 2; ++a)
#pragma unroll
        for (int b = 0; b < 2; ++b)
#pragma unroll
            for (int m = 0; m < 4; ++m)
#pragma unroll
                for (int n = 0; n < 2; ++n) acc[a][b][m][n] = (f32x4){0.f, 0.f, 0.f, 0.f};
    bf16x8 At[4][2], B0[2][2], B1[2][2];
    const char* cA = (const char*)g.A + (size_t)cur.pm * tstep; const char* cB = (const char*)g.Bt + (size_t)cur.pn * tstep;
    S.a_ready(cur);
    if constexpr (SP2) {
        PG8_STAGE(PG8_SB(0, 0), cB, voffB); PG8_STAGE(PG8_SB(0, 1), cB + hstep, voffB); PG8_STAGE(PG8_SA(0, 0), cA, voffA); PG8_STAGE(PG8_SA(0, 1), cA + hstep, voffA);
        if (wr == 1) PG8_BAR;
        PG8_WAIT_V(2); PG8_BAR;
        PG8_STAGE(PG8_SB(1, 0), cB + kstep, voffB); PG8_STAGE(PG8_SA(1, 0), cA + kstep, voffA); PG8_STAGE(PG8_SB(1, 1), cB + hstep + kstep, voffB);
        PG8_WAIT_V(6); PG8_BAR;
    } else {
        PG8_STAGE(PG8_SB(0, 0), cB, voffB); PG8_STAGE(PG8_SA(0, 0), cA, voffA); PG8_STAGE(PG8_SB(0, 1), cB + hstep, voffB); PG8_STAGE(PG8_SA(0, 1), cA + hstep, voffA);
        if (wr == 1) PG8_BAR;
        PG8_WAIT_V(4); PG8_BAR;
        PG8_STAGE(PG8_SB(1, 0), cB + kstep, voffB); PG8_STAGE(PG8_SA(1, 0), cA + kstep, voffA); PG8_STAGE(PG8_SB(1, 1), cB + hstep + kstep, voffB);
        PG8_WAIT_V(6); PG8_BAR;
    }
    for (;;) {
        const bool has_next = S.next(ui + 1, nxt);
        const char* nA = has_next ? (const char*)g.A + (size_t)nxt.pm * tstep : cA; const char* nB = has_next ? (const char*)g.Bt + (size_t)nxt.pn * tstep : cB;
        for (int t = 0; t < nt; t += 2) {
            const bool last = (t == nt - 2);
            const char* a1 = cA + (size_t)(t + 1) * kstep;
            const char* a2 = last ? nA : cA + (size_t)(t + 2) * kstep; const char* b2 = last ? nB : cB + (size_t)(t + 2) * kstep;
            const char* a3 = a2 + kstep; const char* b3 = b2 + kstep;
            if (last && has_next) S.a_ready(nxt);
            if constexpr (SP2) {
            PG8_LDB(B0, 0, 0); PG8_LDB(B1, 0, 1); PG8_SCHED; PG8_LDA(At, 0, 0); PG8_STAGE(PG8_SA(1, 1), a1 + hstep, voffA);
            PG8_WAIT_V(8); PG8_WAIT_L(0); PG8_BAR; PG8_MMA(0, 0, At, B0); PG8_MMA(0, 1, At, B1); PG8_BAR; PG8_SCHED;
            PG8_LDA(At, 0, 1); PG8_STAGE(PG8_SB(0, 0), b2, voffB); PG8_STAGE(PG8_SB(0, 1), b2 + hstep, voffB); PG8_STAGE(PG8_SA(0, 0), a2, voffA);
            PG8_WAIT_V(8); PG8_WAIT_L(0); PG8_BAR; PG8_MMA(1, 0, At, B0); PG8_MMA(1, 1, At, B1); PG8_BAR; PG8_SCHED;
            PG8_LDB(B0, 1, 0); PG8_LDB(B1, 1, 1); PG8_SCHED; PG8_LDA(At, 1, 0); PG8_STAGE(PG8_SA(0, 1), a2 + hstep, voffA);
            PG8_WAIT_V(8); PG8_WAIT_L(0); PG8_BAR; PG8_MMA(0, 0, At, B0); PG8_MMA(0, 1, At, B1); PG8_BAR; PG8_SCHED;
            PG8_LDA(At, 1, 1); PG8_STAGE(PG8_SB(1, 0), b3, voffB); PG8_STAGE(PG8_SB(1, 1), b3 + hstep, voffB); PG8_STAGE(PG8_SA(1, 0), a3, voffA);
            PG8_WAIT_V(8); PG8_WAIT_L(0); PG8_BAR; PG8_MMA(1, 0, At, B0); PG8_MMA(1, 1, At, B1); PG8_BAR; PG8_SCHED;
            } else {
            PG8_LDB(B0, 0, 0); PG8_SCHED; PG8_LDA(At, 0, 0); PG8_STAGE(PG8_SA(1, 1), a1 + hstep, voffA);
            PG8_WAIT_L(8); PG8_BAR; PG8_WAIT_L(0); PG8_MMA(0, 0, At, B0); PG8_BAR; PG8_SCHED;
            PG8_LDB(B1, 0, 1); PG8_STAGE(PG8_SB(0, 0), b2, voffB);
            PG8_BAR; PG8_WAIT_L(0); PG8_MMA(0, 1, At, B1); PG8_BAR;
            PG8_LDA(At, 0, 1); PG8_STAGE(PG8_SA(0, 0), a2, voffA);
            PG8_BAR; PG8_WAIT_L(0); PG8_MMA(1, 0, At, B0); PG8_BAR; PG8_SCHED;
            PG8_STAGE(PG8_SB(0, 1), b2 + hstep, voffB);
            PG8_WAIT_V(6); PG8_BAR; PG8_MMA(1, 1, At, B1); PG8_BAR;
            PG8_LDB(B0, 1, 0); PG8_SCHED; PG8_LDA(At, 1, 0); PG8_STAGE(PG8_SA(0, 1), a2 + hstep, voffA);
            PG8_WAIT_L(8); PG8_BAR; PG8_WAIT_L(0); PG8_MMA(0, 0, At, B0); PG8_BAR; PG8_SCHED;
            PG8_LDB(B1, 1, 1); PG8_STAGE(PG8_SB(1, 0), b3, voffB);
            PG8_BAR; PG8_WAIT_L(0); PG8_MMA(0, 1, At, B1); PG8_BAR;
            PG8_LDA(At, 1, 1); PG8_STAGE(PG8_SA(1, 0), a3, voffA);
            PG8_BAR; PG8_WAIT_L(0); PG8_MMA(1, 0, At, B0); PG8_BAR; PG8_SCHED;
            PG8_STAGE(PG8_SB(1, 1), b3 + hstep, voffB);
            PG8_WAIT_V(6); PG8_BAR; PG8_MMA(1, 1, At, B1); PG8_BAR;
            }
        }
        if constexpr (ALIGN_EPI) { if (wr == 0) PG8_BAR; }
        if constexpr (!Epi::AFTER_DRAIN) { E(acc, cur, wr, wc, fr, fq); S.done(cur); }
        if (!has_next) break;
#pragma unroll
        for (int a = 0; a < 2; ++a)
#pragma unroll
            for (int b = 0; b < 2; ++b)
#pragma unroll
                for (int m = 0; m < 4; ++m)
#pragma unroll
                    for (int n = 0; n < 2; ++n) acc[a][b][m][n] = (f32x4){0.f, 0.f, 0.f, 0.f};
        cur = nxt; cA = nA; cB = nB; ++ui;
        if constexpr (ALIGN_EPI) { if (wr == 1) PG8_BAR; }
    }
    PG8_WAIT_V(0);
    if constexpr (!ALIGN_EPI) { if (wr == 0) PG8_BAR; }
    PG8_BAR;
    if constexpr (Epi::AFTER_DRAIN) { E.fused(acc, cur, wr, wc, fr, fq, lds, wid, lane); S.done(cur); }
#undef PG8_SA
#undef PG8_SB
#undef PG8_STAGE
#undef PG8_LDA
#undef PG8_LDB
#undef PG8_MMA
#undef PG8_WAIT_V
#undef PG8_WAIT_L
#undef PG8_BAR
#undef PG8_SCHED
}
}
#define XB_TMO      128
#define XB_XCNT(j)  (256  + 64 * (j))
#define XB_XSUB(j)  (1280 + 64 * (j))
#define XB_XGEN(j)  (2304 + 64 * (j))
#define XB_TOP      3328
#define XB_TOPGEN   3392
#define XCD_BAR_WORDS 3456
#define XB_SPIN_CAP (1u << 18)

__device__ __forceinline__ unsigned xb_ld(unsigned* p)              { return __hip_atomic_load(p, __ATOMIC_RELAXED, __HIP_MEMORY_SCOPE_AGENT); }
__device__ __forceinline__ unsigned xb_add(unsigned* p, unsigned v) { return __hip_atomic_fetch_add(p, v, __ATOMIC_RELAXED, __HIP_MEMORY_SCOPE_AGENT); }
__device__ __forceinline__ unsigned xb_xcc_id() { return (unsigned)__builtin_amdgcn_s_getreg((3 << 11) | 20) & 0xFu; }
#define XB_SPIN(cond, bar) do { unsigned _sp = 0; while (cond) { __builtin_amdgcn_s_sleep(1); \
    if ((++_sp & 255u) == 0u) { if (xb_ld(&(bar)[XB_TMO])) break; if (_sp > XB_SPIN_CAP) { atomicAdd(&(bar)[XB_TMO], 1u); break; } } } } while (0)

struct XcdBarrier {
    unsigned* bar; unsigned x;
    volatile LAS unsigned* st;
};

__device__ __forceinline__ XcdBarrier xcd_barrier_post(unsigned* bar, volatile LAS unsigned* st) {
    XcdBarrier b; b.bar = bar; b.x = xb_xcc_id(); b.st = st;
    if (threadIdx.x == 0) (void)xb_add(&bar[XB_XCNT(b.x)], 1u);
    return b;
}
__device__ __forceinline__ void xcd_barrier_complete(unsigned* bar, unsigned x, unsigned& nloc, unsigned& nx) {
    const unsigned G = gridDim.x * gridDim.y * gridDim.z;
    unsigned sum, cnt, mine, sp = 0u;
    for (;;) {
        sum = 0u; cnt = 0u; mine = 0u;
#pragma unroll
        for (unsigned j = 0; j < 16; ++j) { const unsigned c = xb_ld(&bar[XB_XCNT(j)]); sum += c; cnt += (c > 0u) ? 1u : 0u; mine = (j == x) ? c : mine; }
        if (sum == G) break;
        __builtin_amdgcn_s_sleep(1);
        if ((++sp & 255u) == 0u) { if (xb_ld(&bar[XB_TMO])) break; if (sp > XB_SPIN_CAP) { atomicAdd(&bar[XB_TMO], 1u); break; } }
    }
    nloc = mine > 0u ? mine : 1u; nx = cnt > 0u ? cnt : 1u;
}

__device__ __forceinline__ void xcd_barrier(const XcdBarrier& b) {
    asm volatile("s_waitcnt vmcnt(0)" ::: "memory");
    __syncthreads();
    if (threadIdx.x == 0) {
        unsigned* bar = b.bar;
        __builtin_amdgcn_s_waitcnt(0);
        unsigned nloc = b.st[0], nx = b.st[1];
        if (nloc == 0u) { xcd_barrier_complete(bar, b.x, nloc, nx); b.st[0] = nloc; b.st[1] = nx; }
        const unsigned old = xb_add(&bar[XB_XSUB(b.x)], 1u);
        const unsigned gen = old / nloc;
        if (old + 1u == (gen + 1u) * nloc) {
            __builtin_amdgcn_fence(__ATOMIC_RELEASE, "agent");
            asm volatile("s_waitcnt vmcnt(0)" ::: "memory");
            const unsigned og = xb_add(&bar[XB_TOP], 1u);
            const unsigned tg = og / nx;
            if (og + 1u == (tg + 1u) * nx) xb_add(&bar[XB_TOPGEN], 1u);
            else XB_SPIN(xb_ld(&bar[XB_TOPGEN]) == tg, bar);
            __builtin_amdgcn_fence(__ATOMIC_ACQUIRE, "agent");
            xb_add(&bar[XB_XGEN(b.x)], 1u);
            asm volatile("s_waitcnt vmcnt(0)" ::: "memory");
        } else {
            XB_SPIN(xb_ld(&bar[XB_XGEN(b.x)]) == gen, bar);
            __builtin_amdgcn_fence(__ATOMIC_ACQUIRE, "agent");
            asm volatile("s_waitcnt vmcnt(0)" ::: "memory");
        }
    }
    __syncthreads();
}
typedef float f4v __attribute__((ext_vector_type(4)));
struct Params {
    const float *x, *p; const int* pos;
    const float *attn_norm, *w_in, *conv_w, *conv_b, *b_ig, *b_fg, *ret_gn, *ml_gn, *w_out, *moe_norm, *w_group, *b_group, *w_router, *b_router,
                *w1, *w3, *w2, *w_up, *ple_norm, *pg_norm, *w_gate, *final_norm;
    float* out; unsigned char* ws;
};

__device__ __forceinline__ void load4(const float* p, float (&o)[4]) { const float4 v = *(const float4*)p; o[0] = v.x; o[1] = v.y; o[2] = v.z; o[3] = v.w; }
__device__ __forceinline__ void load4(const bf16_t* p, float (&o)[4]) { const uint2 v = *(const uint2*)p; o[0] = __uint_as_float(v.x << 16); o[1] = __uint_as_float(v.x & 0xffff0000u); o[2] = __uint_as_float(v.y << 16); o[3] = __uint_as_float(v.y & 0xffff0000u); }

__device__ __forceinline__ void transpose_item(const float* W, int ldw, const float* gain, bf16_t* WT, int K, int kb, int n0, size_t drow0, LAS float* scr, int lane) {
    const int k0 = 64 * kb;
#pragma unroll 8
    for (int i = 0; i < 32; ++i) { const int kk = 2 * i + (lane >> 5); float w = W[(size_t)(k0 + kk) * ldw + n0 + (lane & 31)]; if (gain) w *= gain[k0 + kk]; scr[kk * 33 + (lane & 31)] = w; }
    LDS_WAIT(); asm volatile("" ::: "memory");
    const int c = lane & 7;
#pragma unroll
    for (int j = 0; j < 4; ++j) { const int n = (lane >> 3) + 8 * j; const LAS float* s = scr + (8 * c) * 33 + n;
        v4u o; o.x = pk2(s[0 * 33], s[1 * 33]); o.y = pk2(s[2 * 33], s[3 * 33]); o.z = pk2(s[4 * 33], s[5 * 33]); o.w = pk2(s[6 * 33], s[7 * 33]);
        *(GAS v4u*)(WT + (drow0 + n) * K + k0 + 8 * c) = o; }
    LDS_WAIT(); asm volatile("" ::: "memory");
}

constexpr int NPHASES = 14;
template <int LO, int HI>
__global__ void __launch_bounds__(NTHREADS, 2) mk(Params P) {
    extern __shared__ __attribute__((aligned(16))) unsigned char lds_raw[];
    float* ldsf = (float*)lds_raw;
    LAS unsigned char* ldsl = (LAS unsigned char*)lds_raw;
    const int G = gridDim.x, bid = blockIdx.x, NGW = G * NWAVES;
#define PH_IDS int tid = threadIdx.x; asm volatile("" : "+v"(tid)); const int lane = tid & 63, wave = __builtin_amdgcn_readfirstlane(tid >> 6), gw = bid * NWAVES + wave; (void)lane; (void)gw;
    unsigned char* const ws = P.ws;
#define rstd1 ((float*)(ws + WS_RSTD1))
#define gates ((float*)(ws + WS_GATES))
#define rstdg ((float*)(ws + WS_RSTDG))
#define rstde ((float*)(ws + WS_RSTDE))
#define eid ((int*)(ws + WS_EID))
#define posn ((int*)(ws + WS_POS))
#define gate ((float*)(ws + WS_GATE))
#define mn ((float*)(ws + WS_MN))
#define ml ((float*)(ws + WS_ML))
#define mbl ((float*)(ws + WS_MBL))
#define mm ((float*)(ws + WS_MM))
#define list ((int*)(ws + WS_LIST))
#define cnt ((int*)(ws + WS_CTL) + CW_CNT)
#define part ((float*)(ws + WS_PART))
#define part2 ((float*)(ws + WS_PART2))
#define win_t ((bf16_t*)(ws + WS_WIN))
#define wout_t ((bf16_t*)(ws + WS_WOUT))
#define w13_t ((bf16_t*)(ws + WS_W13))
#define w2_t ((bf16_t*)(ws + WS_W2))
#define wgate_t ((bf16_t*)(ws + WS_WGATE))
#define wup_t ((bf16_t*)(ws + WS_WUP))
#define proj ((bf16_t*)(ws + WS_PROJ))
#define hbuf ((bf16_t*)(ws + WS_HBUF))
#define xs ((bf16_t*)(ws + WS_XS))
#define ybuf ((bf16_t*)(ws + WS_YBUF))
#define peb ((bf16_t*)(ws + WS_PEB))
#define yreg ((bf16_t*)(ws + WS_YREG))
#define pb ((bf16_t*)(ws + WS_PB))
    float* const out = P.out;
#define rst ((float*)((unsigned char*)out + OUT_RST))
#define mst ((float*)((unsigned char*)out + OUT_MST))
    LAS int* s_off = (LAS int*)(ldsl + LDSX_OFF + 256);
    LAS int* s_cnt = s_off + 40;
    LAS int* s_t2e = s_off + 80;
#define IN(k) (LO <= (k) && (k) < HI)
#define GRID_BAR(k) do { if constexpr (IN(k) && IN((k) + 1)) xcd_barrier(bar); } while (0)
    XcdBarrier bar; bar.bar = (unsigned*)(ws + WS_CTL) + CW_BAR; bar.x = 0; bar.st = nullptr;
    if constexpr (HI - LO > 1) {
        PH_IDS
        volatile LAS unsigned* st = (volatile LAS unsigned*)(ldsl + LDSX_OFF);
        if (tid == 0) { st[0] = 0u; st[1] = 0u; }
        __syncthreads();
        bar = xcd_barrier_post((unsigned*)(ws + WS_CTL) + CW_BAR, st);
    }

    if constexpr (IN(0)) {
        PH_IDS
        {
            LAS float* scr = (LAS float*)(ldsl + wave * 16384);
            constexpr int I0 = 16 * 128, I1 = 16 * 32, I2 = 64 * 256, I3 = 32 * 256, I4 = 16 * 32, I5 = 4 * 32;
            for (int it = gw; it < I0 + I1 + I2 + I3 + I4 + I5; it += NGW) {
                int r = it;
                if (r < I0) { transpose_item(P.w_in, NPROJ, P.attn_norm, win_t, D, r / 128, 32 * (r % 128), (size_t)(32 * (r % 128)), scr, lane); continue; } r -= I0;
                if (r < I1) { transpose_item(P.w_out, D, nullptr, wout_t, D, r / 32, 32 * (r % 32), (size_t)(32 * (r % 32)), scr, lane); continue; } r -= I1;
                if (r < I2) { const int mat = r >> 8, q = r & 255, e = mat >> 1, which = mat & 1, kb = q >> 4, n0 = 32 * (q & 15);
                    const float* W = (which ? P.w3 : P.w1) + (size_t)e * D * DE;
                    transpose_item(W, DE, nullptr, w13_t, D, kb, n0, (size_t)e * 1024 + (size_t)((n0 >> 7) * 256 + which * 128 + (n0 & 127)), scr, lane); continue; } r -= I2;
                if (r < I3) { const int e = r >> 8, q = r & 255, kb = q >> 5, n0 = 32 * (q & 31);
                    transpose_item(P.w2 + (size_t)e * DE * D, D, nullptr, w2_t, DE, kb, n0, (size_t)e * 1024 + n0, scr, lane); continue; } r -= I3;
                if (r < I4) { transpose_item(P.w_gate, D, P.pg_norm, wgate_t, D, r / 32, 32 * (r % 32), (size_t)(32 * (r % 32)), scr, lane); continue; } r -= I4;
                transpose_item(P.w_up, D, nullptr, wup_t, PLE, r / 32, 32 * (r % 32), (size_t)(32 * (r % 32)), scr, lane);
            }
        }
        __syncthreads();
        {
            LAS float* gwl = (LAS float*)ldsl;
            for (int idx = tid; idx < D * 8; idx += NTHREADS) { const int k = idx >> 3, j = idx & 7; gwl[idx] = P.w_in[(size_t)k * NPROJ + NP + j] * P.attn_norm[k]; }
            __syncthreads();
            for (int row = gw; row < T; row += NGW) {
                const float4* xr = (const float4*)(P.x + (size_t)row * D) + lane;
                float4 v[4]; float ss = 0.f;
#pragma unroll
                for (int j = 0; j < 4; ++j) { v[j] = xr[64 * j]; ss += v[j].x * v[j].x + v[j].y * v[j].y + v[j].z * v[j].z + v[j].w * v[j].w; }
                ss = wave_sum(ss);
                const float rstd = 1.0f / sqrtf(ss * (1.0f / D) + EPS);
                float g8[8];
#pragma unroll
                for (int i = 0; i < 8; ++i) g8[i] = 0.f;
#pragma unroll
                for (int j = 0; j < 4; ++j) {
                    const int k0 = 4 * (lane + 64 * j);
                    const float xs_[4] = {v[j].x * rstd, v[j].y * rstd, v[j].z * rstd, v[j].w * rstd};
                    uint2 o; o.x = pk2(xs_[0], xs_[1]); o.y = pk2(xs_[2], xs_[3]);
                    *(uint2*)(yreg + (size_t)row * D + k0) = o;
#pragma unroll
                    for (int i = 0; i < 4; ++i) {
                        const LAS f4v* wr = (const LAS f4v*)(gwl + (k0 + i) * 8);
                        const f4v w0 = wr[0], w1 = wr[1];
                        g8[0] += xs_[i] * w0.x; g8[1] += xs_[i] * w0.y; g8[2] += xs_[i] * w0.z; g8[3] += xs_[i] * w0.w;
                        g8[4] += xs_[i] * w1.x; g8[5] += xs_[i] * w1.y; g8[6] += xs_[i] * w1.z; g8[7] += xs_[i] * w1.w;
                    }
                }
#pragma unroll
                for (int i = 0; i < 8; ++i) g8[i] = wave_sum(g8[i]);
                if (lane == 0) {
                    rstd1[row] = rstd;
                    *(float4*)(gates + (size_t)row * 8) = make_float4(g8[0], g8[1], g8[2], g8[3]);
                    *(float4*)(gates + (size_t)row * 8 + 4) = make_float4(g8[4], g8[5], g8[6], g8[7]);
                }
            }
            for (int row = gw; row < T; row += NGW) {
                const float4 v = ((const float4*)(P.p + (size_t)row * PLE))[lane];
                uint2 o; o.x = pk2(v.x, v.y); o.y = pk2(v.z, v.w);
                ((uint2*)(pb + (size_t)row * PLE))[lane] = o;
            }
        }
        __syncthreads();
    }
    GRID_BAR(0);
    if constexpr (IN(1)) {
        PH_IDS
        pg8::Gemm g{yreg, win_t, T, NP, D}; pg8::StaticOrder S; S.init(T, NP, G, bid);
        pg8::EpiStoreBf16 E{proj, NP, 0xffff, nullptr};
        pg8::gemm_phase<pg8::EpiStoreBf16, pg8::StaticOrder, true, true>(ldsl, g, S, E);
    }
    GRID_BAR(1);
    if constexpr (IN(2)) {
        PH_IDS
        const int nitems = BATCH * NCH * (RH + MH);
        for (int it = bid; it < nitems; it += G) {
            const int bn = it / (RH + MH), hh = it % (RH + MH), b = bn / NCH, n = bn % NCH;
            const size_t t0 = (size_t)b * SEQ + (size_t)n * CH;
            __syncthreads();
            if (hh < RH) {
                const int h = hh;
                float* kk = ldsf; float* vv = ldsf + CH * RD;
                const float lg = log1pf(-exp2f(-5.0f - (float)h));
                for (int idx = tid; idx < CH * 32; idx += NTHREADS) {
                    const int c = idx >> 5, j = idx & 31; const size_t t = t0 + c;
                    const float ang = (float)P.pos[t] * powf(10000.0f, -(float)j / 32.0f);
                    float sn, cs; sincosf(ang, &sn, &cs);
                    const float x1 = bf2f(proj[t * NP + C_RK + h * RD + j]), x2 = bf2f(proj[t * NP + C_RK + h * RD + 32 + j]);
                    const float wst = expf(lg * (float)(CH - 1 - c)) * 0.125f;
                    kk[c * RD + j] = (x1 * cs - x2 * sn) * wst; kk[c * RD + 32 + j] = (x1 * sn + x2 * cs) * wst;
                }
                for (int idx = tid; idx < CH * RD; idx += NTHREADS) { const int c = idx >> 6, e = idx & 63; vv[idx] = bf2f(proj[(t0 + c) * NP + C_RV + h * RD + e]); }
                __syncthreads();
                const int d = tid >> 3, e0 = (tid & 7) * 8;
                float acc[8];
#pragma unroll
                for (int i = 0; i < 8; ++i) acc[i] = 0.f;
                for (int c = 0; c < CH; ++c) { const float kv = kk[c * RD + d];
#pragma unroll
                    for (int i = 0; i < 8; ++i) acc[i] += kv * vv[c * RD + e0 + i]; }
                float* dst = rst + ((size_t)(bn * RH + h) * RD + d) * RD + e0;
#pragma unroll
                for (int i = 0; i < 8; ++i) dst[i] = acc[i];
            } else {
                const int h = hh - RH;
                float* kk = ldsf; float* sw = ldsf + CH * MD; float* sb = sw + CH;
                if (tid < CH) {
                    const size_t t = t0 + tid;
                    sw[tid] = gates[t * 8 + h] + P.b_ig[h];
                    sb[tid] = logsigmoidf_(gates[t * 8 + 4 + h] + P.b_fg[h]);
                }
                __syncthreads();
                if (tid == 0) { float run = 0.f; for (int c = 0; c < CH; ++c) { run += sb[c]; sb[c] = run; } }
                __syncthreads();
                const float bL = sb[CH - 1];
                float mloc = -INFINITY;
                for (int c = 0; c < CH; ++c) mloc = fmaxf(mloc, bL - sb[c] + sw[c]);
                __syncthreads();
                if (tid < CH) sw[tid] = expf(bL - sb[tid] + sw[tid] - mloc);
                for (int idx = tid; idx < CH * MD; idx += NTHREADS) {
                    const int c = idx >> 7, d = idx & 127; const int s = n * CH + c; const int chn = 512 + h * MD + d;
                    float a = P.conv_b[chn];
#pragma unroll
                    for (int w = 0; w < 4; ++w) { const int ss = s - 3 + w; if (ss >= 0) a += bf2f(proj[((size_t)b * SEQ + ss) * NP + C_MK + h * MD + d]) * P.conv_w[w * 1024 + chn]; }
                    kk[idx] = siluf_(a) * 0.08838834764831845f;
                }
                __syncthreads();
                const int d = tid >> 2, e0 = (tid & 3) * 32;
                float acc[32]; float nacc = 0.f;
#pragma unroll
                for (int i = 0; i < 32; ++i) acc[i] = 0.f;
                for (int c = 0; c < CH; ++c) {
                    const float kv = kk[c * MD + d] * sw[c]; nacc += kv;
                    const bf16_t* vp = proj + (t0 + c) * NP + C_MV + h * MD + e0;
#pragma unroll
                    for (int i = 0; i < 32; ++i) acc[i] += kv * bf2f(vp[i]);
                }
                const int sidx = bn * MH + h;
                float* dst = mst + ((size_t)sidx * MD + d) * MD + e0;
#pragma unroll
                for (int i = 0; i < 32; ++i) dst[i] = acc[i];
                if ((tid & 3) == 0) mn[(size_t)sidx * MD + d] = nacc;
                if (tid == 0) { ml[sidx] = mloc; mbl[sidx] = bL; }
            }
        }
        __syncthreads();
    }
    GRID_BAR(2);
    if constexpr (IN(3)) {
        PH_IDS
        const long NT = (long)G * NTHREADS; const long NR = (long)BATCH * RH * RD * RD, NM = (long)BATCH * MH * MD * MD, NN = (long)BATCH * MH * MD;
        for (long idx = (long)bid * NTHREADS + tid; idx < NR + NM + NN; idx += NT) {
            if (idx < NR) {
                const int el = (int)(idx % (RD * RD)); const int bh = (int)(idx / (RD * RD)); const int b = bh / RH, h = bh % RH;
                const float dec = expf(log1pf(-exp2f(-5.0f - (float)h)) * (float)CH);
                float R = 0.f;
                for (int n = 0; n < NCH; ++n) { float* ptr = rst + ((size_t)((b * NCH + n) * RH + h)) * (RD * RD) + el; const float tmp = *ptr; *ptr = R; R = dec * R + tmp; }
            } else {
                const long j = idx - NR; const bool isn = j >= NM;
                const long jj = isn ? j - NM : j; const int per = isn ? MD : MD * MD;
                const int el = (int)(jj % per); const int bh = (int)(jj / per); const int b = bh / MH, h = bh % MH;
                float S = 0.f, m = 0.f;
                for (int n = 0; n < NCH; ++n) {
                    const int sidx = (b * NCH + n) * MH + h;
                    const float bL = mbl[sidx], mloc = ml[sidx];
                    const float mnew = fmaxf(bL + m, mloc);
                    const float dec = expf(bL + m - mnew), sc = expf(mloc - mnew);
                    float* ptr = isn ? mn + (size_t)sidx * MD + el : mst + (size_t)sidx * (MD * MD) + el;
                    const float tmp = *ptr; *ptr = S; S = dec * S + sc * tmp;
                    if (isn && el == 0) mm[sidx] = m;
                    m = mnew;
                }
            }
        }
    }
    GRID_BAR(3);
    if constexpr (IN(4)) {
        PH_IDS
        const int nitems = BATCH * NCH * (RH + MH);
        for (int it = bid; it < nitems; it += G) {
            const int bn = it / (RH + MH), hh = it % (RH + MH), b = bn / NCH, n = bn % NCH;
            const size_t t0 = (size_t)b * SEQ + (size_t)n * CH;
            __syncthreads();
            if (hh < RH) {
                const int h = hh;
                float* qq = ldsf; float* kk = qq + CH * RD; float* vv = kk + CH * RD; float* Rp = vv + CH * RD;
                const float lg = log1pf(-exp2f(-5.0f - (float)h));
                for (int idx = tid; idx < CH * 32; idx += NTHREADS) {
                    const int c = idx >> 5, j = idx & 31; const size_t t = t0 + c;
                    const float ang = (float)P.pos[t] * powf(10000.0f, -(float)j / 32.0f);
                    float sn, cs; sincosf(ang, &sn, &cs);
                    float x1 = bf2f(proj[t * NP + C_RK + h * RD + j]), x2 = bf2f(proj[t * NP + C_RK + h * RD + 32 + j]);
                    kk[c * RD + j] = (x1 * cs - x2 * sn) * 0.125f; kk[c * RD + 32 + j] = (x1 * sn + x2 * cs) * 0.125f;
                    x1 = bf2f(proj[t * NP + C_RQ + h * RD + j]); x2 = bf2f(proj[t * NP + C_RQ + h * RD + 32 + j]);
                    qq[c * RD + j] = (x1 * cs - x2 * sn); qq[c * RD + 32 + j] = (x1 * sn + x2 * cs);
                }
                for (int idx = tid; idx < CH * RD; idx += NTHREADS) { const int c = idx >> 6, e = idx & 63; vv[idx] = bf2f(proj[(t0 + c) * NP + C_RV + h * RD + e]); }
                for (int idx = tid; idx < RD * RD; idx += NTHREADS) Rp[idx] = rst[(size_t)(bn * RH + h) * (RD * RD) + idx];
                __syncthreads();
                const int c = tid >> 2, e0 = (tid & 3) * 16;
                float acc[16];
#pragma unroll
                for (int i = 0; i < 16; ++i) acc[i] = 0.f;
                for (int j = 0; j <= c; ++j) {
                    float s = 0.f;
                    for (int d = 0; d < RD; ++d) s += qq[c * RD + d] * kk[j * RD + d];
                    s *= expf(lg * (float)(c - j));
#pragma unroll
                    for (int i = 0; i < 16; ++i) acc[i] += s * vv[j * RD + e0 + i];
                }
                const float wq = expf(lg * (float)(c + 1));
                for (int d = 0; d < RD; ++d) { const float qv = qq[c * RD + d] * wq;
#pragma unroll
                    for (int i = 0; i < 16; ++i) acc[i] += qv * Rp[d * RD + e0 + i]; }
                float ss = 0.f;
#pragma unroll
                for (int i = 0; i < 16; ++i) ss += acc[i] * acc[i];
                ss += __shfl_xor(ss, 1); ss += __shfl_xor(ss, 2);
                const float rn = 1.0f / sqrtf(ss * (1.0f / RD) + EPS);
                const size_t t = t0 + c;
#pragma unroll
                for (int i = 0; i < 16; ++i) {
                    const int e = e0 + i; const float g = bf2f(proj[t * NP + C_RG + h * RD + e]);
                    yreg[t * D + h * RD + e] = (bf16_t)f2bf(siluf_(g) * acc[i] * rn * P.ret_gn[h * RD + e]);
                }
            } else {
                const int h = hh - RH; const int sidx = bn * MH + h;
                float* qq = ldsf; float* kk = qq + CH * MD; float* sb = kk + CH * MD; float* sg = sb + CH; float* spm = sg + CH;
                if (tid < CH) {
                    const size_t t = t0 + tid;
                    sg[tid] = gates[t * 8 + h] + P.b_ig[h];
                    sb[tid] = logsigmoidf_(gates[t * 8 + 4 + h] + P.b_fg[h]);
                }
                __syncthreads();
                if (tid == 0) { float run = 0.f, pm = -INFINITY; for (int c = 0; c < CH; ++c) { run += sb[c]; sb[c] = run; const float g = sg[c] - run; sg[c] = g; pm = fmaxf(pm, g); spm[c] = pm; } }
                for (int idx = tid; idx < CH * MD; idx += NTHREADS) {
                    const int c = idx >> 7, d = idx & 127; const int s = n * CH + c;
                    float aq = P.conv_b[h * MD + d], ak = P.conv_b[512 + h * MD + d];
#pragma unroll
                    for (int w = 0; w < 4; ++w) { const int ss = s - 3 + w; if (ss >= 0) { const size_t tt = (size_t)b * SEQ + ss;
                        aq += bf2f(proj[tt * NP + C_MQ + h * MD + d]) * P.conv_w[w * 1024 + h * MD + d];
                        ak += bf2f(proj[tt * NP + C_MK + h * MD + d]) * P.conv_w[w * 1024 + 512 + h * MD + d]; } }
                    qq[idx] = siluf_(aq); kk[idx] = siluf_(ak) * 0.08838834764831845f;
                }
                __syncthreads();
                const float mprev = mm[sidx];
                const int c = tid >> 2, e0 = (tid & 3) * 32;
                const float bc = sb[c], mrow = bc + fmaxf(spm[c], mprev);
                float acc[32]; float den = 0.f;
#pragma unroll
                for (int i = 0; i < 32; ++i) acc[i] = 0.f;
                for (int j = 0; j <= c; ++j) {
                    float s = 0.f;
                    for (int d = 0; d < MD; ++d) s += qq[c * MD + d] * kk[j * MD + d];
                    const float pj = expf(bc + sg[j] - mrow) * s; den += pj;
                    const bf16_t* vp = proj + (t0 + j) * NP + C_MV + h * MD + e0;
#pragma unroll
                    for (int i = 0; i < 32; ++i) acc[i] += pj * bf2f(vp[i]);
                }
                const float wi = expf(bc + mprev - mrow);
                const float* Sp = mst + (size_t)sidx * (MD * MD); const float* np_ = mn + (size_t)sidx * MD;
                for (int d = 0; d < MD; ++d) { const float qv = qq[c * MD + d] * wi; den += qv * np_[d];
#pragma unroll
                    for (int i = 0; i < 32; ++i) acc[i] += qv * Sp[d * MD + e0 + i]; }
                const float dn = fmaxf(fabsf(den), expf(-mrow));
                const size_t t = t0 + c; float ss = 0.f;
#pragma unroll
                for (int i = 0; i < 32; ++i) { const float o = bf2f(proj[t * NP + C_MO + h * MD + e0 + i]); acc[i] = sigmoidf_(o) * acc[i] / dn; ss += acc[i] * acc[i]; }
                ss += __shfl_xor(ss, 1); ss += __shfl_xor(ss, 2);
                const float rn = 1.0f / sqrtf(ss * (1.0f / MD) + EPS);
#pragma unroll
                for (int i = 0; i < 32; ++i) yreg[t * D + 512 + h * MD + e0 + i] = (bf16_t)f2bf(acc[i] * rn * P.ml_gn[h * MD + e0 + i]);
            }
        }
        __syncthreads();
    }
    GRID_BAR(4);
    if constexpr (IN(5)) {
        PH_IDS
        pg8::Gemm g{yreg, wout_t, T, D, D}; pg8::StaticOrder S; S.init(T, D, G, bid);
        pg8::EpiRes E{P.x, out};
        pg8::gemm_phase<pg8::EpiRes, pg8::StaticOrder, true, true>(ldsl, g, S, E);
    }
    GRID_BAR(5);
    if constexpr (IN(6)) {
        PH_IDS
        for (int row = gw; row < T; row += NGW) {
            const float4* hr = (const float4*)(out + (size_t)row * D) + lane;
            float4 v[4]; float ss = 0.f;
#pragma unroll
            for (int j = 0; j < 4; ++j) { v[j] = hr[64 * j]; ss += v[j].x * v[j].x + v[j].y * v[j].y + v[j].z * v[j].z + v[j].w * v[j].w; }
            ss = wave_sum(ss);
            const float rstd = 1.0f / sqrtf(ss * (1.0f / D) + EPS);
            float lg[36];
#pragma unroll
            for (int i = 0; i < 36; ++i) lg[i] = 0.f;
#pragma unroll 1
            for (int j = 0; j < 4; ++j) {
                const int k0 = 4 * (lane + 64 * j);
                const float4 nv = *(const float4*)(P.moe_norm + k0);
                const float4 vj = hr[64 * j];
                const float xs_[4] = {vj.x * nv.x * rstd, vj.y * nv.y * rstd, vj.z * nv.z * rstd, vj.w * nv.w * rstd};
                uint2 o; o.x = pk2(xs_[0], xs_[1]); o.y = pk2(xs_[2], xs_[3]);
                *(uint2*)(yreg + (size_t)row * D + k0) = o;
#pragma unroll 1
                for (int i = 0; i < 4; ++i) {
                    const float xv = i == 0 ? xs_[0] : i == 1 ? xs_[1] : i == 2 ? xs_[2] : xs_[3];
                    const float4 wg = *(const float4*)(P.w_group + (size_t)(k0 + i) * 4);
                    lg[0] += xv * wg.x; lg[1] += xv * wg.y; lg[2] += xv * wg.z; lg[3] += xv * wg.w;
                    const float4* wr = (const float4*)(P.w_router + (size_t)(k0 + i) * 32);
#pragma unroll
                    for (int q = 0; q < 8; ++q) { const float4 w = wr[q]; lg[4 + 4 * q] += xv * w.x; lg[5 + 4 * q] += xv * w.y; lg[6 + 4 * q] += xv * w.z; lg[7 + 4 * q] += xv * w.w; }
                }
            }
#pragma unroll
            for (int i = 0; i < 36; ++i) lg[i] = wave_sum(lg[i]);
            float gl[4];
#pragma unroll
            for (int i = 0; i < 4; ++i) gl[i] = lg[i] + P.b_group[i];
            int gs = 0; float gmax = gl[0];
#pragma unroll
            for (int i = 1; i < 4; ++i) if (gl[i] > gmax) { gmax = gl[i]; gs = i; }
            float gsum = 0.f;
#pragma unroll
            for (int i = 0; i < 4; ++i) gsum += expf(gl[i] - gmax);
            const float pg = 1.0f / gsum;
            float el[8];
#pragma unroll
            for (int i = 0; i < 8; ++i) {
                float a = lg[4 + i] + P.b_router[i];
                if (gs == 1) a = lg[12 + i] + P.b_router[8 + i];
                if (gs == 2) a = lg[20 + i] + P.b_router[16 + i];
                if (gs == 3) a = lg[28 + i] + P.b_router[24 + i];
                el[i] = a;
            }
            int i0 = 0; float l0 = el[0];
#pragma unroll
            for (int i = 1; i < 8; ++i) if (el[i] > l0) { l0 = el[i]; i0 = i; }
            int i1 = -1; float l1 = -INFINITY;
#pragma unroll
            for (int i = 0; i < 8; ++i) if (i != i0 && el[i] > l1) { l1 = el[i]; i1 = i; }
            const float r = expf(l1 - l0);
            const float g0 = pg / (1.0f + r), g1 = pg * r / (1.0f + r);
            if (lane == 0) {
                const int e0 = gs * 8 + i0, e1 = gs * 8 + i1;
                const int p0 = atomicAdd(&cnt[e0], 1), p1 = atomicAdd(&cnt[e1], 1);
                list[(size_t)e0 * T + p0] = row; list[(size_t)e1 * T + p1] = row;
                eid[row * 2] = e0; eid[row * 2 + 1] = e1; posn[row * 2] = p0; posn[row * 2 + 1] = p1;
                gate[row * 2] = g0; gate[row * 2 + 1] = g1;
            }
        }
    }
    GRID_BAR(6);
    if constexpr (IN(7) || IN(8) || IN(9) || IN(11)) {
        PH_IDS
        __syncthreads();
        if (tid == 0) { int o = 0; for (int e = 0; e < NE; ++e) { const int c = cnt[e]; s_cnt[e] = c; s_off[e] = o; const int nt = (c + 255) >> 8; for (int i = 0; i < nt; ++i) s_t2e[(o >> 8) + i] = e; o += nt << 8; } s_off[NE] = o; }
        __syncthreads();
    }
    if constexpr (IN(7)) {
        PH_IDS
        const int NS = s_off[NE];
        for (int s = gw; s < NS; s += NGW) {
            const int e = s_t2e[s >> 8], i = s - s_off[e];
            v4u a = {0u, 0u, 0u, 0u}, b2 = {0u, 0u, 0u, 0u};
            if (i < s_cnt[e]) { const int tok = list[(size_t)e * T + i]; const v4u* src = (const v4u*)(yreg + (size_t)tok * D); a = src[lane]; b2 = src[lane + 64]; }
            v4u* dst = (v4u*)(xs + (size_t)s * D); dst[lane] = a; dst[lane + 64] = b2;
        }
    }
    GRID_BAR(7);
    if constexpr (IN(8)) {
        PH_IDS
        const int NS = s_off[NE];
        pg8::Gemm g{xs, w13_t, NS, NE * 1024, D}; pg8::GroupedOrder S; S.init(NS >> 8, G, bid, (const LAS int*)s_t2e);
        pg8::EpiSwiglu E{hbuf};
        pg8::gemm_phase<pg8::EpiSwiglu, pg8::GroupedOrder, true, true>(ldsl, g, S, E);
    }
    GRID_BAR(8);
    if constexpr (IN(9)) {
        PH_IDS
        const int NS = s_off[NE];
        pg8::Gemm g{hbuf, w2_t, NS, NE * 1024, DE}; pg8::GroupedOrder S; S.init(NS >> 8, G, bid, (const LAS int*)s_t2e);
        pg8::EpiStoreBf16 E{ybuf, D, 3, nullptr};
        pg8::gemm_phase<pg8::EpiStoreBf16, pg8::GroupedOrder, true, true>(ldsl, g, S, E);
    }
    GRID_BAR(9);
    if constexpr (IN(10)) {
        PH_IDS
        pg8::Gemm g{pb, wup_t, T, D, PLE}; pg8::StaticOrder S; S.init(T, D, G, bid);
        pg8::EpiStoreBf16 E{peb, D, 0xffff, part};
        pg8::gemm_phase<pg8::EpiStoreBf16, pg8::StaticOrder, true, true>(ldsl, g, S, E);
    }
    GRID_BAR(10);
    if constexpr (IN(11)) {
        PH_IDS
        for (int row = gw; row < T; row += NGW) {
            const int s0 = s_off[eid[row * 2]] + posn[row * 2], s1 = s_off[eid[row * 2 + 1]] + posn[row * 2 + 1];
            const float g0 = gate[row * 2], g1 = gate[row * 2 + 1];
            float ss = 0.f;
#pragma unroll
            for (int j = 0; j < 4; ++j) {
                const int k0 = 4 * (lane + 64 * j);
                float4 hv = *(const float4*)(out + (size_t)row * D + k0);
                float y0[4], y1[4]; load4(ybuf + (size_t)s0 * D + k0, y0); load4(ybuf + (size_t)s1 * D + k0, y1);
                hv.x += g0 * y0[0] + g1 * y1[0]; hv.y += g0 * y0[1] + g1 * y1[1]; hv.z += g0 * y0[2] + g1 * y1[2]; hv.w += g0 * y0[3] + g1 * y1[3];
                *(float4*)(out + (size_t)row * D + k0) = hv;
                ss += hv.x * hv.x + hv.y * hv.y + hv.z * hv.z + hv.w * hv.w;
                uint2 o; o.x = pk2(hv.x, hv.y); o.y = pk2(hv.z, hv.w);
                *(uint2*)(yreg + (size_t)row * D + k0) = o;
            }
            ss = wave_sum(ss);
            float pe = lane < 16 ? part[(size_t)row * 16 + lane] : 0.f;
            pe = wave_sum(pe);
            if (lane == 0) { rstdg[row] = 1.0f / sqrtf(ss * (1.0f / D) + EPS); rstde[row] = 1.0f / sqrtf(pe * (1.0f / D) + EPS); }
        }
    }
    GRID_BAR(11);
    if constexpr (IN(12)) {
        PH_IDS
        pg8::Gemm g{yreg, wgate_t, T, D, D}; pg8::StaticOrder S; S.init(T, D, G, bid);
        pg8::EpiGate E{out, peb, rstdg, rstde, P.ple_norm, part2};
        pg8::gemm_phase<pg8::EpiGate, pg8::StaticOrder, true, true>(ldsl, g, S, E);
    }
    GRID_BAR(12);
    if constexpr (IN(13)) {
        PH_IDS
        for (int row = gw; row < T; row += NGW) {
            float4* hr = (float4*)(out + (size_t)row * D) + lane;
            float4 v[4];
#pragma unroll
            for (int j = 0; j < 4; ++j) v[j] = hr[64 * j];
            float ss = lane < 16 ? part2[(size_t)row * 16 + lane] : 0.f;
            ss = wave_sum(ss);
            const float rstd = 1.0f / sqrtf(ss * (1.0f / D) + EPS);
#pragma unroll
            for (int j = 0; j < 4; ++j) {
                const float4 nv = *(const float4*)(P.final_norm + 4 * (lane + 64 * j));
                float4 o; o.x = v[j].x * rstd * nv.x; o.y = v[j].y * rstd * nv.y; o.z = v[j].z * rstd * nv.z; o.w = v[j].w * rstd * nv.w;
                hr[64 * j] = o;
            }
        }
    }
#undef GRID_BAR
#undef PH_IDS
#undef IN
#undef rstd1
#undef gates
#undef rstdg
#undef rstde
#undef eid
#undef posn
#undef gate
#undef mn
#undef ml
#undef mbl
#undef mm
#undef list
#undef cnt
#undef part
#undef part2
#undef win_t
#undef wout_t
#undef w13_t
#undef w2_t
#undef wgate_t
#undef wup_t
#undef proj
#undef hbuf
#undef xs
#undef ybuf
#undef peb
#undef yreg
#undef pb
#undef rst
#undef mst
}

template <int PH> static void launch_one(int grid, const Params& p, hipStream_t stream) {
    static bool attr_done = false;
    if (!attr_done) { (void)hipFuncSetAttribute((const void*)mk<PH, PH + 1>, hipFuncAttributeMaxDynamicSharedMemorySize, LDS_BYTES); attr_done = true; }
    hipLaunchKernelGGL((mk<PH, PH + 1>), dim3(grid), dim3(NTHREADS), LDS_BYTES, stream, p);
}
template <int PH> static void launch_all(int grid, const Params& p, hipStream_t stream) {
    if constexpr (PH < NPHASES) { launch_one<PH>(grid, p, stream); launch_all<PH + 1>(grid, p, stream); }
}
#ifndef MK_N_LAUNCHES
#define MK_N_LAUNCHES 1
#endif

extern "C" void kernel_launch(void* const* d_in, const int* in_sizes, int n_in, void* d_out, int out_size, void* d_ws, size_t ws_size, hipStream_t stream) {
    static int grid = 0;
    if (grid == 0) {
        if (n_in != 25 || in_sizes[0] != T * D || out_size != T * D || ws_size < WS_END) {
            fprintf(stderr, "kernel_launch: unexpected shapes: n_in %d in0 %d out %d ws %zu\n", n_in, n_in > 0 ? in_sizes[0] : -1, out_size, ws_size); grid = -1; return; }
        int dev = 0, cus = 0;
        (void)hipGetDevice(&dev); (void)hipDeviceGetAttribute(&cus, hipDeviceAttributeMultiprocessorCount, dev);
        (void)hipGetLastError();
        grid = cus;
        if (MK_N_LAUNCHES == 1) {
            int per_cu = 0;
            if (hipFuncSetAttribute((const void*)mk<0, NPHASES>, hipFuncAttributeMaxDynamicSharedMemorySize, LDS_BYTES) != hipSuccess) { fprintf(stderr, "kernel_launch: hipFuncSetAttribute failed\n"); grid = -1; return; }
            if (hipOccupancyMaxActiveBlocksPerMultiprocessor(&per_cu, (const void*)mk<0, NPHASES>, NTHREADS, LDS_BYTES) != hipSuccess || per_cu < 1) { fprintf(stderr, "kernel_launch: occupancy query reports %d workgroups per CU; the grid barrier needs one resident workgroup per CU; nothing launched\n", per_cu); grid = -1; return; }
            (void)hipGetLastError();
        }
    }
    if (grid < 0) return;
    (void)hipMemsetAsync((char*)d_ws + WS_CTL, 0, 1 * MiB, stream);
    Params p{};
    p.x = (const float*)d_in[0]; p.p = (const float*)d_in[1]; p.pos = (const int*)d_in[2];
    p.attn_norm = (const float*)d_in[3]; p.w_in = (const float*)d_in[4]; p.conv_w = (const float*)d_in[5]; p.conv_b = (const float*)d_in[6];
    p.b_ig = (const float*)d_in[7]; p.b_fg = (const float*)d_in[8]; p.ret_gn = (const float*)d_in[9]; p.ml_gn = (const float*)d_in[10];
    p.w_out = (const float*)d_in[11]; p.moe_norm = (const float*)d_in[12]; p.w_group = (const float*)d_in[13]; p.b_group = (const float*)d_in[14];
    p.w_router = (const float*)d_in[15]; p.b_router = (const float*)d_in[16]; p.w1 = (const float*)d_in[17]; p.w3 = (const float*)d_in[18]; p.w2 = (const float*)d_in[19];
    p.w_up = (const float*)d_in[20]; p.ple_norm = (const float*)d_in[21]; p.pg_norm = (const float*)d_in[22]; p.w_gate = (const float*)d_in[23]; p.final_norm = (const float*)d_in[24];
    p.out = (float*)d_out; p.ws = (unsigned char*)d_ws;
    if (MK_N_LAUNCHES == 1) hipLaunchKernelGGL((mk<0, NPHASES>), dim3(grid), dim3(NTHREADS), LDS_BYTES, stream, p);
    else launch_all<0>(grid, p, stream);
}
```

```cpp
#include <hip/hip_runtime.h>
#include <cstdio>
#include <cstdint>

constexpr int D = 1024, BATCH = 4, SEQ = 8192, T = BATCH * SEQ, PLE = 256;
constexpr int NPROJ = 4104, NP = 4096;
constexpr int CH = 128, NCH = SEQ / CH;
constexpr int RH = 8, RD = 64, MH = 4, MD = 128;
constexpr int NE = 32, DE = 512;
constexpr float EPS = 1e-6f;
constexpr int C_RQ = 0, C_RK = 512, C_RV = 1024, C_RG = 1536, C_MQ = 2048, C_MK = 2560, C_MV = 3072, C_MO = 3584;

constexpr size_t MiB = 1u << 20;
constexpr size_t WS_CTL = 0;
constexpr size_t WS_RSTD1 = 1 * MiB;
constexpr size_t WS_GATES = WS_RSTD1 + 256 * 1024;
constexpr size_t WS_RSTDG = 3 * MiB;
constexpr size_t WS_RSTDE = WS_RSTDG + 256 * 1024;
constexpr size_t WS_EID = 4 * MiB;
constexpr size_t WS_POS = WS_EID + 256 * 1024;
constexpr size_t WS_GATE = WS_POS + 256 * 1024;
constexpr size_t WS_MN = 5 * MiB;
constexpr size_t WS_ML = WS_MN + 512 * 1024;
constexpr size_t WS_MBL = WS_ML + 4096;
constexpr size_t WS_MM = WS_MBL + 4096;
constexpr size_t WS_LIST = 8 * MiB;
constexpr size_t WS_PART = 12 * MiB;
constexpr size_t WS_PART2 = 14 * MiB;
constexpr size_t WS_WIN = 16 * MiB;
constexpr size_t WS_WOUT = 24 * MiB;
constexpr size_t WS_W13 = 26 * MiB;
constexpr size_t WS_W2 = 90 * MiB;
constexpr size_t WS_WGATE = 122 * MiB;
constexpr size_t WS_WUP = 124 * MiB;
constexpr size_t WS_PROJ = 128 * MiB;
constexpr size_t WS_HBUF = 128 * MiB;
constexpr size_t WS_XS = 200 * MiB;
constexpr size_t WS_YBUF = 200 * MiB;
constexpr size_t WS_PEB = 128 * MiB;
constexpr size_t WS_YREG = 384 * MiB;
constexpr size_t WS_PB = 448 * MiB;
constexpr size_t WS_CS = 464 * MiB;
constexpr size_t WS_END = 472 * MiB;
constexpr size_t OUT_RST = 0;
constexpr size_t OUT_MST = 32 * MiB;
constexpr int CW_CNT = 64;
constexpr int CW_BAR = 4096;

constexpr int NTHREADS = 512, NWAVES = 8;
constexpr int RING_BYTES = 131072;
constexpr int LDSX_OFF = 143360;
constexpr int LDS_BYTES = 147456;

#define GAS __attribute__((address_space(1)))
#define LAS __attribute__((address_space(3)))
typedef unsigned short bf16_t;
typedef unsigned v4u __attribute__((ext_vector_type(4)));
__device__ __forceinline__ float bf2f(bf16_t h) { return __uint_as_float((unsigned)h << 16); }
__device__ __forceinline__ unsigned f2bf(float f) { unsigned u = __float_as_uint(f); return (u + 0x7fffu + ((u >> 16) & 1u)) >> 16; }
__device__ __forceinline__ unsigned pk2(float lo, float hi) { return f2bf(lo) | (f2bf(hi) << 16); }
__device__ __forceinline__ float wave_sum(float v) {
#pragma unroll
    for (int o = 1; o < 64; o <<= 1) v += __shfl_xor(v, o);
    return v;
}
__device__ __forceinline__ float sigmoidf_(float x) { return 1.0f / (1.0f + expf(-x)); }
__device__ __forceinline__ float siluf_(float x) { return x / (1.0f + expf(-x)); }
__device__ __forceinline__ float logsigmoidf_(float x) { return x >= 0.f ? -log1pf(expf(-x)) : x - log1pf(expf(x)); }
#define LDS_WAIT() asm volatile("s_waitcnt lgkmcnt(0)" ::: "memory")

namespace pg8 {
#define PG8_LAS __attribute__((address_space(3)))
typedef unsigned short bf16_t;
typedef short bf16x8 __attribute__((ext_vector_type(8)));
typedef float f32x4 __attribute__((ext_vector_type(4)));
typedef unsigned u32x4 __attribute__((ext_vector_type(4)));
constexpr int BM = 256, BK = 64, HALF = 128, HTB = HALF * BK * 2  , STAGE_BYTES = 8 * HTB, NXCD = 8, WGM = 8;

__host__ __device__ __forceinline__ int lds_byte(int r, int c) { const int st = (r >> 4) * 2 + (c >> 5), rr = r & 15, cc = c & 31, ob = rr * 64 + cc * 2; return st * 1024 + (ob ^ (((ob >> 9) & 1) << 5)); }
__host__ __device__ __forceinline__ void stage_rc(int b, int& R, int& C) { const int st = b / 1024, sb = b % 1024, swz = sb ^ (((sb >> 9) & 1) << 5); R = (st >> 1) * 16 + swz / 64; C = (st & 1) * 32 + (swz % 64) / 2; }
__host__ __device__ __forceinline__ int perm32(int rho) { const int n = rho >> 4, i = rho & 15; return 8 * (i >> 2) + 4 * n + (i & 3); }

struct Unit { int pm, pn; };
struct Gemm { const bf16_t* A; const bf16_t* Bt; int M, N, K; };

struct StaticOrder {
    int nM, nN, nwg, G, c;
    __host__ __device__ void init(int M, int N, int G_, int c_) { nM = M / BM; nN = N / BM; nwg = nM * nN; G = G_; c = c_; }
    __host__ __device__ bool next(int i, Unit& u) const {
        const long L = (long)i * G + c; if (L >= nwg) return false;
        int wgid = (int)L; { const int q = nwg / NXCD, r = nwg % NXCD, xcd = wgid % NXCD, off = wgid / NXCD; wgid = (xcd < r ? xcd * (q + 1) : r * (q + 1) + (xcd - r) * q) + off; }
        const int nig = WGM * nN, gid = wgid / nig, fm = gid * WGM, gsz = (nM - fm) < WGM ? (nM - fm) : WGM;
        u.pm = fm + ((wgid % nig) % gsz); u.pn = (wgid % nig) / gsz; return true;
    }
    __device__ __forceinline__ void a_ready(const Unit&) const {}
    __device__ __forceinline__ void done(const Unit&) const {}
};

__device__ __forceinline__ unsigned cvt_pk_bf16(float lo, float hi) { unsigned r; asm volatile("v_cvt_pk_bf16_f32 %0, %1, %2" : "=v"(r) : "v"(lo), "v"(hi)); return r; }
typedef float f32x2 __attribute__((ext_vector_type(2)));
struct GroupedOrder {
    int nM, nwg, G, c; const PG8_LAS int* t2e;
    __device__ void init(int nM_, int G_, int c_, const PG8_LAS int* t2e_) { nM = nM_; nwg = nM_ * 4; G = G_; c = c_; t2e = t2e_; }
    __device__ bool next(int i, Unit& u) const {
        const long L = (long)i * G + c; if (L >= nwg) return false;
        int wgid = (int)L; { const int q = nwg / NXCD, r = nwg % NXCD, xcd = wgid % NXCD, off = wgid / NXCD; wgid = (xcd < r ? xcd * (q + 1) : r * (q + 1) + (xcd - r) * q) + off; }
        const int nig = WGM * 4, gid = wgid / nig, fm = gid * WGM, gsz = (nM - fm) < WGM ? (nM - fm) : WGM;
        u.pm = fm + ((wgid % nig) % gsz); u.pn = (wgid % nig) / gsz + 4 * t2e[u.pm]; return true;
    }
    __device__ __forceinline__ void a_ready(const Unit&) const {}
    __device__ __forceinline__ void done(const Unit&) const {}
};
__device__ __forceinline__ float fast_sigmoid(float x) { return __builtin_amdgcn_rcpf(1.0f + __builtin_amdgcn_exp2f(-1.4426950408889634f * x)); }
struct EpiStoreBf16 {
    static constexpr bool PERM = true, AFTER_DRAIN = false;
    bf16_t* O; int ldc; int pn_mask; float* part;
    __device__ __forceinline__ void operator()(const f32x4 (&acc)[2][2][4][2], const Unit& u, int wr, int wc, int fr, int fq) const {
        const int pnl = u.pn & pn_mask; const int row0 = u.pm * BM + wr * 64 + fr, col0 = pnl * BM + wc * 32 + 8 * fq;
#pragma unroll
        for (int ai = 0; ai < 2; ++ai)
#pragma unroll
            for (int m = 0; m < 4; ++m) { const int row = row0 + ai * HALF + m * 16; bf16_t* rowp = O + (size_t)row * ldc + col0; float s = 0.f;
#pragma unroll
                for (int bj = 0; bj < 2; ++bj) { const f32x4 v0 = acc[ai][bj][m][0], v1 = acc[ai][bj][m][1];
                    u32x4 w; w.x = cvt_pk_bf16(v0[0], v0[1]); w.y = cvt_pk_bf16(v0[2], v0[3]); w.z = cvt_pk_bf16(v1[0], v1[1]); w.w = cvt_pk_bf16(v1[2], v1[3]);
                    *(u32x4*)(rowp + bj * HALF) = w;
                    s += (v0[0] * v0[0] + v0[1] * v0[1]) + (v0[2] * v0[2] + v0[3] * v0[3]) + (v1[0] * v1[0] + v1[1] * v1[1]) + (v1[2] * v1[2] + v1[3] * v1[3]); }
                if (part) { s += __shfl_xor(s, 16); s += __shfl_xor(s, 32); if (fq == 0) part[(size_t)row * 16 + pnl * 4 + wc] = s; } }
    }
};
struct EpiSwiglu {
    static constexpr bool PERM = true, AFTER_DRAIN = false;
    bf16_t* H;
    __device__ __forceinline__ void operator()(const f32x4 (&acc)[2][2][4][2], const Unit& u, int wr, int wc, int fr, int fq) const {
        const int pnl = u.pn & 3; const int row0 = u.pm * BM + wr * 64 + fr, col0 = pnl * HALF + wc * 32 + 8 * fq;
#pragma unroll
        for (int ai = 0; ai < 2; ++ai)
#pragma unroll
            for (int m = 0; m < 4; ++m) { bf16_t* rowp = H + (size_t)(row0 + ai * HALF + m * 16) * 512 + col0;
                f32x4 h[2];
#pragma unroll
                for (int n = 0; n < 2; ++n) { const f32x4 a = acc[ai][0][m][n], b = acc[ai][1][m][n];
#pragma unroll
                    for (int j = 0; j < 4; ++j) h[n][j] = a[j] * fast_sigmoid(a[j]) * b[j]; }
                u32x4 w; w.x = cvt_pk_bf16(h[0][0], h[0][1]); w.y = cvt_pk_bf16(h[0][2], h[0][3]); w.z = cvt_pk_bf16(h[1][0], h[1][1]); w.w = cvt_pk_bf16(h[1][2], h[1][3]);
                *(u32x4*)rowp = w; }
    }
};
struct EpiRes {
    static constexpr bool PERM = false, AFTER_DRAIN = false;
    const float* base; float* out;
    __device__ __forceinline__ void operator()(const f32x4 (&acc)[2][2][4][2], const Unit& u, int wr, int wc, int fr, int fq) const {
        const int row0 = u.pm * BM + wr * 64 + fr, col0 = u.pn * BM + wc * 32 + 4 * fq;
#pragma unroll
        for (int ai = 0; ai < 2; ++ai)
#pragma unroll
            for (int m = 0; m < 4; ++m) { const size_t off = (size_t)(row0 + ai * HALF + m * 16) * 1024 + col0;
#pragma unroll
                for (int bj = 0; bj < 2; ++bj)
#pragma unroll
                    for (int n = 0; n < 2; ++n) { const f32x4 bs = *(const f32x4*)(base + off + bj * HALF + n * 16); *(f32x4*)(out + off + bj * HALF + n * 16) = bs + acc[ai][bj][m][n]; }
                asm volatile("" ::: "memory"); }
    }
};
struct EpiGate {
    static constexpr bool PERM = false, AFTER_DRAIN = false;
    float* out; const bf16_t* peb; const float* rstdg; const float* rstde; const float* ple_norm; float* part;
    __device__ __forceinline__ void operator()(const f32x4 (&acc)[2][2][4][2], const Unit& u, int wr, int wc, int fr, int fq) const {
        const int row0 = u.pm * BM + wr * 64 + fr, col0 = u.pn * BM + wc * 32 + 4 * fq;
        f32x4 pn4[2][2];
#pragma unroll
        for (int bj = 0; bj < 2; ++bj)
#pragma unroll
            for (int n = 0; n < 2; ++n) pn4[bj][n] = *(const f32x4*)(ple_norm + col0 + bj * HALF + n * 16);
#pragma unroll
        for (int ai = 0; ai < 2; ++ai)
#pragma unroll
            for (int m = 0; m < 4; ++m) { const int row = row0 + ai * HALF + m * 16; const size_t off = (size_t)row * 1024 + col0; const float rg = rstdg[row], re = rstde[row]; float s = 0.f;
#pragma unroll
                for (int bj = 0; bj < 2; ++bj)
#pragma unroll
                    for (int n = 0; n < 2; ++n) { const size_t o = off + bj * HALF + n * 16;
                        const uint2 pe = *(const uint2*)(peb + o); f32x4 h = *(const f32x4*)(out + o); const f32x4 a = acc[ai][bj][m][n];
                        f32x4 e; e[0] = __uint_as_float(pe.x << 16); e[1] = __uint_as_float(pe.x & 0xffff0000u); e[2] = __uint_as_float(pe.y << 16); e[3] = __uint_as_float(pe.y & 0xffff0000u);
#pragma unroll
                        for (int j = 0; j < 4; ++j) { h[j] += fast_sigmoid(rg * a[j]) * (e[j] * re * pn4[bj][n][j]); s += h[j] * h[j]; }
                        *(f32x4*)(out + o) = h; }
                s += __shfl_xor(s, 16); s += __shfl_xor(s, 32); if (fq == 0) part[(size_t)row * 16 + u.pn * 4 + wc] = s;
                asm volatile("" ::: "memory"); }
    }
};

template <class Epi, class Sched, bool ALIGN_EPI = false, bool SP2 = false>
__device__ __forceinline__ void gemm_phase(PG8_LAS unsigned char* lds, const Gemm g, const Sched& S, const Epi& E) {
    int tid_l = threadIdx.x; asm volatile("" : "+v"(tid_l));
    const int tid = tid_l, wid = __builtin_amdgcn_readfirstlane(tid >> 6), lane = tid & 63, wr = wid >> 2, wc = wid & 3, fr = lane & 15, fq = lane >> 4;
    const int K = g.K, nt = K / BK;
    unsigned voffA[2], voffB[2];
#pragma unroll
    for (int i = 0; i < 2; ++i) { int R, C; stage_rc(tid * 16 + i * 8192, R, C); const int Rb = Epi::PERM ? ((R & ~31) + perm32(R & 31)) : R;
        voffA[i] = (unsigned)(R * K + C) * 2u; voffB[i] = (unsigned)(Rb * K + C) * 2u; }
    const size_t kstep = (size_t)(BK * 2);
    const size_t hstep = (size_t)HALF * K * 2;
    const size_t tstep = 2 * hstep;
    const unsigned ldsw = (unsigned)wid * 1024u;
    const int aoff = lds_byte(wr * 64 + fr, fq * 8), boff = lds_byte(wc * 32 + fr, fq * 8);
#define PG8_SA(b, h) (((b) * 2 + (h)) * HTB)
#define PG8_SB(b, h) ((4 + (b) * 2 + (h)) * HTB)
#define PG8_STAGE(bufoff, gbase, voff) do { _Pragma("unroll") for (int _i = 0; _i < 2; ++_i) \
        __builtin_amdgcn_global_load_lds((const unsigned*)((const char*)(gbase) + (voff)[_i]), (PG8_LAS unsigned*)(lds + (bufoff) + ldsw + _i * 8192), 16, 0, 0); } while (0)
#define PG8_LDA(dst, b, h) do { _Pragma("unroll") for (int m = 0; m < 4; ++m) _Pragma("unroll") for (int k = 0; k < 2; ++k) dst[m][k] = *(const PG8_LAS bf16x8*)(lds + PG8_SA(b, h) + aoff + m * 2048 + k * 1024); } while (0)
#define PG8_LDB(dst, b, h) do { _Pragma("unroll") for (int n = 0; n < 2; ++n) _Pragma("unroll") for (int k = 0; k < 2; ++k) dst[n][k] = *(const PG8_LAS bf16x8*)(lds + PG8_SB(b, h) + boff + n * 2048 + k * 1024); } while (0)
#define PG8_MMA(ai, bj, At, Bt) do { __builtin_amdgcn_s_setprio(1); _Pragma("unroll") for (int m = 0; m < 4; ++m) _Pragma("unroll") for (int n = 0; n < 2; ++n) _Pragma("unroll") for (int k = 0; k < 2; ++k) \
        acc[ai][bj][m][n] = __builtin_amdgcn_mfma_f32_16x16x32_bf16(Bt[n][k], At[m][k], acc[ai][bj][m][n], 0, 0, 0); __builtin_amdgcn_s_setprio(0); } while (0)
#define PG8_WAIT_V(n) asm volatile("s_waitcnt vmcnt(" #n ")" ::: "memory")
#define PG8_WAIT_L(n) asm volatile("s_waitcnt lgkmcnt(" #n ")" ::: "memory")
#define PG8_BAR __builtin_amdgcn_s_barrier()
#define PG8_SCHED __builtin_amdgcn_sched_barrier(0)
    Unit cur, nxt; int ui = 0;
    if (!S.next(0, cur)) return;
    f32x4 acc[2][2][4][2];
#pragma unroll
    for (int a = 0; a < 2; ++a)
#pragma unroll
        for (int b = 0; b < 2; ++b)
#pragma unroll
            for (int m = 0; m < 4; ++m)
#pragma unroll
                for (int n = 0; n < 2; ++n) acc[a][b][m][n] = (f32x4){0.f, 0.f, 0.f, 0.f};
    bf16x8 At[4][2], B0[2][2], B1[2][2];
    const char* cA = (const char*)g.A + (size_t)cur.pm * tstep; const char* cB = (const char*)g.Bt + (size_t)cur.pn * tstep;
    S.a_ready(cur);
    if constexpr (SP2) {
        PG8_STAGE(PG8_SB(0, 0), cB, voffB); PG8_STAGE(PG8_SB(0, 1), cB + hstep, voffB); PG8_STAGE(PG8_SA(0, 0), cA, voffA); PG8_STAGE(PG8_SA(0, 1), cA + hstep, voffA);
        if (wr == 1) PG8_BAR;
        PG8_WAIT_V(2); PG8_BAR;
        PG8_STAGE(PG8_SB(1, 0), cB + kstep, voffB); PG8_STAGE(PG8_SA(1, 0), cA + kstep, voffA); PG8_STAGE(PG8_SB(1, 1), cB + hstep + kstep, voffB);
        PG8_WAIT_V(6); PG8_BAR;
    } else {
        PG8_STAGE(PG8_SB(0, 0), cB, voffB); PG8_STAGE(PG8_SA(0, 0), cA, voffA); PG8_STAGE(PG8_SB(0, 1), cB + hstep, voffB); PG8_STAGE(PG8_SA(0, 1), cA + hstep, voffA);
        if (wr == 1) PG8_BAR;
        PG8_WAIT_V(4); PG8_BAR;
        PG8_STAGE(PG8_SB(1, 0), cB + kstep, voffB); PG8_STAGE(PG8_SA(1, 0), cA + kstep, voffA); PG8_STAGE(PG8_SB(1, 1), cB + hstep + kstep, voffB);
        PG8_WAIT_V(6); PG8_BAR;
    }
    for (;;) {
        const bool has_next = S.next(ui + 1, nxt);
        const char* nA = has_next ? (const char*)g.A + (size_t)nxt.pm * tstep : cA; const char* nB = has_next ? (const char*)g.Bt + (size_t)nxt.pn * tstep : cB;
        for (int t = 0; t < nt; t += 2) {
            const bool last = (t == nt - 2);
            const char* a1 = cA + (size_t)(t + 1) * kstep;
            const char* a2 = last ? nA : cA + (size_t)(t + 2) * kstep; const char* b2 = last ? nB : cB + (size_t)(t + 2) * kstep;
            const char* a3 = a2 + kstep; const char* b3 = b2 + kstep;
            if (last && has_next) S.a_ready(nxt);
            if constexpr (SP2) {
            PG8_LDB(B0, 0, 0); PG8_LDB(B1, 0, 1); PG8_SCHED; PG8_LDA(At, 0, 0); PG8_STAGE(PG8_SA(1, 1), a1 + hstep, voffA);
            PG8_WAIT_V(8); PG8_WAIT_L(0); PG8_BAR; PG8_MMA(0, 0, At, B0); PG8_MMA(0, 1, At, B1); PG8_BAR; PG8_SCHED;
            PG8_LDA(At, 0, 1); PG8_STAGE(PG8_SB(0, 0), b2, voffB); PG8_STAGE(PG8_SB(0, 1), b2 + hstep, voffB); PG8_STAGE(PG8_SA(0, 0), a2, voffA);
            PG8_WAIT_V(8); PG8_WAIT_L(0); PG8_BAR; PG8_MMA(1, 0, At, B0); PG8_MMA(1, 1, At, B1); PG8_BAR; PG8_SCHED;
            PG8_LDB(B0, 1, 0); PG8_LDB(B1, 1, 1); PG8_SCHED; PG8_LDA(At, 1, 0); PG8_STAGE(PG8_SA(0, 1), a2 + hstep, voffA);
            PG8_WAIT_V(8); PG8_WAIT_L(0); PG8_BAR; PG8_MMA(0, 0, At, B0); PG8_MMA(0, 1, At, B1); PG8_BAR; PG8_SCHED;
            PG8_LDA(At, 1, 1); PG8_STAGE(PG8_SB(1, 0), b3, voffB); PG8_STAGE(PG8_SB(1, 1), b3 + hstep, voffB); PG8_STAGE(PG8_SA(1, 0), a3, voffA);
            PG8_WAIT_V(8); PG8_WAIT_L(0); PG8_BAR; PG8_MMA(1, 0, At, B0); PG8_MMA(1, 1, At, B1); PG8_BAR; PG8_SCHED;
            } else {
            PG8_LDB(B0, 0, 0); PG8_SCHED; PG8_LDA(At, 0, 0); PG8_STAGE(PG8_SA(1, 1), a1 + hstep, voffA);
            PG8_WAIT_L(8); PG8_BAR; PG8_WAIT_L(0); PG8_MMA(0, 0, At, B0); PG8_BAR; PG8_SCHED;
            PG8_LDB(B1, 0, 1); PG8_STAGE(PG8_SB(0, 0), b2, voffB);
            PG8_BAR; PG8_WAIT_L(0); PG8_MMA(0, 1, At, B1); PG8_BAR;
            PG8_LDA(At, 0, 1); PG8_STAGE(PG8_SA(0, 0), a2, voffA);
            PG8_BAR; PG8_WAIT_L(0); PG8_MMA(1, 0, At, B0); PG8_BAR; PG8_SCHED;
            PG8_STAGE(PG8_SB(0, 1), b2 + hstep, voffB);
            PG8_WAIT_V(6); PG8_BAR; PG8_MMA(1, 1, At, B1); PG8_BAR;
            PG8_LDB(B0, 1, 0); PG8_SCHED; PG8_LDA(At, 1, 0); PG8_STAGE(PG8_SA(0, 1), a2 + hstep, voffA);
            PG8_WAIT_L(8); PG8_BAR; PG8_WAIT_L(0); PG8_MMA(0, 0, At, B0); PG8_BAR; PG8_SCHED;
            PG8_LDB(B1, 1, 1); PG8_STAGE(PG8_SB(1, 0), b3, voffB);
            PG8_BAR; PG8_WAIT_L(0); PG8_MMA(0, 1, At, B1); PG8_BAR;
            PG8_LDA(At, 1, 1); PG8_STAGE(PG8_SA(1, 0), a3, voffA);
            PG8_BAR; PG8_WAIT_L(0); PG8_MMA(1, 0, At, B0); PG8_BAR; PG8_SCHED;
            PG8_STAGE(PG8_SB(1, 1), b3 + hstep, voffB);
            PG8_WAIT_V(6); PG8_BAR; PG8_MMA(1, 1, At, B1); PG8_BAR;
            }
        }
        if constexpr (ALIGN_EPI) { if (wr == 0) PG8_BAR; }
        if constexpr (!Epi::AFTER_DRAIN) { E(acc, cur, wr, wc, fr, fq); S.done(cur); }
        if (!has_next) break;
#pragma unroll
        for (int a = 0; a < 2; ++a)
#pragma unroll
            for (int b = 0; b < 2; ++b)
#pragma unroll
                for (int m = 0; m < 4; ++m)
#pragma unroll
                    for (int n = 0; n < 2; ++n) acc[a][b][m][n] = (f32x4){0.f, 0.f, 0.f, 0.f};
        cur = nxt; cA = nA; cB = nB; ++ui;
        if constexpr (ALIGN_EPI) { if (wr == 1) PG8_BAR; }
    }
    PG8_WAIT_V(0);
    if constexpr (!ALIGN_EPI) { if (wr == 0) PG8_BAR; }
    PG8_BAR;
    if constexpr (Epi::AFTER_DRAIN) { E.fused(acc, cur, wr, wc, fr, fq, lds, wid, lane); S.done(cur); }
#undef PG8_SA
#undef PG8_SB
#undef PG8_STAGE
#undef PG8_LDA
#undef PG8_LDB
#undef PG8_MMA
#undef PG8_WAIT_V
#undef PG8_WAIT_L
#undef PG8_BAR
#undef PG8_SCHED
}
}
#define XB_TMO      128
#define XB_XCNT(j)  (256  + 64 * (j))
#define XB_XSUB(j)  (1280 + 64 * (j))
#define XB_XGEN(j)  (2304 + 64 * (j))
#define XB_TOP      3328
#define XB_TOPGEN   3392
#define XCD_BAR_WORDS 3456
#define XB_SPIN_CAP (1u << 18)

__device__ __forceinline__ unsigned xb_ld(unsigned* p)              { return __hip_atomic_load(p, __ATOMIC_RELAXED, __HIP_MEMORY_SCOPE_AGENT); }
__device__ __forceinline__ unsigned xb_add(unsigned* p, unsigned v) { return __hip_atomic_fetch_add(p, v, __ATOMIC_RELAXED, __HIP_MEMORY_SCOPE_AGENT); }
__device__ __forceinline__ unsigned xb_xcc_id() { return (unsigned)__builtin_amdgcn_s_getreg((3 << 11) | 20) & 0xFu; }
#define XB_SPIN(cond, bar) do { unsigned _sp = 0; while (cond) { __builtin_amdgcn_s_sleep(1); \
    if ((++_sp & 255u) == 0u) { if (xb_ld(&(bar)[XB_TMO])) break; if (_sp > XB_SPIN_CAP) { atomicAdd(&(bar)[XB_TMO], 1u); break; } } } } while (0)

struct XcdBarrier {
    unsigned* bar; unsigned x;
    volatile LAS unsigned* st;
};

__device__ __forceinline__ XcdBarrier xcd_barrier_post(unsigned* bar, volatile LAS unsigned* st) {
    XcdBarrier b; b.bar = bar; b.x = xb_xcc_id(); b.st = st;
    if (threadIdx.x == 0) (void)xb_add(&bar[XB_XCNT(b.x)], 1u);
    return b;
}
__device__ __forceinline__ void xcd_barrier_complete(unsigned* bar, unsigned x, unsigned& nloc, unsigned& nx) {
    const unsigned G = gridDim.x * gridDim.y * gridDim.z;
    unsigned sum, cnt, mine, sp = 0u;
    for (;;) {
        sum = 0u; cnt = 0u; mine = 0u;
#pragma unroll
        for (unsigned j = 0; j < 16; ++j) { const unsigned c = xb_ld(&bar[XB_XCNT(j)]); sum += c; cnt += (c > 0u) ? 1u : 0u; mine = (j == x) ? c : mine; }
        if (sum == G) break;
        __builtin_amdgcn_s_sleep(1);
        if ((++sp & 255u) == 0u) { if (xb_ld(&bar[XB_TMO])) break; if (sp > XB_SPIN_CAP) { atomicAdd(&bar[XB_TMO], 1u); break; } }
    }
    nloc = mine > 0u ? mine : 1u; nx = cnt > 0u ? cnt : 1u;
}

__device__ __forceinline__ void xcd_barrier(const XcdBarrier& b) {
    asm volatile("s_waitcnt vmcnt(0)" ::: "memory");
    __syncthreads();
    if (threadIdx.x == 0) {
        unsigned* bar = b.bar;
        __builtin_amdgcn_s_waitcnt(0);
        unsigned nloc = b.st[0], nx = b.st[1];
        if (nloc == 0u) { xcd_barrier_complete(bar, b.x, nloc, nx); b.st[0] = nloc; b.st[1] = nx; }
        const unsigned old = xb_add(&bar[XB_XSUB(b.x)], 1u);
        const unsigned gen = old / nloc;
        if (old + 1u == (gen + 1u) * nloc) {
            __builtin_amdgcn_fence(__ATOMIC_RELEASE, "agent");
            asm volatile("s_waitcnt vmcnt(0)" ::: "memory");
            const unsigned og = xb_add(&bar[XB_TOP], 1u);
            const unsigned tg = og / nx;
            if (og + 1u == (tg + 1u) * nx) xb_add(&bar[XB_TOPGEN], 1u);
            else XB_SPIN(xb_ld(&bar[XB_TOPGEN]) == tg, bar);
            __builtin_amdgcn_fence(__ATOMIC_ACQUIRE, "agent");
            xb_add(&bar[XB_XGEN(b.x)], 1u);
            asm volatile("s_waitcnt vmcnt(0)" ::: "memory");
        } else {
            XB_SPIN(xb_ld(&bar[XB_XGEN(b.x)]) == gen, bar);
            __builtin_amdgcn_fence(__ATOMIC_ACQUIRE, "agent");
            asm volatile("s_waitcnt vmcnt(0)" ::: "memory");
        }
    }
    __syncthreads();
}
typedef short bf16x8 __attribute__((ext_vector_type(8)));
typedef short v4i16_t __attribute__((ext_vector_type(4)));
typedef float f32x16 __attribute__((ext_vector_type(16)));
typedef float f32x2_t __attribute__((ext_vector_type(2)));
typedef __bf16 bf16x2_t __attribute__((ext_vector_type(2)));
typedef float f4v __attribute__((ext_vector_type(4)));
__device__ __forceinline__ f32x16 MFMA32(const bf16x8 a, const bf16x8 b, const f32x16 c) { return __builtin_amdgcn_mfma_f32_32x32x16_bf16(a, b, c, 0, 0, 0); }
__device__ __forceinline__ unsigned cvtpk(float lo, float hi) { f32x2_t v = {lo, hi}; bf16x2_t b = __builtin_convertvector(v, bf16x2_t); return __builtin_bit_cast(unsigned, b); }
__device__ __forceinline__ int crow(int reg, int h) { return (reg & 3) + 8 * (reg >> 2) + 4 * h; }
__device__ __forceinline__ float blo(unsigned u) { return __uint_as_float(u << 16); }
__device__ __forceinline__ float bhi(unsigned u) { return __uint_as_float(u & 0xffff0000u); }
template <int W> __device__ __forceinline__ unsigned toff(unsigned row, unsigned ch) {
    if constexpr (W == 64) return row * 144u + ch * 16u;
    else return row * 256u + 16u * (ch ^ (((row & 3u) << 2) | ((row >> 2) & 3u)));
}
template <int W> __device__ __forceinline__ bf16x8 frag_row(const LAS unsigned char* tile, int R, int s, int h) { return *(const LAS bf16x8*)(tile + toff<W>(R, 2 * s + h)); }
template <int W, bool PERMK> __device__ __forceinline__ bf16x8 frag_tr(const LAS unsigned char* tile, int rbase, int cbase, int lane) {
    const int h = lane >> 5, blk = (lane >> 4) & 1, q = (lane & 15) >> 2, p = lane & 3;
    const int ch = (cbase >> 3) + 2 * blk + (p >> 1);
    const int r0 = rbase + (PERMK ? 4 * h : 8 * h) + q, r1 = r0 + (PERMK ? 8 : 4);
    const v4i16_t lo = __builtin_amdgcn_ds_read_tr16_b64_v4i16((LAS v4i16_t*)(tile + toff<W>(r0, ch) + 8 * (p & 1)));
    const v4i16_t hi = __builtin_amdgcn_ds_read_tr16_b64_v4i16((LAS v4i16_t*)(tile + toff<W>(r1, ch) + 8 * (p & 1)));
    return __builtin_shufflevector(lo, hi, 0, 1, 2, 3, 4, 5, 6, 7);
}
__device__ __forceinline__ bf16x8 pack_step(const f32x16& x, int s) {
    v4u p; p.x = cvtpk(x[8 * s], x[8 * s + 1]); p.y = cvtpk(x[8 * s + 2], x[8 * s + 3]); p.z = cvtpk(x[8 * s + 4], x[8 * s + 5]); p.w = cvtpk(x[8 * s + 6], x[8 * s + 7]);
    return __builtin_bit_cast(bf16x8, p);
}
__device__ __forceinline__ f32x16 zero16() { f32x16 z;
#pragma unroll
    for (int i = 0; i < 16; ++i) z[i] = 0.f; return z; }
__device__ __forceinline__ void wave_scan_sum2(float& x0, float& x1, int lane) {
    const float loc = x0 + x1; float s = loc;
#pragma unroll
    for (int o = 1; o < 64; o <<= 1) { const float t = __shfl_up(s, o); if (lane >= o) s += t; }
    const float ex = s - loc; x0 = ex + x0; x1 = x0 + x1;
}
__device__ __forceinline__ void wave_scan_max2(float& x0, float& x1, int lane) {
    const float loc = fmaxf(x0, x1); float s = loc;
#pragma unroll
    for (int o = 1; o < 64; o <<= 1) { const float t = __shfl_up(s, o); if (lane >= o) s = fmaxf(s, t); }
    float ex = __shfl_up(s, 1); if (lane == 0) ex = -INFINITY;
    x0 = fmaxf(ex, x0); x1 = fmaxf(x0, x1);
}
__device__ __forceinline__ float wave_max(float v) {
#pragma unroll
    for (int o = 1; o < 64; o <<= 1) v = fmaxf(v, __shfl_xor(v, o));
    return v;
}
__device__ __forceinline__ void rot8_store(LAS unsigned char* tile, int row, int j0, const v4u x1, const v4u x2, const float* cs, float scale) {
    float a[8], b[8];
    a[0] = blo(x1.x); a[1] = bhi(x1.x); a[2] = blo(x1.y); a[3] = bhi(x1.y); a[4] = blo(x1.z); a[5] = bhi(x1.z); a[6] = blo(x1.w); a[7] = bhi(x1.w);
    b[0] = blo(x2.x); b[1] = bhi(x2.x); b[2] = blo(x2.y); b[3] = bhi(x2.y); b[4] = blo(x2.z); b[5] = bhi(x2.z); b[6] = blo(x2.w); b[7] = bhi(x2.w);
    float o1[8], o2[8];
#pragma unroll
    for (int i = 0; i < 8; ++i) { const float c = cs[2 * i], s = cs[2 * i + 1]; o1[i] = (a[i] * c - b[i] * s) * scale; o2[i] = (a[i] * s + b[i] * c) * scale; }
    v4u w1, w2; w1.x = cvtpk(o1[0], o1[1]); w1.y = cvtpk(o1[2], o1[3]); w1.z = cvtpk(o1[4], o1[5]); w1.w = cvtpk(o1[6], o1[7]);
    w2.x = cvtpk(o2[0], o2[1]); w2.y = cvtpk(o2[2], o2[3]); w2.z = cvtpk(o2[4], o2[5]); w2.w = cvtpk(o2[6], o2[7]);
    *(LAS v4u*)(tile + toff<64>(row, j0 >> 3)) = w1; *(LAS v4u*)(tile + toff<64>(row, 4 + (j0 >> 3))) = w2;
}
__device__ __forceinline__ void conv8(const bf16_t* colp, int s, const float* cw, const float* cb, float* o) {
#pragma unroll
    for (int i = 0; i < 8; ++i) o[i] = cb[i];
#pragma unroll
    for (int w = 0; w < 4; ++w) { const int ss = s - 3 + w; if (ss >= 0) { const v4u x = *(const v4u*)(colp + (ptrdiff_t)(w - 3) * NP);
        o[0] += blo(x.x) * cw[w * 8 + 0]; o[1] += bhi(x.x) * cw[w * 8 + 1]; o[2] += blo(x.y) * cw[w * 8 + 2]; o[3] += bhi(x.y) * cw[w * 8 + 3];
        o[4] += blo(x.z) * cw[w * 8 + 4]; o[5] += bhi(x.z) * cw[w * 8 + 5]; o[6] += blo(x.w) * cw[w * 8 + 6]; o[7] += bhi(x.w) * cw[w * 8 + 7]; } }
#pragma unroll
    for (int i = 0; i < 8; ++i) o[i] = o[i] * __builtin_amdgcn_rcpf(1.0f + __builtin_amdgcn_exp2f(-1.4426950408889634f * o[i]));
}

struct Params {
    const float *x, *p; const int* pos;
    const float *attn_norm, *w_in, *conv_w, *conv_b, *b_ig, *b_fg, *ret_gn, *ml_gn, *w_out, *moe_norm, *w_group, *b_group, *w_router, *b_router,
                *w1, *w3, *w2, *w_up, *ple_norm, *pg_norm, *w_gate, *final_norm;
    float* out; unsigned char* ws;
};

__device__ __forceinline__ void load4(const float* p, float (&o)[4]) { const float4 v = *(const float4*)p; o[0] = v.x; o[1] = v.y; o[2] = v.z; o[3] = v.w; }
__device__ __forceinline__ void load4(const bf16_t* p, float (&o)[4]) { const uint2 v = *(const uint2*)p; o[0] = __uint_as_float(v.x << 16); o[1] = __uint_as_float(v.x & 0xffff0000u); o[2] = __uint_as_float(v.y << 16); o[3] = __uint_as_float(v.y & 0xffff0000u); }

__device__ __forceinline__ void transpose_item(const float* W, int ldw, const float* gain, bf16_t* WT, int K, int kb, int n0, size_t drow0, LAS float* scr, int lane) {
    const int k0 = 64 * kb;
#pragma unroll 8
    for (int i = 0; i < 32; ++i) { const int kk = 2 * i + (lane >> 5); float w = W[(size_t)(k0 + kk) * ldw + n0 + (lane & 31)]; if (gain) w *= gain[k0 + kk]; scr[kk * 33 + (lane & 31)] = w; }
    LDS_WAIT(); asm volatile("" ::: "memory");
    const int c = lane & 7;
#pragma unroll
    for (int j = 0; j < 4; ++j) { const int n = (lane >> 3) + 8 * j; const LAS float* s = scr + (8 * c) * 33 + n;
        v4u o; o.x = pk2(s[0 * 33], s[1 * 33]); o.y = pk2(s[2 * 33], s[3 * 33]); o.z = pk2(s[4 * 33], s[5 * 33]); o.w = pk2(s[6 * 33], s[7 * 33]);
        *(GAS v4u*)(WT + (drow0 + n) * K + k0 + 8 * c) = o; }
    LDS_WAIT(); asm volatile("" ::: "memory");
}

constexpr int NPHASES = 14;
template <int LO, int HI>
__global__ void __launch_bounds__(NTHREADS, 2) mk(Params P) {
    extern __shared__ __attribute__((aligned(16))) unsigned char lds_raw[];
    float* ldsf = (float*)lds_raw;
    LAS unsigned char* ldsl = (LAS unsigned char*)lds_raw;
    const int G = gridDim.x, bid = blockIdx.x, NGW = G * NWAVES;
#define PH_IDS int tid = threadIdx.x; asm volatile("" : "+v"(tid)); const int lane = tid & 63, wave = __builtin_amdgcn_readfirstlane(tid >> 6), gw = bid * NWAVES + wave; (void)lane; (void)gw;
    unsigned char* const ws = P.ws;
#define rstd1 ((float*)(ws + WS_RSTD1))
#define gates ((float*)(ws + WS_GATES))
#define rstdg ((float*)(ws + WS_RSTDG))
#define rstde ((float*)(ws + WS_RSTDE))
#define eid ((int*)(ws + WS_EID))
#define posn ((int*)(ws + WS_POS))
#define gate ((float*)(ws + WS_GATE))
#define mn ((float*)(ws + WS_MN))
#define ml ((float*)(ws + WS_ML))
#define mbl ((float*)(ws + WS_MBL))
#define mm ((float*)(ws + WS_MM))
#define list ((int*)(ws + WS_LIST))
#define cnt ((int*)(ws + WS_CTL) + CW_CNT)
#define part ((float*)(ws + WS_PART))
#define part2 ((float*)(ws + WS_PART2))
#define win_t ((bf16_t*)(ws + WS_WIN))
#define wout_t ((bf16_t*)(ws + WS_WOUT))
#define w13_t ((bf16_t*)(ws + WS_W13))
#define w2_t ((bf16_t*)(ws + WS_W2))
#define wgate_t ((bf16_t*)(ws + WS_WGATE))
#define wup_t ((bf16_t*)(ws + WS_WUP))
#define proj ((bf16_t*)(ws + WS_PROJ))
#define hbuf ((bf16_t*)(ws + WS_HBUF))
#define xs ((bf16_t*)(ws + WS_XS))
#define ybuf ((bf16_t*)(ws + WS_YBUF))
#define peb ((bf16_t*)(ws + WS_PEB))
#define yreg ((bf16_t*)(ws + WS_YREG))
#define pb ((bf16_t*)(ws + WS_PB))
    float* const out = P.out;
#define rst ((float*)((unsigned char*)out + OUT_RST))
#define mst ((float*)((unsigned char*)out + OUT_MST))
    LAS int* s_off = (LAS int*)(ldsl + LDSX_OFF + 256);
    LAS int* s_cnt = s_off + 40;
    LAS int* s_t2e = s_off + 80;
#define IN(k) (LO <= (k) && (k) < HI)
#define GRID_BAR(k) do { if constexpr (IN(k) && IN((k) + 1)) xcd_barrier(bar); } while (0)
    XcdBarrier bar; bar.bar = (unsigned*)(ws + WS_CTL) + CW_BAR; bar.x = 0; bar.st = nullptr;
    if constexpr (HI - LO > 1) {
        PH_IDS
        volatile LAS unsigned* st = (volatile LAS unsigned*)(ldsl + LDSX_OFF);
        if (tid == 0) { st[0] = 0u; st[1] = 0u; }
        __syncthreads();
        bar = xcd_barrier_post((unsigned*)(ws + WS_CTL) + CW_BAR, st);
    }

    if constexpr (IN(0)) {
        PH_IDS
        {
            LAS float* scr = (LAS float*)(ldsl + wave * 16384);
            constexpr int I0 = 16 * 128, I1 = 16 * 32, I2 = 64 * 256, I3 = 32 * 256, I4 = 16 * 32, I5 = 4 * 32;
            for (int it = gw; it < I0 + I1 + I2 + I3 + I4 + I5; it += NGW) {
                int r = it;
                if (r < I0) { transpose_item(P.w_in, NPROJ, P.attn_norm, win_t, D, r / 128, 32 * (r % 128), (size_t)(32 * (r % 128)), scr, lane); continue; } r -= I0;
                if (r < I1) { transpose_item(P.w_out, D, nullptr, wout_t, D, r / 32, 32 * (r % 32), (size_t)(32 * (r % 32)), scr, lane); continue; } r -= I1;
                if (r < I2) { const int mat = r >> 8, q = r & 255, e = mat >> 1, which = mat & 1, kb = q >> 4, n0 = 32 * (q & 15);
                    const float* W = (which ? P.w3 : P.w1) + (size_t)e * D * DE;
                    transpose_item(W, DE, nullptr, w13_t, D, kb, n0, (size_t)e * 1024 + (size_t)((n0 >> 7) * 256 + which * 128 + (n0 & 127)), scr, lane); continue; } r -= I2;
                if (r < I3) { const int e = r >> 8, q = r & 255, kb = q >> 5, n0 = 32 * (q & 31);
                    transpose_item(P.w2 + (size_t)e * DE * D, D, nullptr, w2_t, DE, kb, n0, (size_t)e * 1024 + n0, scr, lane); continue; } r -= I3;
                if (r < I4) { transpose_item(P.w_gate, D, P.pg_norm, wgate_t, D, r / 32, 32 * (r % 32), (size_t)(32 * (r % 32)), scr, lane); continue; } r -= I4;
                transpose_item(P.w_up, D, nullptr, wup_t, PLE, r / 32, 32 * (r % 32), (size_t)(32 * (r % 32)), scr, lane);
            }
        }
        __syncthreads();
        {
            LAS float* gwl = (LAS float*)ldsl;
            for (int idx = tid; idx < D * 8; idx += NTHREADS) { const int k = idx >> 3, j = idx & 7; gwl[idx] = P.w_in[(size_t)k * NPROJ + NP + j] * P.attn_norm[k]; }
            __syncthreads();
            for (int row = gw; row < T; row += NGW) {
                const float4* xr = (const float4*)(P.x + (size_t)row * D) + lane;
                float4 v[4]; float ss = 0.f;
#pragma unroll
                for (int j = 0; j < 4; ++j) { v[j] = xr[64 * j]; ss += v[j].x * v[j].x + v[j].y * v[j].y + v[j].z * v[j].z + v[j].w * v[j].w; }
                ss = wave_sum(ss);
                const float rstd = 1.0f / sqrtf(ss * (1.0f / D) + EPS);
                float g8[8];
#pragma unroll
                for (int i = 0; i < 8; ++i) g8[i] = 0.f;
#pragma unroll
                for (int j = 0; j < 4; ++j) {
                    const int k0 = 4 * (lane + 64 * j);
                    const float xs_[4] = {v[j].x * rstd, v[j].y * rstd, v[j].z * rstd, v[j].w * rstd};
                    uint2 o; o.x = pk2(xs_[0], xs_[1]); o.y = pk2(xs_[2], xs_[3]);
                    *(uint2*)(yreg + (size_t)row * D + k0) = o;
#pragma unroll
                    for (int i = 0; i < 4; ++i) {
                        const LAS f4v* wr = (const LAS f4v*)(gwl + (k0 + i) * 8);
                        const f4v w0 = wr[0], w1 = wr[1];
                        g8[0] += xs_[i] * w0.x; g8[1] += xs_[i] * w0.y; g8[2] += xs_[i] * w0.z; g8[3] += xs_[i] * w0.w;
                        g8[4] += xs_[i] * w1.x; g8[5] += xs_[i] * w1.y; g8[6] += xs_[i] * w1.z; g8[7] += xs_[i] * w1.w;
                    }
                }
#pragma unroll
                for (int i = 0; i < 8; ++i) g8[i] = wave_sum(g8[i]);
                if (lane == 0) {
                    rstd1[row] = rstd;
                    *(float4*)(gates + (size_t)row * 8) = make_float4(g8[0], g8[1], g8[2], g8[3]);
                    *(float4*)(gates + (size_t)row * 8 + 4) = make_float4(g8[4], g8[5], g8[6], g8[7]);
                }
            }
            {
                float* cstab = (float*)(ws + WS_CS);
                for (int idx = bid * NTHREADS + tid; idx < T * 32; idx += G * NTHREADS) {
                    const int t = idx >> 5, j = idx & 31;
                    const float ang = (float)P.pos[t] * powf(10000.0f, -(float)j / 32.0f);
                    float sn, cs; sincosf(ang, &sn, &cs);
                    *(float2*)(cstab + (size_t)idx * 2) = make_float2(cs, sn);
                }
            }
            for (int row = gw; row < T; row += NGW) {
                const float4 v = ((const float4*)(P.p + (size_t)row * PLE))[lane];
                uint2 o; o.x = pk2(v.x, v.y); o.y = pk2(v.z, v.w);
                ((uint2*)(pb + (size_t)row * PLE))[lane] = o;
            }
        }
        __syncthreads();
    }
    GRID_BAR(0);
    if constexpr (IN(1)) {
        PH_IDS
        pg8::Gemm g{yreg, win_t, T, NP, D}; pg8::StaticOrder S; S.init(T, NP, G, bid);
        pg8::EpiStoreBf16 E{proj, NP, 0xffff, nullptr};
        pg8::gemm_phase<pg8::EpiStoreBf16, pg8::StaticOrder, true, true>(ldsl, g, S, E);
    }
    GRID_BAR(1);
    if constexpr (IN(2)) {
        PH_IDS
        const int nitems = BATCH * NCH * (RH + MH);
        for (int it = bid; it < nitems; it += G) {
            const int bn = it / (RH + MH), hh = it % (RH + MH), b = bn / NCH, n = bn % NCH;
            const size_t t0 = (size_t)b * SEQ + (size_t)n * CH;
            __syncthreads();
            if (hh < RH) {
                const int h = hh;
                float* kk = ldsf; float* vv = ldsf + CH * RD;
                const float lg = log1pf(-exp2f(-5.0f - (float)h));
                for (int idx = tid; idx < CH * 32; idx += NTHREADS) {
                    const int c = idx >> 5, j = idx & 31; const size_t t = t0 + c;
                    const float ang = (float)P.pos[t] * powf(10000.0f, -(float)j / 32.0f);
                    float sn, cs; sincosf(ang, &sn, &cs);
                    const float x1 = bf2f(proj[t * NP + C_RK + h * RD + j]), x2 = bf2f(proj[t * NP + C_RK + h * RD + 32 + j]);
                    const float wst = expf(lg * (float)(CH - 1 - c)) * 0.125f;
                    kk[c * RD + j] = (x1 * cs - x2 * sn) * wst; kk[c * RD + 32 + j] = (x1 * sn + x2 * cs) * wst;
                }
                for (int idx = tid; idx < CH * RD; idx += NTHREADS) { const int c = idx >> 6, e = idx & 63; vv[idx] = bf2f(proj[(t0 + c) * NP + C_RV + h * RD + e]); }
                __syncthreads();
                const int d = tid >> 3, e0 = (tid & 7) * 8;
                float acc[8];
#pragma unroll
                for (int i = 0; i < 8; ++i) acc[i] = 0.f;
                for (int c = 0; c < CH; ++c) { const float kv = kk[c * RD + d];
#pragma unroll
                    for (int i = 0; i < 8; ++i) acc[i] += kv * vv[c * RD + e0 + i]; }
                float* dst = rst + ((size_t)(bn * RH + h) * RD + d) * RD + e0;
#pragma unroll
                for (int i = 0; i < 8; ++i) dst[i] = acc[i];
            } else {
                const int h = hh - RH;
                float* kk = ldsf; float* sw = ldsf + CH * MD; float* sb = sw + CH;
                if (tid < CH) {
                    const size_t t = t0 + tid;
                    sw[tid] = gates[t * 8 + h] + P.b_ig[h];
                    sb[tid] = logsigmoidf_(gates[t * 8 + 4 + h] + P.b_fg[h]);
                }
                __syncthreads();
                if (tid == 0) { float run = 0.f; for (int c = 0; c < CH; ++c) { run += sb[c]; sb[c] = run; } }
                __syncthreads();
                const float bL = sb[CH - 1];
                float mloc = -INFINITY;
                for (int c = 0; c < CH; ++c) mloc = fmaxf(mloc, bL - sb[c] + sw[c]);
                __syncthreads();
                if (tid < CH) sw[tid] = expf(bL - sb[tid] + sw[tid] - mloc);
                for (int idx = tid; idx < CH * MD; idx += NTHREADS) {
                    const int c = idx >> 7, d = idx & 127; const int s = n * CH + c; const int chn = 512 + h * MD + d;
                    float a = P.conv_b[chn];
#pragma unroll
                    for (int w = 0; w < 4; ++w) { const int ss = s - 3 + w; if (ss >= 0) a += bf2f(proj[((size_t)b * SEQ + ss) * NP + C_MK + h * MD + d]) * P.conv_w[w * 1024 + chn]; }
                    kk[idx] = siluf_(a) * 0.08838834764831845f;
                }
                __syncthreads();
                const int d = tid >> 2, e0 = (tid & 3) * 32;
                float acc[32]; float nacc = 0.f;
#pragma unroll
                for (int i = 0; i < 32; ++i) acc[i] = 0.f;
                for (int c = 0; c < CH; ++c) {
                    const float kv = kk[c * MD + d] * sw[c]; nacc += kv;
                    const bf16_t* vp = proj + (t0 + c) * NP + C_MV + h * MD + e0;
#pragma unroll
                    for (int i = 0; i < 32; ++i) acc[i] += kv * bf2f(vp[i]);
                }
                const int sidx = bn * MH + h;
                float* dst = mst + ((size_t)sidx * MD + d) * MD + e0;
#pragma unroll
                for (int i = 0; i < 32; ++i) dst[i] = acc[i];
                if ((tid & 3) == 0) mn[(size_t)sidx * MD + d] = nacc;
                if (tid == 0) { ml[sidx] = mloc; mbl[sidx] = bL; }
            }
        }
        __syncthreads();
    }
    GRID_BAR(2);
    if constexpr (IN(3)) {
        PH_IDS
        const long NT = (long)G * NTHREADS; const long NR = (long)BATCH * RH * RD * RD, NM = (long)BATCH * MH * MD * MD, NN = (long)BATCH * MH * MD;
        for (long idx = (long)bid * NTHREADS + tid; idx < NR + NM + NN; idx += NT) {
            if (idx < NR) {
                const int el = (int)(idx % (RD * RD)); const int bh = (int)(idx / (RD * RD)); const int b = bh / RH, h = bh % RH;
                const float dec = expf(log1pf(-exp2f(-5.0f - (float)h)) * (float)CH);
                float R = 0.f;
                for (int n = 0; n < NCH; ++n) { float* ptr = rst + ((size_t)((b * NCH + n) * RH + h)) * (RD * RD) + el; const float tmp = *ptr; *ptr = R; R = dec * R + tmp; }
            } else {
                const long j = idx - NR; const bool isn = j >= NM;
                const long jj = isn ? j - NM : j; const int per = isn ? MD : MD * MD;
                const int el = (int)(jj % per); const int bh = (int)(jj / per); const int b = bh / MH, h = bh % MH;
                float S = 0.f, m = 0.f;
                for (int n = 0; n < NCH; ++n) {
                    const int sidx = (b * NCH + n) * MH + h;
                    const float bL = mbl[sidx], mloc = ml[sidx];
                    const float mnew = fmaxf(bL + m, mloc);
                    const float dec = expf(bL + m - mnew), sc = expf(mloc - mnew);
                    float* ptr = isn ? mn + (size_t)sidx * MD + el : mst + (size_t)sidx * (MD * MD) + el;
                    const float tmp = *ptr; *ptr = S; S = dec * S + sc * tmp;
                    if (isn && el == 0) mm[sidx] = m;
                    m = mnew;
                }
            }
        }
    }
    GRID_BAR(3);
    if constexpr (IN(4)) {
        PH_IDS
        const int nitems = BATCH * NCH * (RH + MH);
        const float* cstab = (const float*)(ws + WS_CS);
        for (int it = bid; it < nitems; it += G) {
            const int bn = it / (RH + MH), hh = it % (RH + MH), b = bn / NCH, n = bn % NCH;
            const size_t t0 = (size_t)b * SEQ + (size_t)n * CH;
            __syncthreads();
            if (hh < RH) {
                const int h = hh;
                const float lg2 = log1pf(-exp2f(-5.0f - (float)h)) * 1.4426950408889634f;
                LAS unsigned char* Qt = ldsl; LAS unsigned char* Kt = ldsl + 18432; LAS unsigned char* Vt = ldsl + 36864; LAS unsigned char* Rpt = ldsl + 55296;
                LAS float* Zs = (LAS float*)(ldsl + 65536);
                {
                    const int c = tid >> 2, j0 = (tid & 3) * 8; const size_t t = t0 + c;
                    const f4v* csp = (const f4v*)(cstab + t * 64 + j0 * 2);
                    float cs[16];
#pragma unroll
                    for (int i = 0; i < 4; ++i) { const f4v v = csp[i]; cs[4 * i] = v.x; cs[4 * i + 1] = v.y; cs[4 * i + 2] = v.z; cs[4 * i + 3] = v.w; }
                    const bf16_t* qp = proj + t * NP + C_RQ + h * RD; const bf16_t* kp = proj + t * NP + C_RK + h * RD;
                    rot8_store(Qt, c, j0, *(const v4u*)(qp + j0), *(const v4u*)(qp + 32 + j0), cs, 1.0f);
                    rot8_store(Kt, c, j0, *(const v4u*)(kp + j0), *(const v4u*)(kp + 32 + j0), cs, 0.125f);
                }
#pragma unroll
                for (int i = tid; i < CH * 8; i += NTHREADS) { const int row = i >> 3, ch = i & 7; *(LAS v4u*)(Vt + toff<64>(row, ch)) = *(const v4u*)(proj + (t0 + row) * NP + C_RV + h * RD + ch * 8); }
                {   const int d = tid >> 3, ch = tid & 7; const f4v* rp = (const f4v*)(rst + (size_t)(bn * RH + h) * (RD * RD) + d * RD + ch * 8);
                    const f4v a = rp[0], c2 = rp[1]; v4u w; w.x = cvtpk(a.x, a.y); w.y = cvtpk(a.z, a.w); w.z = cvtpk(c2.x, c2.y); w.w = cvtpk(c2.z, c2.w);
                    *(LAS v4u*)(Rpt + toff<64>(d, ch)) = w; }
                __syncthreads();
                {
                    const int cb = wave >> 1, eb = wave & 1, r = lane & 31, hl = lane >> 5;
                    f32x16 Z = zero16();
                    const int c = cb * 32 + r;
                    for (int jb = 0; jb <= cb; ++jb) {
                        f32x16 X = zero16();
#pragma unroll
                        for (int s = 0; s < 4; ++s) X = MFMA32(frag_row<64>(Kt, jb * 32 + r, s, hl), frag_row<64>(Qt, cb * 32 + r, s, hl), X);
#pragma unroll
                        for (int reg = 0; reg < 16; ++reg) { const int dl = c - (jb * 32 + crow(reg, hl)); X[reg] = dl >= 0 ? X[reg] * __builtin_amdgcn_exp2f(lg2 * (float)dl) : 0.f; }
#pragma unroll
                        for (int s2 = 0; s2 < 2; ++s2) Z = MFMA32(pack_step(X, s2), frag_tr<64, true>(Vt, jb * 32 + 16 * s2, eb * 32, lane), Z);
                    }
                    f32x16 Zi = zero16();
#pragma unroll
                    for (int s = 0; s < 4; ++s) Zi = MFMA32(frag_row<64>(Qt, cb * 32 + r, s, hl), frag_tr<64, false>(Rpt, 16 * s, eb * 32, lane), Zi);
#pragma unroll
                    for (int reg = 0; reg < 16; ++reg) { const int cc = cb * 32 + crow(reg, hl); Z[reg] += __builtin_amdgcn_exp2f(lg2 * (float)(cc + 1)) * Zi[reg]; Zs[cc * 68 + eb * 32 + r] = Z[reg]; }
                }
                __syncthreads();
                {
                    const int c = tid >> 2, e0 = (tid & 3) * 16; const size_t t = t0 + c;
                    float z[16]; float ss = 0.f;
#pragma unroll
                    for (int i = 0; i < 4; ++i) { const f4v v = *(const LAS f4v*)(Zs + c * 68 + e0 + 4 * i); z[4 * i] = v.x; z[4 * i + 1] = v.y; z[4 * i + 2] = v.z; z[4 * i + 3] = v.w; }
#pragma unroll
                    for (int i = 0; i < 16; ++i) ss += z[i] * z[i];
                    ss += __shfl_xor(ss, 1); ss += __shfl_xor(ss, 2);
                    const float rn = 1.0f / sqrtf(ss * (1.0f / RD) + EPS);
                    const v4u g0 = *(const v4u*)(proj + t * NP + C_RG + h * RD + e0), g1 = *(const v4u*)(proj + t * NP + C_RG + h * RD + e0 + 8);
                    const float gg[16] = {blo(g0.x), bhi(g0.x), blo(g0.y), bhi(g0.y), blo(g0.z), bhi(g0.z), blo(g0.w), bhi(g0.w), blo(g1.x), bhi(g1.x), blo(g1.y), bhi(g1.y), blo(g1.z), bhi(g1.z), blo(g1.w), bhi(g1.w)};
                    float o[16];
#pragma unroll
                    for (int i = 0; i < 16; ++i) o[i] = siluf_(gg[i]) * z[i] * rn * P.ret_gn[h * RD + e0 + i];
                    v4u w0, w1; w0.x = cvtpk(o[0], o[1]); w0.y = cvtpk(o[2], o[3]); w0.z = cvtpk(o[4], o[5]); w0.w = cvtpk(o[6], o[7]);
                    w1.x = cvtpk(o[8], o[9]); w1.y = cvtpk(o[10], o[11]); w1.z = cvtpk(o[12], o[13]); w1.w = cvtpk(o[14], o[15]);
                    *(v4u*)(yreg + t * D + h * RD + e0) = w0; *(v4u*)(yreg + t * D + h * RD + e0 + 8) = w1;
                }
            } else {
                const int h = hh - RH; const int sidx = bn * MH + h;
                LAS unsigned char* Qt = ldsl; LAS unsigned char* Kt = ldsl + 32768; LAS unsigned char* Vt = ldsl + 65536; LAS unsigned char* Spt = ldsl + 98304;
                LAS float* sb = (LAS float*)(ldsl + 131072); LAS float* sg = sb + 128; LAS float* spm = sg + 128; LAS float* snp = spm + 128; LAS float* sden = snp + 128; LAS float* swi = sden + 128;
                LAS float* Zs = (LAS float*)(ldsl + 32768);
                const float mprev = mm[sidx];
                if (wave == 0) {
                    const size_t t = t0 + 2 * lane;
                    const float i0 = gates[t * 8 + h] + P.b_ig[h], i1 = gates[(t + 1) * 8 + h] + P.b_ig[h];
                    float b0 = logsigmoidf_(gates[t * 8 + 4 + h] + P.b_fg[h]), b1 = logsigmoidf_(gates[(t + 1) * 8 + 4 + h] + P.b_fg[h]);
                    wave_scan_sum2(b0, b1, lane);
                    const float g0 = i0 - b0, g1 = i1 - b1; float p0 = g0, p1 = g1;
                    wave_scan_max2(p0, p1, lane);
                    sb[2 * lane] = b0; sb[2 * lane + 1] = b1; sg[2 * lane] = g0; sg[2 * lane + 1] = g1; spm[2 * lane] = p0; spm[2 * lane + 1] = p1;
                    swi[2 * lane] = expf(mprev - fmaxf(p0, mprev)); swi[2 * lane + 1] = expf(mprev - fmaxf(p1, mprev));
                } else if (wave == 1) { snp[lane] = mn[(size_t)sidx * MD + lane]; snp[lane + 64] = mn[(size_t)sidx * MD + lane + 64]; }
                {
                    const int cg = tid & 15, d0 = cg * 8;
#pragma unroll 1
                    for (int which = 0; which < 2; ++which) {
                        const int chn = which * 512 + h * MD + d0;
                        float cw[32], cb_[8];
#pragma unroll
                        for (int w = 0; w < 4; ++w)
#pragma unroll
                            for (int i = 0; i < 8; ++i) cw[w * 8 + i] = P.conv_w[w * 1024 + chn + i];
#pragma unroll
                        for (int i = 0; i < 8; ++i) cb_[i] = P.conv_b[chn + i];
                        LAS unsigned char* dst = which ? Kt : Qt; const float sc = which ? 0.08838834764831845f : 1.0f;
#pragma unroll
                        for (int i = 0; i < 4; ++i) {
                            const int c = (tid >> 4) + 32 * i; float o[8];
                            conv8(proj + (t0 + c) * NP + (which ? C_MK : C_MQ) + h * MD + d0, n * CH + c, cw, cb_, o);
                            v4u w; w.x = cvtpk(o[0] * sc, o[1] * sc); w.y = cvtpk(o[2] * sc, o[3] * sc); w.z = cvtpk(o[4] * sc, o[5] * sc); w.w = cvtpk(o[6] * sc, o[7] * sc);
                            *(LAS v4u*)(dst + toff<128>(c, cg)) = w;
                        }
                    }
                }
#pragma unroll
                for (int i = tid; i < CH * 16; i += NTHREADS) { const int row = i >> 4, ch = i & 15; *(LAS v4u*)(Vt + toff<128>(row, ch)) = *(const v4u*)(proj + (t0 + row) * NP + C_MV + h * MD + ch * 8); }
#pragma unroll
                for (int i = tid; i < MD * 16; i += NTHREADS) { const int d = i >> 4, ch = i & 15; const f4v* sp = (const f4v*)(mst + (size_t)sidx * (MD * MD) + d * MD + ch * 8);
                    const f4v a = sp[0], c2 = sp[1]; v4u w; w.x = cvtpk(a.x, a.y); w.y = cvtpk(a.z, a.w); w.z = cvtpk(c2.x, c2.y); w.w = cvtpk(c2.z, c2.w);
                    *(LAS v4u*)(Spt + toff<128>(d, ch)) = w; }
                __syncthreads();
                const int cb = wave >> 1, ep = wave & 1, r = lane & 31, hl = lane >> 5;
                f32x16 Z0 = zero16(), Z1 = zero16();
                {
                    const int c = cb * 32 + r;
                    const float nc = -fmaxf(spm[c], mprev); float den = 0.f;
                    for (int jb = 0; jb <= cb; ++jb) {
                        f32x16 X = zero16();
#pragma unroll
                        for (int s = 0; s < 8; ++s) X = MFMA32(frag_row<128>(Kt, jb * 32 + r, s, hl), frag_row<128>(Qt, cb * 32 + r, s, hl), X);
#pragma unroll
                        for (int reg = 0; reg < 16; ++reg) { const int j = jb * 32 + crow(reg, hl); X[reg] = j <= c ? X[reg] * __expf(nc + sg[j]) : 0.f; den += X[reg]; }
#pragma unroll
                        for (int s2 = 0; s2 < 2; ++s2) { const bf16x8 xs_ = pack_step(X, s2);
                            Z0 = MFMA32(xs_, frag_tr<128, true>(Vt, jb * 32 + 16 * s2, ep * 64, lane), Z0);
                            Z1 = MFMA32(xs_, frag_tr<128, true>(Vt, jb * 32 + 16 * s2, ep * 64 + 32, lane), Z1); }
                    }
                    den += __shfl_xor(den, 32);
                    if (ep == 0 && hl == 0) sden[c] = den;
                    f32x16 Y0 = zero16(), Y1 = zero16();
#pragma unroll
                    for (int s = 0; s < 8; ++s) { const bf16x8 qa = frag_row<128>(Qt, cb * 32 + r, s, hl);
                        Y0 = MFMA32(qa, frag_tr<128, false>(Spt, 16 * s, ep * 64, lane), Y0);
                        Y1 = MFMA32(qa, frag_tr<128, false>(Spt, 16 * s, ep * 64 + 32, lane), Y1); }
#pragma unroll
                    for (int reg = 0; reg < 16; ++reg) { const float wi = swi[cb * 32 + crow(reg, hl)]; Z0[reg] += wi * Y0[reg]; Z1[reg] += wi * Y1[reg]; }
                }
                __syncthreads();
#pragma unroll
                for (int reg = 0; reg < 16; ++reg) { const int cc = cb * 32 + crow(reg, hl); Zs[cc * 132 + ep * 64 + r] = Z0[reg]; Zs[cc * 132 + ep * 64 + 32 + r] = Z1[reg]; }
                __syncthreads();
                {
                    const int c = tid >> 2, qd = tid & 3, e0 = qd * 32; const size_t t = t0 + c;
                    float qn = 0.f;
#pragma unroll
                    for (int i = 0; i < 4; ++i) { const v4u qv = *(const LAS v4u*)(Qt + toff<128>(c, 4 * qd + i)); const LAS float* np_ = snp + 32 * qd + 8 * i;
                        qn += blo(qv.x) * np_[0] + bhi(qv.x) * np_[1] + blo(qv.y) * np_[2] + bhi(qv.y) * np_[3] + blo(qv.z) * np_[4] + bhi(qv.z) * np_[5] + blo(qv.w) * np_[6] + bhi(qv.w) * np_[7]; }
                    qn += __shfl_xor(qn, 1); qn += __shfl_xor(qn, 2);
                    const float M = fmaxf(spm[c], mprev), mrow = sb[c] + M;
                    const float den = sden[c] + swi[c] * qn;
                    const float inv = 1.0f / fmaxf(fabsf(den), expf(-mrow));
                    float z[32]; float ss = 0.f;
#pragma unroll
                    for (int i = 0; i < 8; ++i) { const f4v v = *(const LAS f4v*)(Zs + c * 132 + e0 + 4 * i); z[4 * i] = v.x; z[4 * i + 1] = v.y; z[4 * i + 2] = v.z; z[4 * i + 3] = v.w; }
                    const bf16_t* op = proj + t * NP + C_MO + h * MD + e0;
#pragma unroll
                    for (int i = 0; i < 4; ++i) { const v4u ov = *(const v4u*)(op + 8 * i);
                        const float oo[8] = {blo(ov.x), bhi(ov.x), blo(ov.y), bhi(ov.y), blo(ov.z), bhi(ov.z), blo(ov.w), bhi(ov.w)};
#pragma unroll
                        for (int k = 0; k < 8; ++k) { const float v = sigmoidf_(oo[k]) * z[8 * i + k] * inv; z[8 * i + k] = v; ss += v * v; } }
                    ss += __shfl_xor(ss, 1); ss += __shfl_xor(ss, 2);
                    const float rn = 1.0f / sqrtf(ss * (1.0f / MD) + EPS);
                    bf16_t* yp = yreg + t * D + 512 + h * MD + e0; const float* gn = P.ml_gn + h * MD + e0;
#pragma unroll
                    for (int i = 0; i < 4; ++i) { v4u w; w.x = cvtpk(z[8 * i] * rn * gn[8 * i], z[8 * i + 1] * rn * gn[8 * i + 1]); w.y = cvtpk(z[8 * i + 2] * rn * gn[8 * i + 2], z[8 * i + 3] * rn * gn[8 * i + 3]);
                        w.z = cvtpk(z[8 * i + 4] * rn * gn[8 * i + 4], z[8 * i + 5] * rn * gn[8 * i + 5]); w.w = cvtpk(z[8 * i + 6] * rn * gn[8 * i + 6], z[8 * i + 7] * rn * gn[8 * i + 7]);
                        *(v4u*)(yp + 8 * i) = w; }
                }
            }
        }
        __syncthreads();
    }
    GRID_BAR(4);
    if constexpr (IN(5)) {
        PH_IDS
        pg8::Gemm g{yreg, wout_t, T, D, D}; pg8::StaticOrder S; S.init(T, D, G, bid);
        pg8::EpiRes E{P.x, out};
        pg8::gemm_phase<pg8::EpiRes, pg8::StaticOrder, true, true>(ldsl, g, S, E);
    }
    GRID_BAR(5);
    if constexpr (IN(6)) {
        PH_IDS
        for (int row = gw; row < T; row += NGW) {
            const float4* hr = (const float4*)(out + (size_t)row * D) + lane;
            float4 v[4]; float ss = 0.f;
#pragma unroll
            for (int j = 0; j < 4; ++j) { v[j] = hr[64 * j]; ss += v[j].x * v[j].x + v[j].y * v[j].y + v[j].z * v[j].z + v[j].w * v[j].w; }
            ss = wave_sum(ss);
            const float rstd = 1.0f / sqrtf(ss * (1.0f / D) + EPS);
            float lg[36];
#pragma unroll
            for (int i = 0; i < 36; ++i) lg[i] = 0.f;
#pragma unroll 1
            for (int j = 0; j < 4; ++j) {
                const int k0 = 4 * (lane + 64 * j);
                const float4 nv = *(const float4*)(P.moe_norm + k0);
                const float4 vj = hr[64 * j];
                const float xs_[4] = {vj.x * nv.x * rstd, vj.y * nv.y * rstd, vj.z * nv.z * rstd, vj.w * nv.w * rstd};
                uint2 o; o.x = pk2(xs_[0], xs_[1]); o.y = pk2(xs_[2], xs_[3]);
                *(uint2*)(yreg + (size_t)row * D + k0) = o;
#pragma unroll 1
                for (int i = 0; i < 4; ++i) {
                    const float xv = i == 0 ? xs_[0] : i == 1 ? xs_[1] : i == 2 ? xs_[2] : xs_[3];
                    const float4 wg = *(const float4*)(P.w_group + (size_t)(k0 + i) * 4);
                    lg[0] += xv * wg.x; lg[1] += xv * wg.y; lg[2] += xv * wg.z; lg[3] += xv * wg.w;
                    const float4* wr = (const float4*)(P.w_router + (size_t)(k0 + i) * 32);
#pragma unroll
                    for (int q = 0; q < 8; ++q) { const float4 w = wr[q]; lg[4 + 4 * q] += xv * w.x; lg[5 + 4 * q] += xv * w.y; lg[6 + 4 * q] += xv * w.z; lg[7 + 4 * q] += xv * w.w; }
                }
            }
#pragma unroll
            for (int i = 0; i < 36; ++i) lg[i] = wave_sum(lg[i]);
            float gl[4];
#pragma unroll
            for (int i = 0; i < 4; ++i) gl[i] = lg[i] + P.b_group[i];
            int gs = 0; float gmax = gl[0];
#pragma unroll
            for (int i = 1; i < 4; ++i) if (gl[i] > gmax) { gmax = gl[i]; gs = i; }
            float gsum = 0.f;
#pragma unroll
            for (int i = 0; i < 4; ++i) gsum += expf(gl[i] - gmax);
            const float pg = 1.0f / gsum;
            float el[8];
#pragma unroll
            for (int i = 0; i < 8; ++i) {
                float a = lg[4 + i] + P.b_router[i];
                if (gs == 1) a = lg[12 + i] + P.b_router[8 + i];
                if (gs == 2) a = lg[20 + i] + P.b_router[16 + i];
                if (gs == 3) a = lg[28 + i] + P.b_router[24 + i];
                el[i] = a;
            }
            int i0 = 0; float l0 = el[0];
#pragma unroll
            for (int i = 1; i < 8; ++i) if (el[i] > l0) { l0 = el[i]; i0 = i; }
            int i1 = -1; float l1 = -INFINITY;
#pragma unroll
            for (int i = 0; i < 8; ++i) if (i != i0 && el[i] > l1) { l1 = el[i]; i1 = i; }
            const float r = expf(l1 - l0);
            const float g0 = pg / (1.0f + r), g1 = pg * r / (1.0f + r);
            if (lane == 0) {
                const int e0 = gs * 8 + i0, e1 = gs * 8 + i1;
                const int p0 = atomicAdd(&cnt[e0], 1), p1 = atomicAdd(&cnt[e1], 1);
                list[(size_t)e0 * T + p0] = row; list[(size_t)e1 * T + p1] = row;
                eid[row * 2] = e0; eid[row * 2 + 1] = e1; posn[row * 2] = p0; posn[row * 2 + 1] = p1;
                gate[row * 2] = g0; gate[row * 2 + 1] = g1;
            }
        }
    }
    GRID_BAR(6);
    if constexpr (IN(7) || IN(8) || IN(9) || IN(11)) {
        PH_IDS
        __syncthreads();
        if (tid == 0) { int o = 0; for (int e = 0; e < NE; ++e) { const int c = cnt[e]; s_cnt[e] = c; s_off[e] = o; const int nt = (c + 255) >> 8; for (int i = 0; i < nt; ++i) s_t2e[(o >> 8) + i] = e; o += nt << 8; } s_off[NE] = o; }
        __syncthreads();
    }
    if constexpr (IN(7)) {
        PH_IDS
        const int NS = s_off[NE];
        for (int s = gw; s < NS; s += NGW) {
            const int e = s_t2e[s >> 8], i = s - s_off[e];
            v4u a = {0u, 0u, 0u, 0u}, b2 = {0u, 0u, 0u, 0u};
            if (i < s_cnt[e]) { const int tok = list[(size_t)e * T + i]; const v4u* src = (const v4u*)(yreg + (size_t)tok * D); a = src[lane]; b2 = src[lane + 64]; }
            v4u* dst = (v4u*)(xs + (size_t)s * D); dst[lane] = a; dst[lane + 64] = b2;
        }
    }
    GRID_BAR(7);
    if constexpr (IN(8)) {
        PH_IDS
        const int NS = s_off[NE];
        pg8::Gemm g{xs, w13_t, NS, NE * 1024, D}; pg8::GroupedOrder S; S.init(NS >> 8, G, bid, (const LAS int*)s_t2e);
        pg8::EpiSwiglu E{hbuf};
        pg8::gemm_phase<pg8::EpiSwiglu, pg8::GroupedOrder, true, true>(ldsl, g, S, E);
    }
    GRID_BAR(8);
    if constexpr (IN(9)) {
        PH_IDS
        const int NS = s_off[NE];
        pg8::Gemm g{hbuf, w2_t, NS, NE * 1024, DE}; pg8::GroupedOrder S; S.init(NS >> 8, G, bid, (const LAS int*)s_t2e);
        pg8::EpiStoreBf16 E{ybuf, D, 3, nullptr};
        pg8::gemm_phase<pg8::EpiStoreBf16, pg8::GroupedOrder, true, true>(ldsl, g, S, E);
    }
    GRID_BAR(9);
    if constexpr (IN(10)) {
        PH_IDS
        pg8::Gemm g{pb, wup_t, T, D, PLE}; pg8::StaticOrder S; S.init(T, D, G, bid);
        pg8::EpiStoreBf16 E{peb, D, 0xffff, part};
        pg8::gemm_phase<pg8::EpiStoreBf16, pg8::StaticOrder, true, true>(ldsl, g, S, E);
    }
    GRID_BAR(10);
    if constexpr (IN(11)) {
        PH_IDS
        for (int row = gw; row < T; row += NGW) {
            const int s0 = s_off[eid[row * 2]] + posn[row * 2], s1 = s_off[eid[row * 2 + 1]] + posn[row * 2 + 1];
            const float g0 = gate[row * 2], g1 = gate[row * 2 + 1];
            float ss = 0.f;
#pragma unroll
            for (int j = 0; j < 4; ++j) {
                const int k0 = 4 * (lane + 64 * j);
                float4 hv = *(const float4*)(out + (size_t)row * D + k0);
                float y0[4], y1[4]; load4(ybuf + (size_t)s0 * D + k0, y0); load4(ybuf + (size_t)s1 * D + k0, y1);
                hv.x += g0 * y0[0] + g1 * y1[0]; hv.y += g0 * y0[1] + g1 * y1[1]; hv.z += g0 * y0[2] + g1 * y1[2]; hv.w += g0 * y0[3] + g1 * y1[3];
                *(float4*)(out + (size_t)row * D + k0) = hv;
                ss += hv.x * hv.x + hv.y * hv.y + hv.z * hv.z + hv.w * hv.w;
                uint2 o; o.x = pk2(hv.x, hv.y); o.y = pk2(hv.z, hv.w);
                *(uint2*)(yreg + (size_t)row * D + k0) = o;
            }
            ss = wave_sum(ss);
            float pe = lane < 16 ? part[(size_t)row * 16 + lane] : 0.f;
            pe = wave_sum(pe);
            if (lane == 0) { rstdg[row] = 1.0f / sqrtf(ss * (1.0f / D) + EPS); rstde[row] = 1.0f / sqrtf(pe * (1.0f / D) + EPS); }
        }
    }
    GRID_BAR(11);
    if constexpr (IN(12)) {
        PH_IDS
        pg8::Gemm g{yreg, wgate_t, T, D, D}; pg8::StaticOrder S; S.init(T, D, G, bid);
        pg8::EpiGate E{out, peb, rstdg, rstde, P.ple_norm, part2};
        pg8::gemm_phase<pg8::EpiGate, pg8::StaticOrder, true, true>(ldsl, g, S, E);
    }
    GRID_BAR(12);
    if constexpr (IN(13)) {
        PH_IDS
        for (int row = gw; row < T; row += NGW) {
            float4* hr = (float4*)(out + (size_t)row * D) + lane;
            float4 v[4];
#pragma unroll
            for (int j = 0; j < 4; ++j) v[j] = hr[64 * j];
            float ss = lane < 16 ? part2[(size_t)row * 16 + lane] : 0.f;
            ss = wave_sum(ss);
            const float rstd = 1.0f / sqrtf(ss * (1.0f / D) + EPS);
#pragma unroll
            for (int j = 0; j < 4; ++j) {
                const float4 nv = *(const float4*)(P.final_norm + 4 * (lane + 64 * j));
                float4 o; o.x = v[j].x * rstd * nv.x; o.y = v[j].y * rstd * nv.y; o.z = v[j].z * rstd * nv.z; o.w = v[j].w * rstd * nv.w;
                hr[64 * j] = o;
            }
        }
    }
#undef GRID_BAR
#undef PH_IDS
#undef IN
#undef rstd1
#undef gates
#undef rstdg
#undef rstde
#undef eid
#undef posn
#undef gate
#undef mn
#undef ml
#undef mbl
#undef mm
#undef list
#undef cnt
#undef part
#undef part2
#undef win_t
#undef wout_t
#undef w13_t
#undef w2_t
#undef wgate_t
#undef wup_t
#undef proj
#undef hbuf
#undef xs
#undef ybuf
#undef peb
#undef yreg
#undef pb
#undef rst
#undef mst
}

template <int PH> static void launch_one(int grid, const Params& p, hipStream_t stream) {
    static bool attr_done = false;
    if (!attr_done) { (void)hipFuncSetAttribute((const void*)mk<PH, PH + 1>, hipFuncAttributeMaxDynamicSharedMemorySize, LDS_BYTES); attr_done = true; }
    hipLaunchKernelGGL((mk<PH, PH + 1>), dim3(grid), dim3(NTHREADS), LDS_BYTES, stream, p);
}
template <int PH> static void launch_all(int grid, const Params& p, hipStream_t stream) {
    if constexpr (PH < NPHASES) { launch_one<PH>(grid, p, stream); launch_all<PH + 1>(grid, p, stream); }
}
#ifndef MK_N_LAUNCHES
#define MK_N_LAUNCHES 1
#endif

extern "C" void kernel_launch(void* const* d_in, const int* in_sizes, int n_in, void* d_out, int out_size, void* d_ws, size_t ws_size, hipStream_t stream) {
    static int grid = 0;
    if (grid == 0) {
        if (n_in != 25 || in_sizes[0] != T * D || out_size != T * D || ws_size < WS_END) {
            fprintf(stderr, "kernel_launch: unexpected shapes: n_in %d in0 %d out %d ws %zu\n", n_in, n_in > 0 ? in_sizes[0] : -1, out_size, ws_size); grid = -1; return; }
        int dev = 0, cus = 0;
        (void)hipGetDevice(&dev); (void)hipDeviceGetAttribute(&cus, hipDeviceAttributeMultiprocessorCount, dev);
        (void)hipGetLastError();
        grid = cus;
        if (MK_N_LAUNCHES == 1) {
            int per_cu = 0;
            if (hipFuncSetAttribute((const void*)mk<0, NPHASES>, hipFuncAttributeMaxDynamicSharedMemorySize, LDS_BYTES) != hipSuccess) { fprintf(stderr, "kernel_launch: hipFuncSetAttribute failed\n"); grid = -1; return; }
            if (hipOccupancyMaxActiveBlocksPerMultiprocessor(&per_cu, (const void*)mk<0, NPHASES>, NTHREADS, LDS_BYTES) != hipSuccess || per_cu < 1) { fprintf(stderr, "kernel_launch: occupancy query reports %d workgroups per CU; the grid barrier needs one resident workgroup per CU; nothing launched\n", per_cu); grid = -1; return; }
            (void)hipGetLastError();
        }
    }
    if (grid < 0) return;
    (void)hipMemsetAsync((char*)d_ws + WS_CTL, 0, 1 * MiB, stream);
    Params p{};
    p.x = (const float*)d_in[0]; p.p = (const float*)d_in[1]; p.pos = (const int*)d_in[2];
    p.attn_norm = (const float*)d_in[3]; p.w_in = (const float*)d_in[4]; p.conv_w = (const float*)d_in[5]; p.conv_b = (const float*)d_in[6];
    p.b_ig = (const float*)d_in[7]; p.b_fg = (const float*)d_in[8]; p.ret_gn = (const float*)d_in[9]; p.ml_gn = (const float*)d_in[10];
    p.w_out = (const float*)d_in[11]; p.moe_norm = (const float*)d_in[12]; p.w_group = (const float*)d_in[13]; p.b_group = (const float*)d_in[14];
    p.w_router = (const float*)d_in[15]; p.b_router = (const float*)d_in[16]; p.w1 = (const float*)d_in[17]; p.w3 = (const float*)d_in[18]; p.w2 = (const float*)d_in[19];
    p.w_up = (const float*)d_in[20]; p.ple_norm = (const float*)d_in[21]; p.pg_norm = (const float*)d_in[22]; p.w_gate = (const float*)d_in[23]; p.final_norm = (const float*)d_in[24];
    p.out = (float*)d_out; p.ws = (unsigned char*)d_ws;
    if (MK_N_LAUNCHES == 1) hipLaunchKernelGGL((mk<0, NPHASES>), dim3(grid), dim3(NTHREADS), LDS_BYTES, stream, p);
    else launch_all<0>(grid, p, stream);
}
```

```cpp
#include <hip/hip_runtime.h>
#include <cstdio>
#include <cstdint>

constexpr int D = 1024, BATCH = 4, SEQ = 8192, T = BATCH * SEQ, PLE = 256;
constexpr int NPROJ = 4104, NP = 4096;
constexpr int CH = 128, NCH = SEQ / CH;
constexpr int RH = 8, RD = 64, MH = 4, MD = 128;
constexpr int NE = 32, DE = 512;
constexpr float EPS = 1e-6f;
constexpr int C_RQ = 0, C_RK = 512, C_RV = 1024, C_RG = 1536, C_MQ = 2048, C_MK = 2560, C_MV = 3072, C_MO = 3584;

constexpr size_t MiB = 1u << 20;
constexpr size_t WS_CTL = 0;
constexpr size_t WS_RSTD1 = 1 * MiB;
constexpr size_t WS_GATES = WS_RSTD1 + 256 * 1024;
constexpr size_t WS_RSTDG = 3 * MiB;
constexpr size_t WS_RSTDE = WS_RSTDG + 256 * 1024;
constexpr size_t WS_EID = 4 * MiB;
constexpr size_t WS_POS = WS_EID + 256 * 1024;
constexpr size_t WS_GATE = WS_POS + 256 * 1024;
constexpr size_t WS_MN = 5 * MiB;
constexpr size_t WS_ML = WS_MN + 512 * 1024;
constexpr size_t WS_MBL = WS_ML + 4096;
constexpr size_t WS_MM = WS_MBL + 4096;
constexpr size_t WS_LIST = 8 * MiB;
constexpr size_t WS_PART = 12 * MiB;
constexpr size_t WS_PART2 = 14 * MiB;
constexpr size_t WS_WIN = 16 * MiB;
constexpr size_t WS_WOUT = 24 * MiB;
constexpr size_t WS_W13 = 26 * MiB;
constexpr size_t WS_W2 = 90 * MiB;
constexpr size_t WS_WGATE = 122 * MiB;
constexpr size_t WS_WUP = 124 * MiB;
constexpr size_t WS_PROJ = 128 * MiB;
constexpr size_t WS_HBUF = 128 * MiB;
constexpr size_t WS_XS = 200 * MiB;
constexpr size_t WS_YBUF = 200 * MiB;
constexpr size_t WS_PEB = 128 * MiB;
constexpr size_t WS_YREG = 384 * MiB;
constexpr size_t WS_PB = 448 * MiB;
constexpr size_t WS_CS = 464 * MiB;
constexpr size_t WS_END = 472 * MiB;
constexpr size_t OUT_RST = 0;
constexpr size_t OUT_MST = 32 * MiB;
constexpr int CW_CNT = 64;
constexpr int CW_BAR = 4096;

constexpr int NTHREADS = 512, NWAVES = 8;
constexpr int RING_BYTES = 131072;
constexpr int LDSX_OFF = 143360;
constexpr int LDS_BYTES = 147456;

#define GAS __attribute__((address_space(1)))
#define LAS __attribute__((address_space(3)))
typedef unsigned short bf16_t;
typedef unsigned v4u __attribute__((ext_vector_type(4)));
__device__ __forceinline__ float bf2f(bf16_t h) { return __uint_as_float((unsigned)h << 16); }
__device__ __forceinline__ unsigned f2bf(float f) { unsigned u = __float_as_uint(f); return (u + 0x7fffu + ((u >> 16) & 1u)) >> 16; }
__device__ __forceinline__ unsigned pk2(float lo, float hi) { return f2bf(lo) | (f2bf(hi) << 16); }
__device__ __forceinline__ float wave_sum(float v) {
#pragma unroll
    for (int o = 1; o < 64; o <<= 1) v += __shfl_xor(v, o);
    return v;
}
__device__ __forceinline__ float sigmoidf_(float x) { return 1.0f / (1.0f + expf(-x)); }
__device__ __forceinline__ float siluf_(float x) { return x / (1.0f + expf(-x)); }
__device__ __forceinline__ float logsigmoidf_(float x) { return x >= 0.f ? -log1pf(expf(-x)) : x - log1pf(expf(x)); }
#define LDS_WAIT() asm volatile("s_waitcnt lgkmcnt(0)" ::: "memory")

namespace pg8 {
#define PG8_LAS __attribute__((address_space(3)))
typedef unsigned short bf16_t;
typedef short bf16x8 __attribute__((ext_vector_type(8)));
typedef float f32x4 __attribute__((ext_vector_type(4)));
typedef unsigned u32x4 __attribute__((ext_vector_type(4)));
constexpr int BM = 256, BK = 64, HALF = 128, HTB = HALF * BK * 2  , STAGE_BYTES = 8 * HTB, NXCD = 8, WGM = 8;

__host__ __device__ __forceinline__ int lds_byte(int r, int c) { const int st = (r >> 4) * 2 + (c >> 5), rr = r & 15, cc = c & 31, ob = rr * 64 + cc * 2; return st * 1024 + (ob ^ (((ob >> 9) & 1) << 5)); }
__host__ __device__ __forceinline__ void stage_rc(int b, int& R, int& C) { const int st = b / 1024, sb = b % 1024, swz = sb ^ (((sb >> 9) & 1) << 5); R = (st >> 1) * 16 + swz / 64; C = (st & 1) * 32 + (swz % 64) / 2; }
__host__ __device__ __forceinline__ int perm32(int rho) { const int n = rho >> 4, i = rho & 15; return 8 * (i >> 2) + 4 * n + (i & 3); }

struct Unit { int pm, pn; };
struct Gemm { const bf16_t* A; const bf16_t* Bt; int M, N, K; };

struct StaticOrder {
    int nM, nN, nwg, G, c;
    __host__ __device__ void init(int M, int N, int G_, int c_) { nM = M / BM; nN = N / BM; nwg = nM * nN; G = G_; c = c_; }
    __host__ __device__ bool next(int i, Unit& u) const {
        const long L = (long)i * G + c; if (L >= nwg) return false;
        int wgid = (int)L; { const int q = nwg / NXCD, r = nwg % NXCD, xcd = wgid % NXCD, off = wgid / NXCD; wgid = (xcd < r ? xcd * (q + 1) : r * (q + 1) + (xcd - r) * q) + off; }
        const int nig = WGM * nN, gid = wgid / nig, fm = gid * WGM, gsz = (nM - fm) < WGM ? (nM - fm) : WGM;
        u.pm = fm + ((wgid % nig) % gsz); u.pn = (wgid % nig) / gsz; return true;
    }
    __device__ __forceinline__ void a_ready(const Unit&) const {}
    __device__ __forceinline__ void done(const Unit&) const {}
};

__device__ __forceinline__ unsigned cvt_pk_bf16(float lo, float hi) { unsigned r; asm volatile("v_cvt_pk_bf16_f32 %0, %1, %2" : "=v"(r) : "v"(lo), "v"(hi)); return r; }
typedef float f32x2 __attribute__((ext_vector_type(2)));
struct GroupedOrder {
    int nM, nwg, G, c; const PG8_LAS int* t2e;
    __device__ void init(int nM_, int G_, int c_, const PG8_LAS int* t2e_) { nM = nM_; nwg = nM_ * 4; G = G_; c = c_; t2e = t2e_; }
    __device__ bool next(int i, Unit& u) const {
        const long L = (long)i * G + c; if (L >= nwg) return false;
        int wgid = (int)L; { const int q = nwg / NXCD, r = nwg % NXCD, xcd = wgid % NXCD, off = wgid / NXCD; wgid = (xcd < r ? xcd * (q + 1) : r * (q + 1) + (xcd - r) * q) + off; }
        const int nig = WGM * 4, gid = wgid / nig, fm = gid * WGM, gsz = (nM - fm) < WGM ? (nM - fm) : WGM;
        u.pm = fm + ((wgid % nig) % gsz); u.pn = (wgid % nig) / gsz + 4 * t2e[u.pm]; return true;
    }
    __device__ __forceinline__ void a_ready(const Unit&) const {}
    __device__ __forceinline__ void done(const Unit&) const {}
};
__device__ __forceinline__ float fast_sigmoid(float x) { return __builtin_amdgcn_rcpf(1.0f + __builtin_amdgcn_exp2f(-1.4426950408889634f * x)); }
struct EpiStoreBf16 {
    static constexpr bool PERM = true, AFTER_DRAIN = false;
    bf16_t* O; int ldc; int pn_mask; float* part;
    __device__ __forceinline__ void operator()(const f32x4 (&acc)[2][2][4][2], const Unit& u, int wr, int wc, int fr, int fq) const {
        const int pnl = u.pn & pn_mask; const int row0 = u.pm * BM + wr * 64 + fr, col0 = pnl * BM + wc * 32 + 8 * fq;
#pragma unroll
        for (int ai = 0; ai < 2; ++ai)
#pragma unroll
            for (int m = 0; m < 4; ++m) { const int row = row0 + ai * HALF + m * 16; bf16_t* rowp = O + (size_t)row * ldc + col0; float s = 0.f;
#pragma unroll
                for (int bj = 0; bj < 2; ++bj) { const f32x4 v0 = acc[ai][bj][m][0], v1 = acc[ai][bj][m][1];
                    u32x4 w; w.x = cvt_pk_bf16(v0[0], v0[1]); w.y = cvt_pk_bf16(v0[2], v0[3]); w.z = cvt_pk_bf16(v1[0], v1[1]); w.w = cvt_pk_bf16(v1[2], v1[3]);
                    *(u32x4*)(rowp + bj * HALF) = w;
                    s += (v0[0] * v0[0] + v0[1] * v0[1]) + (v0[2] * v0[2] + v0[3] * v0[3]) + (v1[0] * v1[0] + v1[1] * v1[1]) + (v1[2] * v1[2] + v1[3] * v1[3]); }
                if (part) { s += __shfl_xor(s, 16); s += __shfl_xor(s, 32); if (fq == 0) part[(size_t)row * 16 + pnl * 4 + wc] = s; } }
    }
};
struct EpiSwiglu {
    static constexpr bool PERM = true, AFTER_DRAIN = false;
    bf16_t* H;
    __device__ __forceinline__ void operator()(const f32x4 (&acc)[2][2][4][2], const Unit& u, int wr, int wc, int fr, int fq) const {
        const int pnl = u.pn & 3; const int row0 = u.pm * BM + wr * 64 + fr, col0 = pnl * HALF + wc * 32 + 8 * fq;
#pragma unroll
        for (int ai = 0; ai < 2; ++ai)
#pragma unroll
            for (int m = 0; m < 4; ++m) { bf16_t* rowp = H + (size_t)(row0 + ai * HALF + m * 16) * 512 + col0;
                f32x4 h[2];
#pragma unroll
                for (int n = 0; n < 2; ++n) { const f32x4 a = acc[ai][0][m][n], b = acc[ai][1][m][n];
#pragma unroll
                    for (int j = 0; j < 4; ++j) h[n][j] = a[j] * fast_sigmoid(a[j]) * b[j]; }
                u32x4 w; w.x = cvt_pk_bf16(h[0][0], h[0][1]); w.y = cvt_pk_bf16(h[0][2], h[0][3]); w.z = cvt_pk_bf16(h[1][0], h[1][1]); w.w = cvt_pk_bf16(h[1][2], h[1][3]);
                *(u32x4*)rowp = w; }
    }
};
struct EpiRes {
    static constexpr bool PERM = false, AFTER_DRAIN = false;
    const float* base; float* out;
    __device__ __forceinline__ void operator()(const f32x4 (&acc)[2][2][4][2], const Unit& u, int wr, int wc, int fr, int fq) const {
        const int row0 = u.pm * BM + wr * 64 + fr, col0 = u.pn * BM + wc * 32 + 4 * fq;
#pragma unroll
        for (int ai = 0; ai < 2; ++ai)
#pragma unroll
            for (int m = 0; m < 4; ++m) { const size_t off = (size_t)(row0 + ai * HALF + m * 16) * 1024 + col0;
#pragma unroll
                for (int bj = 0; bj < 2; ++bj)
#pragma unroll
                    for (int n = 0; n < 2; ++n) { const f32x4 bs = *(const f32x4*)(base + off + bj * HALF + n * 16); *(f32x4*)(out + off + bj * HALF + n * 16) = bs + acc[ai][bj][m][n]; }
                asm volatile("" ::: "memory"); }
    }
};
struct EpiGate {
    static constexpr bool PERM = false, AFTER_DRAIN = false;
    float* out; const bf16_t* peb; const float* rstdg; const float* rstde; const float* ple_norm; float* part;
    __device__ __forceinline__ void operator()(const f32x4 (&acc)[2][2][4][2], const Unit& u, int wr, int wc, int fr, int fq) const {
        const int row0 = u.pm * BM + wr * 64 + fr, col0 = u.pn * BM + wc * 32 + 4 * fq;
        f32x4 pn4[2][2];
#pragma unroll
        for (int bj = 0; bj < 2; ++bj)
#pragma unroll
            for (int n = 0; n < 2; ++n) pn4[bj][n] = *(const f32x4*)(ple_norm + col0 + bj * HALF + n * 16);
#pragma unroll
        for (int ai = 0; ai < 2; ++ai)
#pragma unroll
            for (int m = 0; m < 4; ++m) { const int row = row0 + ai * HALF + m * 16; const size_t off = (size_t)row * 1024 + col0; const float rg = rstdg[row], re = rstde[row]; float s = 0.f;
#pragma unroll
                for (int bj = 0; bj < 2; ++bj)
#pragma unroll
                    for (int n = 0; n < 2; ++n) { const size_t o = off + bj * HALF + n * 16;
                        const uint2 pe = *(const uint2*)(peb + o); f32x4 h = *(const f32x4*)(out + o); const f32x4 a = acc[ai][bj][m][n];
                        f32x4 e; e[0] = __uint_as_float(pe.x << 16); e[1] = __uint_as_float(pe.x & 0xffff0000u); e[2] = __uint_as_float(pe.y << 16); e[3] = __uint_as_float(pe.y & 0xffff0000u);
#pragma unroll
                        for (int j = 0; j < 4; ++j) { h[j] += fast_sigmoid(rg * a[j]) * (e[j] * re * pn4[bj][n][j]); s += h[j] * h[j]; }
                        *(f32x4*)(out + o) = h; }
                s += __shfl_xor(s, 16); s += __shfl_xor(s, 32); if (fq == 0) part[(size_t)row * 16 + u.pn * 4 + wc] = s;
                asm volatile("" ::: "memory"); }
    }
};

template <class Epi, class Sched, bool ALIGN_EPI = false, bool SP2 = false>
__device__ __forceinline__ void gemm_phase(PG8_LAS unsigned char* lds, const Gemm g, const Sched& S, const Epi& E) {
    int tid_l = threadIdx.x; asm volatile("" : "+v"(tid_l));
    const int tid = tid_l, wid = __builtin_amdgcn_readfirstlane(tid >> 6), lane = tid & 63, wr = wid >> 2, wc = wid & 3, fr = lane & 15, fq = lane >> 4;
    const int K = g.K, nt = K / BK;
    unsigned voffA[2], voffB[2];
#pragma unroll
    for (int i = 0; i < 2; ++i) { int R, C; stage_rc(tid * 16 + i * 8192, R, C); const int Rb = Epi::PERM ? ((R & ~31) + perm32(R & 31)) : R;
        voffA[i] = (unsigned)(R * K + C) * 2u; voffB[i] = (unsigned)(Rb * K + C) * 2u; }
    const size_t kstep = (size_t)(BK * 2);
    const size_t hstep = (size_t)HALF * K * 2;
    const size_t tstep = 2 * hstep;
    const unsigned ldsw = (unsigned)wid * 1024u;
    const int aoff = lds_byte(wr * 64 + fr, fq * 8), boff = lds_byte(wc * 32 + fr, fq * 8);
#define PG8_SA(b, h) (((b) * 2 + (h)) * HTB)
#define PG8_SB(b, h) ((4 + (b) * 2 + (h)) * HTB)
#define PG8_STAGE(bufoff, gbase, voff) do { _Pragma("unroll") for (int _i = 0; _i < 2; ++_i) \
        __builtin_amdgcn_global_load_lds((const unsigned*)((const char*)(gbase) + (voff)[_i]), (PG8_LAS unsigned*)(lds + (bufoff) + ldsw + _i * 8192), 16, 0, 0); } while (0)
#define PG8_LDA(dst, b, h) do { _Pragma("unroll") for (int m = 0; m < 4; ++m) _Pragma("unroll") for (int k = 0; k < 2; ++k) dst[m][k] = *(const PG8_LAS bf16x8*)(lds + PG8_SA(b, h) + aoff + m * 2048 + k * 1024); } while (0)
#define PG8_LDB(dst, b, h) do { _Pragma("unroll") for (int n = 0; n < 2; ++n) _Pragma("unroll") for (int k = 0; k < 2; ++k) dst[n][k] = *(const PG8_LAS bf16x8*)(lds + PG8_SB(b, h) + boff + n * 2048 + k * 1024); } while (0)
#define PG8_MMA(ai, bj, At, Bt) do { __builtin_amdgcn_s_setprio(1); _Pragma("unroll") for (int m = 0; m < 4; ++m) _Pragma("unroll") for (int n = 0; n < 2; ++n) _Pragma("unroll") for (int k = 0; k < 2; ++k) \
        acc[ai][bj][m][n] = __builtin_amdgcn_mfma_f32_16x16x32_bf16(Bt[n][k], At[m][k], acc[ai][bj][m][n], 0, 0, 0); __builtin_amdgcn_s_setprio(0); } while (0)
#define PG8_WAIT_V(n) asm volatile("s_waitcnt vmcnt(" #n ")" ::: "memory")
#define PG8_WAIT_L(n) asm volatile("s_waitcnt lgkmcnt(" #n ")" ::: "memory")
#define PG8_BAR __builtin_amdgcn_s_barrier()
#define PG8_SCHED __builtin_amdgcn_sched_barrier(0)
    Unit cur, nxt; int ui = 0;
    if (!S.next(0, cur)) return;
    f32x4 acc[2][2][4][2];
#pragma unroll
    for (int a = 0; a < 2; ++a)
#pragma unroll
        for (int b = 0; b < 2; ++b)
#pragma unroll
            for (int m = 0; m < 4; ++m)
#pragma unroll
                for (int n = 0; n < 2; ++n) acc[a][b][m][n] = (f32x4){0.f, 0.f, 0.f, 0.f};
    bf16x8 At[4][2], B0[2][2], B1[2][2];
    const char* cA = (const char*)g.A + (size_t)cur.pm * tstep; const char* cB = (const char*)g.Bt + (size_t)cur.pn * tstep;
    S.a_ready(cur);
    if constexpr (SP2) {
        PG8_STAGE(PG8_SB(0, 0), cB, voffB); PG8_STAGE(PG8_SB(0, 1), cB + hstep, voffB); PG8_STAGE(PG8_SA(0, 0), cA, voffA); PG8_STAGE(PG8_SA(0, 1), cA + hstep, voffA);
        if (wr == 1) PG8_BAR;
        PG8_WAIT_V(2); PG8_BAR;
        PG8_STAGE(PG8_SB(1, 0), cB + kstep, voffB); PG8_STAGE(PG8_SA(1, 0), cA + kstep, voffA); PG8_STAGE(PG8_SB(1, 1), cB + hstep + kstep, voffB);
        PG8_WAIT_V(6); PG8_BAR;
    } else {
        PG8_STAGE(PG8_SB(0, 0), cB, voffB); PG8_STAGE(PG8_SA(0, 0), cA, voffA); PG8_STAGE(PG8_SB(0, 1), cB + hstep, voffB); PG8_STAGE(PG8_SA(0, 1), cA + hstep, voffA);
        if (wr == 1) PG8_BAR;
        PG8_WAIT_V(4); PG8_BAR;
        PG8_STAGE(PG8_SB(1, 0), cB + kstep, voffB); PG8_STAGE(PG8_SA(1, 0), cA + kstep, voffA); PG8_STAGE(PG8_SB(1, 1), cB + hstep + kstep, voffB);
        PG8_WAIT_V(6); PG8_BAR;
    }
    for (;;) {
        const bool has_next = S.next(ui + 1, nxt);
        const char* nA = has_next ? (const char*)g.A + (size_t)nxt.pm * tstep : cA; const char* nB = has_next ? (const char*)g.Bt + (size_t)nxt.pn * tstep : cB;
        for (int t = 0; t < nt; t += 2) {
            const bool last = (t == nt - 2);
            const char* a1 = cA + (size_t)(t + 1) * kstep;
            const char* a2 = last ? nA : cA + (size_t)(t + 2) * kstep; const char* b2 = last ? nB : cB + (size_t)(t + 2) * kstep;
            const char* a3 = a2 + kstep; const char* b3 = b2 + kstep;
            if (last && has_next) S.a_ready(nxt);
            if constexpr (SP2) {
            PG8_LDB(B0, 0, 0); PG8_LDB(B1, 0, 1); PG8_SCHED; PG8_LDA(At, 0, 0); PG8_STAGE(PG8_SA(1, 1), a1 + hstep, voffA);
            PG8_WAIT_V(8); PG8_WAIT_L(0); PG8_BAR; PG8_MMA(0, 0, At, B0); PG8_MMA(0, 1, At, B1); PG8_BAR; PG8_SCHED;
            PG8_LDA(At, 0, 1); PG8_STAGE(PG8_SB(0, 0), b2, voffB); PG8_STAGE(PG8_SB(0, 1), b2 + hstep, voffB); PG8_STAGE(PG8_SA(0, 0), a2, voffA);
            PG8_WAIT_V(8); PG8_WAIT_L(0); PG8_BAR; PG8_MMA(1, 0, At, B0); PG8_MMA(1, 1, At, B1); PG8_BAR; PG8_SCHED;
            PG8_LDB(B0, 1, 0); PG8_LDB(B1, 1, 1); PG8_SCHED; PG8_LDA(At, 1, 0); PG8_STAGE(PG8_SA(0, 1), a2 + hstep, voffA);
            PG8_WAIT_V(8); PG8_WAIT_L(0); PG8_BAR; PG8_MMA(0, 0, At, B0); PG8_MMA(0, 1, At, B1); PG8_BAR; PG8_SCHED;
            PG8_LDA(At, 1, 1); PG8_STAGE(PG8_SB(1, 0), b3, voffB); PG8_STAGE(PG8_SB(1, 1), b3 + hstep, voffB); PG8_STAGE(PG8_SA(1, 0), a3, voffA);
            PG8_WAIT_V(8); PG8_WAIT_L(0); PG8_BAR; PG8_MMA(1, 0, At, B0); PG8_MMA(1, 1, At, B1); PG8_BAR; PG8_SCHED;
            } else {
            PG8_LDB(B0, 0, 0); PG8_SCHED; PG8_LDA(At, 0, 0); PG8_STAGE(PG8_SA(1, 1), a1 + hstep, voffA);
            PG8_WAIT_L(8); PG8_BAR; PG8_WAIT_L(0); PG8_MMA(0, 0, At, B0); PG8_BAR; PG8_SCHED;
            PG8_LDB(B1, 0, 1); PG8_STAGE(PG8_SB(0, 0), b2, voffB);
            PG8_BAR; PG8_WAIT_L(0); PG8_MMA(0, 1, At, B1); PG8_BAR;
            PG8_LDA(At, 0, 1); PG8_STAGE(PG8_SA(0, 0), a2, voffA);
            PG8_BAR; PG8_WAIT_L(0); PG8_MMA(1, 0, At, B0); PG8_BAR; PG8_SCHED;
            PG8_STAGE(PG8_SB(0, 1), b2 + hstep, voffB);
            PG8_WAIT_V(6); PG8_BAR; PG8_MMA(1, 1, At, B1); PG8_BAR;
            PG8_LDB(B0, 1, 0); PG8_SCHED; PG8_LDA(At, 1, 0); PG8_STAGE(PG8_SA(0, 1), a2 + hstep, voffA);
            PG8_WAIT_L(8); PG8_BAR; PG8_WAIT_L(0); PG8_MMA(0, 0, At, B0); PG8_BAR; PG8_SCHED;
            PG8_LDB(B1, 1, 1); PG8_STAGE(PG8_SB(1, 0), b3, voffB);
            PG8_BAR; PG8_WAIT_L(0); PG8_MMA(0, 1, At, B1); PG8_BAR;
            PG8_LDA(At, 1, 1); PG8_STAGE(PG8_SA(1, 0), a3, voffA);
            PG8_BAR; PG8_WAIT_L(0); PG8_MMA(1, 0, At, B0); PG8_BAR; PG8_SCHED;
            PG8_STAGE(PG8_SB(1, 1), b3 + hstep, voffB);
            PG8_WAIT_V(6); PG8_BAR; PG8_MMA(1, 1, At, B1); PG8_BAR;
            }
        }
        if constexpr (ALIGN_EPI) { if (wr == 0) PG8_BAR; }
        if constexpr (!Epi::AFTER_DRAIN) { E(acc, cur, wr, wc, fr, fq); S.done(cur); }
        if (!has_next) break;
#pragma unroll
        for (int a = 0; a < 2; ++a)
#pragma unroll
            for (int b = 0; b < 2; ++b)
#pragma unroll
                for (int m = 0; m < 4; ++m)
#pragma unroll
                    for (int n = 0; n < 2; ++n) acc[a][b][m][n] = (f32x4){0.f, 0.f, 0.f, 0.f};
        cur = nxt; cA = nA; cB = nB; ++ui;
        if constexpr (ALIGN_EPI) { if (wr == 1) PG8_BAR; }
    }
    PG8_WAIT_V(0);
    if constexpr (!ALIGN_EPI) { if (wr == 0) PG8_BAR; }
    PG8_BAR;
    if constexpr (Epi::AFTER_DRAIN) { E.fused(acc, cur, wr, wc, fr, fq, lds, wid, lane); S.done(cur); }
#undef PG8_SA
#undef PG8_SB
#undef PG8_STAGE
#undef PG8_LDA
#undef PG8_LDB
#undef PG8_MMA
#undef PG8_WAIT_V
#undef PG8_WAIT_L
#undef PG8_BAR
#undef PG8_SCHED
}
}
#define XB_TMO      128
#define XB_XCNT(j)  (256  + 64 * (j))
#define XB_XSUB(j)  (1280 + 64 * (j))
#define XB_XGEN(j)  (2304 + 64 * (j))
#define XB_TOP      3328
#define XB_TOPGEN   3392
#define XCD_BAR_WORDS 3456
#define XB_SPIN_CAP (1u << 18)

__device__ __forceinline__ unsigned xb_ld(unsigned* p)              { return __hip_atomic_load(p, __ATOMIC_RELAXED, __HIP_MEMORY_SCOPE_AGENT); }
__device__ __forceinline__ unsigned xb_add(unsigned* p, unsigned v) { return __hip_atomic_fetch_add(p, v, __ATOMIC_RELAXED, __HIP_MEMORY_SCOPE_AGENT); }
__device__ __forceinline__ unsigned xb_xcc_id() { return (unsigned)__builtin_amdgcn_s_getreg((3 << 11) | 20) & 0xFu; }
#define XB_SPIN(cond, bar) do { unsigned _sp = 0; while (cond) { __builtin_amdgcn_s_sleep(1); \
    if ((++_sp & 255u) == 0u) { if (xb_ld(&(bar)[XB_TMO])) break; if (_sp > XB_SPIN_CAP) { atomicAdd(&(bar)[XB_TMO], 1u); break; } } } } while (0)

struct XcdBarrier {
    unsigned* bar; unsigned x;
    volatile LAS unsigned* st;
};

__device__ __forceinline__ XcdBarrier xcd_barrier_post(unsigned* bar, volatile LAS unsigned* st) {
    XcdBarrier b; b.bar = bar; b.x = xb_xcc_id(); b.st = st;
    if (threadIdx.x == 0) (void)xb_add(&bar[XB_XCNT(b.x)], 1u);
    return b;
}
__device__ __forceinline__ void xcd_barrier_complete(unsigned* bar, unsigned x, unsigned& nloc, unsigned& nx) {
    const unsigned G = gridDim.x * gridDim.y * gridDim.z;
    unsigned sum, cnt, mine, sp = 0u;
    for (;;) {
        sum = 0u; cnt = 0u; mine = 0u;
#pragma unroll
        for (unsigned j = 0; j < 16; ++j) { const unsigned c = xb_ld(&bar[XB_XCNT(j)]); sum += c; cnt += (c > 0u) ? 1u : 0u; mine = (j == x) ? c : mine; }
        if (sum == G) break;
        __builtin_amdgcn_s_sleep(1);
        if ((++sp & 255u) == 0u) { if (xb_ld(&bar[XB_TMO])) break; if (sp > XB_SPIN_CAP) { atomicAdd(&bar[XB_TMO], 1u); break; } }
    }
    nloc = mine > 0u ? mine : 1u; nx = cnt > 0u ? cnt : 1u;
}

__device__ __forceinline__ void xcd_barrier(const XcdBarrier& b) {
    asm volatile("s_waitcnt vmcnt(0)" ::: "memory");
    __syncthreads();
    if (threadIdx.x == 0) {
        unsigned* bar = b.bar;
        __builtin_amdgcn_s_waitcnt(0);
        unsigned nloc = b.st[0], nx = b.st[1];
        if (nloc == 0u) { xcd_barrier_complete(bar, b.x, nloc, nx); b.st[0] = nloc; b.st[1] = nx; }
        const unsigned old = xb_add(&bar[XB_XSUB(b.x)], 1u);
        const unsigned gen = old / nloc;
        if (old + 1u == (gen + 1u) * nloc) {
            __builtin_amdgcn_fence(__ATOMIC_RELEASE, "agent");
            asm volatile("s_waitcnt vmcnt(0)" ::: "memory");
            const unsigned og = xb_add(&bar[XB_TOP], 1u);
            const unsigned tg = og / nx;
            if (og + 1u == (tg + 1u) * nx) xb_add(&bar[XB_TOPGEN], 1u);
            else XB_SPIN(xb_ld(&bar[XB_TOPGEN]) == tg, bar);
            __builtin_amdgcn_fence(__ATOMIC_ACQUIRE, "agent");
            xb_add(&bar[XB_XGEN(b.x)], 1u);
            asm volatile("s_waitcnt vmcnt(0)" ::: "memory");
        } else {
            XB_SPIN(xb_ld(&bar[XB_XGEN(b.x)]) == gen, bar);
            __builtin_amdgcn_fence(__ATOMIC_ACQUIRE, "agent");
            asm volatile("s_waitcnt vmcnt(0)" ::: "memory");
        }
    }
    __syncthreads();
}
typedef short bf16x8 __attribute__((ext_vector_type(8)));
typedef short v4i16_t __attribute__((ext_vector_type(4)));
typedef float f32x16 __attribute__((ext_vector_type(16)));
typedef float f32x2_t __attribute__((ext_vector_type(2)));
typedef __bf16 bf16x2_t __attribute__((ext_vector_type(2)));
typedef float f4v __attribute__((ext_vector_type(4)));
__device__ __forceinline__ f32x16 MFMA32(const bf16x8 a, const bf16x8 b, const f32x16 c) { return __builtin_amdgcn_mfma_f32_32x32x16_bf16(a, b, c, 0, 0, 0); }
__device__ __forceinline__ unsigned cvtpk(float lo, float hi) { f32x2_t v = {lo, hi}; bf16x2_t b = __builtin_convertvector(v, bf16x2_t); return __builtin_bit_cast(unsigned, b); }
__device__ __forceinline__ int crow(int reg, int h) { return (reg & 3) + 8 * (reg >> 2) + 4 * h; }
__device__ __forceinline__ float blo(unsigned u) { return __uint_as_float(u << 16); }
__device__ __forceinline__ float bhi(unsigned u) { return __uint_as_float(u & 0xffff0000u); }
template <int W> __device__ __forceinline__ unsigned toff(unsigned row, unsigned ch) {
    if constexpr (W == 64) return row * 144u + ch * 16u;
    else return row * 256u + 16u * (ch ^ (((row & 3u) << 2) | ((row >> 2) & 3u)));
}
template <int W> __device__ __forceinline__ bf16x8 frag_row(const LAS unsigned char* tile, int R, int s, int h) { return *(const LAS bf16x8*)(tile + toff<W>(R, 2 * s + h)); }
template <int W, bool PERMK> __device__ __forceinline__ bf16x8 frag_tr(const LAS unsigned char* tile, int rbase, int cbase, int lane) {
    const int h = lane >> 5, blk = (lane >> 4) & 1, q = (lane & 15) >> 2, p = lane & 3;
    const int ch = (cbase >> 3) + 2 * blk + (p >> 1);
    const int r0 = rbase + (PERMK ? 4 * h : 8 * h) + q, r1 = r0 + (PERMK ? 8 : 4);
    const v4i16_t lo = __builtin_amdgcn_ds_read_tr16_b64_v4i16((LAS v4i16_t*)(tile + toff<W>(r0, ch) + 8 * (p & 1)));
    const v4i16_t hi = __builtin_amdgcn_ds_read_tr16_b64_v4i16((LAS v4i16_t*)(tile + toff<W>(r1, ch) + 8 * (p & 1)));
    return __builtin_shufflevector(lo, hi, 0, 1, 2, 3, 4, 5, 6, 7);
}
__device__ __forceinline__ bf16x8 pack_step(const f32x16& x, int s) {
    v4u p; p.x = cvtpk(x[8 * s], x[8 * s + 1]); p.y = cvtpk(x[8 * s + 2], x[8 * s + 3]); p.z = cvtpk(x[8 * s + 4], x[8 * s + 5]); p.w = cvtpk(x[8 * s + 6], x[8 * s + 7]);
    return __builtin_bit_cast(bf16x8, p);
}
__device__ __forceinline__ f32x16 zero16() { f32x16 z;
#pragma unroll
    for (int i = 0; i < 16; ++i) z[i] = 0.f; return z; }
__device__ __forceinline__ void wave_scan_sum2(float& x0, float& x1, int lane) {
    const float loc = x0 + x1; float s = loc;
#pragma unroll
    for (int o = 1; o < 64; o <<= 1) { const float t = __shfl_up(s, o); if (lane >= o) s += t; }
    const float ex = s - loc; x0 = ex + x0; x1 = x0 + x1;
}
__device__ __forceinline__ void wave_scan_max2(float& x0, float& x1, int lane) {
    const float loc = fmaxf(x0, x1); float s = loc;
#pragma unroll
    for (int o = 1; o < 64; o <<= 1) { const float t = __shfl_up(s, o); if (lane >= o) s = fmaxf(s, t); }
    float ex = __shfl_up(s, 1); if (lane == 0) ex = -INFINITY;
    x0 = fmaxf(ex, x0); x1 = fmaxf(x0, x1);
}
__device__ __forceinline__ float wave_max(float v) {
#pragma unroll
    for (int o = 1; o < 64; o <<= 1) v = fmaxf(v, __shfl_xor(v, o));
    return v;
}
__device__ __forceinline__ void rot8_store(LAS unsigned char* tile, int row, int j0, const v4u x1, const v4u x2, const float* cs, float scale) {
    float a[8], b[8];
    a[0] = blo(x1.x); a[1] = bhi(x1.x); a[2] = blo(x1.y); a[3] = bhi(x1.y); a[4] = blo(x1.z); a[5] = bhi(x1.z); a[6] = blo(x1.w); a[7] = bhi(x1.w);
    b[0] = blo(x2.x); b[1] = bhi(x2.x); b[2] = blo(x2.y); b[3] = bhi(x2.y); b[4] = blo(x2.z); b[5] = bhi(x2.z); b[6] = blo(x2.w); b[7] = bhi(x2.w);
    float o1[8], o2[8];
#pragma unroll
    for (int i = 0; i < 8; ++i) { const float c = cs[2 * i], s = cs[2 * i + 1]; o1[i] = (a[i] * c - b[i] * s) * scale; o2[i] = (a[i] * s + b[i] * c) * scale; }
    v4u w1, w2; w1.x = cvtpk(o1[0], o1[1]); w1.y = cvtpk(o1[2], o1[3]); w1.z = cvtpk(o1[4], o1[5]); w1.w = cvtpk(o1[6], o1[7]);
    w2.x = cvtpk(o2[0], o2[1]); w2.y = cvtpk(o2[2], o2[3]); w2.z = cvtpk(o2[4], o2[5]); w2.w = cvtpk(o2[6], o2[7]);
    *(LAS v4u*)(tile + toff<64>(row, j0 >> 3)) = w1; *(LAS v4u*)(tile + toff<64>(row, 4 + (j0 >> 3))) = w2;
}
__device__ __forceinline__ void conv8(const bf16_t* colp, int s, const float* cw, const float* cb, float* o) {
#pragma unroll
    for (int i = 0; i < 8; ++i) o[i] = cb[i];
#pragma unroll
    for (int w = 0; w < 4; ++w) { const int ss = s - 3 + w; if (ss >= 0) { const v4u x = *(const v4u*)(colp + (ptrdiff_t)(w - 3) * NP);
        o[0] += blo(x.x) * cw[w * 8 + 0]; o[1] += bhi(x.x) * cw[w * 8 + 1]; o[2] += blo(x.y) * cw[w * 8 + 2]; o[3] += bhi(x.y) * cw[w * 8 + 3];
        o[4] += blo(x.z) * cw[w * 8 + 4]; o[5] += bhi(x.z) * cw[w * 8 + 5]; o[6] += blo(x.w) * cw[w * 8 + 6]; o[7] += bhi(x.w) * cw[w * 8 + 7]; } }
#pragma unroll
    for (int i = 0; i < 8; ++i) o[i] = o[i] * __builtin_amdgcn_rcpf(1.0f + __builtin_amdgcn_exp2f(-1.4426950408889634f * o[i]));
}

struct Params {
    const float *x, *p; const int* pos;
    const float *attn_norm, *w_in, *conv_w, *conv_b, *b_ig, *b_fg, *ret_gn, *ml_gn, *w_out, *moe_norm, *w_group, *b_group, *w_router, *b_router,
                *w1, *w3, *w2, *w_up, *ple_norm, *pg_norm, *w_gate, *final_norm;
    float* out; unsigned char* ws;
};

__device__ __forceinline__ void load4(const float* p, float (&o)[4]) { const float4 v = *(const float4*)p; o[0] = v.x; o[1] = v.y; o[2] = v.z; o[3] = v.w; }
__device__ __forceinline__ void load4(const bf16_t* p, float (&o)[4]) { const uint2 v = *(const uint2*)p; o[0] = __uint_as_float(v.x << 16); o[1] = __uint_as_float(v.x & 0xffff0000u); o[2] = __uint_as_float(v.y << 16); o[3] = __uint_as_float(v.y & 0xffff0000u); }

__device__ __forceinline__ void transpose_item(const float* W, int ldw, const float* gain, bf16_t* WT, int K, int kb, int n0, size_t drow0, LAS float* scr, int lane) {
    const int k0 = 64 * kb;
#pragma unroll 8
    for (int i = 0; i < 32; ++i) { const int kk = 2 * i + (lane >> 5); float w = W[(size_t)(k0 + kk) * ldw + n0 + (lane & 31)]; if (gain) w *= gain[k0 + kk]; scr[kk * 33 + (lane & 31)] = w; }
    LDS_WAIT(); asm volatile("" ::: "memory");
    const int c = lane & 7;
#pragma unroll
    for (int j = 0; j < 4; ++j) { const int n = (lane >> 3) + 8 * j; const LAS float* s = scr + (8 * c) * 33 + n;
        v4u o; o.x = pk2(s[0 * 33], s[1 * 33]); o.y = pk2(s[2 * 33], s[3 * 33]); o.z = pk2(s[4 * 33], s[5 * 33]); o.w = pk2(s[6 * 33], s[7 * 33]);
        *(GAS v4u*)(WT + (drow0 + n) * K + k0 + 8 * c) = o; }
    LDS_WAIT(); asm volatile("" ::: "memory");
}

constexpr int NPHASES = 14;
template <int LO, int HI>
__global__ void __launch_bounds__(NTHREADS, 2) mk(Params P) {
    extern __shared__ __attribute__((aligned(16))) unsigned char lds_raw[];
    float* ldsf = (float*)lds_raw;
    LAS unsigned char* ldsl = (LAS unsigned char*)lds_raw;
    const int G = gridDim.x, bid = blockIdx.x, NGW = G * NWAVES;
#define PH_IDS int tid = threadIdx.x; asm volatile("" : "+v"(tid)); const int lane = tid & 63, wave = __builtin_amdgcn_readfirstlane(tid >> 6), gw = bid * NWAVES + wave; (void)lane; (void)gw;
    unsigned char* const ws = P.ws;
#define rstd1 ((float*)(ws + WS_RSTD1))
#define gates ((float*)(ws + WS_GATES))
#define rstdg ((float*)(ws + WS_RSTDG))
#define rstde ((float*)(ws + WS_RSTDE))
#define eid ((int*)(ws + WS_EID))
#define posn ((int*)(ws + WS_POS))
#define gate ((float*)(ws + WS_GATE))
#define mn ((float*)(ws + WS_MN))
#define ml ((float*)(ws + WS_ML))
#define mbl ((float*)(ws + WS_MBL))
#define mm ((float*)(ws + WS_MM))
#define list ((int*)(ws + WS_LIST))
#define cnt ((int*)(ws + WS_CTL) + CW_CNT)
#define part ((float*)(ws + WS_PART))
#define part2 ((float*)(ws + WS_PART2))
#define win_t ((bf16_t*)(ws + WS_WIN))
#define wout_t ((bf16_t*)(ws + WS_WOUT))
#define w13_t ((bf16_t*)(ws + WS_W13))
#define w2_t ((bf16_t*)(ws + WS_W2))
#define wgate_t ((bf16_t*)(ws + WS_WGATE))
#define wup_t ((bf16_t*)(ws + WS_WUP))
#define proj ((bf16_t*)(ws + WS_PROJ))
#define hbuf ((bf16_t*)(ws + WS_HBUF))
#define xs ((bf16_t*)(ws + WS_XS))
#define ybuf ((bf16_t*)(ws + WS_YBUF))
#define peb ((bf16_t*)(ws + WS_PEB))
#define yreg ((bf16_t*)(ws + WS_YREG))
#define pb ((bf16_t*)(ws + WS_PB))
    float* const out = P.out;
#define rst ((float*)((unsigned char*)out + OUT_RST))
#define mst ((float*)((unsigned char*)out + OUT_MST))
    LAS int* s_off = (LAS int*)(ldsl + LDSX_OFF + 256);
    LAS int* s_cnt = s_off + 40;
    LAS int* s_t2e = s_off + 80;
#define IN(k) (LO <= (k) && (k) < HI)
#define GRID_BAR(k) do { if constexpr (IN(k) && IN((k) + 1)) xcd_barrier(bar); } while (0)
    XcdBarrier bar; bar.bar = (unsigned*)(ws + WS_CTL) + CW_BAR; bar.x = 0; bar.st = nullptr;
    if constexpr (HI - LO > 1) {
        PH_IDS
        volatile LAS unsigned* st = (volatile LAS unsigned*)(ldsl + LDSX_OFF);
        if (tid == 0) { st[0] = 0u; st[1] = 0u; }
        __syncthreads();
        bar = xcd_barrier_post((unsigned*)(ws + WS_CTL) + CW_BAR, st);
    }

    if constexpr (IN(0)) {
        PH_IDS
        {
            LAS float* scr = (LAS float*)(ldsl + wave * 16384);
            constexpr int I0 = 16 * 128, I1 = 16 * 32, I2 = 64 * 256, I3 = 32 * 256, I4 = 16 * 32, I5 = 4 * 32;
            for (int it = gw; it < I0 + I1 + I2 + I3 + I4 + I5; it += NGW) {
                int r = it;
                if (r < I0) { transpose_item(P.w_in, NPROJ, P.attn_norm, win_t, D, r / 128, 32 * (r % 128), (size_t)(32 * (r % 128)), scr, lane); continue; } r -= I0;
                if (r < I1) { transpose_item(P.w_out, D, nullptr, wout_t, D, r / 32, 32 * (r % 32), (size_t)(32 * (r % 32)), scr, lane); continue; } r -= I1;
                if (r < I2) { const int mat = r >> 8, q = r & 255, e = mat >> 1, which = mat & 1, kb = q >> 4, n0 = 32 * (q & 15);
                    const float* W = (which ? P.w3 : P.w1) + (size_t)e * D * DE;
                    transpose_item(W, DE, nullptr, w13_t, D, kb, n0, (size_t)e * 1024 + (size_t)((n0 >> 7) * 256 + which * 128 + (n0 & 127)), scr, lane); continue; } r -= I2;
                if (r < I3) { const int e = r >> 8, q = r & 255, kb = q >> 5, n0 = 32 * (q & 31);
                    transpose_item(P.w2 + (size_t)e * DE * D, D, nullptr, w2_t, DE, kb, n0, (size_t)e * 1024 + n0, scr, lane); continue; } r -= I3;
                if (r < I4) { transpose_item(P.w_gate, D, P.pg_norm, wgate_t, D, r / 32, 32 * (r % 32), (size_t)(32 * (r % 32)), scr, lane); continue; } r -= I4;
                transpose_item(P.w_up, D, nullptr, wup_t, PLE, r / 32, 32 * (r % 32), (size_t)(32 * (r % 32)), scr, lane);
            }
        }
        __syncthreads();
        {
            LAS float* gwl = (LAS float*)ldsl;
            for (int idx = tid; idx < D * 8; idx += NTHREADS) { const int k = idx >> 3, j = idx & 7; gwl[idx] = P.w_in[(size_t)k * NPROJ + NP + j] * P.attn_norm[k]; }
            __syncthreads();
            for (int row = gw; row < T; row += NGW) {
                const float4* xr = (const float4*)(P.x + (size_t)row * D) + lane;
                float4 v[4]; float ss = 0.f;
#pragma unroll
                for (int j = 0; j < 4; ++j) { v[j] = xr[64 * j]; ss += v[j].x * v[j].x + v[j].y * v[j].y + v[j].z * v[j].z + v[j].w * v[j].w; }
                ss = wave_sum(ss);
                const float rstd = 1.0f / sqrtf(ss * (1.0f / D) + EPS);
                float g8[8];
#pragma unroll
                for (int i = 0; i < 8; ++i) g8[i] = 0.f;
#pragma unroll
                for (int j = 0; j < 4; ++j) {
                    const int k0 = 4 * (lane + 64 * j);
                    const float xs_[4] = {v[j].x * rstd, v[j].y * rstd, v[j].z * rstd, v[j].w * rstd};
                    uint2 o; o.x = pk2(xs_[0], xs_[1]); o.y = pk2(xs_[2], xs_[3]);
                    *(uint2*)(yreg + (size_t)row * D + k0) = o;
#pragma unroll
                    for (int i = 0; i < 4; ++i) {
                        const LAS f4v* wr = (const LAS f4v*)(gwl + (k0 + i) * 8);
                        const f4v w0 = wr[0], w1 = wr[1];
                        g8[0] += xs_[i] * w0.x; g8[1] += xs_[i] * w0.y; g8[2] += xs_[i] * w0.z; g8[3] += xs_[i] * w0.w;
                        g8[4] += xs_[i] * w1.x; g8[5] += xs_[i] * w1.y; g8[6] += xs_[i] * w1.z; g8[7] += xs_[i] * w1.w;
                    }
                }
#pragma unroll
                for (int i = 0; i < 8; ++i) g8[i] = wave_sum(g8[i]);
                if (lane == 0) {
                    rstd1[row] = rstd;
                    *(float4*)(gates + (size_t)row * 8) = make_float4(g8[0], g8[1], g8[2], g8[3]);
                    *(float4*)(gates + (size_t)row * 8 + 4) = make_float4(g8[4], g8[5], g8[6], g8[7]);
                }
            }
            {
                float* cstab = (float*)(ws + WS_CS);
                for (int idx = bid * NTHREADS + tid; idx < T * 32; idx += G * NTHREADS) {
                    const int t = idx >> 5, j = idx & 31;
                    const float ang = (float)P.pos[t] * powf(10000.0f, -(float)j / 32.0f);
                    float sn, cs; sincosf(ang, &sn, &cs);
                    *(float2*)(cstab + (size_t)idx * 2) = make_float2(cs, sn);
                }
            }
            for (int row = gw; row < T; row += NGW) {
                const float4 v = ((const float4*)(P.p + (size_t)row * PLE))[lane];
                uint2 o; o.x = pk2(v.x, v.y); o.y = pk2(v.z, v.w);
                ((uint2*)(pb + (size_t)row * PLE))[lane] = o;
            }
        }
        __syncthreads();
    }
    GRID_BAR(0);
    if constexpr (IN(1)) {
        PH_IDS
        pg8::Gemm g{yreg, win_t, T, NP, D}; pg8::StaticOrder S; S.init(T, NP, G, bid);
        pg8::EpiStoreBf16 E{proj, NP, 0xffff, nullptr};
        pg8::gemm_phase<pg8::EpiStoreBf16, pg8::StaticOrder, true, true>(ldsl, g, S, E);
    }
    GRID_BAR(1);
    if constexpr (IN(2)) {
        PH_IDS
        const int nitems = BATCH * NCH * (RH + MH);
        const float* cstab = (const float*)(ws + WS_CS);
        for (int it = bid; it < nitems; it += G) {
            const int bn = it / (RH + MH), hh = it % (RH + MH), b = bn / NCH, n = bn % NCH;
            const size_t t0 = (size_t)b * SEQ + (size_t)n * CH;
            __syncthreads();
            if (hh < RH) {
                const int h = hh;
                const float lg2 = log1pf(-exp2f(-5.0f - (float)h)) * 1.4426950408889634f;
                LAS unsigned char* Kt = ldsl; LAS unsigned char* Vt = ldsl + 18432;
                {   const int c = tid >> 2, j0 = (tid & 3) * 8; const size_t t = t0 + c;
                    const f4v* csp = (const f4v*)(cstab + t * 64 + j0 * 2);
                    float cs[16];
#pragma unroll
                    for (int i = 0; i < 4; ++i) { const f4v v = csp[i]; cs[4 * i] = v.x; cs[4 * i + 1] = v.y; cs[4 * i + 2] = v.z; cs[4 * i + 3] = v.w; }
                    const bf16_t* kp = proj + t * NP + C_RK + h * RD;
                    rot8_store(Kt, c, j0, *(const v4u*)(kp + j0), *(const v4u*)(kp + 32 + j0), cs, 0.125f * __builtin_amdgcn_exp2f(lg2 * (float)(CH - 1 - c)));
                }
#pragma unroll
                for (int i = tid; i < CH * 8; i += NTHREADS) { const int row = i >> 3, ch = i & 7; *(LAS v4u*)(Vt + toff<64>(row, ch)) = *(const v4u*)(proj + (t0 + row) * NP + C_RV + h * RD + ch * 8); }
                __syncthreads();
                if (wave < 4) {
                    const int db = wave >> 1, eb = wave & 1, r = lane & 31, hl = lane >> 5;
                    f32x16 acc = zero16();
#pragma unroll
                    for (int s = 0; s < 8; ++s) acc = MFMA32(frag_tr<64, false>(Kt, 16 * s, db * 32, lane), frag_tr<64, false>(Vt, 16 * s, eb * 32, lane), acc);
                    float* dst = rst + (size_t)(bn * RH + h) * (RD * RD) + eb * 32 + r;
#pragma unroll
                    for (int reg = 0; reg < 16; ++reg) dst[(db * 32 + crow(reg, hl)) * RD] = acc[reg];
                }
            } else {
                const int h = hh - RH; const int sidx = bn * MH + h;
                LAS unsigned char* Kt = ldsl; LAS unsigned char* Vt = ldsl + 32768; LAS float* sw = (LAS float*)(ldsl + 65536);
                if (wave == 0) {
                    const size_t t = t0 + 2 * lane;
                    const float i0 = gates[t * 8 + h] + P.b_ig[h], i1 = gates[(t + 1) * 8 + h] + P.b_ig[h];
                    float b0 = logsigmoidf_(gates[t * 8 + 4 + h] + P.b_fg[h]), b1 = logsigmoidf_(gates[(t + 1) * 8 + 4 + h] + P.b_fg[h]);
                    wave_scan_sum2(b0, b1, lane);
                    const float bL = __shfl(b1, 63);
                    const float a0 = bL - b0 + i0, a1 = bL - b1 + i1;
                    const float mloc = wave_max(fmaxf(a0, a1));
                    sw[2 * lane] = expf(a0 - mloc); sw[2 * lane + 1] = expf(a1 - mloc);
                    if (lane == 0) { ml[sidx] = mloc; mbl[sidx] = bL; }
                }
#pragma unroll
                for (int i = tid; i < CH * 16; i += NTHREADS) { const int row = i >> 4, ch = i & 15; *(LAS v4u*)(Vt + toff<128>(row, ch)) = *(const v4u*)(proj + (t0 + row) * NP + C_MV + h * MD + ch * 8); }
                __syncthreads();
                {   const int cg = tid & 15, d0 = cg * 8; const int chn = 512 + h * MD + d0;
                    float cw[32], cb_[8];
#pragma unroll
                    for (int w = 0; w < 4; ++w)
#pragma unroll
                        for (int i = 0; i < 8; ++i) cw[w * 8 + i] = P.conv_w[w * 1024 + chn + i];
#pragma unroll
                    for (int i = 0; i < 8; ++i) cb_[i] = P.conv_b[chn + i];
#pragma unroll
                    for (int i = 0; i < 4; ++i) {
                        const int c = (tid >> 4) + 32 * i; float o[8];
                        conv8(proj + (t0 + c) * NP + C_MK + h * MD + d0, n * CH + c, cw, cb_, o);
                        const float sc = 0.08838834764831845f * sw[c];
                        v4u w; w.x = cvtpk(o[0] * sc, o[1] * sc); w.y = cvtpk(o[2] * sc, o[3] * sc); w.z = cvtpk(o[4] * sc, o[5] * sc); w.w = cvtpk(o[6] * sc, o[7] * sc);
                        *(LAS v4u*)(Kt + toff<128>(c, cg)) = w;
                    }
                }
                __syncthreads();
                {
                    const int db = wave >> 1, ep = wave & 1, r = lane & 31, hl = lane >> 5;
                    f32x16 acc0 = zero16(), acc1 = zero16(), accn = zero16();
                    bf16x8 ones;
#pragma unroll
                    for (int i = 0; i < 8; ++i) ones[i] = (short)0x3F80;
#pragma unroll
                    for (int s = 0; s < 8; ++s) { const bf16x8 ka = frag_tr<128, false>(Kt, 16 * s, db * 32, lane);
                        acc0 = MFMA32(ka, frag_tr<128, false>(Vt, 16 * s, ep * 64, lane), acc0);
                        acc1 = MFMA32(ka, frag_tr<128, false>(Vt, 16 * s, ep * 64 + 32, lane), acc1);
                        if (ep == 0) accn = MFMA32(ka, ones, accn); }
                    float* dst = mst + (size_t)sidx * (MD * MD) + ep * 64 + r;
#pragma unroll
                    for (int reg = 0; reg < 16; ++reg) { const int d = db * 32 + crow(reg, hl); dst[d * MD] = acc0[reg]; dst[d * MD + 32] = acc1[reg]; }
                    if (ep == 0 && r == 0) {
#pragma unroll
                        for (int reg = 0; reg < 16; ++reg) mn[(size_t)sidx * MD + db * 32 + crow(reg, hl)] = accn[reg];
                    }
                }
            }
        }
        __syncthreads();
    }
    GRID_BAR(2);
    if constexpr (IN(3)) {
        PH_IDS
        const long NT = (long)G * NTHREADS; const long NR = (long)BATCH * RH * RD * RD, NM = (long)BATCH * MH * MD * MD, NN = (long)BATCH * MH * MD;
        for (long idx = (long)bid * NTHREADS + tid; idx < NR + NM + NN; idx += NT) {
            if (idx < NR) {
                const int el = (int)(idx % (RD * RD)); const int bh = (int)(idx / (RD * RD)); const int b = bh / RH, h = bh % RH;
                const float dec = expf(log1pf(-exp2f(-5.0f - (float)h)) * (float)CH);
                float R = 0.f;
                for (int n = 0; n < NCH; ++n) { float* ptr = rst + ((size_t)((b * NCH + n) * RH + h)) * (RD * RD) + el; const float tmp = *ptr; *ptr = R; R = dec * R + tmp; }
            } else {
                const long j = idx - NR; const bool isn = j >= NM;
                const long jj = isn ? j - NM : j; const int per = isn ? MD : MD * MD;
                const int el = (int)(jj % per); const int bh = (int)(jj / per); const int b = bh / MH, h = bh % MH;
                float S = 0.f, m = 0.f;
                for (int n = 0; n < NCH; ++n) {
                    const int sidx = (b * NCH + n) * MH + h;
                    const float bL = mbl[sidx], mloc = ml[sidx];
                    const float mnew = fmaxf(bL + m, mloc);
                    const float dec = expf(bL + m - mnew), sc = expf(mloc - mnew);
                    float* ptr = isn ? mn + (size_t)sidx * MD + el : mst + (size_t)sidx * (MD * MD) + el;
                    const float tmp = *ptr; *ptr = S; S = dec * S + sc * tmp;
                    if (isn && el == 0) mm[sidx] = m;
                    m = mnew;
                }
            }
        }
    }
    GRID_BAR(3);
    if constexpr (IN(4)) {
        PH_IDS
        const int nitems = BATCH * NCH * (RH + MH);
        const float* cstab = (const float*)(ws + WS_CS);
        for (int it = bid; it < nitems; it += G) {
            const int bn = it / (RH + MH), hh = it % (RH + MH), b = bn / NCH, n = bn % NCH;
            const size_t t0 = (size_t)b * SEQ + (size_t)n * CH;
            __syncthreads();
            if (hh < RH) {
                const int h = hh;
                const float lg2 = log1pf(-exp2f(-5.0f - (float)h)) * 1.4426950408889634f;
                LAS unsigned char* Qt = ldsl; LAS unsigned char* Kt = ldsl + 18432; LAS unsigned char* Vt = ldsl + 36864; LAS unsigned char* Rpt = ldsl + 55296;
                LAS float* Zs = (LAS float*)(ldsl + 65536);
                {
                    const int c = tid >> 2, j0 = (tid & 3) * 8; const size_t t = t0 + c;
                    const f4v* csp = (const f4v*)(cstab + t * 64 + j0 * 2);
                    float cs[16];
#pragma unroll
                    for (int i = 0; i < 4; ++i) { const f4v v = csp[i]; cs[4 * i] = v.x; cs[4 * i + 1] = v.y; cs[4 * i + 2] = v.z; cs[4 * i + 3] = v.w; }
                    const bf16_t* qp = proj + t * NP + C_RQ + h * RD; const bf16_t* kp = proj + t * NP + C_RK + h * RD;
                    rot8_store(Qt, c, j0, *(const v4u*)(qp + j0), *(const v4u*)(qp + 32 + j0), cs, 1.0f);
                    rot8_store(Kt, c, j0, *(const v4u*)(kp + j0), *(const v4u*)(kp + 32 + j0), cs, 0.125f);
                }
#pragma unroll
                for (int i = tid; i < CH * 8; i += NTHREADS) { const int row = i >> 3, ch = i & 7; *(LAS v4u*)(Vt + toff<64>(row, ch)) = *(const v4u*)(proj + (t0 + row) * NP + C_RV + h * RD + ch * 8); }
                {   const int d = tid >> 3, ch = tid & 7; const f4v* rp = (const f4v*)(rst + (size_t)(bn * RH + h) * (RD * RD) + d * RD + ch * 8);
                    const f4v a = rp[0], c2 = rp[1]; v4u w; w.x = cvtpk(a.x, a.y); w.y = cvtpk(a.z, a.w); w.z = cvtpk(c2.x, c2.y); w.w = cvtpk(c2.z, c2.w);
                    *(LAS v4u*)(Rpt + toff<64>(d, ch)) = w; }
                __syncthreads();
                {
                    const int cb = wave >> 1, eb = wave & 1, r = lane & 31, hl = lane >> 5;
                    f32x16 Z = zero16();
                    const int c = cb * 32 + r;
                    for (int jb = 0; jb <= cb; ++jb) {
                        f32x16 X = zero16();
#pragma unroll
                        for (int s = 0; s < 4; ++s) X = MFMA32(frag_row<64>(Kt, jb * 32 + r, s, hl), frag_row<64>(Qt, cb * 32 + r, s, hl), X);
#pragma unroll
                        for (int reg = 0; reg < 16; ++reg) { const int dl = c - (jb * 32 + crow(reg, hl)); X[reg] = dl >= 0 ? X[reg] * __builtin_amdgcn_exp2f(lg2 * (float)dl) : 0.f; }
#pragma unroll
                        for (int s2 = 0; s2 < 2; ++s2) Z = MFMA32(pack_step(X, s2), frag_tr<64, true>(Vt, jb * 32 + 16 * s2, eb * 32, lane), Z);
                    }
                    f32x16 Zi = zero16();
#pragma unroll
                    for (int s = 0; s < 4; ++s) Zi = MFMA32(frag_row<64>(Qt, cb * 32 + r, s, hl), frag_tr<64, false>(Rpt, 16 * s, eb * 32, lane), Zi);
#pragma unroll
                    for (int reg = 0; reg < 16; ++reg) { const int cc = cb * 32 + crow(reg, hl); Z[reg] += __builtin_amdgcn_exp2f(lg2 * (float)(cc + 1)) * Zi[reg]; Zs[cc * 68 + eb * 32 + r] = Z[reg]; }
                }
                __syncthreads();
                {
                    const int c = tid >> 2, e0 = (tid & 3) * 16; const size_t t = t0 + c;
                    float z[16]; float ss = 0.f;
#pragma unroll
                    for (int i = 0; i < 4; ++i) { const f4v v = *(const LAS f4v*)(Zs + c * 68 + e0 + 4 * i); z[4 * i] = v.x; z[4 * i + 1] = v.y; z[4 * i + 2] = v.z; z[4 * i + 3] = v.w; }
#pragma unroll
                    for (int i = 0; i < 16; ++i) ss += z[i] * z[i];
                    ss += __shfl_xor(ss, 1); ss += __shfl_xor(ss, 2);
                    const float rn = 1.0f / sqrtf(ss * (1.0f / RD) + EPS);
                    const v4u g0 = *(const v4u*)(proj + t * NP + C_RG + h * RD + e0), g1 = *(const v4u*)(proj + t * NP + C_RG + h * RD + e0 + 8);
                    const float gg[16] = {blo(g0.x), bhi(g0.x), blo(g0.y), bhi(g0.y), blo(g0.z), bhi(g0.z), blo(g0.w), bhi(g0.w), blo(g1.x), bhi(g1.x), blo(g1.y), bhi(g1.y), blo(g1.z), bhi(g1.z), blo(g1.w), bhi(g1.w)};
                    float o[16];
#pragma unroll
                    for (int i = 0; i < 16; ++i) o[i] = siluf_(gg[i]) * z[i] * rn * P.ret_gn[h * RD + e0 + i];
                    v4u w0, w1; w0.x = cvtpk(o[0], o[1]); w0.y = cvtpk(o[2], o[3]); w0.z = cvtpk(o[4], o[5]); w0.w = cvtpk(o[6], o[7]);
                    w1.x = cvtpk(o[8], o[9]); w1.y = cvtpk(o[10], o[11]); w1.z = cvtpk(o[12], o[13]); w1.w = cvtpk(o[14], o[15]);
                    *(v4u*)(yreg + t * D + h * RD + e0) = w0; *(v4u*)(yreg + t * D + h * RD + e0 + 8) = w1;
                }
            } else {
                const int h = hh - RH; const int sidx = bn * MH + h;
                LAS unsigned char* Qt = ldsl; LAS unsigned char* Kt = ldsl + 32768; LAS unsigned char* Vt = ldsl + 65536; LAS unsigned char* Spt = ldsl + 98304;
                LAS float* sb = (LAS float*)(ldsl + 131072); LAS float* sg = sb + 128; LAS float* spm = sg + 128; LAS float* snp = spm + 128; LAS float* sden = snp + 128; LAS float* swi = sden + 128;
                LAS float* Zs = (LAS float*)(ldsl + 32768);
                const float mprev = mm[sidx];
                if (wave == 0) {
                    const size_t t = t0 + 2 * lane;
                    const float i0 = gates[t * 8 + h] + P.b_ig[h], i1 = gates[(t + 1) * 8 + h] + P.b_ig[h];
                    float b0 = logsigmoidf_(gates[t * 8 + 4 + h] + P.b_fg[h]), b1 = logsigmoidf_(gates[(t + 1) * 8 + 4 + h] + P.b_fg[h]);
                    wave_scan_sum2(b0, b1, lane);
                    const float g0 = i0 - b0, g1 = i1 - b1; float p0 = g0, p1 = g1;
                    wave_scan_max2(p0, p1, lane);
                    sb[2 * lane] = b0; sb[2 * lane + 1] = b1; sg[2 * lane] = g0; sg[2 * lane + 1] = g1; spm[2 * lane] = p0; spm[2 * lane + 1] = p1;
                    swi[2 * lane] = expf(mprev - fmaxf(p0, mprev)); swi[2 * lane + 1] = expf(mprev - fmaxf(p1, mprev));
                } else if (wave == 1) { snp[lane] = mn[(size_t)sidx * MD + lane]; snp[lane + 64] = mn[(size_t)sidx * MD + lane + 64]; }
                {
                    const int cg = tid & 15, d0 = cg * 8;
#pragma unroll 1
                    for (int which = 0; which < 2; ++which) {
                        const int chn = which * 512 + h * MD + d0;
                        float cw[32], cb_[8];
#pragma unroll
                        for (int w = 0; w < 4; ++w)
#pragma unroll
                            for (int i = 0; i < 8; ++i) cw[w * 8 + i] = P.conv_w[w * 1024 + chn + i];
#pragma unroll
                        for (int i = 0; i < 8; ++i) cb_[i] = P.conv_b[chn + i];
                        LAS unsigned char* dst = which ? Kt : Qt; const float sc = which ? 0.08838834764831845f : 1.0f;
#pragma unroll
                        for (int i = 0; i < 4; ++i) {
                            const int c = (tid >> 4) + 32 * i; float o[8];
                            conv8(proj + (t0 + c) * NP + (which ? C_MK : C_MQ) + h * MD + d0, n * CH + c, cw, cb_, o);
                            v4u w; w.x = cvtpk(o[0] * sc, o[1] * sc); w.y = cvtpk(o[2] * sc, o[3] * sc); w.z = cvtpk(o[4] * sc, o[5] * sc); w.w = cvtpk(o[6] * sc, o[7] * sc);
                            *(LAS v4u*)(dst + toff<128>(c, cg)) = w;
                        }
                    }
                }
#pragma unroll
                for (int i = tid; i < CH * 16; i += NTHREADS) { const int row = i >> 4, ch = i & 15; *(LAS v4u*)(Vt + toff<128>(row, ch)) = *(const v4u*)(proj + (t0 + row) * NP + C_MV + h * MD + ch * 8); }
#pragma unroll
                for (int i = tid; i < MD * 16; i += NTHREADS) { const int d = i >> 4, ch = i & 15; const f4v* sp = (const f4v*)(mst + (size_t)sidx * (MD * MD) + d * MD + ch * 8);
                    const f4v a = sp[0], c2 = sp[1]; v4u w; w.x = cvtpk(a.x, a.y); w.y = cvtpk(a.z, a.w); w.z = cvtpk(c2.x, c2.y); w.w = cvtpk(c2.z, c2.w);
                    *(LAS v4u*)(Spt + toff<128>(d, ch)) = w; }
                __syncthreads();
                const int cb = wave >> 1, ep = wave & 1, r = lane & 31, hl = lane >> 5;
                f32x16 Z0 = zero16(), Z1 = zero16();
                {
                    const int c = cb * 32 + r;
                    const float nc = -fmaxf(spm[c], mprev); float den = 0.f;
                    for (int jb = 0; jb <= cb; ++jb) {
                        f32x16 X = zero16();
#pragma unroll
                        for (int s = 0; s < 8; ++s) X = MFMA32(frag_row<128>(Kt, jb * 32 + r, s, hl), frag_row<128>(Qt, cb * 32 + r, s, hl), X);
#pragma unroll
                        for (int reg = 0; reg < 16; ++reg) { const int j = jb * 32 + crow(reg, hl); X[reg] = j <= c ? X[reg] * __expf(nc + sg[j]) : 0.f; den += X[reg]; }
#pragma unroll
                        for (int s2 = 0; s2 < 2; ++s2) { const bf16x8 xs_ = pack_step(X, s2);
                            Z0 = MFMA32(xs_, frag_tr<128, true>(Vt, jb * 32 + 16 * s2, ep * 64, lane), Z0);
                            Z1 = MFMA32(xs_, frag_tr<128, true>(Vt, jb * 32 + 16 * s2, ep * 64 + 32, lane), Z1); }
                    }
                    den += __shfl_xor(den, 32);
                    if (ep == 0 && hl == 0) sden[c] = den;
                    f32x16 Y0 = zero16(), Y1 = zero16();
#pragma unroll
                    for (int s = 0; s < 8; ++s) { const bf16x8 qa = frag_row<128>(Qt, cb * 32 + r, s, hl);
                        Y0 = MFMA32(qa, frag_tr<128, false>(Spt, 16 * s, ep * 64, lane), Y0);
                        Y1 = MFMA32(qa, frag_tr<128, false>(Spt, 16 * s, ep * 64 + 32, lane), Y1); }
#pragma unroll
                    for (int reg = 0; reg < 16; ++reg) { const float wi = swi[cb * 32 + crow(reg, hl)]; Z0[reg] += wi * Y0[reg]; Z1[reg] += wi * Y1[reg]; }
                }
                __syncthreads();
#pragma unroll
                for (int reg = 0; reg < 16; ++reg) { const int cc = cb * 32 + crow(reg, hl); Zs[cc * 132 + ep * 64 + r] = Z0[reg]; Zs[cc * 132 + ep * 64 + 32 + r] = Z1[reg]; }
                __syncthreads();
                {
                    const int c = tid >> 2, qd = tid & 3, e0 = qd * 32; const size_t t = t0 + c;
                    float qn = 0.f;
#pragma unroll
                    for (int i = 0; i < 4; ++i) { const v4u qv = *(const LAS v4u*)(Qt + toff<128>(c, 4 * qd + i)); const LAS float* np_ = snp + 32 * qd + 8 * i;
                        qn += blo(qv.x) * np_[0] + bhi(qv.x) * np_[1] + blo(qv.y) * np_[2] + bhi(qv.y) * np_[3] + blo(qv.z) * np_[4] + bhi(qv.z) * np_[5] + blo(qv.w) * np_[6] + bhi(qv.w) * np_[7]; }
                    qn += __shfl_xor(qn, 1); qn += __shfl_xor(qn, 2);
                    const float M = fmaxf(spm[c], mprev), mrow = sb[c] + M;
                    const float den = sden[c] + swi[c] * qn;
                    const float inv = 1.0f / fmaxf(fabsf(den), expf(-mrow));
                    float z[32]; float ss = 0.f;
#pragma unroll
                    for (int i = 0; i < 8; ++i) { const f4v v = *(const LAS f4v*)(Zs + c * 132 + e0 + 4 * i); z[4 * i] = v.x; z[4 * i + 1] = v.y; z[4 * i + 2] = v.z; z[4 * i + 3] = v.w; }
                    const bf16_t* op = proj + t * NP + C_MO + h * MD + e0;
#pragma unroll
                    for (int i = 0; i < 4; ++i) { const v4u ov = *(const v4u*)(op + 8 * i);
                        const float oo[8] = {blo(ov.x), bhi(ov.x), blo(ov.y), bhi(ov.y), blo(ov.z), bhi(ov.z), blo(ov.w), bhi(ov.w)};
#pragma unroll
                        for (int k = 0; k < 8; ++k) { const float v = sigmoidf_(oo[k]) * z[8 * i + k] * inv; z[8 * i + k] = v; ss += v * v; } }
                    ss += __shfl_xor(ss, 1); ss += __shfl_xor(ss, 2);
                    const float rn = 1.0f / sqrtf(ss * (1.0f / MD) + EPS);
                    bf16_t* yp = yreg + t * D + 512 + h * MD + e0; const float* gn = P.ml_gn + h * MD + e0;
#pragma unroll
                    for (int i = 0; i < 4; ++i) { v4u w; w.x = cvtpk(z[8 * i] * rn * gn[8 * i], z[8 * i + 1] * rn * gn[8 * i + 1]); w.y = cvtpk(z[8 * i + 2] * rn * gn[8 * i + 2], z[8 * i + 3] * rn * gn[8 * i + 3]);
                        w.z = cvtpk(z[8 * i + 4] * rn * gn[8 * i + 4], z[8 * i + 5] * rn * gn[8 * i + 5]); w.w = cvtpk(z[8 * i + 6] * rn * gn[8 * i + 6], z[8 * i + 7] * rn * gn[8 * i + 7]);
                        *(v4u*)(yp + 8 * i) = w; }
                }
            }
        }
        __syncthreads();
    }
    GRID_BAR(4);
    if constexpr (IN(5)) {
        PH_IDS
        pg8::Gemm g{yreg, wout_t, T, D, D}; pg8::StaticOrder S; S.init(T, D, G, bid);
        pg8::EpiRes E{P.x, out};
        pg8::gemm_phase<pg8::EpiRes, pg8::StaticOrder, true, true>(ldsl, g, S, E);
    }
    GRID_BAR(5);
    if constexpr (IN(6)) {
        PH_IDS
        for (int row = gw; row < T; row += NGW) {
            const float4* hr = (const float4*)(out + (size_t)row * D) + lane;
            float4 v[4]; float ss = 0.f;
#pragma unroll
            for (int j = 0; j < 4; ++j) { v[j] = hr[64 * j]; ss += v[j].x * v[j].x + v[j].y * v[j].y + v[j].z * v[j].z + v[j].w * v[j].w; }
            ss = wave_sum(ss);
            const float rstd = 1.0f / sqrtf(ss * (1.0f / D) + EPS);
            float lg[36];
#pragma unroll
            for (int i = 0; i < 36; ++i) lg[i] = 0.f;
#pragma unroll 1
            for (int j = 0; j < 4; ++j) {
                const int k0 = 4 * (lane + 64 * j);
                const float4 nv = *(const float4*)(P.moe_norm + k0);
                const float4 vj = hr[64 * j];
                const float xs_[4] = {vj.x * nv.x * rstd, vj.y * nv.y * rstd, vj.z * nv.z * rstd, vj.w * nv.w * rstd};
                uint2 o; o.x = pk2(xs_[0], xs_[1]); o.y = pk2(xs_[2], xs_[3]);
                *(uint2*)(yreg + (size_t)row * D + k0) = o;
#pragma unroll 1
                for (int i = 0; i < 4; ++i) {
                    const float xv = i == 0 ? xs_[0] : i == 1 ? xs_[1] : i == 2 ? xs_[2] : xs_[3];
                    const float4 wg = *(const float4*)(P.w_group + (size_t)(k0 + i) * 4);
                    lg[0] += xv * wg.x; lg[1] += xv * wg.y; lg[2] += xv * wg.z; lg[3] += xv * wg.w;
                    const float4* wr = (const float4*)(P.w_router + (size_t)(k0 + i) * 32);
#pragma unroll
                    for (int q = 0; q < 8; ++q) { const float4 w = wr[q]; lg[4 + 4 * q] += xv * w.x; lg[5 + 4 * q] += xv * w.y; lg[6 + 4 * q] += xv * w.z; lg[7 + 4 * q] += xv * w.w; }
                }
            }
#pragma unroll
            for (int i = 0; i < 36; ++i) lg[i] = wave_sum(lg[i]);
            float gl[4];
#pragma unroll
            for (int i = 0; i < 4; ++i) gl[i] = lg[i] + P.b_group[i];
            int gs = 0; float gmax = gl[0];
#pragma unroll
            for (int i = 1; i < 4; ++i) if (gl[i] > gmax) { gmax = gl[i]; gs = i; }
            float gsum = 0.f;
#pragma unroll
            for (int i = 0; i < 4; ++i) gsum += expf(gl[i] - gmax);
            const float pg = 1.0f / gsum;
            float el[8];
#pragma unroll
            for (int i = 0; i < 8; ++i) {
                float a = lg[4 + i] + P.b_router[i];
                if (gs == 1) a = lg[12 + i] + P.b_router[8 + i];
                if (gs == 2) a = lg[20 + i] + P.b_router[16 + i];
                if (gs == 3) a = lg[28 + i] + P.b_router[24 + i];
                el[i] = a;
            }
            int i0 = 0; float l0 = el[0];
#pragma unroll
            for (int i = 1; i < 8; ++i) if (el[i] > l0) { l0 = el[i]; i0 = i; }
            int i1 = -1; float l1 = -INFINITY;
#pragma unroll
            for (int i = 0; i < 8; ++i) if (i != i0 && el[i] > l1) { l1 = el[i]; i1 = i; }
            const float r = expf(l1 - l0);
            const float g0 = pg / (1.0f + r), g1 = pg * r / (1.0f + r);
            if (lane == 0) {
                const int e0 = gs * 8 + i0, e1 = gs * 8 + i1;
                const int p0 = atomicAdd(&cnt[e0], 1), p1 = atomicAdd(&cnt[e1], 1);
                list[(size_t)e0 * T + p0] = row; list[(size_t)e1 * T + p1] = row;
                eid[row * 2] = e0; eid[row * 2 + 1] = e1; posn[row * 2] = p0; posn[row * 2 + 1] = p1;
                gate[row * 2] = g0; gate[row * 2 + 1] = g1;
            }
        }
    }
    GRID_BAR(6);
    if constexpr (IN(7) || IN(8) || IN(9) || IN(11)) {
        PH_IDS
        __syncthreads();
        if (tid == 0) { int o = 0; for (int e = 0; e < NE; ++e) { const int c = cnt[e]; s_cnt[e] = c; s_off[e] = o; const int nt = (c + 255) >> 8; for (int i = 0; i < nt; ++i) s_t2e[(o >> 8) + i] = e; o += nt << 8; } s_off[NE] = o; }
        __syncthreads();
    }
    if constexpr (IN(7)) {
        PH_IDS
        const int NS = s_off[NE];
        for (int s = gw; s < NS; s += NGW) {
            const int e = s_t2e[s >> 8], i = s - s_off[e];
            v4u a = {0u, 0u, 0u, 0u}, b2 = {0u, 0u, 0u, 0u};
            if (i < s_cnt[e]) { const int tok = list[(size_t)e * T + i]; const v4u* src = (const v4u*)(yreg + (size_t)tok * D); a = src[lane]; b2 = src[lane + 64]; }
            v4u* dst = (v4u*)(xs + (size_t)s * D); dst[lane] = a; dst[lane + 64] = b2;
        }
    }
    GRID_BAR(7);
    if constexpr (IN(8)) {
        PH_IDS
        const int NS = s_off[NE];
        pg8::Gemm g{xs, w13_t, NS, NE * 1024, D}; pg8::GroupedOrder S; S.init(NS >> 8, G, bid, (const LAS int*)s_t2e);
        pg8::EpiSwiglu E{hbuf};
        pg8::gemm_phase<pg8::EpiSwiglu, pg8::GroupedOrder, true, true>(ldsl, g, S, E);
    }
    GRID_BAR(8);
    if constexpr (IN(9)) {
        PH_IDS
        const int NS = s_off[NE];
        pg8::Gemm g{hbuf, w2_t, NS, NE * 1024, DE}; pg8::GroupedOrder S; S.init(NS >> 8, G, bid, (const LAS int*)s_t2e);
        pg8::EpiStoreBf16 E{ybuf, D, 3, nullptr};
        pg8::gemm_phase<pg8::EpiStoreBf16, pg8::GroupedOrder, true, true>(ldsl, g, S, E);
    }
    GRID_BAR(9);
    if constexpr (IN(10)) {
        PH_IDS
        pg8::Gemm g{pb, wup_t, T, D, PLE}; pg8::StaticOrder S; S.init(T, D, G, bid);
        pg8::EpiStoreBf16 E{peb, D, 0xffff, part};
        pg8::gemm_phase<pg8::EpiStoreBf16, pg8::StaticOrder, true, true>(ldsl, g, S, E);
    }
    GRID_BAR(10);
    if constexpr (IN(11)) {
        PH_IDS
        for (int row = gw; row < T; row += NGW) {
            const int s0 = s_off[eid[row * 2]] + posn[row * 2], s1 = s_off[eid[row * 2 + 1]] + posn[row * 2 + 1];
            const float g0 = gate[row * 2], g1 = gate[row * 2 + 1];
            float ss = 0.f;
#pragma unroll
            for (int j = 0; j < 4; ++j) {
                const int k0 = 4 * (lane + 64 * j);
                float4 hv = *(const float4*)(out + (size_t)row * D + k0);
                float y0[4], y1[4]; load4(ybuf + (size_t)s0 * D + k0, y0); load4(ybuf + (size_t)s1 * D + k0, y1);
                hv.x += g0 * y0[0] + g1 * y1[0]; hv.y += g0 * y0[1] + g1 * y1[1]; hv.z += g0 * y0[2] + g1 * y1[2]; hv.w += g0 * y0[3] + g1 * y1[3];
                *(float4*)(out + (size_t)row * D + k0) = hv;
                ss += hv.x * hv.x + hv.y * hv.y + hv.z * hv.z + hv.w * hv.w;
                uint2 o; o.x = pk2(hv.x, hv.y); o.y = pk2(hv.z, hv.w);
                *(uint2*)(yreg + (size_t)row * D + k0) = o;
            }
            ss = wave_sum(ss);
            float pe = lane < 16 ? part[(size_t)row * 16 + lane] : 0.f;
            pe = wave_sum(pe);
            if (lane == 0) { rstdg[row] = 1.0f / sqrtf(ss * (1.0f / D) + EPS); rstde[row] = 1.0f / sqrtf(pe * (1.0f / D) + EPS); }
        }
    }
    GRID_BAR(11);
    if constexpr (IN(12)) {
        PH_IDS
        pg8::Gemm g{yreg, wgate_t, T, D, D}; pg8::StaticOrder S; S.init(T, D, G, bid);
        pg8::EpiGate E{out, peb, rstdg, rstde, P.ple_norm, part2};
        pg8::gemm_phase<pg8::EpiGate, pg8::StaticOrder, true, true>(ldsl, g, S, E);
    }
    GRID_BAR(12);
    if constexpr (IN(13)) {
        PH_IDS
        for (int row = gw; row < T; row += NGW) {
            float4* hr = (float4*)(out + (size_t)row * D) + lane;
            float4 v[4];
#pragma unroll
            for (int j = 0; j < 4; ++j) v[j] = hr[64 * j];
            float ss = lane < 16 ? part2[(size_t)row * 16 + lane] : 0.f;
            ss = wave_sum(ss);
            const float rstd = 1.0f / sqrtf(ss * (1.0f / D) + EPS);
#pragma unroll
            for (int j = 0; j < 4; ++j) {
                const float4 nv = *(const float4*)(P.final_norm + 4 * (lane + 64 * j));
                float4 o; o.x = v[j].x * rstd * nv.x; o.y = v[j].y * rstd * nv.y; o.z = v[j].z * rstd * nv.z; o.w = v[j].w * rstd * nv.w;
                hr[64 * j] = o;
            }
        }
    }
#undef GRID_BAR
#undef PH_IDS
#undef IN
#undef rstd1
#undef gates
#undef rstdg
#undef rstde
#undef eid
#undef posn
#undef gate
#undef mn
#undef ml
#undef mbl
#undef mm
#undef list
#undef cnt
#undef part
#undef part2
#undef win_t
#undef wout_t
#undef w13_t
#undef w2_t
#undef wgate_t
#undef wup_t
#undef proj
#undef hbuf
#undef xs
#undef ybuf
#undef peb
#undef yreg
#undef pb
#undef rst
#undef mst
}

template <int PH> static void launch_one(int grid, const Params& p, hipStream_t stream) {
    static bool attr_done = false;
    if (!attr_done) { (void)hipFuncSetAttribute((const void*)mk<PH, PH + 1>, hipFuncAttributeMaxDynamicSharedMemorySize, LDS_BYTES); attr_done = true; }
    hipLaunchKernelGGL((mk<PH, PH + 1>), dim3(grid), dim3(NTHREADS), LDS_BYTES, stream, p);
}
template <int PH> static void launch_all(int grid, const Params& p, hipStream_t stream) {
    if constexpr (PH < NPHASES) { launch_one<PH>(grid, p, stream); launch_all<PH + 1>(grid, p, stream); }
}
#ifndef MK_N_LAUNCHES
#define MK_N_LAUNCHES 1
#endif

extern "C" void kernel_launch(void* const* d_in, const int* in_sizes, int n_in, void* d_out, int out_size, void* d_ws, size_t ws_size, hipStream_t stream) {
    static int grid = 0;
    if (grid == 0) {
        if (n_in != 25 || in_sizes[0] != T * D || out_size != T * D || ws_size < WS_END) {
            fprintf(stderr, "kernel_launch: unexpected shapes: n_in %d in0 %d out %d ws %zu\n", n_in, n_in > 0 ? in_sizes[0] : -1, out_size, ws_size); grid = -1; return; }
        int dev = 0, cus = 0;
        (void)hipGetDevice(&dev); (void)hipDeviceGetAttribute(&cus, hipDeviceAttributeMultiprocessorCount, dev);
        (void)hipGetLastError();
        grid = cus;
        if (MK_N_LAUNCHES == 1) {
            int per_cu = 0;
            if (hipFuncSetAttribute((const void*)mk<0, NPHASES>, hipFuncAttributeMaxDynamicSharedMemorySize, LDS_BYTES) != hipSuccess) { fprintf(stderr, "kernel_launch: hipFuncSetAttribute failed\n"); grid = -1; return; }
            if (hipOccupancyMaxActiveBlocksPerMultiprocessor(&per_cu, (const void*)mk<0, NPHASES>, NTHREADS, LDS_BYTES) != hipSuccess || per_cu < 1) { fprintf(stderr, "kernel_launch: occupancy query reports %d workgroups per CU; the grid barrier needs one resident workgroup per CU; nothing launched\n", per_cu); grid = -1; return; }
            (void)hipGetLastError();
        }
    }
    if (grid < 0) return;
    (void)hipMemsetAsync((char*)d_ws + WS_CTL, 0, 1 * MiB, stream);
    Params p{};
    p.x = (const float*)d_in[0]; p.p = (const float*)d_in[1]; p.pos = (const int*)d_in[2];
    p.attn_norm = (const float*)d_in[3]; p.w_in = (const float*)d_in[4]; p.conv_w = (const float*)d_in[5]; p.conv_b = (const float*)d_in[6];
    p.b_ig = (const float*)d_in[7]; p.b_fg = (const float*)d_in[8]; p.ret_gn = (const float*)d_in[9]; p.ml_gn = (const float*)d_in[10];
    p.w_out = (const float*)d_in[11]; p.moe_norm = (const float*)d_in[12]; p.w_group = (const float*)d_in[13]; p.b_group = (const float*)d_in[14];
    p.w_router = (const float*)d_in[15]; p.b_router = (const float*)d_in[16]; p.w1 = (const float*)d_in[17]; p.w3 = (const float*)d_in[18]; p.w2 = (const float*)d_in[19];
    p.w_up = (const float*)d_in[20]; p.ple_norm = (const float*)d_in[21]; p.pg_norm = (const float*)d_in[22]; p.w_gate = (const float*)d_in[23]; p.final_norm = (const float*)d_in[24];
    p.out = (float*)d_out; p.ws = (unsigned char*)d_ws;
    if (MK_N_LAUNCHES == 1) hipLaunchKernelGGL((mk<0, NPHASES>), dim3(grid), dim3(NTHREADS), LDS_BYTES, stream, p);
    else launch_all<0>(grid, p, stream);
}
```

```cpp
#include <hip/hip_runtime.h>
#include <cstdio>
#include <cstdint>

constexpr int D = 1024, BATCH = 4, SEQ = 8192, T = BATCH * SEQ, PLE = 256;
constexpr int NPROJ = 4104, NP = 4096;
constexpr int CH = 128, NCH = SEQ / CH;
constexpr int RH = 8, RD = 64, MH = 4, MD = 128;
constexpr int NE = 32, DE = 512;
constexpr float EPS = 1e-6f;
constexpr int C_RQ = 0, C_RK = 512, C_RV = 1024, C_RG = 1536, C_MQ = 2048, C_MK = 2560, C_MV = 3072, C_MO = 3584;

constexpr size_t MiB = 1u << 20;
constexpr size_t WS_CTL = 0;
constexpr size_t WS_RSTD1 = 1 * MiB;
constexpr size_t WS_GATES = WS_RSTD1 + 256 * 1024;
constexpr size_t WS_SLOTR = 2560 * 1024;
constexpr size_t WS_RSTDG = 3 * MiB;
constexpr size_t WS_RSTDE = WS_RSTDG + 256 * 1024;
constexpr size_t WS_EID = 4 * MiB;
constexpr size_t WS_POS = WS_EID + 256 * 1024;
constexpr size_t WS_GATE = WS_POS + 256 * 1024;
constexpr size_t WS_MN = 5 * MiB;
constexpr size_t WS_ML = WS_MN + 512 * 1024;
constexpr size_t WS_MBL = WS_ML + 4096;
constexpr size_t WS_MM = WS_MBL + 4096;
constexpr size_t WS_LIST = 8 * MiB;
constexpr size_t WS_PART = 12 * MiB;
constexpr size_t WS_PART2 = 14 * MiB;
constexpr size_t WS_WIN = 16 * MiB;
constexpr size_t WS_WOUT = 24 * MiB;
constexpr size_t WS_W13 = 26 * MiB;
constexpr size_t WS_W2 = 90 * MiB;
constexpr size_t WS_WGATE = 122 * MiB;
constexpr size_t WS_WUP = 124 * MiB;
constexpr size_t WS_PROJ = 128 * MiB;
constexpr size_t WS_HB = 128 * MiB;
constexpr size_t WS_HBUF = 128 * MiB;
constexpr size_t WS_XS = 200 * MiB;
constexpr size_t WS_YBUF = 200 * MiB;
constexpr size_t WS_PEB = 128 * MiB;
constexpr size_t WS_YREG = 384 * MiB;
constexpr size_t WS_PB = 448 * MiB;
constexpr size_t WS_CS = 464 * MiB;
constexpr size_t WS_END = 472 * MiB;
constexpr size_t OUT_RST = 0;
constexpr size_t OUT_MST = 32 * MiB;
constexpr int CW_CNT = 64;
constexpr int CW_BAR = 4096;

constexpr int NTHREADS = 512, NWAVES = 8;
constexpr int RING_BYTES = 131072;
constexpr int LDSX_OFF = 143360;
constexpr int LDS_BYTES = 147456;

#define GAS __attribute__((address_space(1)))
#define LAS __attribute__((address_space(3)))
typedef unsigned short bf16_t;
typedef unsigned v4u __attribute__((ext_vector_type(4)));
__device__ __forceinline__ float bf2f(bf16_t h) { return __uint_as_float((unsigned)h << 16); }
__device__ __forceinline__ unsigned f2bf(float f) { unsigned u = __float_as_uint(f); return (u + 0x7fffu + ((u >> 16) & 1u)) >> 16; }
__device__ __forceinline__ unsigned pk2(float lo, float hi) { return f2bf(lo) | (f2bf(hi) << 16); }
__device__ __forceinline__ float wave_sum(float v) {
#pragma unroll
    for (int o = 1; o < 64; o <<= 1) v += __shfl_xor(v, o);
    return v;
}
__device__ __forceinline__ float sigmoidf_(float x) { return 1.0f / (1.0f + expf(-x)); }
__device__ __forceinline__ float siluf_(float x) { return x / (1.0f + expf(-x)); }
__device__ __forceinline__ float logsigmoidf_(float x) { return x >= 0.f ? -log1pf(expf(-x)) : x - log1pf(expf(x)); }
#define LDS_WAIT() asm volatile("s_waitcnt lgkmcnt(0)" ::: "memory")

namespace pg8 {
#define PG8_LAS __attribute__((address_space(3)))
typedef unsigned short bf16_t;
typedef short bf16x8 __attribute__((ext_vector_type(8)));
typedef float f32x4 __attribute__((ext_vector_type(4)));
typedef unsigned u32x4 __attribute__((ext_vector_type(4)));
constexpr int BM = 256, BK = 64, HALF = 128, HTB = HALF * BK * 2  , STAGE_BYTES = 8 * HTB, NXCD = 8, WGM = 8;

__host__ __device__ __forceinline__ int lds_byte(int r, int c) { const int st = (r >> 4) * 2 + (c >> 5), rr = r & 15, cc = c & 31, ob = rr * 64 + cc * 2; return st * 1024 + (ob ^ (((ob >> 9) & 1) << 5)); }
__host__ __device__ __forceinline__ void stage_rc(int b, int& R, int& C) { const int st = b / 1024, sb = b % 1024, swz = sb ^ (((sb >> 9) & 1) << 5); R = (st >> 1) * 16 + swz / 64; C = (st & 1) * 32 + (swz % 64) / 2; }
__host__ __device__ __forceinline__ int perm32(int rho) { const int n = rho >> 4, i = rho & 15; return 8 * (i >> 2) + 4 * n + (i & 3); }

struct Unit { int pm, pn; };
struct Gemm { const bf16_t* A; const bf16_t* Bt; int M, N, K; };

struct StaticOrder {
    int nM, nN, nwg, G, c;
    __host__ __device__ void init(int M, int N, int G_, int c_) { nM = M / BM; nN = N / BM; nwg = nM * nN; G = G_; c = c_; }
    __host__ __device__ bool next(int i, Unit& u) const {
        const long L = (long)i * G + c; if (L >= nwg) return false;
        int wgid = (int)L; { const int q = nwg / NXCD, r = nwg % NXCD, xcd = wgid % NXCD, off = wgid / NXCD; wgid = (xcd < r ? xcd * (q + 1) : r * (q + 1) + (xcd - r) * q) + off; }
        const int nig = WGM * nN, gid = wgid / nig, fm = gid * WGM, gsz = (nM - fm) < WGM ? (nM - fm) : WGM;
        u.pm = fm + ((wgid % nig) % gsz); u.pn = (wgid % nig) / gsz; return true;
    }
    __device__ __forceinline__ void a_ready(const Unit&) const {}
    __device__ __forceinline__ void done(const Unit&) const {}
};

__device__ __forceinline__ unsigned cvt_pk_bf16(float lo, float hi) { unsigned r; asm volatile("v_cvt_pk_bf16_f32 %0, %1, %2" : "=v"(r) : "v"(lo), "v"(hi)); return r; }
typedef float f32x2 __attribute__((ext_vector_type(2)));
struct GroupedOrder {
    int nM, nwg, G, c; const PG8_LAS int* t2e;
    __device__ void init(int nM_, int G_, int c_, const PG8_LAS int* t2e_) { nM = nM_; nwg = nM_ * 4; G = G_; c = c_; t2e = t2e_; }
    __device__ bool next(int i, Unit& u) const {
        const long L = (long)i * G + c; if (L >= nwg) return false;
        int wgid = (int)L; { const int q = nwg / NXCD, r = nwg % NXCD, xcd = wgid % NXCD, off = wgid / NXCD; wgid = (xcd < r ? xcd * (q + 1) : r * (q + 1) + (xcd - r) * q) + off; }
        const int nig = WGM * 4, gid = wgid / nig, fm = gid * WGM, gsz = (nM - fm) < WGM ? (nM - fm) : WGM;
        u.pm = fm + ((wgid % nig) % gsz); u.pn = (wgid % nig) / gsz + 4 * t2e[u.pm]; return true;
    }
    __device__ __forceinline__ void a_ready(const Unit&) const {}
    __device__ __forceinline__ void done(const Unit&) const {}
};
__device__ __forceinline__ float fast_sigmoid(float x) { return __builtin_amdgcn_rcpf(1.0f + __builtin_amdgcn_exp2f(-1.4426950408889634f * x)); }
struct EpiStoreBf16 {
    static constexpr bool PERM = true, AFTER_DRAIN = false;
    bf16_t* O; int ldc; int pn_mask; float* part;
    __device__ __forceinline__ void operator()(const f32x4 (&acc)[2][2][4][2], const Unit& u, int wr, int wc, int fr, int fq) const {
        const int pnl = u.pn & pn_mask; const int row0 = u.pm * BM + wr * 64 + fr, col0 = pnl * BM + wc * 32 + 8 * fq;
#pragma unroll
        for (int ai = 0; ai < 2; ++ai)
#pragma unroll
            for (int m = 0; m < 4; ++m) { const int row = row0 + ai * HALF + m * 16; bf16_t* rowp = O + (size_t)row * ldc + col0; float s = 0.f;
#pragma unroll
                for (int bj = 0; bj < 2; ++bj) { const f32x4 v0 = acc[ai][bj][m][0], v1 = acc[ai][bj][m][1];
                    u32x4 w; w.x = cvt_pk_bf16(v0[0], v0[1]); w.y = cvt_pk_bf16(v0[2], v0[3]); w.z = cvt_pk_bf16(v1[0], v1[1]); w.w = cvt_pk_bf16(v1[2], v1[3]);
                    *(u32x4*)(rowp + bj * HALF) = w;
                    s += (v0[0] * v0[0] + v0[1] * v0[1]) + (v0[2] * v0[2] + v0[3] * v0[3]) + (v1[0] * v1[0] + v1[1] * v1[1]) + (v1[2] * v1[2] + v1[3] * v1[3]); }
                if (part) { s += __shfl_xor(s, 16); s += __shfl_xor(s, 32); if (fq == 0) part[(size_t)row * 16 + pnl * 4 + wc] = s; } }
    }
};
struct EpiSwiglu {
    static constexpr bool PERM = true, AFTER_DRAIN = false;
    bf16_t* H; const float* slotr;
    __device__ __forceinline__ void operator()(const f32x4 (&acc)[2][2][4][2], const Unit& u, int wr, int wc, int fr, int fq) const {
        const int pnl = u.pn & 3; const int row0 = u.pm * BM + wr * 64 + fr, col0 = pnl * HALF + wc * 32 + 8 * fq;
#pragma unroll
        for (int ai = 0; ai < 2; ++ai)
#pragma unroll
            for (int m = 0; m < 4; ++m) { const int row = row0 + ai * HALF + m * 16; bf16_t* rowp = H + (size_t)row * 512 + col0; const float rs = slotr[row];
                f32x4 h[2];
#pragma unroll
                for (int n = 0; n < 2; ++n) { const f32x4 a = acc[ai][0][m][n] * rs, b = acc[ai][1][m][n] * rs;
#pragma unroll
                    for (int j = 0; j < 4; ++j) h[n][j] = a[j] * fast_sigmoid(a[j]) * b[j]; }
                u32x4 w; w.x = cvt_pk_bf16(h[0][0], h[0][1]); w.y = cvt_pk_bf16(h[0][2], h[0][3]); w.z = cvt_pk_bf16(h[1][0], h[1][1]); w.w = cvt_pk_bf16(h[1][2], h[1][3]);
                *(u32x4*)rowp = w; }
    }
};
struct EpiRes {
    static constexpr bool PERM = false, AFTER_DRAIN = false;
    const float* base; float* out; bf16_t* hb;
    __device__ __forceinline__ void operator()(const f32x4 (&acc)[2][2][4][2], const Unit& u, int wr, int wc, int fr, int fq) const {
        const int row0 = u.pm * BM + wr * 64 + fr, col0 = u.pn * BM + wc * 32 + 4 * fq;
#pragma unroll
        for (int ai = 0; ai < 2; ++ai)
#pragma unroll
            for (int m = 0; m < 4; ++m) { const size_t off = (size_t)(row0 + ai * HALF + m * 16) * 1024 + col0;
#pragma unroll
                for (int bj = 0; bj < 2; ++bj)
#pragma unroll
                    for (int n = 0; n < 2; ++n) { const f32x4 hv = *(const f32x4*)(base + off + bj * HALF + n * 16) + acc[ai][bj][m][n]; *(f32x4*)(out + off + bj * HALF + n * 16) = hv;
                        uint2 hw; hw.x = cvt_pk_bf16(hv[0], hv[1]); hw.y = cvt_pk_bf16(hv[2], hv[3]); *(uint2*)(hb + off + bj * HALF + n * 16) = hw; }
                asm volatile("" ::: "memory"); }
    }
};
struct EpiGate {
    static constexpr bool PERM = false, AFTER_DRAIN = false;
    float* out; const bf16_t* peb; const float* rstdg; const float* rstde; const float* ple_norm; float* part;
    __device__ __forceinline__ void operator()(const f32x4 (&acc)[2][2][4][2], const Unit& u, int wr, int wc, int fr, int fq) const {
        const int row0 = u.pm * BM + wr * 64 + fr, col0 = u.pn * BM + wc * 32 + 4 * fq;
        f32x4 pn4[2][2];
#pragma unroll
        for (int bj = 0; bj < 2; ++bj)
#pragma unroll
            for (int n = 0; n < 2; ++n) pn4[bj][n] = *(const f32x4*)(ple_norm + col0 + bj * HALF + n * 16);
#pragma unroll
        for (int ai = 0; ai < 2; ++ai)
#pragma unroll
            for (int m = 0; m < 4; ++m) { const int row = row0 + ai * HALF + m * 16; const size_t off = (size_t)row * 1024 + col0; const float rg = rstdg[row], re = rstde[row]; float s = 0.f;
#pragma unroll
                for (int bj = 0; bj < 2; ++bj)
#pragma unroll
                    for (int n = 0; n < 2; ++n) { const size_t o = off + bj * HALF + n * 16;
                        const uint2 pe = *(const uint2*)(peb + o); f32x4 h = *(const f32x4*)(out + o); const f32x4 a = acc[ai][bj][m][n];
                        f32x4 e; e[0] = __uint_as_float(pe.x << 16); e[1] = __uint_as_float(pe.x & 0xffff0000u); e[2] = __uint_as_float(pe.y << 16); e[3] = __uint_as_float(pe.y & 0xffff0000u);
#pragma unroll
                        for (int j = 0; j < 4; ++j) { h[j] += fast_sigmoid(rg * a[j]) * (e[j] * re * pn4[bj][n][j]); s += h[j] * h[j]; }
                        *(f32x4*)(out + o) = h; }
                s += __shfl_xor(s, 16); s += __shfl_xor(s, 32); if (fq == 0) part[(size_t)row * 16 + u.pn * 4 + wc] = s;
                asm volatile("" ::: "memory"); }
    }
};

template <class Epi, class Sched, bool ALIGN_EPI = false, bool SP2 = false>
__device__ __forceinline__ void gemm_phase(PG8_LAS unsigned char* lds, const Gemm g, const Sched& S, const Epi& E) {
    int tid_l = threadIdx.x; asm volatile("" : "+v"(tid_l));
    const int tid = tid_l, wid = __builtin_amdgcn_readfirstlane(tid >> 6), lane = tid & 63, wr = wid >> 2, wc = wid & 3, fr = lane & 15, fq = lane >> 4;
    const int K = g.K, nt = K / BK;
    unsigned voffA[2], voffB[2];
#pragma unroll
    for (int i = 0; i < 2; ++i) { int R, C; stage_rc(tid * 16 + i * 8192, R, C); const int Rb = Epi::PERM ? ((R & ~31) + perm32(R & 31)) : R;
        voffA[i] = (unsigned)(R * K + C) * 2u; voffB[i] = (unsigned)(Rb * K + C) * 2u; }
    const size_t kstep = (size_t)(BK * 2);
    const size_t hstep = (size_t)HALF * K * 2;
    const size_t tstep = 2 * hstep;
    const unsigned ldsw = (unsigned)wid * 1024u;
    const int aoff = lds_byte(wr * 64 + fr, fq * 8), boff = lds_byte(wc * 32 + fr, fq * 8);
#define PG8_SA(b, h) (((b) * 2 + (h)) * HTB)
#define PG8_SB(b, h) ((4 + (b) * 2 + (h)) * HTB)
#define PG8_STAGE(bufoff, gbase, voff) do { _Pragma("unroll") for (int _i = 0; _i < 2; ++_i) \
        __builtin_amdgcn_global_load_lds((const unsigned*)((const char*)(gbase) + (voff)[_i]), (PG8_LAS unsigned*)(lds + (bufoff) + ldsw + _i * 8192), 16, 0, 0); } while (0)
#define PG8_LDA(dst, b, h) do { _Pragma("unroll") for (int m = 0; m < 4; ++m) _Pragma("unroll") for (int k = 0; k < 2; ++k) dst[m][k] = *(const PG8_LAS bf16x8*)(lds + PG8_SA(b, h) + aoff + m * 2048 + k * 1024); } while (0)
#define PG8_LDB(dst, b, h) do { _Pragma("unroll") for (int n = 0; n < 2; ++n) _Pragma("unroll") for (int k = 0; k < 2; ++k) dst[n][k] = *(const PG8_LAS bf16x8*)(lds + PG8_SB(b, h) + boff + n * 2048 + k * 1024); } while (0)
#define PG8_MMA(ai, bj, At, Bt) do { __builtin_amdgcn_s_setprio(1); _Pragma("unroll") for (int m = 0; m < 4; ++m) _Pragma("unroll") for (int n = 0; n < 2; ++n) _Pragma("unroll") for (int k = 0; k < 2; ++k) \
        acc[ai][bj][m][n] = __builtin_amdgcn_mfma_f32_16x16x32_bf16(Bt[n][k], At[m][k], acc[ai][bj][m][n], 0, 0, 0); __builtin_amdgcn_s_setprio(0); } while (0)
#define PG8_WAIT_V(n) asm volatile("s_waitcnt vmcnt(" #n ")" ::: "memory")
#define PG8_WAIT_L(n) asm volatile("s_waitcnt lgkmcnt(" #n ")" ::: "memory")
#define PG8_BAR __builtin_amdgcn_s_barrier()
#define PG8_SCHED __builtin_amdgcn_sched_barrier(0)
    Unit cur, nxt; int ui = 0;
    if (!S.next(0, cur)) return;
    f32x4 acc[2][2][4][2];
#pragma unroll
    for (int a = 0; a < 2; ++a)
#pragma unroll
        for (int b = 0; b < 2; ++b)
#pragma unroll
            for (int m = 0; m < 4; ++m)
#pragma unroll
                for (int n = 0; n < 2; ++n) acc[a][b][m][n] = (f32x4){0.f, 0.f, 0.f, 0.f};
    bf16x8 At[4][2], B0[2][2], B1[2][2];
    const char* cA = (const char*)g.A + (size_t)cur.pm * tstep; const char* cB = (const char*)g.Bt + (size_t)cur.pn * tstep;
    S.a_ready(cur);
    if constexpr (SP2) {
        PG8_STAGE(PG8_SB(0, 0), cB, voffB); PG8_STAGE(PG8_SB(0, 1), cB + hstep, voffB); PG8_STAGE(PG8_SA(0, 0), cA, voffA); PG8_STAGE(PG8_SA(0, 1), cA + hstep, voffA);
        if (wr == 1) PG8_BAR;
        PG8_WAIT_V(2); PG8_BAR;
        PG8_STAGE(PG8_SB(1, 0), cB + kstep, voffB); PG8_STAGE(PG8_SA(1, 0), cA + kstep, voffA); PG8_STAGE(PG8_SB(1, 1), cB + hstep + kstep, voffB);
        PG8_WAIT_V(6); PG8_BAR;
    } else {
        PG8_STAGE(PG8_SB(0, 0), cB, voffB); PG8_STAGE(PG8_SA(0, 0), cA, voffA); PG8_STAGE(PG8_SB(0, 1), cB + hstep, voffB); PG8_STAGE(PG8_SA(0, 1), cA + hstep, voffA);
        if (wr == 1) PG8_BAR;
        PG8_WAIT_V(4); PG8_BAR;
        PG8_STAGE(PG8_SB(1, 0), cB + kstep, voffB); PG8_STAGE(PG8_SA(1, 0), cA + kstep, voffA); PG8_STAGE(PG8_SB(1, 1), cB + hstep + kstep, voffB);
        PG8_WAIT_V(6); PG8_BAR;
    }
    for (;;) {
        const bool has_next = S.next(ui + 1, nxt);
        const char* nA = has_next ? (const char*)g.A + (size_t)nxt.pm * tstep : cA; const char* nB = has_next ? (const char*)g.Bt + (size_t)nxt.pn * tstep : cB;
        for (int t = 0; t < nt; t += 2) {
            const bool last = (t == nt - 2);
            const char* a1 = cA + (size_t)(t + 1) * kstep;
            const char* a2 = last ? nA : cA + (size_t)(t + 2) * kstep; const char* b2 = last ? nB : cB + (size_t)(t + 2) * kstep;
            const char* a3 = a2 + kstep; const char* b3 = b2 + kstep;
            if (last && has_next) S.a_ready(nxt);
            if constexpr (SP2) {
            PG8_LDB(B0, 0, 0); PG8_LDB(B1, 0, 1); PG8_SCHED; PG8_LDA(At, 0, 0); PG8_STAGE(PG8_SA(1, 1), a1 + hstep, voffA);
            PG8_WAIT_V(8); PG8_WAIT_L(0); PG8_BAR; PG8_MMA(0, 0, At, B0); PG8_MMA(0, 1, At, B1); PG8_BAR; PG8_SCHED;
            PG8_LDA(At, 0, 1); PG8_STAGE(PG8_SB(0, 0), b2, voffB); PG8_STAGE(PG8_SB(0, 1), b2 + hstep, voffB); PG8_STAGE(PG8_SA(0, 0), a2, voffA);
            PG8_WAIT_V(8); PG8_WAIT_L(0); PG8_BAR; PG8_MMA(1, 0, At, B0); PG8_MMA(1, 1, At, B1); PG8_BAR; PG8_SCHED;
            PG8_LDB(B0, 1, 0); PG8_LDB(B1, 1, 1); PG8_SCHED; PG8_LDA(At, 1, 0); PG8_STAGE(PG8_SA(0, 1), a2 + hstep, voffA);
            PG8_WAIT_V(8); PG8_WAIT_L(0); PG8_BAR; PG8_MMA(0, 0, At, B0); PG8_MMA(0, 1, At, B1); PG8_BAR; PG8_SCHED;
            PG8_LDA(At, 1, 1); PG8_STAGE(PG8_SB(1, 0), b3, voffB); PG8_STAGE(PG8_SB(1, 1), b3 + hstep, voffB); PG8_STAGE(PG8_SA(1, 0), a3, voffA);
            PG8_WAIT_V(8); PG8_WAIT_L(0); PG8_BAR; PG8_MMA(1, 0, At, B0); PG8_MMA(1, 1, At, B1); PG8_BAR; PG8_SCHED;
            } else {
            PG8_LDB(B0, 0, 0); PG8_SCHED; PG8_LDA(At, 0, 0); PG8_STAGE(PG8_SA(1, 1), a1 + hstep, voffA);
            PG8_WAIT_L(8); PG8_BAR; PG8_WAIT_L(0); PG8_MMA(0, 0, At, B0); PG8_BAR; PG8_SCHED;
            PG8_LDB(B1, 0, 1); PG8_STAGE(PG8_SB(0, 0), b2, voffB);
            PG8_BAR; PG8_WAIT_L(0); PG8_MMA(0, 1, At, B1); PG8_BAR;
            PG8_LDA(At, 0, 1); PG8_STAGE(PG8_SA(0, 0), a2, voffA);
            PG8_BAR; PG8_WAIT_L(0); PG8_MMA(1, 0, At, B0); PG8_BAR; PG8_SCHED;
            PG8_STAGE(PG8_SB(0, 1), b2 + hstep, voffB);
            PG8_WAIT_V(6); PG8_BAR; PG8_MMA(1, 1, At, B1); PG8_BAR;
            PG8_LDB(B0, 1, 0); PG8_SCHED; PG8_LDA(At, 1, 0); PG8_STAGE(PG8_SA(0, 1), a2 + hstep, voffA);
            PG8_WAIT_L(8); PG8_BAR; PG8_WAIT_L(0); PG8_MMA(0, 0, At, B0); PG8_BAR; PG8_SCHED;
            PG8_LDB(B1, 1, 1); PG8_STAGE(PG8_SB(1, 0), b3, voffB);
            PG8_BAR; PG8_WAIT_L(0); PG8_MMA(0, 1, At, B1); PG8_BAR;
            PG8_LDA(At, 1, 1); PG8_STAGE(PG8_SA(1, 0), a3, voffA);
            PG8_BAR; PG8_WAIT_L(0); PG8_MMA(1, 0, At, B0); PG8_BAR; PG8_SCHED;
            PG8_STAGE(PG8_SB(1, 1), b3 + hstep, voffB);
            PG8_WAIT_V(6); PG8_BAR; PG8_MMA(1, 1, At, B1); PG8_BAR;
            }
        }
        if constexpr (ALIGN_EPI) { if (wr == 0) PG8_BAR; }
        if constexpr (!Epi::AFTER_DRAIN) { E(acc, cur, wr, wc, fr, fq); S.done(cur); }
        if (!has_next) break;
#pragma unroll
        for (int a = 0; a < 2; ++a)
#pragma unroll
            for (int b = 0; b < 2; ++b)
#pragma unroll
                for (int m = 0; m < 4; ++m)
#pragma unroll
                    for (int n = 0; n < 2; ++n) acc[a][b][m][n] = (f32x4){0.f, 0.f, 0.f, 0.f};
        cur = nxt; cA = nA; cB = nB; ++ui;
        if constexpr (ALIGN_EPI) { if (wr == 1) PG8_BAR; }
    }
    PG8_WAIT_V(0);
    if constexpr (!ALIGN_EPI) { if (wr == 0) PG8_BAR; }
    PG8_BAR;
    if constexpr (Epi::AFTER_DRAIN) { E.fused(acc, cur, wr, wc, fr, fq, lds, wid, lane); S.done(cur); }
#undef PG8_SA
#undef PG8_SB
#undef PG8_STAGE
#undef PG8_LDA
#undef PG8_LDB
#undef PG8_MMA
#undef PG8_WAIT_V
#undef PG8_WAIT_L
#undef PG8_BAR
#undef PG8_SCHED
}
}
#define XB_TMO      128
#define XB_XCNT(j)  (256  + 64 * (j))
#define XB_XSUB(j)  (1280 + 64 * (j))
#define XB_XGEN(j)  (2304 + 64 * (j))
#define XB_TOP      3328
#define XB_TOPGEN   3392
#define XCD_BAR_WORDS 3456
#define XB_SPIN_CAP (1u << 18)

__device__ __forceinline__ unsigned xb_ld(unsigned* p)              { return __hip_atomic_load(p, __ATOMIC_RELAXED, __HIP_MEMORY_SCOPE_AGENT); }
__device__ __forceinline__ unsigned xb_add(unsigned* p, unsigned v) { return __hip_atomic_fetch_add(p, v, __ATOMIC_RELAXED, __HIP_MEMORY_SCOPE_AGENT); }
__device__ __forceinline__ unsigned xb_xcc_id() { return (unsigned)__builtin_amdgcn_s_getreg((3 << 11) | 20) & 0xFu; }
#define XB_SPIN(cond, bar) do { unsigned _sp = 0; while (cond) { __builtin_amdgcn_s_sleep(1); \
    if ((++_sp & 255u) == 0u) { if (xb_ld(&(bar)[XB_TMO])) break; if (_sp > XB_SPIN_CAP) { atomicAdd(&(bar)[XB_TMO], 1u); break; } } } } while (0)

struct XcdBarrier {
    unsigned* bar; unsigned x;
    volatile LAS unsigned* st;
};

__device__ __forceinline__ XcdBarrier xcd_barrier_post(unsigned* bar, volatile LAS unsigned* st) {
    XcdBarrier b; b.bar = bar; b.x = xb_xcc_id(); b.st = st;
    if (threadIdx.x == 0) (void)xb_add(&bar[XB_XCNT(b.x)], 1u);
    return b;
}
__device__ __forceinline__ void xcd_barrier_complete(unsigned* bar, unsigned x, unsigned& nloc, unsigned& nx) {
    const unsigned G = gridDim.x * gridDim.y * gridDim.z;
    unsigned sum, cnt, mine, sp = 0u;
    for (;;) {
        sum = 0u; cnt = 0u; mine = 0u;
#pragma unroll
        for (unsigned j = 0; j < 16; ++j) { const unsigned c = xb_ld(&bar[XB_XCNT(j)]); sum += c; cnt += (c > 0u) ? 1u : 0u; mine = (j == x) ? c : mine; }
        if (sum == G) break;
        __builtin_amdgcn_s_sleep(1);
        if ((++sp & 255u) == 0u) { if (xb_ld(&bar[XB_TMO])) break; if (sp > XB_SPIN_CAP) { atomicAdd(&bar[XB_TMO], 1u); break; } }
    }
    nloc = mine > 0u ? mine : 1u; nx = cnt > 0u ? cnt : 1u;
}

__device__ __forceinline__ void xcd_barrier(const XcdBarrier& b) {
    asm volatile("s_waitcnt vmcnt(0)" ::: "memory");
    __syncthreads();
    if (threadIdx.x == 0) {
        unsigned* bar = b.bar;
        __builtin_amdgcn_s_waitcnt(0);
        unsigned nloc = b.st[0], nx = b.st[1];
        if (nloc == 0u) { xcd_barrier_complete(bar, b.x, nloc, nx); b.st[0] = nloc; b.st[1] = nx; }
        const unsigned old = xb_add(&bar[XB_XSUB(b.x)], 1u);
        const unsigned gen = old / nloc;
        if (old + 1u == (gen + 1u) * nloc) {
            __builtin_amdgcn_fence(__ATOMIC_RELEASE, "agent");
            asm volatile("s_waitcnt vmcnt(0)" ::: "memory");
            const unsigned og = xb_add(&bar[XB_TOP], 1u);
            const unsigned tg = og / nx;
            if (og + 1u == (tg + 1u) * nx) xb_add(&bar[XB_TOPGEN], 1u);
            else XB_SPIN(xb_ld(&bar[XB_TOPGEN]) == tg, bar);
            __builtin_amdgcn_fence(__ATOMIC_ACQUIRE, "agent");
            xb_add(&bar[XB_XGEN(b.x)], 1u);
            asm volatile("s_waitcnt vmcnt(0)" ::: "memory");
        } else {
            XB_SPIN(xb_ld(&bar[XB_XGEN(b.x)]) == gen, bar);
            __builtin_amdgcn_fence(__ATOMIC_ACQUIRE, "agent");
            asm volatile("s_waitcnt vmcnt(0)" ::: "memory");
        }
    }
    __syncthreads();
}
typedef short bf16x8 __attribute__((ext_vector_type(8)));
typedef short v4i16_t __attribute__((ext_vector_type(4)));
typedef float f32x16 __attribute__((ext_vector_type(16)));
typedef float f32x2_t __attribute__((ext_vector_type(2)));
typedef __bf16 bf16x2_t __attribute__((ext_vector_type(2)));
typedef float f4v __attribute__((ext_vector_type(4)));
__device__ __forceinline__ f32x16 MFMA32(const bf16x8 a, const bf16x8 b, const f32x16 c) { return __builtin_amdgcn_mfma_f32_32x32x16_bf16(a, b, c, 0, 0, 0); }
__device__ __forceinline__ unsigned cvtpk(float lo, float hi) { f32x2_t v = {lo, hi}; bf16x2_t b = __builtin_convertvector(v, bf16x2_t); return __builtin_bit_cast(unsigned, b); }
__device__ __forceinline__ int crow(int reg, int h) { return (reg & 3) + 8 * (reg >> 2) + 4 * h; }
__device__ __forceinline__ float blo(unsigned u) { return __uint_as_float(u << 16); }
__device__ __forceinline__ float bhi(unsigned u) { return __uint_as_float(u & 0xffff0000u); }
template <int W> __device__ __forceinline__ unsigned toff(unsigned row, unsigned ch) {
    if constexpr (W == 64) return row * 144u + ch * 16u;
    else return row * 256u + 16u * (ch ^ (((row & 3u) << 2) | ((row >> 2) & 3u)));
}
template <int W> __device__ __forceinline__ bf16x8 frag_row(const LAS unsigned char* tile, int R, int s, int h) { return *(const LAS bf16x8*)(tile + toff<W>(R, 2 * s + h)); }
template <int W, bool PERMK> __device__ __forceinline__ bf16x8 frag_tr(const LAS unsigned char* tile, int rbase, int cbase, int lane) {
    const int h = lane >> 5, blk = (lane >> 4) & 1, q = (lane & 15) >> 2, p = lane & 3;
    const int ch = (cbase >> 3) + 2 * blk + (p >> 1);
    const int r0 = rbase + (PERMK ? 4 * h : 8 * h) + q, r1 = r0 + (PERMK ? 8 : 4);
    const v4i16_t lo = __builtin_amdgcn_ds_read_tr16_b64_v4i16((LAS v4i16_t*)(tile + toff<W>(r0, ch) + 8 * (p & 1)));
    const v4i16_t hi = __builtin_amdgcn_ds_read_tr16_b64_v4i16((LAS v4i16_t*)(tile + toff<W>(r1, ch) + 8 * (p & 1)));
    return __builtin_shufflevector(lo, hi, 0, 1, 2, 3, 4, 5, 6, 7);
}
__device__ __forceinline__ bf16x8 pack_step(const f32x16& x, int s) {
    v4u p; p.x = cvtpk(x[8 * s], x[8 * s + 1]); p.y = cvtpk(x[8 * s + 2], x[8 * s + 3]); p.z = cvtpk(x[8 * s + 4], x[8 * s + 5]); p.w = cvtpk(x[8 * s + 6], x[8 * s + 7]);
    return __builtin_bit_cast(bf16x8, p);
}
__device__ __forceinline__ f32x16 zero16() { f32x16 z;
#pragma unroll
    for (int i = 0; i < 16; ++i) z[i] = 0.f; return z; }
__device__ __forceinline__ void wave_scan_sum2(float& x0, float& x1, int lane) {
    const float loc = x0 + x1; float s = loc;
#pragma unroll
    for (int o = 1; o < 64; o <<= 1) { const float t = __shfl_up(s, o); if (lane >= o) s += t; }
    const float ex = s - loc; x0 = ex + x0; x1 = x0 + x1;
}
__device__ __forceinline__ void wave_scan_max2(float& x0, float& x1, int lane) {
    const float loc = fmaxf(x0, x1); float s = loc;
#pragma unroll
    for (int o = 1; o < 64; o <<= 1) { const float t = __shfl_up(s, o); if (lane >= o) s = fmaxf(s, t); }
    float ex = __shfl_up(s, 1); if (lane == 0) ex = -INFINITY;
    x0 = fmaxf(ex, x0); x1 = fmaxf(x0, x1);
}
__device__ __forceinline__ float wave_max(float v) {
#pragma unroll
    for (int o = 1; o < 64; o <<= 1) v = fmaxf(v, __shfl_xor(v, o));
    return v;
}
__device__ __forceinline__ void rot8_store(LAS unsigned char* tile, int row, int j0, const v4u x1, const v4u x2, const float* cs, float scale) {
    float a[8], b[8];
    a[0] = blo(x1.x); a[1] = bhi(x1.x); a[2] = blo(x1.y); a[3] = bhi(x1.y); a[4] = blo(x1.z); a[5] = bhi(x1.z); a[6] = blo(x1.w); a[7] = bhi(x1.w);
    b[0] = blo(x2.x); b[1] = bhi(x2.x); b[2] = blo(x2.y); b[3] = bhi(x2.y); b[4] = blo(x2.z); b[5] = bhi(x2.z); b[6] = blo(x2.w); b[7] = bhi(x2.w);
    float o1[8], o2[8];
#pragma unroll
    for (int i = 0; i < 8; ++i) { const float c = cs[2 * i], s = cs[2 * i + 1]; o1[i] = (a[i] * c - b[i] * s) * scale; o2[i] = (a[i] * s + b[i] * c) * scale; }
    v4u w1, w2; w1.x = cvtpk(o1[0], o1[1]); w1.y = cvtpk(o1[2], o1[3]); w1.z = cvtpk(o1[4], o1[5]); w1.w = cvtpk(o1[6], o1[7]);
    w2.x = cvtpk(o2[0], o2[1]); w2.y = cvtpk(o2[2], o2[3]); w2.z = cvtpk(o2[4], o2[5]); w2.w = cvtpk(o2[6], o2[7]);
    *(LAS v4u*)(tile + toff<64>(row, j0 >> 3)) = w1; *(LAS v4u*)(tile + toff<64>(row, 4 + (j0 >> 3))) = w2;
}
__device__ __forceinline__ void conv8(const bf16_t* colp, int s, const float* cw, const float* cb, float* o) {
#pragma unroll
    for (int i = 0; i < 8; ++i) o[i] = cb[i];
#pragma unroll
    for (int w = 0; w < 4; ++w) { const int ss = s - 3 + w; if (ss >= 0) { const v4u x = *(const v4u*)(colp + (ptrdiff_t)(w - 3) * NP);
        o[0] += blo(x.x) * cw[w * 8 + 0]; o[1] += bhi(x.x) * cw[w * 8 + 1]; o[2] += blo(x.y) * cw[w * 8 + 2]; o[3] += bhi(x.y) * cw[w * 8 + 3];
        o[4] += blo(x.z) * cw[w * 8 + 4]; o[5] += bhi(x.z) * cw[w * 8 + 5]; o[6] += blo(x.w) * cw[w * 8 + 6]; o[7] += bhi(x.w) * cw[w * 8 + 7]; } }
#pragma unroll
    for (int i = 0; i < 8; ++i) o[i] = o[i] * __builtin_amdgcn_rcpf(1.0f + __builtin_amdgcn_exp2f(-1.4426950408889634f * o[i]));
}

struct Params {
    const float *x, *p; const int* pos;
    const float *attn_norm, *w_in, *conv_w, *conv_b, *b_ig, *b_fg, *ret_gn, *ml_gn, *w_out, *moe_norm, *w_group, *b_group, *w_router, *b_router,
                *w1, *w3, *w2, *w_up, *ple_norm, *pg_norm, *w_gate, *final_norm;
    float* out; unsigned char* ws;
};

__device__ __forceinline__ void load4(const float* p, float (&o)[4]) { const float4 v = *(const float4*)p; o[0] = v.x; o[1] = v.y; o[2] = v.z; o[3] = v.w; }
__device__ __forceinline__ void load4(const bf16_t* p, float (&o)[4]) { const uint2 v = *(const uint2*)p; o[0] = __uint_as_float(v.x << 16); o[1] = __uint_as_float(v.x & 0xffff0000u); o[2] = __uint_as_float(v.y << 16); o[3] = __uint_as_float(v.y & 0xffff0000u); }

__device__ __forceinline__ void transpose_item(const float* W, int ldw, const float* gain, bf16_t* WT, int K, int kb, int n0, size_t drow0, LAS float* scr, int lane) {
    const int k0 = 64 * kb;
#pragma unroll 8
    for (int i = 0; i < 32; ++i) { const int kk = 2 * i + (lane >> 5); float w = W[(size_t)(k0 + kk) * ldw + n0 + (lane & 31)]; if (gain) w *= gain[k0 + kk]; scr[kk * 33 + (lane & 31)] = w; }
    LDS_WAIT(); asm volatile("" ::: "memory");
    const int c = lane & 7;
#pragma unroll
    for (int j = 0; j < 4; ++j) { const int n = (lane >> 3) + 8 * j; const LAS float* s = scr + (8 * c) * 33 + n;
        v4u o; o.x = pk2(s[0 * 33], s[1 * 33]); o.y = pk2(s[2 * 33], s[3 * 33]); o.z = pk2(s[4 * 33], s[5 * 33]); o.w = pk2(s[6 * 33], s[7 * 33]);
        *(GAS v4u*)(WT + (drow0 + n) * K + k0 + 8 * c) = o; }
    LDS_WAIT(); asm volatile("" ::: "memory");
}

constexpr int NPHASES = 14;
template <int LO, int HI>
__global__ void __launch_bounds__(NTHREADS, 2) mk(Params P) {
    extern __shared__ __attribute__((aligned(16))) unsigned char lds_raw[];
    float* ldsf = (float*)lds_raw;
    LAS unsigned char* ldsl = (LAS unsigned char*)lds_raw;
    const int G = gridDim.x, bid = blockIdx.x, NGW = G * NWAVES;
#define PH_IDS int tid = threadIdx.x; asm volatile("" : "+v"(tid)); const int lane = tid & 63, wave = __builtin_amdgcn_readfirstlane(tid >> 6), gw = bid * NWAVES + wave; (void)lane; (void)gw;
    unsigned char* const ws = P.ws;
#define rstd1 ((float*)(ws + WS_RSTD1))
#define gates ((float*)(ws + WS_GATES))
#define rstdg ((float*)(ws + WS_RSTDG))
#define rstde ((float*)(ws + WS_RSTDE))
#define eid ((int*)(ws + WS_EID))
#define posn ((int*)(ws + WS_POS))
#define gate ((float*)(ws + WS_GATE))
#define mn ((float*)(ws + WS_MN))
#define ml ((float*)(ws + WS_ML))
#define mbl ((float*)(ws + WS_MBL))
#define mm ((float*)(ws + WS_MM))
#define list ((int*)(ws + WS_LIST))
#define cnt ((int*)(ws + WS_CTL) + CW_CNT)
#define part ((float*)(ws + WS_PART))
#define part2 ((float*)(ws + WS_PART2))
#define win_t ((bf16_t*)(ws + WS_WIN))
#define wout_t ((bf16_t*)(ws + WS_WOUT))
#define w13_t ((bf16_t*)(ws + WS_W13))
#define w2_t ((bf16_t*)(ws + WS_W2))
#define wgate_t ((bf16_t*)(ws + WS_WGATE))
#define wup_t ((bf16_t*)(ws + WS_WUP))
#define proj ((bf16_t*)(ws + WS_PROJ))
#define hbuf ((bf16_t*)(ws + WS_HBUF))
#define xs ((bf16_t*)(ws + WS_XS))
#define ybuf ((bf16_t*)(ws + WS_YBUF))
#define peb ((bf16_t*)(ws + WS_PEB))
#define yreg ((bf16_t*)(ws + WS_YREG))
#define pb ((bf16_t*)(ws + WS_PB))
    float* const out = P.out;
#define rst ((float*)((unsigned char*)out + OUT_RST))
#define mst ((float*)((unsigned char*)out + OUT_MST))
    LAS int* s_off = (LAS int*)(ldsl + LDSX_OFF + 256);
    LAS int* s_cnt = s_off + 40;
    LAS int* s_t2e = s_off + 80;
#define IN(k) (LO <= (k) && (k) < HI)
#define GRID_BAR(k) do { if constexpr (IN(k) && IN((k) + 1)) xcd_barrier(bar); } while (0)
    XcdBarrier bar; bar.bar = (unsigned*)(ws + WS_CTL) + CW_BAR; bar.x = 0; bar.st = nullptr;
    if constexpr (HI - LO > 1) {
        PH_IDS
        volatile LAS unsigned* st = (volatile LAS unsigned*)(ldsl + LDSX_OFF);
        if (tid == 0) { st[0] = 0u; st[1] = 0u; }
        __syncthreads();
        bar = xcd_barrier_post((unsigned*)(ws + WS_CTL) + CW_BAR, st);
    }

    if constexpr (IN(0)) {
        PH_IDS
        {
            LAS float* scr = (LAS float*)(ldsl + wave * 16384);
            constexpr int I0 = 16 * 128, I1 = 16 * 32, I2 = 64 * 256, I3 = 32 * 256, I4 = 16 * 32, I5 = 4 * 32;
            for (int it = gw; it < I0 + I1 + I2 + I3 + I4 + I5; it += NGW) {
                int r = it;
                if (r < I0) { transpose_item(P.w_in, NPROJ, P.attn_norm, win_t, D, r / 128, 32 * (r % 128), (size_t)(32 * (r % 128)), scr, lane); continue; } r -= I0;
                if (r < I1) { transpose_item(P.w_out, D, nullptr, wout_t, D, r / 32, 32 * (r % 32), (size_t)(32 * (r % 32)), scr, lane); continue; } r -= I1;
                if (r < I2) { const int mat = r >> 8, q = r & 255, e = mat >> 1, which = mat & 1, kb = q >> 4, n0 = 32 * (q & 15);
                    const float* W = (which ? P.w3 : P.w1) + (size_t)e * D * DE;
                    transpose_item(W, DE, P.moe_norm, w13_t, D, kb, n0, (size_t)e * 1024 + (size_t)((n0 >> 7) * 256 + which * 128 + (n0 & 127)), scr, lane); continue; } r -= I2;
                if (r < I3) { const int e = r >> 8, q = r & 255, kb = q >> 5, n0 = 32 * (q & 31);
                    transpose_item(P.w2 + (size_t)e * DE * D, D, nullptr, w2_t, DE, kb, n0, (size_t)e * 1024 + n0, scr, lane); continue; } r -= I3;
                if (r < I4) { transpose_item(P.w_gate, D, P.pg_norm, wgate_t, D, r / 32, 32 * (r % 32), (size_t)(32 * (r % 32)), scr, lane); continue; } r -= I4;
                transpose_item(P.w_up, D, nullptr, wup_t, PLE, r / 32, 32 * (r % 32), (size_t)(32 * (r % 32)), scr, lane);
            }
        }
        __syncthreads();
        {
            LAS float* gwl = (LAS float*)ldsl;
            for (int idx = tid; idx < D * 8; idx += NTHREADS) { const int k = idx >> 3, j = idx & 7; gwl[idx] = P.w_in[(size_t)k * NPROJ + NP + j] * P.attn_norm[k]; }
            __syncthreads();
            for (int row = gw; row < T; row += NGW) {
                const float4* xr = (const float4*)(P.x + (size_t)row * D) + lane;
                float4 v[4]; float ss = 0.f;
#pragma unroll
                for (int j = 0; j < 4; ++j) { v[j] = xr[64 * j]; ss += v[j].x * v[j].x + v[j].y * v[j].y + v[j].z * v[j].z + v[j].w * v[j].w; }
                ss = wave_sum(ss);
                const float rstd = 1.0f / sqrtf(ss * (1.0f / D) + EPS);
                float g8[8];
#pragma unroll
                for (int i = 0; i < 8; ++i) g8[i] = 0.f;
#pragma unroll
                for (int j = 0; j < 4; ++j) {
                    const int k0 = 4 * (lane + 64 * j);
                    const float xs_[4] = {v[j].x * rstd, v[j].y * rstd, v[j].z * rstd, v[j].w * rstd};
                    uint2 o; o.x = pk2(xs_[0], xs_[1]); o.y = pk2(xs_[2], xs_[3]);
                    *(uint2*)(yreg + (size_t)row * D + k0) = o;
#pragma unroll
                    for (int i = 0; i < 4; ++i) {
                        const LAS f4v* wr = (const LAS f4v*)(gwl + (k0 + i) * 8);
                        const f4v w0 = wr[0], w1 = wr[1];
                        g8[0] += xs_[i] * w0.x; g8[1] += xs_[i] * w0.y; g8[2] += xs_[i] * w0.z; g8[3] += xs_[i] * w0.w;
                        g8[4] += xs_[i] * w1.x; g8[5] += xs_[i] * w1.y; g8[6] += xs_[i] * w1.z; g8[7] += xs_[i] * w1.w;
                    }
                }
#pragma unroll
                for (int i = 0; i < 8; ++i) g8[i] = wave_sum(g8[i]);
                if (lane == 0) {
                    rstd1[row] = rstd;
                    *(float4*)(gates + (size_t)row * 8) = make_float4(g8[0], g8[1], g8[2], g8[3]);
                    *(float4*)(gates + (size_t)row * 8 + 4) = make_float4(g8[4], g8[5], g8[6], g8[7]);
                }
            }
            {
                float* cstab = (float*)(ws + WS_CS);
                for (int idx = bid * NTHREADS + tid; idx < T * 32; idx += G * NTHREADS) {
                    const int t = idx >> 5, j = idx & 31;
                    const float ang = (float)P.pos[t] * powf(10000.0f, -(float)j / 32.0f);
                    float sn, cs; sincosf(ang, &sn, &cs);
                    *(float2*)(cstab + (size_t)idx * 2) = make_float2(cs, sn);
                }
            }
            for (int row = gw; row < T; row += NGW) {
                const float4 v = ((const float4*)(P.p + (size_t)row * PLE))[lane];
                uint2 o; o.x = pk2(v.x, v.y); o.y = pk2(v.z, v.w);
                ((uint2*)(pb + (size_t)row * PLE))[lane] = o;
            }
        }
        __syncthreads();
    }
    GRID_BAR(0);
    if constexpr (IN(1)) {
        PH_IDS
        pg8::Gemm g{yreg, win_t, T, NP, D}; pg8::StaticOrder S; S.init(T, NP, G, bid);
        pg8::EpiStoreBf16 E{proj, NP, 0xffff, nullptr};
        pg8::gemm_phase<pg8::EpiStoreBf16, pg8::StaticOrder, true, true>(ldsl, g, S, E);
    }
    GRID_BAR(1);
    if constexpr (IN(2)) {
        PH_IDS
        const int nitems = BATCH * NCH * (RH + MH);
        const float* cstab = (const float*)(ws + WS_CS);
        for (int it = bid; it < nitems; it += G) {
            const int bn = it / (RH + MH), hh = it % (RH + MH), b = bn / NCH, n = bn % NCH;
            const size_t t0 = (size_t)b * SEQ + (size_t)n * CH;
            __syncthreads();
            if (hh < RH) {
                const int h = hh;
                const float lg2 = log1pf(-exp2f(-5.0f - (float)h)) * 1.4426950408889634f;
                LAS unsigned char* Kt = ldsl; LAS unsigned char* Vt = ldsl + 18432;
                {   const int c = tid >> 2, j0 = (tid & 3) * 8; const size_t t = t0 + c;
                    const f4v* csp = (const f4v*)(cstab + t * 64 + j0 * 2);
                    float cs[16];
#pragma unroll
                    for (int i = 0; i < 4; ++i) { const f4v v = csp[i]; cs[4 * i] = v.x; cs[4 * i + 1] = v.y; cs[4 * i + 2] = v.z; cs[4 * i + 3] = v.w; }
                    const bf16_t* kp = proj + t * NP + C_RK + h * RD;
                    rot8_store(Kt, c, j0, *(const v4u*)(kp + j0), *(const v4u*)(kp + 32 + j0), cs, 0.125f * __builtin_amdgcn_exp2f(lg2 * (float)(CH - 1 - c)));
                }
#pragma unroll
                for (int i = tid; i < CH * 8; i += NTHREADS) { const int row = i >> 3, ch = i & 7; *(LAS v4u*)(Vt + toff<64>(row, ch)) = *(const v4u*)(proj + (t0 + row) * NP + C_RV + h * RD + ch * 8); }
                __syncthreads();
                if (wave < 4) {
                    const int db = wave >> 1, eb = wave & 1, r = lane & 31, hl = lane >> 5;
                    f32x16 acc = zero16();
#pragma unroll
                    for (int s = 0; s < 8; ++s) acc = MFMA32(frag_tr<64, false>(Kt, 16 * s, db * 32, lane), frag_tr<64, false>(Vt, 16 * s, eb * 32, lane), acc);
                    float* dst = rst + (size_t)(bn * RH + h) * (RD * RD) + eb * 32 + r;
#pragma unroll
                    for (int reg = 0; reg < 16; ++reg) dst[(db * 32 + crow(reg, hl)) * RD] = acc[reg];
                }
            } else {
                const int h = hh - RH; const int sidx = bn * MH + h;
                LAS unsigned char* Kt = ldsl; LAS unsigned char* Vt = ldsl + 32768; LAS float* sw = (LAS float*)(ldsl + 65536);
                if (wave == 0) {
                    const size_t t = t0 + 2 * lane;
                    const float i0 = gates[t * 8 + h] + P.b_ig[h], i1 = gates[(t + 1) * 8 + h] + P.b_ig[h];
                    float b0 = logsigmoidf_(gates[t * 8 + 4 + h] + P.b_fg[h]), b1 = logsigmoidf_(gates[(t + 1) * 8 + 4 + h] + P.b_fg[h]);
                    wave_scan_sum2(b0, b1, lane);
                    const float bL = __shfl(b1, 63);
                    const float a0 = bL - b0 + i0, a1 = bL - b1 + i1;
                    const float mloc = wave_max(fmaxf(a0, a1));
                    sw[2 * lane] = expf(a0 - mloc); sw[2 * lane + 1] = expf(a1 - mloc);
                    if (lane == 0) { ml[sidx] = mloc; mbl[sidx] = bL; }
                }
#pragma unroll
                for (int i = tid; i < CH * 16; i += NTHREADS) { const int row = i >> 4, ch = i & 15; *(LAS v4u*)(Vt + toff<128>(row, ch)) = *(const v4u*)(proj + (t0 + row) * NP + C_MV + h * MD + ch * 8); }
                __syncthreads();
                {   const int cg = tid & 15, d0 = cg * 8; const int chn = 512 + h * MD + d0;
                    float cw[32], cb_[8];
#pragma unroll
                    for (int w = 0; w < 4; ++w)
#pragma unroll
                        for (int i = 0; i < 8; ++i) cw[w * 8 + i] = P.conv_w[w * 1024 + chn + i];
#pragma unroll
                    for (int i = 0; i < 8; ++i) cb_[i] = P.conv_b[chn + i];
#pragma unroll
                    for (int i = 0; i < 4; ++i) {
                        const int c = (tid >> 4) + 32 * i; float o[8];
                        conv8(proj + (t0 + c) * NP + C_MK + h * MD + d0, n * CH + c, cw, cb_, o);
                        const float sc = 0.08838834764831845f * sw[c];
                        v4u w; w.x = cvtpk(o[0] * sc, o[1] * sc); w.y = cvtpk(o[2] * sc, o[3] * sc); w.z = cvtpk(o[4] * sc, o[5] * sc); w.w = cvtpk(o[6] * sc, o[7] * sc);
                        *(LAS v4u*)(Kt + toff<128>(c, cg)) = w;
                    }
                }
                __syncthreads();
                {
                    const int db = wave >> 1, ep = wave & 1, r = lane & 31, hl = lane >> 5;
                    f32x16 acc0 = zero16(), acc1 = zero16(), accn = zero16();
                    bf16x8 ones;
#pragma unroll
                    for (int i = 0; i < 8; ++i) ones[i] = (short)0x3F80;
#pragma unroll
                    for (int s = 0; s < 8; ++s) { const bf16x8 ka = frag_tr<128, false>(Kt, 16 * s, db * 32, lane);
                        acc0 = MFMA32(ka, frag_tr<128, false>(Vt, 16 * s, ep * 64, lane), acc0);
                        acc1 = MFMA32(ka, frag_tr<128, false>(Vt, 16 * s, ep * 64 + 32, lane), acc1);
                        if (ep == 0) accn = MFMA32(ka, ones, accn); }
                    float* dst = mst + (size_t)sidx * (MD * MD) + ep * 64 + r;
#pragma unroll
                    for (int reg = 0; reg < 16; ++reg) { const int d = db * 32 + crow(reg, hl); dst[d * MD] = acc0[reg]; dst[d * MD + 32] = acc1[reg]; }
                    if (ep == 0 && r == 0) {
#pragma unroll
                        for (int reg = 0; reg < 16; ++reg) mn[(size_t)sidx * MD + db * 32 + crow(reg, hl)] = accn[reg];
                    }
                }
            }
        }
        __syncthreads();
    }
    GRID_BAR(2);
    if constexpr (IN(3)) {
        PH_IDS
        const long NT = (long)G * NTHREADS; const long NR = (long)BATCH * RH * RD * RD, NM = (long)BATCH * MH * MD * MD, NN = (long)BATCH * MH * MD;
        for (long idx = (long)bid * NTHREADS + tid; idx < NR + NM + NN; idx += NT) {
            if (idx < NR) {
                const int el = (int)(idx % (RD * RD)); const int bh = (int)(idx / (RD * RD)); const int b = bh / RH, h = bh % RH;
                const float dec = expf(log1pf(-exp2f(-5.0f - (float)h)) * (float)CH);
                float R = 0.f;
                for (int n = 0; n < NCH; ++n) { float* ptr = rst + ((size_t)((b * NCH + n) * RH + h)) * (RD * RD) + el; const float tmp = *ptr; *ptr = R; R = dec * R + tmp; }
            } else {
                const long j = idx - NR; const bool isn = j >= NM;
                const long jj = isn ? j - NM : j; const int per = isn ? MD : MD * MD;
                const int el = (int)(jj % per); const int bh = (int)(jj / per); const int b = bh / MH, h = bh % MH;
                float S = 0.f, m = 0.f;
                for (int n = 0; n < NCH; ++n) {
                    const int sidx = (b * NCH + n) * MH + h;
                    const float bL = mbl[sidx], mloc = ml[sidx];
                    const float mnew = fmaxf(bL + m, mloc);
                    const float dec = expf(bL + m - mnew), sc = expf(mloc - mnew);
                    float* ptr = isn ? mn + (size_t)sidx * MD + el : mst + (size_t)sidx * (MD * MD) + el;
                    const float tmp = *ptr; *ptr = S; S = dec * S + sc * tmp;
                    if (isn && el == 0) mm[sidx] = m;
                    m = mnew;
                }
            }
        }
    }
    GRID_BAR(3);
    if constexpr (IN(4)) {
        PH_IDS
        const int nitems = BATCH * NCH * (RH + MH);
        const float* cstab = (const float*)(ws + WS_CS);
        for (int it = bid; it < nitems; it += G) {
            const int bn = it / (RH + MH), hh = it % (RH + MH), b = bn / NCH, n = bn % NCH;
            const size_t t0 = (size_t)b * SEQ + (size_t)n * CH;
            __syncthreads();
            if (hh < RH) {
                const int h = hh;
                const float lg2 = log1pf(-exp2f(-5.0f - (float)h)) * 1.4426950408889634f;
                LAS unsigned char* Qt = ldsl; LAS unsigned char* Kt = ldsl + 18432; LAS unsigned char* Vt = ldsl + 36864; LAS unsigned char* Rpt = ldsl + 55296;
                LAS float* Zs = (LAS float*)(ldsl + 65536);
                {
                    const int c = tid >> 2, j0 = (tid & 3) * 8; const size_t t = t0 + c;
                    const f4v* csp = (const f4v*)(cstab + t * 64 + j0 * 2);
                    float cs[16];
#pragma unroll
                    for (int i = 0; i < 4; ++i) { const f4v v = csp[i]; cs[4 * i] = v.x; cs[4 * i + 1] = v.y; cs[4 * i + 2] = v.z; cs[4 * i + 3] = v.w; }
                    const bf16_t* qp = proj + t * NP + C_RQ + h * RD; const bf16_t* kp = proj + t * NP + C_RK + h * RD;
                    rot8_store(Qt, c, j0, *(const v4u*)(qp + j0), *(const v4u*)(qp + 32 + j0), cs, 1.0f);
                    rot8_store(Kt, c, j0, *(const v4u*)(kp + j0), *(const v4u*)(kp + 32 + j0), cs, 0.125f);
                }
#pragma unroll
                for (int i = tid; i < CH * 8; i += NTHREADS) { const int row = i >> 3, ch = i & 7; *(LAS v4u*)(Vt + toff<64>(row, ch)) = *(const v4u*)(proj + (t0 + row) * NP + C_RV + h * RD + ch * 8); }
                {   const int d = tid >> 3, ch = tid & 7; const f4v* rp = (const f4v*)(rst + (size_t)(bn * RH + h) * (RD * RD) + d * RD + ch * 8);
                    const f4v a = rp[0], c2 = rp[1]; v4u w; w.x = cvtpk(a.x, a.y); w.y = cvtpk(a.z, a.w); w.z = cvtpk(c2.x, c2.y); w.w = cvtpk(c2.z, c2.w);
                    *(LAS v4u*)(Rpt + toff<64>(d, ch)) = w; }
                __syncthreads();
                {
                    const int cb = wave >> 1, eb = wave & 1, r = lane & 31, hl = lane >> 5;
                    f32x16 Z = zero16();
                    const int c = cb * 32 + r;
                    for (int jb = 0; jb <= cb; ++jb) {
                        f32x16 X = zero16();
#pragma unroll
                        for (int s = 0; s < 4; ++s) X = MFMA32(frag_row<64>(Kt, jb * 32 + r, s, hl), frag_row<64>(Qt, cb * 32 + r, s, hl), X);
#pragma unroll
                        for (int reg = 0; reg < 16; ++reg) { const int dl = c - (jb * 32 + crow(reg, hl)); X[reg] = dl >= 0 ? X[reg] * __builtin_amdgcn_exp2f(lg2 * (float)dl) : 0.f; }
#pragma unroll
                        for (int s2 = 0; s2 < 2; ++s2) Z = MFMA32(pack_step(X, s2), frag_tr<64, true>(Vt, jb * 32 + 16 * s2, eb * 32, lane), Z);
                    }
                    f32x16 Zi = zero16();
#pragma unroll
                    for (int s = 0; s < 4; ++s) Zi = MFMA32(frag_row<64>(Qt, cb * 32 + r, s, hl), frag_tr<64, false>(Rpt, 16 * s, eb * 32, lane), Zi);
#pragma unroll
                    for (int reg = 0; reg < 16; ++reg) { const int cc = cb * 32 + crow(reg, hl); Z[reg] += __builtin_amdgcn_exp2f(lg2 * (float)(cc + 1)) * Zi[reg]; Zs[cc * 68 + eb * 32 + r] = Z[reg]; }
                }
                __syncthreads();
                {
                    const int c = tid >> 2, e0 = (tid & 3) * 16; const size_t t = t0 + c;
                    float z[16]; float ss = 0.f;
#pragma unroll
                    for (int i = 0; i < 4; ++i) { const f4v v = *(const LAS f4v*)(Zs + c * 68 + e0 + 4 * i); z[4 * i] = v.x; z[4 * i + 1] = v.y; z[4 * i + 2] = v.z; z[4 * i + 3] = v.w; }
#pragma unroll
                    for (int i = 0; i < 16; ++i) ss += z[i] * z[i];
                    ss += __shfl_xor(ss, 1); ss += __shfl_xor(ss, 2);
                    const float rn = 1.0f / sqrtf(ss * (1.0f / RD) + EPS);
                    const v4u g0 = *(const v4u*)(proj + t * NP + C_RG + h * RD + e0), g1 = *(const v4u*)(proj + t * NP + C_RG + h * RD + e0 + 8);
                    const float gg[16] = {blo(g0.x), bhi(g0.x), blo(g0.y), bhi(g0.y), blo(g0.z), bhi(g0.z), blo(g0.w), bhi(g0.w), blo(g1.x), bhi(g1.x), blo(g1.y), bhi(g1.y), blo(g1.z), bhi(g1.z), blo(g1.w), bhi(g1.w)};
                    float o[16];
#pragma unroll
                    for (int i = 0; i < 16; ++i) o[i] = siluf_(gg[i]) * z[i] * rn * P.ret_gn[h * RD + e0 + i];
                    v4u w0, w1; w0.x = cvtpk(o[0], o[1]); w0.y = cvtpk(o[2], o[3]); w0.z = cvtpk(o[4], o[5]); w0.w = cvtpk(o[6], o[7]);
                    w1.x = cvtpk(o[8], o[9]); w1.y = cvtpk(o[10], o[11]); w1.z = cvtpk(o[12], o[13]); w1.w = cvtpk(o[14], o[15]);
                    *(v4u*)(yreg + t * D + h * RD + e0) = w0; *(v4u*)(yreg + t * D + h * RD + e0 + 8) = w1;
                }
            } else {
                const int h = hh - RH; const int sidx = bn * MH + h;
                LAS unsigned char* Qt = ldsl; LAS unsigned char* Kt = ldsl + 32768; LAS unsigned char* Vt = ldsl + 65536; LAS unsigned char* Spt = ldsl + 98304;
                LAS float* sb = (LAS float*)(ldsl + 131072); LAS float* sg = sb + 128; LAS float* spm = sg + 128; LAS float* snp = spm + 128; LAS float* sden = snp + 128; LAS float* swi = sden + 128;
                LAS float* Zs = (LAS float*)(ldsl + 32768);
                const float mprev = mm[sidx];
                if (wave == 0) {
                    const size_t t = t0 + 2 * lane;
                    const float i0 = gates[t * 8 + h] + P.b_ig[h], i1 = gates[(t + 1) * 8 + h] + P.b_ig[h];
                    float b0 = logsigmoidf_(gates[t * 8 + 4 + h] + P.b_fg[h]), b1 = logsigmoidf_(gates[(t + 1) * 8 + 4 + h] + P.b_fg[h]);
                    wave_scan_sum2(b0, b1, lane);
                    const float g0 = i0 - b0, g1 = i1 - b1; float p0 = g0, p1 = g1;
                    wave_scan_max2(p0, p1, lane);
                    sb[2 * lane] = b0; sb[2 * lane + 1] = b1; sg[2 * lane] = g0; sg[2 * lane + 1] = g1; spm[2 * lane] = p0; spm[2 * lane + 1] = p1;
                    swi[2 * lane] = expf(mprev - fmaxf(p0, mprev)); swi[2 * lane + 1] = expf(mprev - fmaxf(p1, mprev));
                } else if (wave == 1) { snp[lane] = mn[(size_t)sidx * MD + lane]; snp[lane + 64] = mn[(size_t)sidx * MD + lane + 64]; }
                {
                    const int cg = tid & 15, d0 = cg * 8;
#pragma unroll 1
                    for (int which = 0; which < 2; ++which) {
                        const int chn = which * 512 + h * MD + d0;
                        float cw[32], cb_[8];
#pragma unroll
                        for (int w = 0; w < 4; ++w)
#pragma unroll
                            for (int i = 0; i < 8; ++i) cw[w * 8 + i] = P.conv_w[w * 1024 + chn + i];
#pragma unroll
                        for (int i = 0; i < 8; ++i) cb_[i] = P.conv_b[chn + i];
                        LAS unsigned char* dst = which ? Kt : Qt; const float sc = which ? 0.08838834764831845f : 1.0f;
#pragma unroll
                        for (int i = 0; i < 4; ++i) {
                            const int c = (tid >> 4) + 32 * i; float o[8];
                            conv8(proj + (t0 + c) * NP + (which ? C_MK : C_MQ) + h * MD + d0, n * CH + c, cw, cb_, o);
                            v4u w; w.x = cvtpk(o[0] * sc, o[1] * sc); w.y = cvtpk(o[2] * sc, o[3] * sc); w.z = cvtpk(o[4] * sc, o[5] * sc); w.w = cvtpk(o[6] * sc, o[7] * sc);
                            *(LAS v4u*)(dst + toff<128>(c, cg)) = w;
                        }
                    }
                }
#pragma unroll
                for (int i = tid; i < CH * 16; i += NTHREADS) { const int row = i >> 4, ch = i & 15; *(LAS v4u*)(Vt + toff<128>(row, ch)) = *(const v4u*)(proj + (t0 + row) * NP + C_MV + h * MD + ch * 8); }
#pragma unroll
                for (int i = tid; i < MD * 16; i += NTHREADS) { const int d = i >> 4, ch = i & 15; const f4v* sp = (const f4v*)(mst + (size_t)sidx * (MD * MD) + d * MD + ch * 8);
                    const f4v a = sp[0], c2 = sp[1]; v4u w; w.x = cvtpk(a.x, a.y); w.y = cvtpk(a.z, a.w); w.z = cvtpk(c2.x, c2.y); w.w = cvtpk(c2.z, c2.w);
                    *(LAS v4u*)(Spt + toff<128>(d, ch)) = w; }
                __syncthreads();
                const int cb = wave >> 1, ep = wave & 1, r = lane & 31, hl = lane >> 5;
                f32x16 Z0 = zero16(), Z1 = zero16();
                {
                    const int c = cb * 32 + r;
                    const float nc = -fmaxf(spm[c], mprev); float den = 0.f;
                    for (int jb = 0; jb <= cb; ++jb) {
                        f32x16 X = zero16();
#pragma unroll
                        for (int s = 0; s < 8; ++s) X = MFMA32(frag_row<128>(Kt, jb * 32 + r, s, hl), frag_row<128>(Qt, cb * 32 + r, s, hl), X);
#pragma unroll
                        for (int reg = 0; reg < 16; ++reg) { const int j = jb * 32 + crow(reg, hl); X[reg] = j <= c ? X[reg] * __expf(nc + sg[j]) : 0.f; den += X[reg]; }
#pragma unroll
                        for (int s2 = 0; s2 < 2; ++s2) { const bf16x8 xs_ = pack_step(X, s2);
                            Z0 = MFMA32(xs_, frag_tr<128, true>(Vt, jb * 32 + 16 * s2, ep * 64, lane), Z0);
                            Z1 = MFMA32(xs_, frag_tr<128, true>(Vt, jb * 32 + 16 * s2, ep * 64 + 32, lane), Z1); }
                    }
                    den += __shfl_xor(den, 32);
                    if (ep == 0 && hl == 0) sden[c] = den;
                    f32x16 Y0 = zero16(), Y1 = zero16();
#pragma unroll
                    for (int s = 0; s < 8; ++s) { const bf16x8 qa = frag_row<128>(Qt, cb * 32 + r, s, hl);
                        Y0 = MFMA32(qa, frag_tr<128, false>(Spt, 16 * s, ep * 64, lane), Y0);
                        Y1 = MFMA32(qa, frag_tr<128, false>(Spt, 16 * s, ep * 64 + 32, lane), Y1); }
#pragma unroll
                    for (int reg = 0; reg < 16; ++reg) { const float wi = swi[cb * 32 + crow(reg, hl)]; Z0[reg] += wi * Y0[reg]; Z1[reg] += wi * Y1[reg]; }
                }
                __syncthreads();
#pragma unroll
                for (int reg = 0; reg < 16; ++reg) { const int cc = cb * 32 + crow(reg, hl); Zs[cc * 132 + ep * 64 + r] = Z0[reg]; Zs[cc * 132 + ep * 64 + 32 + r] = Z1[reg]; }
                __syncthreads();
                {
                    const int c = tid >> 2, qd = tid & 3, e0 = qd * 32; const size_t t = t0 + c;
                    float qn = 0.f;
#pragma unroll
                    for (int i = 0; i < 4; ++i) { const v4u qv = *(const LAS v4u*)(Qt + toff<128>(c, 4 * qd + i)); const LAS float* np_ = snp + 32 * qd + 8 * i;
                        qn += blo(qv.x) * np_[0] + bhi(qv.x) * np_[1] + blo(qv.y) * np_[2] + bhi(qv.y) * np_[3] + blo(qv.z) * np_[4] + bhi(qv.z) * np_[5] + blo(qv.w) * np_[6] + bhi(qv.w) * np_[7]; }
                    qn += __shfl_xor(qn, 1); qn += __shfl_xor(qn, 2);
                    const float M = fmaxf(spm[c], mprev), mrow = sb[c] + M;
                    const float den = sden[c] + swi[c] * qn;
                    const float inv = 1.0f / fmaxf(fabsf(den), expf(-mrow));
                    float z[32]; float ss = 0.f;
#pragma unroll
                    for (int i = 0; i < 8; ++i) { const f4v v = *(const LAS f4v*)(Zs + c * 132 + e0 + 4 * i); z[4 * i] = v.x; z[4 * i + 1] = v.y; z[4 * i + 2] = v.z; z[4 * i + 3] = v.w; }
                    const bf16_t* op = proj + t * NP + C_MO + h * MD + e0;
#pragma unroll
                    for (int i = 0; i < 4; ++i) { const v4u ov = *(const v4u*)(op + 8 * i);
                        const float oo[8] = {blo(ov.x), bhi(ov.x), blo(ov.y), bhi(ov.y), blo(ov.z), bhi(ov.z), blo(ov.w), bhi(ov.w)};
#pragma unroll
                        for (int k = 0; k < 8; ++k) { const float v = sigmoidf_(oo[k]) * z[8 * i + k] * inv; z[8 * i + k] = v; ss += v * v; } }
                    ss += __shfl_xor(ss, 1); ss += __shfl_xor(ss, 2);
                    const float rn = 1.0f / sqrtf(ss * (1.0f / MD) + EPS);
                    bf16_t* yp = yreg + t * D + 512 + h * MD + e0; const float* gn = P.ml_gn + h * MD + e0;
#pragma unroll
                    for (int i = 0; i < 4; ++i) { v4u w; w.x = cvtpk(z[8 * i] * rn * gn[8 * i], z[8 * i + 1] * rn * gn[8 * i + 1]); w.y = cvtpk(z[8 * i + 2] * rn * gn[8 * i + 2], z[8 * i + 3] * rn * gn[8 * i + 3]);
                        w.z = cvtpk(z[8 * i + 4] * rn * gn[8 * i + 4], z[8 * i + 5] * rn * gn[8 * i + 5]); w.w = cvtpk(z[8 * i + 6] * rn * gn[8 * i + 6], z[8 * i + 7] * rn * gn[8 * i + 7]);
                        *(v4u*)(yp + 8 * i) = w; }
                }
            }
        }
        __syncthreads();
    }
    GRID_BAR(4);
    if constexpr (IN(5)) {
        PH_IDS
        pg8::Gemm g{yreg, wout_t, T, D, D}; pg8::StaticOrder S; S.init(T, D, G, bid);
        pg8::EpiRes E{P.x, out, (bf16_t*)(ws + WS_HB)};
        pg8::gemm_phase<pg8::EpiRes, pg8::StaticOrder, true, true>(ldsl, g, S, E);
    }
    GRID_BAR(5);
    if constexpr (IN(6)) {
        PH_IDS
        LAS float* Wl = (LAS float*)ldsl;
        LAS float* Ls = (LAS float*)(ldsl + 106496);
        LAS int* lcnt = (LAS int*)(ldsl + 131584); LAS int* lbase = lcnt + 32;
        for (int idx = tid; idx < 512 * 16; idx += NTHREADS) Wl[(idx >> 4) * 52 + 36 + (idx & 15)] = 0.f;
        for (int unit = bid; unit < T / 128; unit += G) {
            const int tok0 = unit * 128 + wave * 16, row = lane & 15, kq = lane >> 4;
            const float* ap = out + (size_t)(tok0 + row) * D + 4 * kq;
            pg8::f32x4 c0 = {0.f, 0.f, 0.f, 0.f}, c1 = c0, c2 = c0; float ss = 0.f;
            if (tid < 32) lcnt[tid] = 0;
#pragma unroll 1
            for (int kh = 0; kh < 2; ++kh) {
                __syncthreads();
                for (int idx = tid; idx < 512 * 36; idx += NTHREADS) { const int kl = idx / 36, j = idx - kl * 36, k = kh * 512 + kl;
                    const float w = j < 4 ? P.w_group[k * 4 + j] : P.w_router[k * 32 + j - 4];
                    Wl[kl * 52 + j] = w * P.moe_norm[k]; }
                __syncthreads();
#pragma unroll 4
                for (int st = 0; st < 32; ++st) {
                    const f4v a = *(const f4v*)(ap + kh * 512 + st * 16);
                    ss += (a.x * a.x + a.y * a.y) + (a.z * a.z + a.w * a.w);
                    const LAS float* wb = Wl + (st * 16 + 4 * kq) * 52 + row;
                    c0 = __builtin_amdgcn_mfma_f32_16x16x4f32(a.x, wb[0], c0, 0, 0, 0); c1 = __builtin_amdgcn_mfma_f32_16x16x4f32(a.x, wb[16], c1, 0, 0, 0); c2 = __builtin_amdgcn_mfma_f32_16x16x4f32(a.x, wb[32], c2, 0, 0, 0);
                    c0 = __builtin_amdgcn_mfma_f32_16x16x4f32(a.y, wb[52], c0, 0, 0, 0); c1 = __builtin_amdgcn_mfma_f32_16x16x4f32(a.y, wb[68], c1, 0, 0, 0); c2 = __builtin_amdgcn_mfma_f32_16x16x4f32(a.y, wb[84], c2, 0, 0, 0);
                    c0 = __builtin_amdgcn_mfma_f32_16x16x4f32(a.z, wb[104], c0, 0, 0, 0); c1 = __builtin_amdgcn_mfma_f32_16x16x4f32(a.z, wb[120], c1, 0, 0, 0); c2 = __builtin_amdgcn_mfma_f32_16x16x4f32(a.z, wb[136], c2, 0, 0, 0);
                    c0 = __builtin_amdgcn_mfma_f32_16x16x4f32(a.w, wb[156], c0, 0, 0, 0); c1 = __builtin_amdgcn_mfma_f32_16x16x4f32(a.w, wb[172], c1, 0, 0, 0); c2 = __builtin_amdgcn_mfma_f32_16x16x4f32(a.w, wb[188], c2, 0, 0, 0);
                }
            }
            ss += __shfl_xor(ss, 16); ss += __shfl_xor(ss, 32);
            const float rstd = 1.0f / sqrtf(ss * (1.0f / D) + EPS);
#pragma unroll
            for (int reg = 0; reg < 4; ++reg) { LAS float* lp = Ls + (wave * 16 + 4 * kq + reg) * 49 + row; lp[0] = c0[reg]; lp[16] = c1[reg]; lp[32] = c2[reg]; }
            __syncthreads();
            const int tok = tok0 + row;
            const LAS float* lp = Ls + (wave * 16 + row) * 49;
            float gl[4];
#pragma unroll
            for (int i = 0; i < 4; ++i) gl[i] = lp[i] * rstd + P.b_group[i];
            int gs = 0; float gmax = gl[0];
#pragma unroll
            for (int i = 1; i < 4; ++i) if (gl[i] > gmax) { gmax = gl[i]; gs = i; }
            float gsum = 0.f;
#pragma unroll
            for (int i = 0; i < 4; ++i) gsum += expf(gl[i] - gmax);
            const float pg = 1.0f / gsum;
            float el[8];
#pragma unroll
            for (int i = 0; i < 8; ++i) el[i] = lp[4 + gs * 8 + i] * rstd + P.b_router[gs * 8 + i];
            int i0 = 0; float l0 = el[0];
#pragma unroll
            for (int i = 1; i < 8; ++i) if (el[i] > l0) { l0 = el[i]; i0 = i; }
            int i1 = -1; float l1 = -INFINITY;
#pragma unroll
            for (int i = 0; i < 8; ++i) if (i != i0 && el[i] > l1) { l1 = el[i]; i1 = i; }
            const float rr = expf(l1 - l0);
            const float g0 = pg / (1.0f + rr), g1 = pg * rr / (1.0f + rr);
            const int e0 = gs * 8 + i0, e1 = gs * 8 + i1;
            int lp0 = 0, lp1 = 0;
            if (lane < 16) { lp0 = __hip_atomic_fetch_add(&lcnt[e0], 1, __ATOMIC_RELAXED, __HIP_MEMORY_SCOPE_WORKGROUP); lp1 = __hip_atomic_fetch_add(&lcnt[e1], 1, __ATOMIC_RELAXED, __HIP_MEMORY_SCOPE_WORKGROUP); }
            __syncthreads();
            if (tid < 32) { const int c = lcnt[tid]; lbase[tid] = c ? atomicAdd(&cnt[tid], c) : 0; }
            __syncthreads();
            if (lane < 16) {
                const int p0 = lbase[e0] + lp0, p1 = lbase[e1] + lp1;
                list[(size_t)e0 * T + p0] = tok; list[(size_t)e1 * T + p1] = tok;
                *(int2*)(eid + tok * 2) = make_int2(e0, e1); *(int2*)(posn + tok * 2) = make_int2(p0, p1);
                *(float2*)(gate + tok * 2) = make_float2(g0, g1);
                rstd1[tok] = rstd;
            }
        }
        __syncthreads();
    }
    GRID_BAR(6);
    if constexpr (IN(7) || IN(8) || IN(9) || IN(11)) {
        PH_IDS
        __syncthreads();
        if (tid == 0) { int o = 0; for (int e = 0; e < NE; ++e) { const int c = cnt[e]; s_cnt[e] = c; s_off[e] = o; const int nt = (c + 255) >> 8; for (int i = 0; i < nt; ++i) s_t2e[(o >> 8) + i] = e; o += nt << 8; } s_off[NE] = o; }
        __syncthreads();
    }
    if constexpr (IN(7)) {
        PH_IDS
        const int NS = s_off[NE];
        const bf16_t* hb = (const bf16_t*)(ws + WS_HB); float* slotr = (float*)(ws + WS_SLOTR);
        for (int s = gw; s < NS; s += NGW) {
            const int e = s_t2e[s >> 8], i = s - s_off[e];
            v4u a = {0u, 0u, 0u, 0u}, b2 = {0u, 0u, 0u, 0u}; float rs = 0.f;
            if (i < s_cnt[e]) { const int tok = list[(size_t)e * T + i]; const v4u* src = (const v4u*)(hb + (size_t)tok * D); a = src[lane]; b2 = src[lane + 64]; rs = rstd1[tok]; }
            v4u* dst = (v4u*)(xs + (size_t)s * D); dst[lane] = a; dst[lane + 64] = b2;
            if (lane == 0) slotr[s] = rs;
        }
    }
    GRID_BAR(7);
    if constexpr (IN(8)) {
        PH_IDS
        const int NS = s_off[NE];
        pg8::Gemm g{xs, w13_t, NS, NE * 1024, D}; pg8::GroupedOrder S; S.init(NS >> 8, G, bid, (const LAS int*)s_t2e);
        pg8::EpiSwiglu E{hbuf, (const float*)(ws + WS_SLOTR)};
        pg8::gemm_phase<pg8::EpiSwiglu, pg8::GroupedOrder, true, true>(ldsl, g, S, E);
    }
    GRID_BAR(8);
    if constexpr (IN(9)) {
        PH_IDS
        const int NS = s_off[NE];
        pg8::Gemm g{hbuf, w2_t, NS, NE * 1024, DE}; pg8::GroupedOrder S; S.init(NS >> 8, G, bid, (const LAS int*)s_t2e);
        pg8::EpiStoreBf16 E{ybuf, D, 3, nullptr};
        pg8::gemm_phase<pg8::EpiStoreBf16, pg8::GroupedOrder, true, true>(ldsl, g, S, E);
    }
    GRID_BAR(9);
    if constexpr (IN(10)) {
        PH_IDS
        pg8::Gemm g{pb, wup_t, T, D, PLE}; pg8::StaticOrder S; S.init(T, D, G, bid);
        pg8::EpiStoreBf16 E{peb, D, 0xffff, part};
        pg8::gemm_phase<pg8::EpiStoreBf16, pg8::StaticOrder, true, true>(ldsl, g, S, E);
    }
    GRID_BAR(10);
    if constexpr (IN(11)) {
        PH_IDS
        for (int row = gw; row < T; row += NGW) {
            const int s0 = s_off[eid[row * 2]] + posn[row * 2], s1 = s_off[eid[row * 2 + 1]] + posn[row * 2 + 1];
            const float g0 = gate[row * 2], g1 = gate[row * 2 + 1];
            float ss = 0.f;
#pragma unroll
            for (int j = 0; j < 4; ++j) {
                const int k0 = 4 * (lane + 64 * j);
                float4 hv = *(const float4*)(out + (size_t)row * D + k0);
                float y0[4], y1[4]; load4(ybuf + (size_t)s0 * D + k0, y0); load4(ybuf + (size_t)s1 * D + k0, y1);
                hv.x += g0 * y0[0] + g1 * y1[0]; hv.y += g0 * y0[1] + g1 * y1[1]; hv.z += g0 * y0[2] + g1 * y1[2]; hv.w += g0 * y0[3] + g1 * y1[3];
                *(float4*)(out + (size_t)row * D + k0) = hv;
                ss += hv.x * hv.x + hv.y * hv.y + hv.z * hv.z + hv.w * hv.w;
                uint2 o; o.x = pk2(hv.x, hv.y); o.y = pk2(hv.z, hv.w);
                *(uint2*)(yreg + (size_t)row * D + k0) = o;
            }
            ss = wave_sum(ss);
            float pe = lane < 16 ? part[(size_t)row * 16 + lane] : 0.f;
            pe = wave_sum(pe);
            if (lane == 0) { rstdg[row] = 1.0f / sqrtf(ss * (1.0f / D) + EPS); rstde[row] = 1.0f / sqrtf(pe * (1.0f / D) + EPS); }
        }
    }
    GRID_BAR(11);
    if constexpr (IN(12)) {
        PH_IDS
        pg8::Gemm g{yreg, wgate_t, T, D, D}; pg8::StaticOrder S; S.init(T, D, G, bid);
        pg8::EpiGate E{out, peb, rstdg, rstde, P.ple_norm, part2};
        pg8::gemm_phase<pg8::EpiGate, pg8::StaticOrder, true, true>(ldsl, g, S, E);
    }
    GRID_BAR(12);
    if constexpr (IN(13)) {
        PH_IDS
        for (int row = gw; row < T; row += NGW) {
            float4* hr = (float4*)(out + (size_t)row * D) + lane;
            float4 v[4];
#pragma unroll
            for (int j = 0; j < 4; ++j) v[j] = hr[64 * j];
            float ss = lane < 16 ? part2[(size_t)row * 16 + lane] : 0.f;
            ss = wave_sum(ss);
            const float rstd = 1.0f / sqrtf(ss * (1.0f / D) + EPS);
#pragma unroll
            for (int j = 0; j < 4; ++j) {
                const float4 nv = *(const float4*)(P.final_norm + 4 * (lane + 64 * j));
                float4 o; o.x = v[j].x * rstd * nv.x; o.y = v[j].y * rstd * nv.y; o.z = v[j].z * rstd * nv.z; o.w = v[j].w * rstd * nv.w;
                hr[64 * j] = o;
            }
        }
    }
#undef GRID_BAR
#undef PH_IDS
#undef IN
#undef rstd1
#undef gates
#undef rstdg
#undef rstde
#undef eid
#undef posn
#undef gate
#undef mn
#undef ml
#undef mbl
#undef mm
#undef list
#undef cnt
#undef part
#undef part2
#undef win_t
#undef wout_t
#undef w13_t
#undef w2_t
#undef wgate_t
#undef wup_t
#undef proj
#undef hbuf
#undef xs
#undef ybuf
#undef peb
#undef yreg
#undef pb
#undef rst
#undef mst
}

template <int PH> static void launch_one(int grid, const Params& p, hipStream_t stream) {
    static bool attr_done = false;
    if (!attr_done) { (void)hipFuncSetAttribute((const void*)mk<PH, PH + 1>, hipFuncAttributeMaxDynamicSharedMemorySize, LDS_BYTES); attr_done = true; }
    hipLaunchKernelGGL((mk<PH, PH + 1>), dim3(grid), dim3(NTHREADS), LDS_BYTES, stream, p);
}
template <int PH> static void launch_all(int grid, const Params& p, hipStream_t stream) {
    if constexpr (PH < NPHASES) { launch_one<PH>(grid, p, stream); launch_all<PH + 1>(grid, p, stream); }
}
#ifndef MK_N_LAUNCHES
#define MK_N_LAUNCHES 1
#endif

extern "C" void kernel_launch(void* const* d_in, const int* in_sizes, int n_in, void* d_out, int out_size, void* d_ws, size_t ws_size, hipStream_t stream) {
    static int grid = 0;
    if (grid == 0) {
        if (n_in != 25 || in_sizes[0] != T * D || out_size != T * D || ws_size < WS_END) {
            fprintf(stderr, "kernel_launch: unexpected shapes: n_in %d in0 %d out %d ws %zu\n", n_in, n_in > 0 ? in_sizes[0] : -1, out_size, ws_size); grid = -1; return; }
        int dev = 0, cus = 0;
        (void)hipGetDevice(&dev); (void)hipDeviceGetAttribute(&cus, hipDeviceAttributeMultiprocessorCount, dev);
        (void)hipGetLastError();
        grid = cus;
        if (MK_N_LAUNCHES == 1) {
            int per_cu = 0;
            if (hipFuncSetAttribute((const void*)mk<0, NPHASES>, hipFuncAttributeMaxDynamicSharedMemorySize, LDS_BYTES) != hipSuccess) { fprintf(stderr, "kernel_launch: hipFuncSetAttribute failed\n"); grid = -1; return; }
            if (hipOccupancyMaxActiveBlocksPerMultiprocessor(&per_cu, (const void*)mk<0, NPHASES>, NTHREADS, LDS_BYTES) != hipSuccess || per_cu < 1) { fprintf(stderr, "kernel_launch: occupancy query reports %d workgroups per CU; the grid barrier needs one resident workgroup per CU; nothing launched\n", per_cu); grid = -1; return; }
            (void)hipGetLastError();
        }
    }
    if (grid < 0) return;
    (void)hipMemsetAsync((char*)d_ws + WS_CTL, 0, 1 * MiB, stream);
    Params p{};
    p.x = (const float*)d_in[0]; p.p = (const float*)d_in[1]; p.pos = (const int*)d_in[2];
    p.attn_norm = (const float*)d_in[3]; p.w_in = (const float*)d_in[4]; p.conv_w = (const float*)d_in[5]; p.conv_b = (const float*)d_in[6];
    p.b_ig = (const float*)d_in[7]; p.b_fg = (const float*)d_in[8]; p.ret_gn = (const float*)d_in[9]; p.ml_gn = (const float*)d_in[10];
    p.w_out = (const float*)d_in[11]; p.moe_norm = (const float*)d_in[12]; p.w_group = (const float*)d_in[13]; p.b_group = (const float*)d_in[14];
    p.w_router = (const float*)d_in[15]; p.b_router = (const float*)d_in[16]; p.w1 = (const float*)d_in[17]; p.w3 = (const float*)d_in[18]; p.w2 = (const float*)d_in[19];
    p.w_up = (const float*)d_in[20]; p.ple_norm = (const float*)d_in[21]; p.pg_norm = (const float*)d_in[22]; p.w_gate = (const float*)d_in[23]; p.final_norm = (const float*)d_in[24];
    p.out = (float*)d_out; p.ws = (unsigned char*)d_ws;
    if (MK_N_LAUNCHES == 1) hipLaunchKernelGGL((mk<0, NPHASES>), dim3(grid), dim3(NTHREADS), LDS_BYTES, stream, p);
    else launch_all<0>(grid, p, stream);
}
```

```cpp
#include <hip/hip_runtime.h>
#include <cstdio>
#include <cstdint>

constexpr int D = 1024, BATCH = 4, SEQ = 8192, T = BATCH * SEQ, PLE = 256;
constexpr int NPROJ = 4104, NP = 4096;
constexpr int CH = 128, NCH = SEQ / CH;
constexpr int RH = 8, RD = 64, MH = 4, MD = 128;
constexpr int NE = 32, DE = 512;
constexpr float EPS = 1e-6f;
constexpr int C_RQ = 0, C_RK = 512, C_RV = 1024, C_RG = 1536, C_MQ = 2048, C_MK = 2560, C_MV = 3072, C_MO = 3584;

constexpr size_t MiB = 1u << 20;
constexpr size_t WS_CTL = 0;
constexpr size_t WS_RSTD1 = 1 * MiB;
constexpr size_t WS_GATES = WS_RSTD1 + 256 * 1024;
constexpr size_t WS_SLOTR = 2560 * 1024;
constexpr size_t WS_RSTDG = 3 * MiB;
constexpr size_t WS_RSTDE = WS_RSTDG + 256 * 1024;
constexpr size_t WS_EID = 4 * MiB;
constexpr size_t WS_POS = WS_EID + 256 * 1024;
constexpr size_t WS_GATE = WS_POS + 256 * 1024;
constexpr size_t WS_MN = 5 * MiB;
constexpr size_t WS_ML = WS_MN + 512 * 1024;
constexpr size_t WS_MBL = WS_ML + 4096;
constexpr size_t WS_MM = WS_MBL + 4096;
constexpr size_t WS_WR = 6 * MiB;
constexpr size_t WS_LIST = 8 * MiB;
constexpr size_t WS_PART = 12 * MiB;
constexpr size_t WS_PART2 = 14 * MiB;
constexpr size_t WS_WIN = 16 * MiB;
constexpr size_t WS_WOUT = 24 * MiB;
constexpr size_t WS_W13 = 26 * MiB;
constexpr size_t WS_W2 = 90 * MiB;
constexpr size_t WS_WGATE = 122 * MiB;
constexpr size_t WS_WUP = 124 * MiB;
constexpr size_t WS_PROJ = 128 * MiB;
constexpr size_t WS_HBUF = 128 * MiB;
constexpr size_t WS_XS = 200 * MiB;
constexpr size_t WS_YBUF = 200 * MiB;
constexpr size_t WS_A2 = 128 * MiB;
constexpr size_t WS_H3B = 200 * MiB;
constexpr size_t WS_PEB = 344 * MiB;
constexpr size_t WS_YREG = 384 * MiB;
constexpr size_t WS_PB = 448 * MiB;
constexpr size_t WS_CS = 464 * MiB;
constexpr size_t WS_RSTB = 472 * MiB;
constexpr size_t WS_END = 488 * MiB;
constexpr size_t OUT_RST = 0;
constexpr size_t OUT_MST = 32 * MiB;
constexpr size_t OUT_HB = 0;
constexpr size_t OUT_MSTB = 96 * MiB;
constexpr int CW_CNT = 64;
constexpr int CW_BAR = 4096;

constexpr int NTHREADS = 512, NWAVES = 8;
constexpr int RING_BYTES = 131072;
constexpr int LDSX_OFF = 143360;
constexpr int LDS_BYTES = 147456;

__host__ __device__ __forceinline__ size_t pix(size_t t, int col) {
    const size_t bn = t >> 7; const int r = (int)(t & 127);
    return bn * (size_t)(CH * NP) + (col < 2048 ? (size_t)((col >> 6) * (CH * 64) + r * 64 + (col & 63)) : (size_t)(CH * 2048 + ((col - 2048) >> 7) * (CH * 128) + r * 128 + (col & 127)));
}
#define GAS __attribute__((address_space(1)))
#define LAS __attribute__((address_space(3)))
typedef unsigned short bf16_t;
typedef unsigned v4u __attribute__((ext_vector_type(4)));
typedef unsigned v2u __attribute__((ext_vector_type(2)));
__device__ __forceinline__ float bf2f(bf16_t h) { return __uint_as_float((unsigned)h << 16); }
__device__ __forceinline__ unsigned f2bf(float f) { unsigned u = __float_as_uint(f); return (u + 0x7fffu + ((u >> 16) & 1u)) >> 16; }
__device__ __forceinline__ unsigned pk2(float lo, float hi) { return f2bf(lo) | (f2bf(hi) << 16); }
__device__ __forceinline__ float wave_sum(float v) {
#pragma unroll
    for (int o = 1; o < 64; o <<= 1) v += __shfl_xor(v, o);
    return v;
}
__device__ __forceinline__ float sigmoidf_(float x) { return 1.0f / (1.0f + expf(-x)); }
__device__ __forceinline__ float siluf_(float x) { return x / (1.0f + expf(-x)); }
__device__ __forceinline__ float logsigmoidf_(float x) { return x >= 0.f ? -log1pf(expf(-x)) : x - log1pf(expf(x)); }
#define LDS_WAIT() asm volatile("s_waitcnt lgkmcnt(0)" ::: "memory")

namespace pg8 {
#define PG8_LAS __attribute__((address_space(3)))
typedef unsigned short bf16_t;
typedef short bf16x8 __attribute__((ext_vector_type(8)));
typedef float f32x4 __attribute__((ext_vector_type(4)));
typedef unsigned u32x4 __attribute__((ext_vector_type(4)));
constexpr int BM = 256, BK = 64, HALF = 128, HTB = HALF * BK * 2  , STAGE_BYTES = 8 * HTB, NXCD = 8, WGM = 8;

__host__ __device__ __forceinline__ int lds_byte(int r, int c) { const int st = (r >> 4) * 2 + (c >> 5), rr = r & 15, cc = c & 31, ob = rr * 64 + cc * 2; return st * 1024 + (ob ^ (((ob >> 9) & 1) << 5)); }
__host__ __device__ __forceinline__ void stage_rc(int b, int& R, int& C) { const int st = b / 1024, sb = b % 1024, swz = sb ^ (((sb >> 9) & 1) << 5); R = (st >> 1) * 16 + swz / 64; C = (st & 1) * 32 + (swz % 64) / 2; }
__host__ __device__ __forceinline__ int perm32(int rho) { const int n = rho >> 4, i = rho & 15; return 8 * (i >> 2) + 4 * n + (i & 3); }

struct Unit { int pm, pn, ord; };
struct Gemm { const bf16_t* A; const bf16_t* Bt; int M, N, K; const PG8_LAS int* gtok; };

struct StaticOrder {
    int nM, nN, nwg, G, c;
    __host__ __device__ __forceinline__ void init(int M, int N, int G_, int c_) { nM = M / BM; nN = N / BM; nwg = nM * nN; G = G_; c = c_; }
    __host__ __device__ __forceinline__ bool next(int i, Unit& u) const {
        const long L = (long)i * G + c; if (L >= nwg) return false;
        int wgid = (int)L; { const int q = nwg / NXCD, r = nwg % NXCD, xcd = wgid % NXCD, off = wgid / NXCD; wgid = (xcd < r ? xcd * (q + 1) : r * (q + 1) + (xcd - r) * q) + off; }
        const int nig = WGM * nN, gid = wgid / nig, fm = gid * WGM, gsz = (nM - fm) < WGM ? (nM - fm) : WGM;
        u.pm = fm + ((wgid % nig) % gsz); u.pn = (wgid % nig) / gsz; u.ord = i; return true;
    }
    __device__ __forceinline__ void a_ready(const Unit&) const {}
    __device__ __forceinline__ void done(const Unit&) const {}
};

__device__ __forceinline__ unsigned cvt_pk_bf16(float lo, float hi) { unsigned r; asm volatile("v_cvt_pk_bf16_f32 %0, %1, %2" : "=v"(r) : "v"(lo), "v"(hi)); return r; }
typedef float f32x2 __attribute__((ext_vector_type(2)));
struct GroupedOrder {
    int nM, nwg, G, c; const PG8_LAS int* t2e;
    __device__ __forceinline__ void init(int nM_, int G_, int c_, const PG8_LAS int* t2e_) { nM = nM_; nwg = nM_ * 4; G = G_; c = c_; t2e = t2e_; }
    __device__ __forceinline__ bool next(int i, Unit& u) const {
        const long L = (long)i * G + c; if (L >= nwg) return false;
        int wgid = (int)L; { const int q = nwg / NXCD, r = nwg % NXCD, xcd = wgid % NXCD, off = wgid / NXCD; wgid = (xcd < r ? xcd * (q + 1) : r * (q + 1) + (xcd - r) * q) + off; }
        const int nig = WGM * 4, gid = wgid / nig, fm = gid * WGM, gsz = (nM - fm) < WGM ? (nM - fm) : WGM;
        u.pm = fm + ((wgid % nig) % gsz); u.pn = (wgid % nig) / gsz + 4 * t2e[u.pm]; u.ord = i; return true;
    }
    __device__ __forceinline__ void a_ready(const Unit&) const {}
    __device__ __forceinline__ void done(const Unit&) const {}
};
struct SkewOrder {
    int nunits, stride, j;
    __device__ __forceinline__ void init(int nunits_, int G_, int c_, int skip_) { if (skip_ >= G_) skip_ = 0; nunits = nunits_; stride = G_ - skip_; j = c_ - skip_; }
    __device__ __forceinline__ bool next(int i, Unit& u) const { if (j < 0) return false; const int idx = j + i * stride; if (idx >= nunits) return false; u.pm = idx >> 2; u.pn = idx & 3; u.ord = i; return true; }
    __device__ __forceinline__ void a_ready(const Unit&) const {}
    __device__ __forceinline__ void done(const Unit&) const {}
};
__device__ __forceinline__ float fast_sigmoid(float x) { return __builtin_amdgcn_rcpf(1.0f + __builtin_amdgcn_exp2f(-1.4426950408889634f * x)); }
struct EpiStoreBf16 {
    static constexpr bool PERM = true, AFTER_DRAIN = false;
    bf16_t* O; int ldc; int pn_mask; float* part; int blocked;
    __device__ __forceinline__ void operator()(const f32x4 (&acc)[2][2][4][2], const Unit& u, int wr, int wc, int fr, int fq) const {
        const int pnl = u.pn & pn_mask; const int row0 = u.pm * BM + wr * 64 + fr, col0 = pnl * BM + wc * 32 + 8 * fq;
#pragma unroll
        for (int ai = 0; ai < 2; ++ai)
#pragma unroll
            for (int m = 0; m < 4; ++m) { const int row = row0 + ai * HALF + m * 16; bf16_t* rowp = O + (size_t)row * ldc + col0; bf16_t* rowq = rowp + HALF;
                if (blocked) { rowp = O + pix((size_t)row, col0); rowq = O + pix((size_t)row, col0 + HALF); }
                float s = 0.f;
#pragma unroll
                for (int bj = 0; bj < 2; ++bj) { const f32x4 v0 = acc[ai][bj][m][0], v1 = acc[ai][bj][m][1];
                    u32x4 w; w.x = cvt_pk_bf16(v0[0], v0[1]); w.y = cvt_pk_bf16(v0[2], v0[3]); w.z = cvt_pk_bf16(v1[0], v1[1]); w.w = cvt_pk_bf16(v1[2], v1[3]);
                    if (blocked) __builtin_nontemporal_store(w, (u32x4*)(bj ? rowq : rowp)); else *(u32x4*)(bj ? rowq : rowp) = w;
                    s += (v0[0] * v0[0] + v0[1] * v0[1]) + (v0[2] * v0[2] + v0[3] * v0[3]) + (v1[0] * v1[0] + v1[1] * v1[1]) + (v1[2] * v1[2] + v1[3] * v1[3]); }
                if (part) { s += __shfl_xor(s, 16); s += __shfl_xor(s, 32); if (fq == 0) part[(size_t)row * 16 + pnl * 4 + wc] = s; } }
    }
};
struct EpiSwiglu {
    static constexpr bool PERM = true, AFTER_DRAIN = false;
    bf16_t* H; const PG8_LAS float* rtab;
    __device__ __forceinline__ void operator()(const f32x4 (&acc)[2][2][4][2], const Unit& u, int wr, int wc, int fr, int fq) const {
        const int pnl = u.pn & 3; const int row0 = u.pm * BM + wr * 64 + fr, col0 = pnl * HALF + wc * 32 + 8 * fq;
#pragma unroll
        for (int ai = 0; ai < 2; ++ai)
#pragma unroll
            for (int m = 0; m < 4; ++m) { const int row = row0 + ai * HALF + m * 16; bf16_t* rowp = H + (size_t)row * 512 + col0; const float rs = rtab[u.ord * 256 + (row - u.pm * BM)];
                f32x4 h[2];
#pragma unroll
                for (int n = 0; n < 2; ++n) { const f32x4 a = acc[ai][0][m][n] * rs, b = acc[ai][1][m][n] * rs;
#pragma unroll
                    for (int j = 0; j < 4; ++j) h[n][j] = a[j] * fast_sigmoid(a[j]) * b[j]; }
                u32x4 w; w.x = cvt_pk_bf16(h[0][0], h[0][1]); w.y = cvt_pk_bf16(h[0][2], h[0][3]); w.z = cvt_pk_bf16(h[1][0], h[1][1]); w.w = cvt_pk_bf16(h[1][2], h[1][3]);
                *(u32x4*)rowp = w; }
    }
};
struct EpiRes {
    static constexpr bool PERM = true, AFTER_DRAIN = false;
    const float* base; bf16_t* hb;
    __device__ __forceinline__ void operator()(const f32x4 (&acc)[2][2][4][2], const Unit& u, int wr, int wc, int fr, int fq) const {
        const int row0 = u.pm * BM + wr * 64 + fr, col0 = u.pn * BM + wc * 32 + 8 * fq;
#pragma unroll
        for (int ai = 0; ai < 2; ++ai) {
            f32x4 xv[4][2][2];
#pragma unroll
            for (int m = 0; m < 4; ++m) { const size_t off = (size_t)(row0 + ai * HALF + m * 16) * 1024 + col0;
#pragma unroll
                for (int bj = 0; bj < 2; ++bj) { xv[m][bj][0] = __builtin_nontemporal_load((const f32x4*)(base + off + bj * HALF)); xv[m][bj][1] = __builtin_nontemporal_load((const f32x4*)(base + off + bj * HALF + 4)); } }
#pragma unroll
            for (int m = 0; m < 4; ++m) { const size_t off = (size_t)(row0 + ai * HALF + m * 16) * 1024 + col0;
#pragma unroll
                for (int bj = 0; bj < 2; ++bj) { const f32x4 v0 = xv[m][bj][0] + acc[ai][bj][m][0], v1 = xv[m][bj][1] + acc[ai][bj][m][1];
                    u32x4 w; w.x = cvt_pk_bf16(v0[0], v0[1]); w.y = cvt_pk_bf16(v0[2], v0[3]); w.z = cvt_pk_bf16(v1[0], v1[1]); w.w = cvt_pk_bf16(v1[2], v1[3]);
                    *(u32x4*)(hb + off + bj * HALF) = w; } }
            asm volatile("" ::: "memory");
        }
    }
};
struct EpiGate {
    static constexpr bool PERM = true, AFTER_DRAIN = false;
    bf16_t* h3; const bf16_t* a2; const bf16_t* peb; const float* rstdg; const float* rstde; const float* ple_norm; float* part;
    __device__ __forceinline__ void operator()(const f32x4 (&acc)[2][2][4][2], const Unit& u, int wr, int wc, int fr, int fq) const {
        const int row0 = u.pm * BM + wr * 64 + fr, col0 = u.pn * BM + wc * 32 + 8 * fq;
        f32x4 pn4[2][2];
#pragma unroll
        for (int bj = 0; bj < 2; ++bj)
#pragma unroll
            for (int n = 0; n < 2; ++n) pn4[bj][n] = *(const f32x4*)(ple_norm + col0 + bj * HALF + n * 4);
#pragma unroll
        for (int ap = 0; ap < 4; ++ap) { const int ai = ap >> 1, m0 = (ap & 1) * 2;
            u32x4 pev[4][2], hqv[4][2]; float rgv[4], rev[4];
#pragma unroll
            for (int m = m0; m < m0 + 2; ++m) { const int row = row0 + ai * HALF + m * 16; const size_t off = (size_t)row * 1024 + col0; rgv[m] = rstdg[row]; rev[m] = rstde[row];
#pragma unroll
                for (int bj = 0; bj < 2; ++bj) { pev[m][bj] = __builtin_nontemporal_load((const u32x4*)(peb + off + bj * HALF)); hqv[m][bj] = *(const u32x4*)(a2 + off + bj * HALF); } }
#pragma unroll
            for (int m = m0; m < m0 + 2; ++m) { const int row = row0 + ai * HALF + m * 16; const size_t off = (size_t)row * 1024 + col0; const float rg = rgv[m], re = rev[m]; float s = 0.f;
#pragma unroll
                for (int bj = 0; bj < 2; ++bj) { const size_t o = off + bj * HALF;
                    const u32x4 pe = pev[m][bj], hq = hqv[m][bj];
                    float hv[8];
#pragma unroll
                    for (int n = 0; n < 2; ++n) { const f32x4 a = acc[ai][bj][m][n]; const unsigned p0 = n ? pe.z : pe.x, p1 = n ? pe.w : pe.y, h0 = n ? hq.z : hq.x, h1 = n ? hq.w : hq.y;
                        const float e4[4] = {__uint_as_float(p0 << 16), __uint_as_float(p0 & 0xffff0000u), __uint_as_float(p1 << 16), __uint_as_float(p1 & 0xffff0000u)};
                        const float b4[4] = {__uint_as_float(h0 << 16), __uint_as_float(h0 & 0xffff0000u), __uint_as_float(h1 << 16), __uint_as_float(h1 & 0xffff0000u)};
#pragma unroll
                        for (int j = 0; j < 4; ++j) hv[4 * n + j] = b4[j] + fast_sigmoid(rg * a[j]) * (e4[j] * re * pn4[bj][n][j]); }
                    u32x4 w; w.x = cvt_pk_bf16(hv[0], hv[1]); w.y = cvt_pk_bf16(hv[2], hv[3]); w.z = cvt_pk_bf16(hv[4], hv[5]); w.w = cvt_pk_bf16(hv[6], hv[7]);
                    *(u32x4*)(h3 + o) = w;
                    const float r8[8] = {__uint_as_float(w.x << 16), __uint_as_float(w.x & 0xffff0000u), __uint_as_float(w.y << 16), __uint_as_float(w.y & 0xffff0000u), __uint_as_float(w.z << 16), __uint_as_float(w.z & 0xffff0000u), __uint_as_float(w.w << 16), __uint_as_float(w.w & 0xffff0000u)};
#pragma unroll
                    for (int j = 0; j < 8; ++j) s += r8[j] * r8[j]; }
                s += __shfl_xor(s, 16); s += __shfl_xor(s, 32); if (fq == 0) part[(size_t)row * 16 + u.pn * 4 + wc] = s; }
            asm volatile("" ::: "memory");
        }
    }
};

template <class Epi, class Sched, bool ALIGN_EPI = false, bool SP2 = false, bool GATHER = false>
__device__ __forceinline__ void gemm_phase(PG8_LAS unsigned char* lds, const Gemm g, const Sched& S, const Epi& E) {
    int tid_l = threadIdx.x; asm volatile("" : "+v"(tid_l));
    const int tid = tid_l, wid = __builtin_amdgcn_readfirstlane(tid >> 6), lane = tid & 63, wr = wid >> 2, wc = wid & 3, fr = lane & 15, fq = lane >> 4;
    const int K = g.K, nt = K / BK;
    unsigned voffA[2], voffB[2];
    int RAi[2]; unsigned CA2[2];
#pragma unroll
    for (int i = 0; i < 2; ++i) { int R, C; stage_rc(tid * 16 + i * 8192, R, C); const int Rb = Epi::PERM ? ((R & ~31) + perm32(R & 31)) : R;
        voffA[i] = (unsigned)(R * K + C) * 2u; voffB[i] = (unsigned)(Rb * K + C) * 2u; RAi[i] = R; CA2[i] = (unsigned)C * 2u; }
    unsigned gvc[2][2] = {{0u, 0u}, {0u, 0u}}, gvn[2][2] = {{0u, 0u}, {0u, 0u}};
#define PG8_GOFF(gv, ord_) do { _Pragma("unroll") for (int _h = 0; _h < 2; ++_h) _Pragma("unroll") for (int _i = 0; _i < 2; ++_i) \
        gv[_h][_i] = (unsigned)g.gtok[(ord_) * 256 + _h * HALF + RAi[_i]] * (unsigned)(K * 2) + CA2[_i]; } while (0)
    const size_t kstep = (size_t)(BK * 2);
    const size_t hstep = (size_t)HALF * K * 2;
    const size_t tstep = 2 * hstep;
    const unsigned ldsw = (unsigned)wid * 1024u;
    const int aoff = lds_byte(wr * 64 + fr, fq * 8), boff = lds_byte(wc * 32 + fr, fq * 8);
#define PG8_SA(b, h) (((b) * 2 + (h)) * HTB)
#define PG8_SB(b, h) ((4 + (b) * 2 + (h)) * HTB)
#define PG8_STAGE(bufoff, gbase, voff) do { _Pragma("unroll") for (int _i = 0; _i < 2; ++_i) \
        __builtin_amdgcn_global_load_lds((const unsigned*)((const char*)(gbase) + (voff)[_i]), (PG8_LAS unsigned*)(lds + (bufoff) + ldsw + _i * 8192), 16, 0, 0); } while (0)
#define PG8_STAGEA(bufoff, gbase, h, sel) do { _Pragma("unroll") for (int _i = 0; _i < 2; ++_i) { \
        const char* _p = GATHER ? (const char*)(gbase) + ((sel) ? gvn[h][_i] : gvc[h][_i]) : (const char*)(gbase) + (size_t)(h) * hstep + voffA[_i]; \
        __builtin_amdgcn_global_load_lds((const unsigned*)_p, (PG8_LAS unsigned*)(lds + (bufoff) + ldsw + _i * 8192), 16, 0, 0); } } while (0)
#define PG8_LDA(dst, b, h) do { _Pragma("unroll") for (int m = 0; m < 4; ++m) _Pragma("unroll") for (int k = 0; k < 2; ++k) dst[m][k] = *(const PG8_LAS bf16x8*)(lds + PG8_SA(b, h) + aoff + m * 2048 + k * 1024); } while (0)
#define PG8_LDB(dst, b, h) do { _Pragma("unroll") for (int n = 0; n < 2; ++n) _Pragma("unroll") for (int k = 0; k < 2; ++k) dst[n][k] = *(const PG8_LAS bf16x8*)(lds + PG8_SB(b, h) + boff + n * 2048 + k * 1024); } while (0)
#define PG8_MMA(ai, bj, At, Bt) do { __builtin_amdgcn_s_setprio(1); _Pragma("unroll") for (int m = 0; m < 4; ++m) _Pragma("unroll") for (int n = 0; n < 2; ++n) _Pragma("unroll") for (int k = 0; k < 2; ++k) \
        acc[ai][bj][m][n] = __builtin_amdgcn_mfma_f32_16x16x32_bf16(Bt[n][k], At[m][k], acc[ai][bj][m][n], 0, 0, 0); __builtin_amdgcn_s_setprio(0); } while (0)
#define PG8_WAIT_V(n) asm volatile("s_waitcnt vmcnt(" #n ")" ::: "memory")
#define PG8_WAIT_L(n) asm volatile("s_waitcnt lgkmcnt(" #n ")" ::: "memory")
#define PG8_BAR __builtin_amdgcn_s_barrier()
#define PG8_SCHED __builtin_amdgcn_sched_barrier(0)
    Unit cur, nxt; int ui = 0;
    if (!S.next(0, cur)) return;
    f32x4 acc[2][2][4][2];
#pragma unroll
    for (int a = 0; a < 2; ++a)
#pragma unroll
        for (int b = 0; b < 2; ++b)
#pragma unroll
            for (int m = 0; m < 4; ++m)
#pragma unroll
                for (int n = 0; n < 2; ++n) acc[a][b][m][n] = (f32x4){0.f, 0.f, 0.f, 0.f};
    bf16x8 At[4][2], B0[2][2], B1[2][2];
    const char* cA = GATHER ? (const char*)g.A : (const char*)g.A + (size_t)cur.pm * tstep; const char* cB = (const char*)g.Bt + (size_t)cur.pn * tstep;
    if constexpr (GATHER) PG8_GOFF(gvc, cur.ord);
    S.a_ready(cur);
    if constexpr (SP2) {
        PG8_STAGE(PG8_SB(0, 0), cB, voffB); PG8_STAGE(PG8_SB(0, 1), cB + hstep, voffB); PG8_STAGEA(PG8_SA(0, 0), cA, 0, false); PG8_STAGEA(PG8_SA(0, 1), cA, 1, false);
        if (wr == 1) PG8_BAR;
        PG8_WAIT_V(2); PG8_BAR;
        PG8_STAGE(PG8_SB(1, 0), cB + kstep, voffB); PG8_STAGEA(PG8_SA(1, 0), cA + kstep, 0, false); PG8_STAGE(PG8_SB(1, 1), cB + hstep + kstep, voffB);
        PG8_WAIT_V(6); PG8_BAR;
    } else {
        PG8_STAGE(PG8_SB(0, 0), cB, voffB); PG8_STAGEA(PG8_SA(0, 0), cA, 0, false); PG8_STAGE(PG8_SB(0, 1), cB + hstep, voffB); PG8_STAGEA(PG8_SA(0, 1), cA, 1, false);
        if (wr == 1) PG8_BAR;
        PG8_WAIT_V(4); PG8_BAR;
        PG8_STAGE(PG8_SB(1, 0), cB + kstep, voffB); PG8_STAGEA(PG8_SA(1, 0), cA + kstep, 0, false); PG8_STAGE(PG8_SB(1, 1), cB + hstep + kstep, voffB);
        PG8_WAIT_V(6); PG8_BAR;
    }
    for (;;) {
        const bool has_next = S.next(ui + 1, nxt);
        const char* nA = GATHER ? (const char*)g.A : (has_next ? (const char*)g.A + (size_t)nxt.pm * tstep : cA); const char* nB = has_next ? (const char*)g.Bt + (size_t)nxt.pn * tstep : cB;
        if constexpr (GATHER) { if (has_next) PG8_GOFF(gvn, nxt.ord); }
        for (int t = 0; t < nt; t += 2) {
            const bool last = (t == nt - 2); const bool seln = last && has_next; (void)seln;
            const char* a1 = cA + (size_t)(t + 1) * kstep;
            const char* a2 = last ? nA : cA + (size_t)(t + 2) * kstep; const char* b2 = last ? nB : cB + (size_t)(t + 2) * kstep;
            const char* a3 = a2 + kstep; const char* b3 = b2 + kstep;
            if (last && has_next) S.a_ready(nxt);
            if constexpr (SP2) {
            PG8_LDB(B0, 0, 0); PG8_LDB(B1, 0, 1); PG8_SCHED; PG8_LDA(At, 0, 0); PG8_STAGEA(PG8_SA(1, 1), a1, 1, false);
            PG8_WAIT_V(8); PG8_WAIT_L(0); PG8_BAR; PG8_MMA(0, 0, At, B0); PG8_MMA(0, 1, At, B1); PG8_BAR; PG8_SCHED;
            PG8_LDA(At, 0, 1); PG8_STAGE(PG8_SB(0, 0), b2, voffB); PG8_STAGE(PG8_SB(0, 1), b2 + hstep, voffB); PG8_STAGEA(PG8_SA(0, 0), a2, 0, seln);
            PG8_WAIT_V(8); PG8_WAIT_L(0); PG8_BAR; PG8_MMA(1, 0, At, B0); PG8_MMA(1, 1, At, B1); PG8_BAR; PG8_SCHED;
            PG8_LDB(B0, 1, 0); PG8_LDB(B1, 1, 1); PG8_SCHED; PG8_LDA(At, 1, 0); PG8_STAGEA(PG8_SA(0, 1), a2, 1, seln);
            PG8_WAIT_V(8); PG8_WAIT_L(0); PG8_BAR; PG8_MMA(0, 0, At, B0); PG8_MMA(0, 1, At, B1); PG8_BAR; PG8_SCHED;
            PG8_LDA(At, 1, 1); PG8_STAGE(PG8_SB(1, 0), b3, voffB); PG8_STAGE(PG8_SB(1, 1), b3 + hstep, voffB); PG8_STAGEA(PG8_SA(1, 0), a3, 0, seln);
            PG8_WAIT_V(8); PG8_WAIT_L(0); PG8_BAR; PG8_MMA(1, 0, At, B0); PG8_MMA(1, 1, At, B1); PG8_BAR; PG8_SCHED;
            } else {
            PG8_LDB(B0, 0, 0); PG8_SCHED; PG8_LDA(At, 0, 0); PG8_STAGEA(PG8_SA(1, 1), a1, 1, false);
            PG8_WAIT_L(8); PG8_BAR; PG8_WAIT_L(0); PG8_MMA(0, 0, At, B0); PG8_BAR; PG8_SCHED;
            PG8_LDB(B1, 0, 1); PG8_STAGE(PG8_SB(0, 0), b2, voffB);
            PG8_BAR; PG8_WAIT_L(0); PG8_MMA(0, 1, At, B1); PG8_BAR;
            PG8_LDA(At, 0, 1); PG8_STAGEA(PG8_SA(0, 0), a2, 0, seln);
            PG8_BAR; PG8_WAIT_L(0); PG8_MMA(1, 0, At, B0); PG8_BAR; PG8_SCHED;
            PG8_STAGE(PG8_SB(0, 1), b2 + hstep, voffB);
            PG8_WAIT_V(6); PG8_BAR; PG8_MMA(1, 1, At, B1); PG8_BAR;
            PG8_LDB(B0, 1, 0); PG8_SCHED; PG8_LDA(At, 1, 0); PG8_STAGEA(PG8_SA(0, 1), a2, 1, seln);
            PG8_WAIT_L(8); PG8_BAR; PG8_WAIT_L(0); PG8_MMA(0, 0, At, B0); PG8_BAR; PG8_SCHED;
            PG8_LDB(B1, 1, 1); PG8_STAGE(PG8_SB(1, 0), b3, voffB);
            PG8_BAR; PG8_WAIT_L(0); PG8_MMA(0, 1, At, B1); PG8_BAR;
            PG8_LDA(At, 1, 1); PG8_STAGEA(PG8_SA(1, 0), a3, 0, seln);
            PG8_BAR; PG8_WAIT_L(0); PG8_MMA(1, 0, At, B0); PG8_BAR; PG8_SCHED;
            PG8_STAGE(PG8_SB(1, 1), b3 + hstep, voffB);
            PG8_WAIT_V(6); PG8_BAR; PG8_MMA(1, 1, At, B1); PG8_BAR;
            }
        }
        if constexpr (ALIGN_EPI) { if (wr == 0) PG8_BAR; }
        if constexpr (!Epi::AFTER_DRAIN) { E(acc, cur, wr, wc, fr, fq); S.done(cur); }
        if (!has_next) break;
#pragma unroll
        for (int a = 0; a < 2; ++a)
#pragma unroll
            for (int b = 0; b < 2; ++b)
#pragma unroll
                for (int m = 0; m < 4; ++m)
#pragma unroll
                    for (int n = 0; n < 2; ++n) acc[a][b][m][n] = (f32x4){0.f, 0.f, 0.f, 0.f};
        cur = nxt; cA = nA; cB = nB; ++ui;
        if constexpr (GATHER) { gvc[0][0] = gvn[0][0]; gvc[0][1] = gvn[0][1]; gvc[1][0] = gvn[1][0]; gvc[1][1] = gvn[1][1]; }
        if constexpr (ALIGN_EPI) { if (wr == 1) PG8_BAR; }
    }
    PG8_WAIT_V(0);
    if constexpr (!ALIGN_EPI) { if (wr == 0) PG8_BAR; }
    PG8_BAR;
    if constexpr (Epi::AFTER_DRAIN) { E.fused(acc, cur, wr, wc, fr, fq, lds, wid, lane); S.done(cur); }
#undef PG8_SA
#undef PG8_SB
#undef PG8_STAGE
#undef PG8_STAGEA
#undef PG8_GOFF
#undef PG8_LDA
#undef PG8_LDB
#undef PG8_MMA
#undef PG8_WAIT_V
#undef PG8_WAIT_L
#undef PG8_BAR
#undef PG8_SCHED
}
}
#define XB_TMO      128
#define XB_XCNT(j)  (256  + 64 * (j))
#define XB_XSUB(j)  (1280 + 64 * (j))
#define XB_XGEN(j)  (2304 + 64 * (j))
#define XB_TOP      3328
#define XB_TOPGEN   3392
#define XCD_BAR_WORDS 3456
#define XB_SPIN_CAP (1u << 18)

__device__ __forceinline__ unsigned xb_ld(unsigned* p)              { return __hip_atomic_load(p, __ATOMIC_RELAXED, __HIP_MEMORY_SCOPE_AGENT); }
__device__ __forceinline__ unsigned xb_add(unsigned* p, unsigned v) { return __hip_atomic_fetch_add(p, v, __ATOMIC_RELAXED, __HIP_MEMORY_SCOPE_AGENT); }
__device__ __forceinline__ unsigned xb_xcc_id() { return (unsigned)__builtin_amdgcn_s_getreg((3 << 11) | 20) & 0xFu; }
#define XB_SPIN(cond, bar) do { unsigned _sp = 0; while (cond) { __builtin_amdgcn_s_sleep(1); \
    if ((++_sp & 255u) == 0u) { if (xb_ld(&(bar)[XB_TMO])) break; if (_sp > XB_SPIN_CAP) { atomicAdd(&(bar)[XB_TMO], 1u); break; } } } } while (0)

struct XcdBarrier {
    unsigned* bar; unsigned x;
    volatile LAS unsigned* st;
};

__device__ __forceinline__ XcdBarrier xcd_barrier_post(unsigned* bar, volatile LAS unsigned* st) {
    XcdBarrier b; b.bar = bar; b.x = xb_xcc_id(); b.st = st;
    if (threadIdx.x == 0) (void)xb_add(&bar[XB_XCNT(b.x)], 1u);
    return b;
}
__device__ __forceinline__ void xcd_barrier_complete(unsigned* bar, unsigned x, unsigned& nloc, unsigned& nx) {
    const unsigned G = gridDim.x * gridDim.y * gridDim.z;
    unsigned sum, cnt, mine, sp = 0u;
    for (;;) {
        sum = 0u; cnt = 0u; mine = 0u;
#pragma unroll
        for (unsigned j = 0; j < 16; ++j) { const unsigned c = xb_ld(&bar[XB_XCNT(j)]); sum += c; cnt += (c > 0u) ? 1u : 0u; mine = (j == x) ? c : mine; }
        if (sum == G) break;
        __builtin_amdgcn_s_sleep(1);
        if ((++sp & 255u) == 0u) { if (xb_ld(&bar[XB_TMO])) break; if (sp > XB_SPIN_CAP) { atomicAdd(&bar[XB_TMO], 1u); break; } }
    }
    nloc = mine > 0u ? mine : 1u; nx = cnt > 0u ? cnt : 1u;
}

__device__ __forceinline__ void xcd_barrier(const XcdBarrier& b) {
    asm volatile("s_waitcnt vmcnt(0)" ::: "memory");
    __syncthreads();
    if (threadIdx.x == 0) {
        unsigned* bar = b.bar;
        __builtin_amdgcn_s_waitcnt(0);
        unsigned nloc = b.st[0], nx = b.st[1];
        if (nloc == 0u) { xcd_barrier_complete(bar, b.x, nloc, nx); b.st[0] = nloc; b.st[1] = nx; }
        const unsigned old = xb_add(&bar[XB_XSUB(b.x)], 1u);
        const unsigned gen = old / nloc;
        if (old + 1u == (gen + 1u) * nloc) {
            __builtin_amdgcn_fence(__ATOMIC_RELEASE, "agent");
            asm volatile("s_waitcnt vmcnt(0)" ::: "memory");
            const unsigned og = xb_add(&bar[XB_TOP], 1u);
            const unsigned tg = og / nx;
            if (og + 1u == (tg + 1u) * nx) xb_add(&bar[XB_TOPGEN], 1u);
            else XB_SPIN(xb_ld(&bar[XB_TOPGEN]) == tg, bar);
            __builtin_amdgcn_fence(__ATOMIC_ACQUIRE, "agent");
            xb_add(&bar[XB_XGEN(b.x)], 1u);
            asm volatile("s_waitcnt vmcnt(0)" ::: "memory");
        } else {
            XB_SPIN(xb_ld(&bar[XB_XGEN(b.x)]) == gen, bar);
            __builtin_amdgcn_fence(__ATOMIC_ACQUIRE, "agent");
            asm volatile("s_waitcnt vmcnt(0)" ::: "memory");
        }
    }
    __syncthreads();
}
typedef short bf16x8 __attribute__((ext_vector_type(8)));
typedef short v4i16_t __attribute__((ext_vector_type(4)));
typedef float f32x16 __attribute__((ext_vector_type(16)));
typedef float f32x2_t __attribute__((ext_vector_type(2)));
typedef __bf16 bf16x2_t __attribute__((ext_vector_type(2)));
typedef float f4v __attribute__((ext_vector_type(4)));
__device__ __forceinline__ f32x16 MFMA32(const bf16x8 a, const bf16x8 b, const f32x16 c) { return __builtin_amdgcn_mfma_f32_32x32x16_bf16(a, b, c, 0, 0, 0); }
__device__ __forceinline__ unsigned cvtpk(float lo, float hi) { f32x2_t v = {lo, hi}; bf16x2_t b = __builtin_convertvector(v, bf16x2_t); return __builtin_bit_cast(unsigned, b); }
__device__ __forceinline__ int crow(int reg, int h) { return (reg & 3) + 8 * (reg >> 2) + 4 * h; }
__device__ __forceinline__ float blo(unsigned u) { return __uint_as_float(u << 16); }
__device__ __forceinline__ float bhi(unsigned u) { return __uint_as_float(u & 0xffff0000u); }
template <int W> __device__ __forceinline__ unsigned toff(unsigned row, unsigned ch) {
    if constexpr (W == 64) return row * 144u + ch * 16u;
    else return row * 272u + ch * 16u;
}
template <int W> __device__ __forceinline__ bf16x8 frag_row(const LAS unsigned char* tile, int R, int s, int h) { return *(const LAS bf16x8*)(tile + toff<W>(R, 2 * s + h)); }
template <int W, bool PERMK> __device__ __forceinline__ bf16x8 frag_tr(const LAS unsigned char* tile, int rbase, int cbase, int lane) {
    const int h = lane >> 5, blk = (lane >> 4) & 1, q = (lane & 15) >> 2, p = lane & 3;
    const int ch = (cbase >> 3) + 2 * blk + (p >> 1);
    const int r0 = rbase + (PERMK ? 4 * h : 8 * h) + q, r1 = r0 + (PERMK ? 8 : 4);
    const v4i16_t lo = __builtin_amdgcn_ds_read_tr16_b64_v4i16((LAS v4i16_t*)(tile + toff<W>(r0, ch) + 8 * (p & 1)));
    const v4i16_t hi = __builtin_amdgcn_ds_read_tr16_b64_v4i16((LAS v4i16_t*)(tile + toff<W>(r1, ch) + 8 * (p & 1)));
    return __builtin_shufflevector(lo, hi, 0, 1, 2, 3, 4, 5, 6, 7);
}
__device__ __forceinline__ bf16x8 pack_step(const f32x16& x, int s) {
    v4u p; p.x = cvtpk(x[8 * s], x[8 * s + 1]); p.y = cvtpk(x[8 * s + 2], x[8 * s + 3]); p.z = cvtpk(x[8 * s + 4], x[8 * s + 5]); p.w = cvtpk(x[8 * s + 6], x[8 * s + 7]);
    return __builtin_bit_cast(bf16x8, p);
}
__device__ __forceinline__ f32x16 zero16() { f32x16 z;
#pragma unroll
    for (int i = 0; i < 16; ++i) z[i] = 0.f; return z; }
__device__ __forceinline__ void wave_scan_sum2(float& x0, float& x1, int lane) {
    const float loc = x0 + x1; float s = loc;
#pragma unroll
    for (int o = 1; o < 64; o <<= 1) { const float t = __shfl_up(s, o); if (lane >= o) s += t; }
    const float ex = s - loc; x0 = ex + x0; x1 = x0 + x1;
}
__device__ __forceinline__ void wave_scan_max2(float& x0, float& x1, int lane) {
    const float loc = fmaxf(x0, x1); float s = loc;
#pragma unroll
    for (int o = 1; o < 64; o <<= 1) { const float t = __shfl_up(s, o); if (lane >= o) s = fmaxf(s, t); }
    float ex = __shfl_up(s, 1); if (lane == 0) ex = -INFINITY;
    x0 = fmaxf(ex, x0); x1 = fmaxf(x0, x1);
}
__device__ __forceinline__ float wave_max(float v) {
#pragma unroll
    for (int o = 1; o < 64; o <<= 1) v = fmaxf(v, __shfl_xor(v, o));
    return v;
}
__device__ __forceinline__ void rot8_store(LAS unsigned char* tile, int row, int j0, const v4u x1, const v4u x2, const float* cs, float scale) {
    float a[8], b[8];
    a[0] = blo(x1.x); a[1] = bhi(x1.x); a[2] = blo(x1.y); a[3] = bhi(x1.y); a[4] = blo(x1.z); a[5] = bhi(x1.z); a[6] = blo(x1.w); a[7] = bhi(x1.w);
    b[0] = blo(x2.x); b[1] = bhi(x2.x); b[2] = blo(x2.y); b[3] = bhi(x2.y); b[4] = blo(x2.z); b[5] = bhi(x2.z); b[6] = blo(x2.w); b[7] = bhi(x2.w);
    float o1[8], o2[8];
#pragma unroll
    for (int i = 0; i < 8; ++i) { const float c = cs[2 * i], s = cs[2 * i + 1]; o1[i] = (a[i] * c - b[i] * s) * scale; o2[i] = (a[i] * s + b[i] * c) * scale; }
    v4u w1, w2; w1.x = cvtpk(o1[0], o1[1]); w1.y = cvtpk(o1[2], o1[3]); w1.z = cvtpk(o1[4], o1[5]); w1.w = cvtpk(o1[6], o1[7]);
    w2.x = cvtpk(o2[0], o2[1]); w2.y = cvtpk(o2[2], o2[3]); w2.z = cvtpk(o2[4], o2[5]); w2.w = cvtpk(o2[6], o2[7]);
    *(LAS v4u*)(tile + toff<64>(row, j0 >> 3)) = w1; *(LAS v4u*)(tile + toff<64>(row, 4 + (j0 >> 3))) = w2;
}
__device__ __forceinline__ void conv8(const bf16_t* colp, int s, const float* cw, const float* cb, float* o) {
#pragma unroll
    for (int i = 0; i < 8; ++i) o[i] = cb[i];
#pragma unroll
    for (int w = 0; w < 4; ++w) { const int ss = s - 3 + w; if (ss >= 0) { const v4u x = *(const v4u*)(colp + (ptrdiff_t)(w - 3) * NP);
        o[0] += blo(x.x) * cw[w * 8 + 0]; o[1] += bhi(x.x) * cw[w * 8 + 1]; o[2] += blo(x.y) * cw[w * 8 + 2]; o[3] += bhi(x.y) * cw[w * 8 + 3];
        o[4] += blo(x.z) * cw[w * 8 + 4]; o[5] += bhi(x.z) * cw[w * 8 + 5]; o[6] += blo(x.w) * cw[w * 8 + 6]; o[7] += bhi(x.w) * cw[w * 8 + 7]; } }
#pragma unroll
    for (int i = 0; i < 8; ++i) o[i] = o[i] * __builtin_amdgcn_rcpf(1.0f + __builtin_amdgcn_exp2f(-1.4426950408889634f * o[i]));
}

__device__ __forceinline__ float fast_sig(float x) { return __builtin_amdgcn_rcpf(1.0f + __builtin_amdgcn_exp2f(-1.4426950408889634f * x)); }
__device__ __forceinline__ size_t ret_tile(int bn, int slot) { return (size_t)bn * (size_t)(CH * NP) + (size_t)slot * (CH * 64); }
__device__ __forceinline__ size_t ml_tile(int bn, int slot) { return (size_t)bn * (size_t)(CH * NP) + (size_t)(CH * 2048) + (size_t)slot * (CH * 128); }
struct RetPre { v4u q1, q2, k1, k2, v0, v1, rp; f4v cs[4]; };
__device__ __forceinline__ void ret_issue(RetPre& R, const bf16_t* projp, const float* cstab, const bf16_t* rstb, int ri, int tid) {
    const int h = ri & 7, bn = ri >> 3;
    const int c = tid >> 2, j0 = (tid & 3) * 8;
    const f4v* csp = (const f4v*)(cstab + ((size_t)bn * CH + c) * 64 + j0 * 2);
#pragma unroll
    for (int i = 0; i < 4; ++i) R.cs[i] = csp[i];
    const int qo = c * 64 + j0;
    const bf16_t* qp = projp + ret_tile(bn, h) + qo; const bf16_t* kp = projp + ret_tile(bn, 8 + h) + qo;
    R.q1 = __builtin_nontemporal_load((const v4u*)qp); R.q2 = __builtin_nontemporal_load((const v4u*)(qp + 32)); R.k1 = __builtin_nontemporal_load((const v4u*)kp); R.k2 = __builtin_nontemporal_load((const v4u*)(kp + 32));
    const bf16_t* vp = projp + ret_tile(bn, 16 + h) + tid * 8;
    R.v0 = __builtin_nontemporal_load((const v4u*)vp); R.v1 = __builtin_nontemporal_load((const v4u*)(vp + 64 * 64));
    R.rp = __builtin_nontemporal_load((const v4u*)(rstb + (size_t)ri * (RD * RD) + tid * 8));
}
__device__ __forceinline__ void ret_stage(const RetPre& R, LAS unsigned char* Qt, LAS unsigned char* Kt, LAS unsigned char* Vt, LAS unsigned char* Rpt, int tid) {
    const int c = tid >> 2, j0 = (tid & 3) * 8;
    float cs[16];
#pragma unroll
    for (int i = 0; i < 4; ++i) { cs[4 * i] = R.cs[i].x; cs[4 * i + 1] = R.cs[i].y; cs[4 * i + 2] = R.cs[i].z; cs[4 * i + 3] = R.cs[i].w; }
    rot8_store(Qt, c, j0, R.q1, R.q2, cs, 1.0f); rot8_store(Kt, c, j0, R.k1, R.k2, cs, 0.125f);
    const int row = tid >> 3, ch = tid & 7;
    *(LAS v4u*)(Vt + toff<64>(row, ch)) = R.v0; *(LAS v4u*)(Vt + toff<64>(row + 64, ch)) = R.v1; *(LAS v4u*)(Rpt + toff<64>(row, ch)) = R.rp;
}
struct MlPre { v4u raw[11]; v4u v[4]; v4u sp[4]; float gi0, gi1, gf0, gf1, np0, np1, mprev; };
__device__ __forceinline__ void ml_issue_a(MlPre& M, const bf16_t* projp, const float* gatesp, const bf16_t* mstb, const float* mnp, const float* mmp, int mi, int tid, int lane) {
    const int h = mi & 3, bn = mi >> 2;
    const bf16_t* vp = projp + ml_tile(bn, 8 + h) + tid * 8; const bf16_t* sp = mstb + (size_t)mi * (MD * MD) + tid * 8;
#pragma unroll
    for (int i = 0; i < 4; ++i) { M.v[i] = __builtin_nontemporal_load((const v4u*)(vp + i * (NTHREADS * 8))); M.sp[i] = __builtin_nontemporal_load((const v4u*)(sp + i * (NTHREADS * 8))); }
    const float* gp = gatesp + ((size_t)bn * CH + 2 * lane) * 8 + h;
    M.gi0 = gp[0]; M.gi1 = gp[8]; M.gf0 = gp[4]; M.gf1 = gp[12];
    M.np0 = mnp[(size_t)mi * MD + lane]; M.np1 = mnp[(size_t)mi * MD + lane + 64]; M.mprev = mmp[mi];
}
__device__ __forceinline__ void ml_issue_b(MlPre& M, const bf16_t* projp, int mi, int tid) {
    const int h = mi & 3, bn = mi >> 2, n = bn % NCH;
    const int which = tid >> 8, u = tid & 255, cg = u & 15, c0 = 8 * (u >> 4);
    const bf16_t* tp = projp + ml_tile(bn, which * 4 + h) + c0 * 128 + cg * 8;
#pragma unroll
    for (int rr = 0; rr < 11; ++rr) {
        const bool halo = rr < 3 && c0 == 0, valid = !halo || n > 0;
        const ptrdiff_t off = (rr - 3) * 128 + (halo ? (n > 0 ? -(ptrdiff_t)(CH * NP) + CH * 128 : (3 - rr) * 128) : 0);
        v4u x = *(const v4u*)(tp + off);
        if (!valid) x = (v4u){0u, 0u, 0u, 0u};
        M.raw[rr] = x; }
}
__device__ __forceinline__ void ml_stage(const MlPre& M, LAS unsigned char* Qt, LAS unsigned char* Kt, LAS unsigned char* Vt, LAS unsigned char* Spt, const float* conv_w, const float* conv_b, int h, int tid) {
    const int which = tid >> 8, u = tid & 255, cg = u & 15, c0 = 8 * (u >> 4);
    const int chn = which * 512 + h * MD + cg * 8;
    float cw[32], cb_[8];
#pragma unroll
    for (int w = 0; w < 4; ++w) { const f4v a = *(const f4v*)(conv_w + w * 1024 + chn), b = *(const f4v*)(conv_w + w * 1024 + chn + 4);
        cw[w * 8] = a.x; cw[w * 8 + 1] = a.y; cw[w * 8 + 2] = a.z; cw[w * 8 + 3] = a.w; cw[w * 8 + 4] = b.x; cw[w * 8 + 5] = b.y; cw[w * 8 + 6] = b.z; cw[w * 8 + 7] = b.w; }
    { const f4v a = *(const f4v*)(conv_b + chn), b = *(const f4v*)(conv_b + chn + 4); cb_[0] = a.x; cb_[1] = a.y; cb_[2] = a.z; cb_[3] = a.w; cb_[4] = b.x; cb_[5] = b.y; cb_[6] = b.z; cb_[7] = b.w; }
    LAS unsigned char* dst = which ? Kt : Qt; const float sc = which ? 0.08838834764831845f : 1.0f;
#pragma unroll
    for (int o = 0; o < 8; ++o) {
        float a[8];
#pragma unroll
        for (int i = 0; i < 8; ++i) a[i] = cb_[i];
#pragma unroll
        for (int w = 0; w < 4; ++w) { const v4u x = M.raw[o + w];
            a[0] += blo(x.x) * cw[w * 8 + 0]; a[1] += bhi(x.x) * cw[w * 8 + 1]; a[2] += blo(x.y) * cw[w * 8 + 2]; a[3] += bhi(x.y) * cw[w * 8 + 3];
            a[4] += blo(x.z) * cw[w * 8 + 4]; a[5] += bhi(x.z) * cw[w * 8 + 5]; a[6] += blo(x.w) * cw[w * 8 + 6]; a[7] += bhi(x.w) * cw[w * 8 + 7]; }
#pragma unroll
        for (int i = 0; i < 8; ++i) a[i] = a[i] * fast_sig(a[i]) * sc;
        v4u w; w.x = cvtpk(a[0], a[1]); w.y = cvtpk(a[2], a[3]); w.z = cvtpk(a[4], a[5]); w.w = cvtpk(a[6], a[7]);
        *(LAS v4u*)(dst + toff<128>(c0 + o, cg)) = w;
    }
#pragma unroll
    for (int i = 0; i < 4; ++i) { const int idx = tid + NTHREADS * i, row = idx >> 4, ch = idx & 15; *(LAS v4u*)(Vt + toff<128>(row, ch)) = M.v[i]; *(LAS v4u*)(Spt + toff<128>(row, ch)) = M.sp[i]; }
}
struct Params {
    const float *x, *p; const int* pos;
    const float *attn_norm, *w_in, *conv_w, *conv_b, *b_ig, *b_fg, *ret_gn, *ml_gn, *w_out, *moe_norm, *w_group, *b_group, *w_router, *b_router,
                *w1, *w3, *w2, *w_up, *ple_norm, *pg_norm, *w_gate, *final_norm;
    float* out; unsigned char* ws;
};

__device__ __forceinline__ void load4(const float* p, float (&o)[4]) { const float4 v = *(const float4*)p; o[0] = v.x; o[1] = v.y; o[2] = v.z; o[3] = v.w; }
__device__ __forceinline__ void load4(const bf16_t* p, float (&o)[4]) { const uint2 v = *(const uint2*)p; o[0] = __uint_as_float(v.x << 16); o[1] = __uint_as_float(v.x & 0xffff0000u); o[2] = __uint_as_float(v.y << 16); o[3] = __uint_as_float(v.y & 0xffff0000u); }

__device__ __forceinline__ void transpose_item(const float* W, int ldw, const float* gain, bf16_t* WT, int K, int kb, int n0, size_t drow0, LAS float* scr, int lane) {
    const int k0 = 64 * kb;
#pragma unroll 8
    for (int i = 0; i < 32; ++i) { const int kk = 2 * i + (lane >> 5); float w = W[(size_t)(k0 + kk) * ldw + n0 + (lane & 31)]; if (gain) w *= gain[k0 + kk]; scr[kk * 33 + (lane & 31)] = w; }
    LDS_WAIT(); asm volatile("" ::: "memory");
    const int c = lane & 7;
#pragma unroll
    for (int j = 0; j < 4; ++j) { const int n = (lane >> 3) + 8 * j; const LAS float* s = scr + (8 * c) * 33 + n;
        v4u o; o.x = pk2(s[0 * 33], s[1 * 33]); o.y = pk2(s[2 * 33], s[3 * 33]); o.z = pk2(s[4 * 33], s[5 * 33]); o.w = pk2(s[6 * 33], s[7 * 33]);
        *(GAS v4u*)(WT + (drow0 + n) * K + k0 + 8 * c) = o; }
    LDS_WAIT(); asm volatile("" ::: "memory");
}

constexpr int NPHASES = 14;
template <int LO, int HI>
__global__ void __launch_bounds__(NTHREADS, 2) mk(Params P) {
    extern __shared__ __attribute__((aligned(16))) unsigned char lds_raw[];
    float* ldsf = (float*)lds_raw;
    LAS unsigned char* ldsl = (LAS unsigned char*)lds_raw;
    const int G = gridDim.x, bid = blockIdx.x, NGW = G * NWAVES;
#define PH_IDS int tid = threadIdx.x; asm volatile("" : "+v"(tid)); const int lane = tid & 63, wave = __builtin_amdgcn_readfirstlane(tid >> 6), gw = bid * NWAVES + wave; (void)lane; (void)gw;
    unsigned char* const ws = P.ws;
#define rstd1 ((float*)(ws + WS_RSTD1))
#define gates ((float*)(ws + WS_GATES))
#define rstdg ((float*)(ws + WS_RSTDG))
#define rstde ((float*)(ws + WS_RSTDE))
#define eid ((int*)(ws + WS_EID))
#define posn ((int*)(ws + WS_POS))
#define gate ((float*)(ws + WS_GATE))
#define mn ((float*)(ws + WS_MN))
#define ml ((float*)(ws + WS_ML))
#define mbl ((float*)(ws + WS_MBL))
#define mm ((float*)(ws + WS_MM))
#define list ((int*)(ws + WS_LIST))
#define cnt ((int*)(ws + WS_CTL) + CW_CNT)
#define part ((float*)(ws + WS_PART))
#define part2 ((float*)(ws + WS_PART2))
#define win_t ((bf16_t*)(ws + WS_WIN))
#define wout_t ((bf16_t*)(ws + WS_WOUT))
#define w13_t ((bf16_t*)(ws + WS_W13))
#define w2_t ((bf16_t*)(ws + WS_W2))
#define wgate_t ((bf16_t*)(ws + WS_WGATE))
#define wup_t ((bf16_t*)(ws + WS_WUP))
#define proj ((bf16_t*)(ws + WS_PROJ))
#define hbuf ((bf16_t*)(ws + WS_HBUF))
#define xs ((bf16_t*)(ws + WS_XS))
#define ybuf ((bf16_t*)(ws + WS_YBUF))
#define peb ((bf16_t*)(ws + WS_PEB))
#define yreg ((bf16_t*)(ws + WS_YREG))
#define pb ((bf16_t*)(ws + WS_PB))
    float* const out = P.out;
#define rst ((float*)((unsigned char*)out + OUT_RST))
#define mst ((float*)((unsigned char*)out + OUT_MST))
    LAS int* s_off = (LAS int*)(ldsl + LDSX_OFF + 256);
    LAS int* s_cnt = s_off + 40;
    LAS int* s_t2e = s_off + 80;
#define IN(k) (LO <= (k) && (k) < HI)
#ifndef PROBE_PH
#define PROBE_PH (-1)
#endif
    unsigned long long pt0 = 0ull, pt1 = 0ull, pseg = 0ull, plast = 0ull; (void)pseg; (void)plast;
#define SEG(k) do { if (PROBE_PH >= 110 && PROBE_PH < 140) { const unsigned long long _n = __builtin_amdgcn_s_memrealtime(); if (PROBE_PH == 110 + (k)) pseg += _n - plast; plast = _n; } } while (0)
    if (PROBE_PH == 0) pt0 = __builtin_amdgcn_s_memrealtime();
#define GRID_BAR(k) do { if constexpr (IN(k) && IN((k) + 1)) xcd_barrier(bar); if (PROBE_PH == (k)) pt1 = __builtin_amdgcn_s_memrealtime(); if (PROBE_PH == (k) + 1) pt0 = __builtin_amdgcn_s_memrealtime(); } while (0)
    XcdBarrier bar; bar.bar = (unsigned*)(ws + WS_CTL) + CW_BAR; bar.x = 0; bar.st = nullptr;
    if constexpr (HI - LO > 1) {
        PH_IDS
        volatile LAS unsigned* st = (volatile LAS unsigned*)(ldsl + LDSX_OFF);
        if (tid == 0) { st[0] = 0u; st[1] = 0u; }
        __syncthreads();
        bar = xcd_barrier_post((unsigned*)(ws + WS_CTL) + CW_BAR, st);
    }

    if constexpr (IN(0)) {
        PH_IDS
        if (PROBE_PH >= 120 && PROBE_PH < 130) plast = __builtin_amdgcn_s_memrealtime();
        {
            constexpr int I0 = 8 * 16, I1 = 8 * 4, I2 = 0, I3 = 0, I4 = 8 * 4, I5 = 2 * 4;
#define P0_DECODE(it_, W, ldw, K, kb, n0, gain, WT, drow0, dsplit) do { int r = (it_); gain = nullptr; dsplit = 0; \
                if (r < I0) { W = P.w_in; ldw = NPROJ; K = D; kb = r >> 4; n0 = 256 * (r & 15); gain = P.attn_norm; WT = win_t; drow0 = n0; } \
                else if ((r -= I0) < I1) { W = P.w_out; ldw = D; K = D; kb = r >> 2; n0 = 256 * (r & 3); WT = wout_t; drow0 = n0; } \
                else if ((r -= I1) < I2) { const int mat = r >> 4, q = r & 15, e = mat >> 1, which = mat & 1; W = (which ? P.w3 : P.w1) + (size_t)e * D * DE; ldw = DE; K = D; kb = q >> 1; n0 = 256 * (q & 1); \
                    gain = P.moe_norm; WT = w13_t; drow0 = (size_t)e * 1024 + (size_t)((n0 >> 7) * 256 + which * 128); dsplit = 1; } \
                else if ((r -= I2) < I3) { const int e = r >> 4, q = r & 15; W = P.w2 + (size_t)e * DE * D; ldw = D; K = DE; kb = q >> 2; n0 = 256 * (q & 3); WT = w2_t; drow0 = (size_t)e * 1024 + n0; } \
                else if ((r -= I3) < I4) { W = P.w_gate; ldw = D; K = D; kb = r >> 2; n0 = 256 * (r & 3); gain = P.pg_norm; WT = wgate_t; drow0 = n0; } \
                else { r -= I4; W = P.w_up; ldw = D; K = PLE; kb = r >> 2; n0 = 256 * (r & 3); WT = wup_t; drow0 = n0; } } while (0)
            constexpr int NIT = I0 + I1 + I2 + I3 + I4 + I5;
            const int c4 = tid & 63, r0 = tid >> 6;
            f4v va[16], vb[16]; float ga[16], gb[16];
#define P0_LOAD(v_, g_, it_) do { if ((it_) < NIT) { const float* W; int ldw, K, kb, n0; const float* gain; bf16_t* WT; size_t drow0; int dsplit; \
                P0_DECODE((it_), W, ldw, K, kb, n0, gain, WT, drow0, dsplit); (void)K; (void)WT; (void)drow0; (void)dsplit; \
                _Pragma("unroll") for (int i = 0; i < 16; ++i) { v_[i] = __builtin_nontemporal_load((const f4v*)(W + (size_t)(128 * kb + r0 + 8 * i) * ldw + n0 + 4 * c4)); g_[i] = gain ? gain[128 * kb + r0 + 8 * i] : 1.0f; } } } while (0)
#define P0_PROCESS(v_, g_, it_, itn_) do { const float* W; int ldw, K, kb, n0; const float* gain; bf16_t* WT; size_t drow0; int dsplit; \
                P0_DECODE((it_), W, ldw, K, kb, n0, gain, WT, drow0, dsplit); (void)W; (void)ldw; (void)gain; const int k0 = 128 * kb; \
                __syncthreads(); \
                _Pragma("unroll") for (int i = 0; i < 16; ++i) { v2u o; o.x = cvtpk(v_[i].x * g_[i], v_[i].y * g_[i]); o.y = cvtpk(v_[i].z * g_[i], v_[i].w * g_[i]); \
                    *(LAS v2u*)(ldsl + (r0 + 8 * i) * 576 + c4 * 8) = o; } \
                P0_LOAD(v_, g_, (itn_)); \
                __syncthreads(); \
                { const int grp = lane >> 4, q = (lane & 15) >> 2, p = lane & 3, i16 = lane & 15; \
                    \
                  _Pragma("unroll") for (int cg = 0; cg < 2; ++cg) { const int nl = 32 * wave + 16 * cg + i16; \
                    const size_t drow = drow0 + (dsplit && nl >= 128 ? (size_t)(256 + nl - 128) : (size_t)nl); \
                    _Pragma("unroll") for (int cq = 0; cq < 4; ++cq) { \
                        const LAS unsigned char* src = ldsl + ((4 * cq + grp) * 8 + q) * 576 + (32 * wave + 16 * cg + 4 * p) * 2; \
                        const v4i16_t lo = __builtin_amdgcn_ds_read_tr16_b64_v4i16((LAS v4i16_t*)src); \
                        const v4i16_t hi = __builtin_amdgcn_ds_read_tr16_b64_v4i16((LAS v4i16_t*)(src + 4 * 576)); \
                        const bf16x8 o = __builtin_shufflevector(lo, hi, 0, 1, 2, 3, 4, 5, 6, 7); \
                        *(bf16x8*)(WT + drow * K + k0 + (4 * cq + grp) * 8) = o; } } } } while (0)
            P0_LOAD(va, ga, bid); P0_LOAD(vb, gb, bid + G);
            for (int it = bid; it < NIT; it += 2 * G) {
                P0_PROCESS(va, ga, it, it + 2 * G);
                if (it + G < NIT) P0_PROCESS(vb, gb, it + G, it + 3 * G);
            }
#undef P0_LOAD
#undef P0_PROCESS
#undef P0_DECODE
        }
        __syncthreads();
        SEG(10);
        {
            LAS float* gwl = (LAS float*)ldsl;
            for (int idx = tid; idx < D * 8; idx += NTHREADS) { const int k = idx >> 3, j = idx & 7; gwl[idx] = P.w_in[(size_t)k * NPROJ + NP + j] * P.attn_norm[k]; }
            __syncthreads();
            for (int row0 = gw; row0 < T; row0 += 2 * NGW) {
                float4 v[2][4];
#pragma unroll
                for (int u = 0; u < 2; ++u) { const float4* xr = (const float4*)(P.x + (size_t)(row0 + u * NGW) * D) + lane;
#pragma unroll
                    for (int j = 0; j < 4; ++j) { const f4v t_ = __builtin_nontemporal_load((const f4v*)(xr + 64 * j)); v[u][j] = make_float4(t_.x, t_.y, t_.z, t_.w); } }
#pragma unroll
                for (int u = 0; u < 2; ++u) {
                    const int row = row0 + u * NGW; float ss = 0.f;
#pragma unroll
                    for (int j = 0; j < 4; ++j) ss += v[u][j].x * v[u][j].x + v[u][j].y * v[u][j].y + v[u][j].z * v[u][j].z + v[u][j].w * v[u][j].w;
                    ss = wave_sum(ss);
                    const float rstd = 1.0f / sqrtf(ss * (1.0f / D) + EPS);
                    float g8[8];
#pragma unroll
                    for (int i = 0; i < 8; ++i) g8[i] = 0.f;
#pragma unroll
                    for (int j = 0; j < 4; ++j) {
                        const int k0 = 4 * (lane + 64 * j);
                        const float xs_[4] = {v[u][j].x * rstd, v[u][j].y * rstd, v[u][j].z * rstd, v[u][j].w * rstd};
                        uint2 o; o.x = cvtpk(xs_[0], xs_[1]); o.y = cvtpk(xs_[2], xs_[3]);
                        *(uint2*)(yreg + (size_t)row * D + k0) = o;
#pragma unroll
                        for (int i = 0; i < 4; ++i) {
                            const LAS f4v* wr = (const LAS f4v*)(gwl + (k0 + i) * 8);
                            const f4v w0 = wr[0], w1 = wr[1];
                            g8[0] += xs_[i] * w0.x; g8[1] += xs_[i] * w0.y; g8[2] += xs_[i] * w0.z; g8[3] += xs_[i] * w0.w;
                            g8[4] += xs_[i] * w1.x; g8[5] += xs_[i] * w1.y; g8[6] += xs_[i] * w1.z; g8[7] += xs_[i] * w1.w;
                        }
                    }
#pragma unroll
                    for (int i = 0; i < 8; ++i) g8[i] = wave_sum(g8[i]);
                    if (lane == 0) {
                        *(float4*)(gates + (size_t)row * 8) = make_float4(g8[0], g8[1], g8[2], g8[3]);
                        *(float4*)(gates + (size_t)row * 8 + 4) = make_float4(g8[4], g8[5], g8[6], g8[7]);
                    }
                }
            }
            SEG(11);
            {
                bf16_t* wrh = (bf16_t*)(ws + WS_WR); bf16_t* wrl = wrh + 48 * D;
                for (int idx = bid * NTHREADS + tid; idx < 48 * D; idx += G * NTHREADS) {
                    const int col = idx >> 10, k = idx & 1023;
                    float w = 0.f; if (col < 4) w = P.w_group[k * 4 + col] * P.moe_norm[k]; else if (col < 36) w = P.w_router[k * 32 + col - 4] * P.moe_norm[k];
                    const unsigned hi = f2bf(w); const float r = w - __uint_as_float(hi << 16);
                    wrh[idx] = (bf16_t)hi; wrl[idx] = (bf16_t)f2bf(r);
                }
            }
            {
                float* cstab = (float*)(ws + WS_CS);
                for (int idx = bid * NTHREADS + tid; idx < T * 32; idx += G * NTHREADS) {
                    const int t = idx >> 5, j = idx & 31;
                    const float ang = (float)P.pos[t] * powf(10000.0f, -(float)j / 32.0f);
                    float sn, cs; sincosf(ang, &sn, &cs);
                    *(float2*)(cstab + (size_t)idx * 2) = make_float2(cs, sn);
                }
            }
            SEG(12);
        }
        __syncthreads();
        SEG(13);
    }
    GRID_BAR(0);
#ifdef PROBE_XBAR
    xcd_barrier(bar); xcd_barrier(bar); xcd_barrier(bar); xcd_barrier(bar); xcd_barrier(bar);
#endif
    if constexpr (IN(1)) {
        PH_IDS
        pg8::Gemm g{yreg, win_t, T, NP, D, nullptr}; pg8::StaticOrder S; S.init(T, NP, G, bid);
        pg8::EpiStoreBf16 E{proj, NP, 0xffff, nullptr, 1};
        pg8::gemm_phase<pg8::EpiStoreBf16, pg8::StaticOrder, true, true>(ldsl, g, S, E);
    }
    GRID_BAR(1);
    if constexpr (IN(2)) {
        PH_IDS
        const float* cstab = (const float*)(ws + WS_CS);
#define BAR_LDS() do { asm volatile("s_waitcnt lgkmcnt(0)" ::: "memory"); __builtin_amdgcn_s_barrier(); asm volatile("" ::: "memory"); } while (0)
        LAS unsigned char* tl = ldsl + 73728;
        f4v tv[8]; float tg[8]; int tk = 0;
        const int tc4 = tid & 63, tr0 = tid >> 6;
#define MOE_DECODE(it_, W, ldw, K, kb, n0, gain, WT, drow0, dsplit) do { int r = (it_); dsplit = 0; gain = nullptr; \
            if (r < 2048) { const int mat = r >> 5, q = r & 31, e = mat >> 1, which = mat & 1; W = (which ? P.w3 : P.w1) + (size_t)e * D * DE; ldw = DE; K = D; kb = q >> 1; n0 = 256 * (q & 1); \
                gain = P.moe_norm; WT = w13_t; drow0 = (size_t)e * 1024 + (size_t)((n0 >> 7) * 256 + which * 128); dsplit = 1; } \
            else { r -= 2048; const int e = r >> 5, q = r & 31; W = P.w2 + (size_t)e * DE * D; ldw = D; K = DE; kb = q >> 2; n0 = 256 * (q & 3); WT = w2_t; drow0 = (size_t)e * 1024 + n0; } } while (0)
#define MOE_LOAD(k_) do { int it_ = bid + G * (k_); if (it_ > 3071) it_ = 3071; { const float* W; int ldw, K, kb, n0; const float* gain; bf16_t* WT; size_t drow0; int dsplit; \
            MOE_DECODE(it_, W, ldw, K, kb, n0, gain, WT, drow0, dsplit); (void)K; (void)WT; (void)drow0; (void)dsplit; \
            _Pragma("unroll") for (int i = 0; i < 8; ++i) { tv[i] = __builtin_nontemporal_load((const f4v*)(W + (size_t)(64 * kb + tr0 + 8 * i) * ldw + n0 + 4 * tc4)); tg[i] = gain ? gain[64 * kb + tr0 + 8 * i] : 1.0f; } } } while (0)
#define MOE_PROCESS(k_) do { const int it_ = bid + G * (k_); if (it_ < 3072) { const float* W; int ldw, K, kb, n0; const float* gain; bf16_t* WT; size_t drow0; int dsplit; \
            MOE_DECODE(it_, W, ldw, K, kb, n0, gain, WT, drow0, dsplit); (void)W; (void)ldw; (void)gain; const int k0 = 64 * kb; \
            _Pragma("unroll") for (int i = 0; i < 8; ++i) { v2u o; o.x = cvtpk(tv[i].x * tg[i], tv[i].y * tg[i]); o.y = cvtpk(tv[i].z * tg[i], tv[i].w * tg[i]); \
                *(LAS v2u*)(tl + (tr0 + 8 * i) * 576 + tc4 * 8) = o; } \
            MOE_LOAD((k_) + 1); \
            BAR_LDS(); \
            { const int grp = lane >> 4, q = (lane & 15) >> 2, p = lane & 3, i16 = lane & 15; \
              _Pragma("unroll") for (int cg = 0; cg < 2; ++cg) { const int nl = 32 * wave + 16 * cg + i16; \
                const size_t drow = drow0 + (dsplit && nl >= 128 ? (size_t)(256 + nl - 128) : (size_t)nl); \
                _Pragma("unroll") for (int cq = 0; cq < 2; ++cq) { \
                    const LAS unsigned char* src = tl + ((4 * cq + grp) * 8 + q) * 576 + (32 * wave + 16 * cg + 4 * p) * 2; \
                    const v4i16_t lo = __builtin_amdgcn_ds_read_tr16_b64_v4i16((LAS v4i16_t*)src); \
                    const v4i16_t hi = __builtin_amdgcn_ds_read_tr16_b64_v4i16((LAS v4i16_t*)(src + 4 * 576)); \
                    const bf16x8 o = __builtin_shufflevector(lo, hi, 0, 1, 2, 3, 4, 5, 6, 7); \
                    *(bf16x8*)(WT + drow * K + k0 + (4 * cq + grp) * 8) = o; } } } } } while (0)
        MOE_LOAD(0);
        BAR_LDS();
        {
            LAS unsigned char* Kt = ldsl; LAS unsigned char* Vt = ldsl + 18432;
            v4u k1, k2, v0, v1; f4v csr[4];
#define RET1_ISSUE(ri_) do { const int h_ = (ri_) & 7, bn_ = (ri_) >> 3; const int c_ = tid >> 2, j0_ = (tid & 3) * 8; \
                const f4v* csp_ = (const f4v*)(cstab + ((size_t)bn_ * CH + c_) * 64 + j0_ * 2); csr[0] = csp_[0]; csr[1] = csp_[1]; csr[2] = csp_[2]; csr[3] = csp_[3]; \
                const bf16_t* kp_ = proj + ret_tile(bn_, 8 + h_) + c_ * 64 + j0_; k1 = *(const v4u*)kp_; k2 = *(const v4u*)(kp_ + 32); \
                const bf16_t* vp_ = proj + ret_tile(bn_, 16 + h_) + tid * 8; v0 = *(const v4u*)vp_; v1 = *(const v4u*)(vp_ + 64 * 64); } while (0)
            const int rpb = (BATCH * NCH * RH + G - 1) / G, ri0 = bid * rpb, ri1 = (ri0 + rpb < BATCH * NCH * RH) ? ri0 + rpb : BATCH * NCH * RH;
            if (ri0 < ri1) RET1_ISSUE(ri0);
            for (int ri = ri0; ri < ri1; ++ri) {
                const int h = ri & 7;
                const float lg2 = log1pf(-exp2f(-5.0f - (float)h)) * 1.4426950408889634f;
                BAR_LDS();
                {   const int c = tid >> 2, j0 = (tid & 3) * 8; float cs[16];
#pragma unroll
                    for (int i = 0; i < 4; ++i) { cs[4 * i] = csr[i].x; cs[4 * i + 1] = csr[i].y; cs[4 * i + 2] = csr[i].z; cs[4 * i + 3] = csr[i].w; }
                    rot8_store(Kt, c, j0, k1, k2, cs, 0.125f * __builtin_amdgcn_exp2f(lg2 * (float)(CH - 1 - c)));
                    const int row = tid >> 3, ch = tid & 7;
                    *(LAS v4u*)(Vt + toff<64>(row, ch)) = v0; *(LAS v4u*)(Vt + toff<64>(row + 64, ch)) = v1; }
                BAR_LDS();
                RET1_ISSUE((ri + 1 < ri1 ? ri + 1 : ri));
                if (wave < 4) {
                    const int db = wave >> 1, eb = wave & 1, r = lane & 31, hl = lane >> 5;
                    f32x16 acc = zero16();
#pragma unroll
                    for (int s = 0; s < 8; ++s) acc = MFMA32(frag_tr<64, false>(Kt, 16 * s, db * 32, lane), frag_tr<64, false>(Vt, 16 * s, eb * 32, lane), acc);
                    bf16_t* dst = (bf16_t*)rst + (size_t)ri * (RD * RD) + eb * 32 + r;
#pragma unroll
                    for (int reg = 0; reg < 16; ++reg) { const float o = __shfl_down(acc[reg], 1); if ((r & 1) == 0) *(unsigned*)(dst + (db * 32 + crow(reg, hl)) * RD) = cvtpk(acc[reg], o); }
                }
                MOE_PROCESS(tk); ++tk;
            }
#undef RET1_ISSUE
        }
        {
            LAS unsigned char* Kt = ldsl; LAS unsigned char* Vt = ldsl + 34816; LAS float* sw = (LAS float*)(ldsl + 69632);
            v4u raw[7], vv[4]; float gi0, gi1, gf0, gf1;
#define ML1_ISSUE(mi_) do { const int h_ = (mi_) & 3, bn_ = (mi_) >> 2, n_ = bn_ % NCH; const int cg_ = tid & 15, c0_ = 4 * (tid >> 4); \
                const bf16_t* tp_ = proj + ml_tile(bn_, 4 + h_) + c0_ * 128 + cg_ * 8; \
                _Pragma("unroll") for (int rr = 0; rr < 7; ++rr) { const bool halo_ = rr < 3 && c0_ == 0, valid_ = !halo_ || n_ > 0; \
                    const ptrdiff_t off_ = (rr - 3) * 128 + (halo_ ? (n_ > 0 ? -(ptrdiff_t)(CH * NP) + CH * 128 : (3 - rr) * 128) : 0); \
                    v4u x_ = *(const v4u*)(tp_ + off_); if (!valid_) x_ = (v4u){0u, 0u, 0u, 0u}; raw[rr] = x_; } \
                const bf16_t* vp_ = proj + ml_tile(bn_, 8 + h_) + tid * 8; \
                _Pragma("unroll") for (int i = 0; i < 4; ++i) vv[i] = *(const v4u*)(vp_ + i * (NTHREADS * 8)); \
                const float* gp_ = gates + ((size_t)bn_ * CH + 2 * lane) * 8 + h_; gi0 = gp_[0]; gi1 = gp_[8]; gf0 = gp_[4]; gf1 = gp_[12]; } while (0)
            const int mpb = (BATCH * NCH * MH + G - 1) / G, mi0 = bid * mpb, mi1 = (mi0 + mpb < BATCH * NCH * MH) ? mi0 + mpb : BATCH * NCH * MH;
            if (mi0 < mi1) ML1_ISSUE(mi0);
            for (int mi = mi0; mi < mi1; ++mi) {
                const int h = mi & 3;
                BAR_LDS();
                if (wave == 0) {
                    const float i0 = gi0 + P.b_ig[h], i1 = gi1 + P.b_ig[h];
                    float b0 = logsigmoidf_(gf0 + P.b_fg[h]), b1 = logsigmoidf_(gf1 + P.b_fg[h]);
                    wave_scan_sum2(b0, b1, lane);
                    const float bL = __shfl(b1, 63);
                    const float a0 = bL - b0 + i0, a1 = bL - b1 + i1;
                    const float mloc = wave_max(fmaxf(a0, a1));
                    sw[2 * lane] = expf(a0 - mloc); sw[2 * lane + 1] = expf(a1 - mloc);
                    if (lane == 0) { ml[mi] = mloc; mbl[mi] = bL; }
                }
#pragma unroll
                for (int i = 0; i < 4; ++i) { const int idx = tid + NTHREADS * i, row = idx >> 4, ch = idx & 15; *(LAS v4u*)(Vt + toff<128>(row, ch)) = vv[i]; }
                BAR_LDS();
                {   const int cg = tid & 15, c0 = 4 * (tid >> 4); const int chn = 512 + h * MD + cg * 8;
                    float cw[32], cb_[8];
#pragma unroll
                    for (int w = 0; w < 4; ++w) { const f4v a = *(const f4v*)(P.conv_w + w * 1024 + chn), b2 = *(const f4v*)(P.conv_w + w * 1024 + chn + 4);
                        cw[w * 8] = a.x; cw[w * 8 + 1] = a.y; cw[w * 8 + 2] = a.z; cw[w * 8 + 3] = a.w; cw[w * 8 + 4] = b2.x; cw[w * 8 + 5] = b2.y; cw[w * 8 + 6] = b2.z; cw[w * 8 + 7] = b2.w; }
                    { const f4v a = *(const f4v*)(P.conv_b + chn), b2 = *(const f4v*)(P.conv_b + chn + 4); cb_[0] = a.x; cb_[1] = a.y; cb_[2] = a.z; cb_[3] = a.w; cb_[4] = b2.x; cb_[5] = b2.y; cb_[6] = b2.z; cb_[7] = b2.w; }
#pragma unroll
                    for (int o = 0; o < 4; ++o) {
                        float a[8];
#pragma unroll
                        for (int i = 0; i < 8; ++i) a[i] = cb_[i];
#pragma unroll
                        for (int w = 0; w < 4; ++w) { const v4u x = raw[o + w];
                            a[0] += blo(x.x) * cw[w * 8 + 0]; a[1] += bhi(x.x) * cw[w * 8 + 1]; a[2] += blo(x.y) * cw[w * 8 + 2]; a[3] += bhi(x.y) * cw[w * 8 + 3];
                            a[4] += blo(x.z) * cw[w * 8 + 4]; a[5] += bhi(x.z) * cw[w * 8 + 5]; a[6] += blo(x.w) * cw[w * 8 + 6]; a[7] += bhi(x.w) * cw[w * 8 + 7]; }
                        const float sc = 0.08838834764831845f * sw[c0 + o];
#pragma unroll
                        for (int i = 0; i < 8; ++i) a[i] = a[i] * fast_sig(a[i]) * sc;
                        v4u w; w.x = cvtpk(a[0], a[1]); w.y = cvtpk(a[2], a[3]); w.z = cvtpk(a[4], a[5]); w.w = cvtpk(a[6], a[7]);
                        *(LAS v4u*)(Kt + toff<128>(c0 + o, cg)) = w;
                    }
                }
                BAR_LDS();
                ML1_ISSUE((mi + 1 < mi1 ? mi + 1 : mi));
                {
                    const int db = wave >> 1, ep = wave & 1, r = lane & 31, hl = lane >> 5;
                    f32x16 acc0 = zero16(), acc1 = zero16(), accn = zero16();
                    bf16x8 ones;
#pragma unroll
                    for (int i = 0; i < 8; ++i) ones[i] = (short)0x3F80;
#pragma unroll
                    for (int s = 0; s < 8; ++s) { const bf16x8 ka = frag_tr<128, false>(Kt, 16 * s, db * 32, lane);
                        acc0 = MFMA32(ka, frag_tr<128, false>(Vt, 16 * s, ep * 64, lane), acc0);
                        acc1 = MFMA32(ka, frag_tr<128, false>(Vt, 16 * s, ep * 64 + 32, lane), acc1);
                        if (ep == 0) accn = MFMA32(ka, ones, accn); }
                    bf16_t* dst = (bf16_t*)mst + (size_t)mi * (MD * MD) + ep * 64 + r;
#pragma unroll
                    for (int reg = 0; reg < 16; ++reg) { const int d = db * 32 + crow(reg, hl); const float o0 = __shfl_down(acc0[reg], 1), o1 = __shfl_down(acc1[reg], 1);
                        if ((r & 1) == 0) { *(unsigned*)(dst + d * MD) = cvtpk(acc0[reg], o0); *(unsigned*)(dst + d * MD + 32) = cvtpk(acc1[reg], o1); } }
                    if (ep == 0 && r == 0) {
#pragma unroll
                        for (int reg = 0; reg < 16; ++reg) mn[(size_t)mi * MD + db * 32 + crow(reg, hl)] = accn[reg];
                    }
                }
                MOE_PROCESS(tk); ++tk;
            }
#undef ML1_ISSUE
        }
        BAR_LDS();
        for (; tk < 12; ++tk) { MOE_PROCESS(tk); BAR_LDS(); }
#undef MOE_DECODE
#undef MOE_LOAD
#undef MOE_PROCESS
#undef BAR_LDS
    }
    GRID_BAR(2);
    if constexpr (IN(3)) {
        PH_IDS
        constexpr int NRT = BATCH * RH * (RD * RD / 4), NMT = BATCH * MH * (MD * MD / 4), NNT = BATCH * MH * (MD / 4);
        bf16_t* rstb = (bf16_t*)(ws + WS_RSTB); bf16_t* mstb = (bf16_t*)((unsigned char*)out + OUT_MSTB);
        for (int task = bid * NTHREADS + tid; task < NRT + NMT + NNT; task += G * NTHREADS) {
            if (task < NRT) {
                const int el = (task % (RD * RD / 4)) * 4, bh = task / (RD * RD / 4), b = bh / RH, h = bh % RH;
                const float dec = expf(log1pf(-exp2f(-5.0f - (float)h)) * (float)CH);
                const size_t base = (size_t)(b * NCH * RH + h) * (RD * RD) + el, nstride = (size_t)RH * RD * RD;
                f4v R = {0.f, 0.f, 0.f, 0.f};
#pragma unroll 1
                for (int n0 = 0; n0 < NCH; n0 += 8) {
                    f4v v[8];
#pragma unroll
                    for (int i = 0; i < 8; ++i) { const v2u q = __builtin_nontemporal_load((const v2u*)((const bf16_t*)rst + base + (size_t)(n0 + i) * nstride)); v[i].x = blo(q.x); v[i].y = bhi(q.x); v[i].z = blo(q.y); v[i].w = bhi(q.y); }
#pragma unroll
                    for (int i = 0; i < 8; ++i) { v2u o; o.x = cvtpk(R.x, R.y); o.y = cvtpk(R.z, R.w); *(v2u*)(rstb + base + (size_t)(n0 + i) * nstride) = o; R = R * dec + v[i]; }
                }
            } else {
                const int j = task - NRT; const bool isn = j >= NMT; const int jj = isn ? j - NMT : j, per = isn ? MD / 4 : MD * MD / 4;
                const int el = (jj % per) * 4, bh = jj / per, b = bh / MH, h = bh % MH;
                const int s0 = b * NCH * MH + h;
                f4v S = {0.f, 0.f, 0.f, 0.f}; float m = 0.f;
#pragma unroll 1
                for (int n0 = 0; n0 < NCH; n0 += 8) {
                    f4v v[8]; float bl[8], mlc[8];
#pragma unroll
                    for (int i = 0; i < 8; ++i) { const int sidx = s0 + (n0 + i) * MH; bl[i] = mbl[sidx]; mlc[i] = ml[sidx];
                        if (isn) v[i] = *(const f4v*)(mn + (size_t)sidx * MD + el);
                        else { const v2u q = __builtin_nontemporal_load((const v2u*)((const bf16_t*)mst + (size_t)sidx * (MD * MD) + el)); v[i].x = blo(q.x); v[i].y = bhi(q.x); v[i].z = blo(q.y); v[i].w = bhi(q.y); } }
#pragma unroll
                    for (int i = 0; i < 8; ++i) { const int sidx = s0 + (n0 + i) * MH;
                        const float mnew = fmaxf(bl[i] + m, mlc[i]);
                        const float dec = expf(bl[i] + m - mnew), sc = expf(mlc[i] - mnew);
                        if (isn) { *(f4v*)(mn + (size_t)sidx * MD + el) = S; if (el == 0) mm[sidx] = m; }
                        else { v2u o; o.x = cvtpk(S.x, S.y); o.y = cvtpk(S.z, S.w); *(v2u*)(mstb + (size_t)sidx * (MD * MD) + el) = o; }
                        S = S * dec + v[i] * sc; m = mnew; }
                }
            }
        }
    }
    GRID_BAR(3);
    if constexpr (IN(4)) {
        PH_IDS
        const float* cstab = (const float*)(ws + WS_CS);
        const bf16_t* rstb = (const bf16_t*)(ws + WS_RSTB); const bf16_t* mstb = (const bf16_t*)((unsigned char*)out + OUT_MSTB);
#define BAR_LDS() do { asm volatile("s_waitcnt lgkmcnt(0)" ::: "memory"); __builtin_amdgcn_s_barrier(); asm volatile("" ::: "memory"); } while (0)
        BAR_LDS();
        if (PROBE_PH == 100) pt0 = __builtin_amdgcn_s_memrealtime();
        {
            LAS unsigned char* Qt = ldsl; LAS unsigned char* Kt = ldsl + 18432; LAS unsigned char* Vt = ldsl + 36864; LAS unsigned char* Rpt = ldsl + 55296;
            LAS float* Zs = (LAS float*)(ldsl + 65536);
            LAS float* sgn = (LAS float*)(ldsl + 110592);
            sgn[tid] = P.ret_gn[tid];
            RetPre R;
            const int rpb = (BATCH * NCH * RH + G - 1) / G, ri0 = bid * rpb, ri1 = (ri0 + rpb < BATCH * NCH * RH) ? ri0 + rpb : BATCH * NCH * RH;
            if (ri0 < ri1) ret_issue(R, proj, cstab, rstb, ri0, tid);
            for (int ri = ri0; ri < ri1; ++ri) {
                int tid_i = threadIdx.x; asm volatile("" : "+v"(tid_i));
                const int tid = tid_i, lane = tid & 63;
                const int h = ri & 7; const size_t t0 = (size_t)(ri >> 3) * CH;
                const float lg2 = log1pf(-exp2f(-5.0f - (float)h)) * 1.4426950408889634f;
                ret_stage(R, Qt, Kt, Vt, Rpt, tid);
                BAR_LDS();
                const int ce = tid >> 2, e0 = (tid & 3) * 16; const size_t te = t0 + ce;
                const bf16_t* gp_ = proj + ret_tile(ri >> 3, 24 + h) + ce * 64 + e0; const v4u g0 = __builtin_nontemporal_load((const v4u*)gp_), g1 = __builtin_nontemporal_load((const v4u*)(gp_ + 8));
                asm volatile("" ::: "memory");
                ret_issue(R, proj, cstab, rstb, ri + 1 < ri1 ? ri + 1 : ri, tid);
                const int prow = bid * (T / 256) + (ri - ri0) * 16 + wave * 2;
                const bool pdo = (ri - ri0) < 8 && G == 256;
                f4v pv0 = {0.f, 0.f, 0.f, 0.f}, pv1 = pv0;
                { const int pr_ = pdo ? prow : 0; pv0 = __builtin_nontemporal_load((const f4v*)(P.p + (size_t)pr_ * PLE) + lane); pv1 = __builtin_nontemporal_load((const f4v*)(P.p + (size_t)(pr_ + 1) * PLE) + lane); }
                {
                    const int cb = wave >> 1, eb = wave & 1, r = lane & 31, hl = lane >> 5;
                    f32x16 Z = zero16();
                    const int c = cb * 32 + r;
                    for (int jb = 0; jb <= cb; ++jb) {
                        f32x16 X = zero16();
#pragma unroll
                        for (int s = 0; s < 4; ++s) X = MFMA32(frag_row<64>(Kt, jb * 32 + r, s, hl), frag_row<64>(Qt, cb * 32 + r, s, hl), X);
#pragma unroll
                        for (int reg = 0; reg < 16; ++reg) { const int dl = c - (jb * 32 + crow(reg, hl)); X[reg] = dl >= 0 ? X[reg] * __builtin_amdgcn_exp2f(lg2 * (float)dl) : 0.f; }
#pragma unroll
                        for (int s2 = 0; s2 < 2; ++s2) Z = MFMA32(pack_step(X, s2), frag_tr<64, true>(Vt, jb * 32 + 16 * s2, eb * 32, lane), Z);
                    }
                    f32x16 Zi = zero16();
#pragma unroll
                    for (int s = 0; s < 4; ++s) Zi = MFMA32(frag_row<64>(Qt, cb * 32 + r, s, hl), frag_tr<64, false>(Rpt, 16 * s, eb * 32, lane), Zi);
#pragma unroll
                    for (int reg = 0; reg < 16; ++reg) { const int cc = cb * 32 + crow(reg, hl); Z[reg] += __builtin_amdgcn_exp2f(lg2 * (float)(cc + 1)) * Zi[reg]; Zs[cc * 68 + eb * 32 + r] = Z[reg]; }
                }
                BAR_LDS();
                {
                    float z[16]; float ss = 0.f;
#pragma unroll
                    for (int i = 0; i < 4; ++i) { const f4v v = *(const LAS f4v*)(Zs + ce * 68 + e0 + 4 * i); z[4 * i] = v.x; z[4 * i + 1] = v.y; z[4 * i + 2] = v.z; z[4 * i + 3] = v.w; }
#pragma unroll
                    for (int i = 0; i < 16; ++i) ss += z[i] * z[i];
                    ss += __shfl_xor(ss, 1); ss += __shfl_xor(ss, 2);
                    const float rn = 1.0f / sqrtf(ss * (1.0f / RD) + EPS);
                    const float gg[16] = {blo(g0.x), bhi(g0.x), blo(g0.y), bhi(g0.y), blo(g0.z), bhi(g0.z), blo(g0.w), bhi(g0.w), blo(g1.x), bhi(g1.x), blo(g1.y), bhi(g1.y), blo(g1.z), bhi(g1.z), blo(g1.w), bhi(g1.w)};
                    float o[16];
#pragma unroll
                    for (int i = 0; i < 16; ++i) o[i] = gg[i] * fast_sig(gg[i]) * z[i] * rn * sgn[h * RD + e0 + i];
                    v4u w0, w1; w0.x = cvtpk(o[0], o[1]); w0.y = cvtpk(o[2], o[3]); w0.z = cvtpk(o[4], o[5]); w0.w = cvtpk(o[6], o[7]);
                    w1.x = cvtpk(o[8], o[9]); w1.y = cvtpk(o[10], o[11]); w1.z = cvtpk(o[12], o[13]); w1.w = cvtpk(o[14], o[15]);
                    *(v4u*)(yreg + te * D + h * RD + e0) = w0; *(v4u*)(yreg + te * D + h * RD + e0 + 8) = w1;
                }
                if (pdo) { v2u o0, o1; o0.x = cvtpk(pv0.x, pv0.y); o0.y = cvtpk(pv0.z, pv0.w); o1.x = cvtpk(pv1.x, pv1.y); o1.y = cvtpk(pv1.z, pv1.w);
                    ((v2u*)(pb + (size_t)prow * PLE))[lane] = o0; ((v2u*)(pb + (size_t)(prow + 1) * PLE))[lane] = o1; }
            }
        }
        BAR_LDS();
        if (PROBE_PH == 100) pt1 = __builtin_amdgcn_s_memrealtime();
        if (PROBE_PH == 101) pt0 = __builtin_amdgcn_s_memrealtime();
        {
            LAS unsigned char* Qt = ldsl; LAS unsigned char* Kt = ldsl + 34816; LAS unsigned char* Vt = ldsl + 69632; LAS unsigned char* Spt = ldsl + 104448;
            LAS float* sb = (LAS float*)(ldsl + 139264); LAS float* sg = sb + 128; LAS float* spm = sg + 128; LAS float* snp = spm + 128; LAS float* sden = snp + 128; LAS float* swi = sden + 128;
            LAS float* Zs = (LAS float*)(ldsl + 34816);
            MlPre M;
            const int mpb = (BATCH * NCH * MH + G - 1) / G, mi0 = bid * mpb, mi1 = (mi0 + mpb < BATCH * NCH * MH) ? mi0 + mpb : BATCH * NCH * MH;
            if (mi0 < mi1) { ml_issue_a(M, proj, gates, mstb, mn, mm, mi0, tid, lane); ml_issue_b(M, proj, mi0, tid); }
            if (PROBE_PH >= 110 && PROBE_PH < 120) plast = __builtin_amdgcn_s_memrealtime();
            for (int mi = mi0; mi < mi1; ++mi) {
                int tid_i = threadIdx.x; asm volatile("" : "+v"(tid_i));
                const int tid = tid_i, lane = tid & 63;
                const int h = mi & 3; const size_t t0 = (size_t)(mi >> 2) * CH;
                const float mprev = M.mprev;
                SEG(3);
                BAR_LDS();
                if (wave == 0) {
                    const float i0 = M.gi0 + P.b_ig[h], i1 = M.gi1 + P.b_ig[h];
                    float b0 = logsigmoidf_(M.gf0 + P.b_fg[h]), b1 = logsigmoidf_(M.gf1 + P.b_fg[h]);
                    wave_scan_sum2(b0, b1, lane);
                    const float g0 = i0 - b0, g1 = i1 - b1; float p0 = g0, p1 = g1;
                    wave_scan_max2(p0, p1, lane);
                    sb[2 * lane] = b0; sb[2 * lane + 1] = b1; sg[2 * lane] = g0; sg[2 * lane + 1] = g1; spm[2 * lane] = p0; spm[2 * lane + 1] = p1;
                    swi[2 * lane] = expf(mprev - fmaxf(p0, mprev)); swi[2 * lane + 1] = expf(mprev - fmaxf(p1, mprev));
                } else if (wave == 1) { snp[lane] = M.np0; snp[lane + 64] = M.np1; }
                ml_stage(M, Qt, Kt, Vt, Spt, P.conv_w, P.conv_b, h, tid);
                BAR_LDS();
                SEG(0);
                const int ce = tid >> 2, qd = tid & 3, e0 = qd * 32; const size_t te = t0 + ce;
                ml_issue_a(M, proj, gates, mstb, mn, mm, mi + 1 < mi1 ? mi + 1 : mi, tid, lane);
                const int cb = wave >> 1, ep = wave & 1, r = lane & 31, hl = lane >> 5;
                f32x16 Z0 = zero16(), Z1 = zero16();
                {
                    const int c = cb * 32 + r;
#pragma unroll
                    for (int s = 0; s < 8; ++s) { const bf16x8 qa = frag_row<128>(Qt, cb * 32 + r, s, hl);
                        Z0 = MFMA32(qa, frag_tr<128, false>(Spt, 16 * s, ep * 64, lane), Z0);
                        Z1 = MFMA32(qa, frag_tr<128, false>(Spt, 16 * s, ep * 64 + 32, lane), Z1); }
#pragma unroll
                    for (int reg = 0; reg < 16; ++reg) { const float wi = swi[cb * 32 + crow(reg, hl)]; Z0[reg] *= wi; Z1[reg] *= wi; }
                    const float nc = -fmaxf(spm[c], mprev); float den = 0.f;
                    for (int jb = 0; jb <= cb; ++jb) {
                        f32x16 X = zero16();
#pragma unroll
                        for (int s = 0; s < 8; ++s) X = MFMA32(frag_row<128>(Kt, jb * 32 + r, s, hl), frag_row<128>(Qt, cb * 32 + r, s, hl), X);
                        {
                            f4v gq[4];
#pragma unroll
                            for (int g4 = 0; g4 < 4; ++g4) gq[g4] = *(const LAS f4v*)(sg + jb * 32 + 8 * g4 + 4 * hl);
#pragma unroll
                            for (int reg = 0; reg < 16; ++reg) { const int j = jb * 32 + crow(reg, hl);
                                const float f = __builtin_amdgcn_exp2f(1.4426950408889634f * (nc + gq[reg >> 2][reg & 3]));
                                const float xv = X[reg] * f; X[reg] = j <= c ? xv : 0.f; den += X[reg]; }
                        }
#pragma unroll
                        for (int s2 = 0; s2 < 2; ++s2) { const bf16x8 xs_ = pack_step(X, s2);
                            Z0 = MFMA32(xs_, frag_tr<128, true>(Vt, jb * 32 + 16 * s2, ep * 64, lane), Z0);
                            Z1 = MFMA32(xs_, frag_tr<128, true>(Vt, jb * 32 + 16 * s2, ep * 64 + 32, lane), Z1); }
                    }
                    den += __shfl_xor(den, 32);
                    if (ep == 0 && hl == 0) sden[c] = den;
                }
                BAR_LDS();
                SEG(1);
#pragma unroll
                for (int reg = 0; reg < 16; ++reg) { const int cc = cb * 32 + crow(reg, hl); Zs[cc * 132 + ep * 64 + r] = Z0[reg]; Zs[cc * 132 + ep * 64 + 32 + r] = Z1[reg]; }
                BAR_LDS();
                SEG(2);
                v4u ov[4];
#pragma unroll
                for (int i = 0; i < 4; ++i) ov[i] = __builtin_nontemporal_load((const v4u*)(proj + ml_tile(mi >> 2, 12 + h) + ce * 128 + e0 + 8 * i));
                f4v gnm[8];
#pragma unroll
                for (int i = 0; i < 8; ++i) gnm[i] = *(const f4v*)(P.ml_gn + h * MD + e0 + 4 * i);
                asm volatile("" ::: "memory");
                ml_issue_b(M, proj, mi + 1 < mi1 ? mi + 1 : mi, tid);
                {
                    float qn = 0.f;
#pragma unroll
                    for (int i = 0; i < 4; ++i) { const v4u qv = *(const LAS v4u*)(Qt + toff<128>(ce, 4 * qd + i)); const LAS float* np_ = snp + 32 * qd + 8 * i;
                        qn += blo(qv.x) * np_[0] + bhi(qv.x) * np_[1] + blo(qv.y) * np_[2] + bhi(qv.y) * np_[3] + blo(qv.z) * np_[4] + bhi(qv.z) * np_[5] + blo(qv.w) * np_[6] + bhi(qv.w) * np_[7]; }
                    qn += __shfl_xor(qn, 1); qn += __shfl_xor(qn, 2);
                    const float Mx = fmaxf(spm[ce], mprev), mrow = sb[ce] + Mx;
                    const float den = sden[ce] + swi[ce] * qn;
                    const float inv = 1.0f / fmaxf(fabsf(den), expf(-mrow));
                    float z[32]; float ss = 0.f;
#pragma unroll
                    for (int i = 0; i < 8; ++i) { const f4v v = *(const LAS f4v*)(Zs + ce * 132 + e0 + 4 * i); z[4 * i] = v.x; z[4 * i + 1] = v.y; z[4 * i + 2] = v.z; z[4 * i + 3] = v.w; }
#pragma unroll
                    for (int i = 0; i < 4; ++i) { const v4u ovi = ov[i];
                        const float oo[8] = {blo(ovi.x), bhi(ovi.x), blo(ovi.y), bhi(ovi.y), blo(ovi.z), bhi(ovi.z), blo(ovi.w), bhi(ovi.w)};
#pragma unroll
                        for (int k = 0; k < 8; ++k) { const float v = fast_sig(oo[k]) * z[8 * i + k] * inv; z[8 * i + k] = v; ss += v * v; } }
                    ss += __shfl_xor(ss, 1); ss += __shfl_xor(ss, 2);
                    const float rn = 1.0f / sqrtf(ss * (1.0f / MD) + EPS);
                    bf16_t* yp = yreg + te * D + 512 + h * MD + e0;
#pragma unroll
                    for (int i = 0; i < 4; ++i) { const f4v ga = gnm[2 * i], gb = gnm[2 * i + 1];
                        v4u w; w.x = cvtpk(z[8 * i] * rn * ga.x, z[8 * i + 1] * rn * ga.y); w.y = cvtpk(z[8 * i + 2] * rn * ga.z, z[8 * i + 3] * rn * ga.w);
                        w.z = cvtpk(z[8 * i + 4] * rn * gb.x, z[8 * i + 5] * rn * gb.y); w.w = cvtpk(z[8 * i + 6] * rn * gb.z, z[8 * i + 7] * rn * gb.w);
                        *(v4u*)(yp + 8 * i) = w; }
                }
            }
        }
        BAR_LDS();
        if (PROBE_PH == 101) pt1 = __builtin_amdgcn_s_memrealtime();
#undef BAR_LDS
    }
    GRID_BAR(4);
    if constexpr (IN(5)) {
        PH_IDS
        pg8::Gemm g{yreg, wout_t, T, D, D, nullptr}; pg8::StaticOrder S; S.init(T, D, G, bid);
        pg8::EpiRes E{P.x, (bf16_t*)((unsigned char*)out + OUT_HB)};
        pg8::gemm_phase<pg8::EpiRes, pg8::StaticOrder, true, true>(ldsl, g, S, E);
    }
    GRID_BAR(5);
    if constexpr (IN(6)) {
        PH_IDS
        LAS unsigned char* Bh = ldsl;
        LAS unsigned char* Bl = ldsl + 49920;
        LAS float* Ls = (LAS float*)(ldsl + 106496);
        LAS int* lcnt = (LAS int*)(ldsl + 131584); LAS int* lbase = lcnt + 32;
        const bf16_t* wrh = (const bf16_t*)(ws + WS_WR); const bf16_t* wrl = wrh + 48 * D;
        for (int unit = bid; unit < T / 128; unit += G) {
            const int tok0 = unit * 128 + wave * 16, row = lane & 15, kq = lane >> 4;
            const bf16_t* ap = (const bf16_t*)((unsigned char*)out + OUT_HB) + (size_t)(tok0 + row) * D + 8 * kq;
            pg8::f32x4 c0 = {0.f, 0.f, 0.f, 0.f}, c1 = c0, c2 = c0; float ss = 0.f;
            if (tid < 32) lcnt[tid] = 0;
#pragma unroll 1
            for (int kh = 0; kh < 2; ++kh) {
                __syncthreads();
                for (int idx = tid; idx < 48 * 64; idx += NTHREADS) { const int col = idx >> 6, ch = idx & 63;
                    *(LAS v4u*)(Bh + col * 1040 + ch * 16) = *(const v4u*)(wrh + col * D + kh * 512 + ch * 8);
                    *(LAS v4u*)(Bl + col * 1040 + ch * 16) = *(const v4u*)(wrl + col * D + kh * 512 + ch * 8); }
                __syncthreads();
#pragma unroll 4
                for (int st = 0; st < 16; ++st) {
                    const v4u hq = *(const v4u*)(ap + kh * 512 + st * 32);
                    const float a8[8] = {blo(hq.x), bhi(hq.x), blo(hq.y), bhi(hq.y), blo(hq.z), bhi(hq.z), blo(hq.w), bhi(hq.w)};
#pragma unroll
                    for (int i = 0; i < 8; ++i) ss += a8[i] * a8[i];
                    const bf16x8 af = __builtin_bit_cast(bf16x8, hq);
                    const int bo = row * 1040 + (st * 32 + 8 * kq) * 2;
                    c0 = __builtin_amdgcn_mfma_f32_16x16x32_bf16(af, *(const LAS bf16x8*)(Bh + bo), c0, 0, 0, 0);
                    c0 = __builtin_amdgcn_mfma_f32_16x16x32_bf16(af, *(const LAS bf16x8*)(Bl + bo), c0, 0, 0, 0);
                    c1 = __builtin_amdgcn_mfma_f32_16x16x32_bf16(af, *(const LAS bf16x8*)(Bh + bo + 16 * 1040), c1, 0, 0, 0);
                    c1 = __builtin_amdgcn_mfma_f32_16x16x32_bf16(af, *(const LAS bf16x8*)(Bl + bo + 16 * 1040), c1, 0, 0, 0);
                    c2 = __builtin_amdgcn_mfma_f32_16x16x32_bf16(af, *(const LAS bf16x8*)(Bh + bo + 32 * 1040), c2, 0, 0, 0);
                    c2 = __builtin_amdgcn_mfma_f32_16x16x32_bf16(af, *(const LAS bf16x8*)(Bl + bo + 32 * 1040), c2, 0, 0, 0);
                }
            }
            ss += __shfl_xor(ss, 16); ss += __shfl_xor(ss, 32);
            const float rstd = 1.0f / sqrtf(ss * (1.0f / D) + EPS);
#pragma unroll
            for (int reg = 0; reg < 4; ++reg) { LAS float* lp = Ls + (wave * 16 + 4 * kq + reg) * 49 + row; lp[0] = c0[reg]; lp[16] = c1[reg]; lp[32] = c2[reg]; }
            __syncthreads();
            const int tok = tok0 + row;
            const LAS float* lp = Ls + (wave * 16 + row) * 49;
            float gl[4];
#pragma unroll
            for (int i = 0; i < 4; ++i) gl[i] = lp[i] * rstd + P.b_group[i];
            int gs = 0; float gmax = gl[0];
#pragma unroll
            for (int i = 1; i < 4; ++i) if (gl[i] > gmax) { gmax = gl[i]; gs = i; }
            float gsum = 0.f;
#pragma unroll
            for (int i = 0; i < 4; ++i) gsum += expf(gl[i] - gmax);
            const float pg = 1.0f / gsum;
            float el[8];
#pragma unroll
            for (int i = 0; i < 8; ++i) el[i] = lp[4 + gs * 8 + i] * rstd + P.b_router[gs * 8 + i];
            int i0 = 0; float l0 = el[0];
#pragma unroll
            for (int i = 1; i < 8; ++i) if (el[i] > l0) { l0 = el[i]; i0 = i; }
            int i1 = -1; float l1 = -INFINITY;
#pragma unroll
            for (int i = 0; i < 8; ++i) if (i != i0 && el[i] > l1) { l1 = el[i]; i1 = i; }
            const float rr = expf(l1 - l0);
            const float g0 = pg / (1.0f + rr), g1 = pg * rr / (1.0f + rr);
            const int e0 = gs * 8 + i0, e1 = gs * 8 + i1;
            int lp0 = 0, lp1 = 0;
            if (lane < 16) { lp0 = __hip_atomic_fetch_add(&lcnt[e0], 1, __ATOMIC_RELAXED, __HIP_MEMORY_SCOPE_WORKGROUP); lp1 = __hip_atomic_fetch_add(&lcnt[e1], 1, __ATOMIC_RELAXED, __HIP_MEMORY_SCOPE_WORKGROUP); }
            __syncthreads();
            if (tid < 32) { const int c = lcnt[tid]; lbase[tid] = c ? atomicAdd(&cnt[tid], c) : 0; }
            __syncthreads();
            if (lane < 16) {
                const int p0 = lbase[e0] + lp0, p1 = lbase[e1] + lp1;
                list[(size_t)e0 * T + p0] = tok; list[(size_t)e1 * T + p1] = tok;
                *(int2*)(eid + tok * 2) = make_int2(e0, e1); *(int2*)(posn + tok * 2) = make_int2(p0, p1);
                *(float2*)(gate + tok * 2) = make_float2(g0, g1);
                rstd1[tok] = rstd;
            }
        }
        __syncthreads();
    }
    GRID_BAR(6);
    if constexpr (IN(8) || IN(9) || IN(11)) {
        PH_IDS
        __syncthreads();
        if (tid == 0) { int o = 0; for (int e = 0; e < NE; ++e) { const int c = cnt[e]; s_cnt[e] = c; s_off[e] = o; const int nt = (c + 255) >> 8; for (int i = 0; i < nt; ++i) s_t2e[(o >> 8) + i] = e; o += nt << 8; } s_off[NE] = o; }
        __syncthreads();
    }
    if constexpr (IN(8)) {
        PH_IDS
        const int NS = s_off[NE];
        LAS int* gtok = (LAS int*)(ldsl + RING_BYTES); LAS float* rtab = (LAS float*)(ldsl + RING_BYTES + 6144);
        pg8::GroupedOrder S; S.init(NS >> 8, G, bid, (const LAS int*)s_t2e);
        {   pg8::Unit u;
            for (int ui = 0; ui < 6 && S.next(ui, u); ++ui) {
                const int e = s_t2e[u.pm], base = s_off[e], c = s_cnt[e];
                if (tid < 256) { const int i = u.pm * 256 + tid - base; int tok = 0; float rs = 0.f; if (i < c) { tok = list[(size_t)e * T + i]; rs = rstd1[tok]; } gtok[ui * 256 + tid] = tok; rtab[ui * 256 + tid] = rs; }
            }
        }
        __syncthreads();
        pg8::Gemm g{(const bf16_t*)((unsigned char*)out + OUT_HB), w13_t, NS, NE * 1024, D, (const LAS int*)gtok};
        pg8::EpiSwiglu E{hbuf, (const LAS float*)rtab};
        pg8::gemm_phase<pg8::EpiSwiglu, pg8::GroupedOrder, true, true, true>(ldsl, g, S, E);
        {
            const int nwg8 = (NS >> 8) * 4, full = nwg8 / G, extra = nwg8 - full * G;
            pg8::Gemm g2{pb, wup_t, T, D, PLE, nullptr}; pg8::SkewOrder S2; S2.init((T / 256) * 4, G, bid, extra);
            pg8::EpiStoreBf16 E2{peb, D, 0xffff, part, 0};
            pg8::gemm_phase<pg8::EpiStoreBf16, pg8::SkewOrder, true, true>(ldsl, g2, S2, E2);
        }
    }
    GRID_BAR(8);
    if constexpr (IN(9)) {
        PH_IDS
        const int NS = s_off[NE];
        pg8::Gemm g{hbuf, w2_t, NS, NE * 1024, DE, nullptr}; pg8::GroupedOrder S; S.init(NS >> 8, G, bid, (const LAS int*)s_t2e);
        pg8::EpiStoreBf16 E{ybuf, D, 3, nullptr, 0};
        pg8::gemm_phase<pg8::EpiStoreBf16, pg8::GroupedOrder, true, true>(ldsl, g, S, E);
    }
    GRID_BAR(9);
    if constexpr (IN(11)) {
        PH_IDS
        const bf16_t* hb = (const bf16_t*)((unsigned char*)out + OUT_HB); bf16_t* a2b = (bf16_t*)(ws + WS_A2);
        const int ntrip = T / (2 * NGW);
        int sA[2][2], sB[2][2]; float gA[2][2], gB[2][2]; v4u dA[2][3][2], dB[2][3][2]; float pA[2], pB[2];
#define E0_IDX(s_, g_, trip_) do { _Pragma("unroll") for (int u = 0; u < 2; ++u) { const int row = gw + (2 * (trip_) + u) * NGW; \
            const int2 e2 = *(const int2*)(eid + row * 2), p2 = *(const int2*)(posn + row * 2); const float2 g2 = *(const float2*)(gate + row * 2); \
            s_[u][0] = s_off[e2.x] + p2.x; s_[u][1] = s_off[e2.y] + p2.y; g_[u][0] = g2.x; g_[u][1] = g2.y; } } while (0)
#define E0_LOAD(d_, p_, s_, trip_) do { _Pragma("unroll") for (int u = 0; u < 2; ++u) { const int row = gw + (2 * (trip_) + u) * NGW; \
            _Pragma("unroll") for (int j = 0; j < 2; ++j) { const int k0 = 8 * (lane + 64 * j); \
                d_[u][0][j] = __builtin_nontemporal_load((const v4u*)(hb + (size_t)row * D + k0)); d_[u][1][j] = __builtin_nontemporal_load((const v4u*)(ybuf + (size_t)s_[u][0] * D + k0)); d_[u][2][j] = __builtin_nontemporal_load((const v4u*)(ybuf + (size_t)s_[u][1] * D + k0)); } \
            p_[u] = lane < 16 ? part[(size_t)row * 16 + lane] : 0.f; } } while (0)
#define E0_COMP(d_, p_, g_, trip_) do { _Pragma("unroll") for (int u = 0; u < 2; ++u) { const int row = gw + (2 * (trip_) + u) * NGW; const float g0 = g_[u][0], g1 = g_[u][1]; float ss = 0.f; \
            _Pragma("unroll") for (int j = 0; j < 2; ++j) { const int k0 = 8 * (lane + 64 * j); const v4u hq = d_[u][0][j], y0 = d_[u][1][j], y1 = d_[u][2][j]; float hv[8]; \
                hv[0] = blo(hq.x) + g0 * blo(y0.x) + g1 * blo(y1.x); hv[1] = bhi(hq.x) + g0 * bhi(y0.x) + g1 * bhi(y1.x); \
                hv[2] = blo(hq.y) + g0 * blo(y0.y) + g1 * blo(y1.y); hv[3] = bhi(hq.y) + g0 * bhi(y0.y) + g1 * bhi(y1.y); \
                hv[4] = blo(hq.z) + g0 * blo(y0.z) + g1 * blo(y1.z); hv[5] = bhi(hq.z) + g0 * bhi(y0.z) + g1 * bhi(y1.z); \
                hv[6] = blo(hq.w) + g0 * blo(y0.w) + g1 * blo(y1.w); hv[7] = bhi(hq.w) + g0 * bhi(y0.w) + g1 * bhi(y1.w); \
                v4u o; o.x = cvtpk(hv[0], hv[1]); o.y = cvtpk(hv[2], hv[3]); o.z = cvtpk(hv[4], hv[5]); o.w = cvtpk(hv[6], hv[7]); \
                  \
                const float r8[8] = {blo(o.x), bhi(o.x), blo(o.y), bhi(o.y), blo(o.z), bhi(o.z), blo(o.w), bhi(o.w)}; \
                _Pragma("unroll") for (int i = 0; i < 8; ++i) ss += r8[i] * r8[i]; \
                *(v4u*)(a2b + (size_t)row * D + k0) = o; } \
            ss = wave_sum(ss); const float pe = wave_sum(p_[u]); \
            if (lane == 0) { rstdg[row] = 1.0f / sqrtf(ss * (1.0f / D) + EPS); rstde[row] = 1.0f / sqrtf(pe * (1.0f / D) + EPS); } } } while (0)
        E0_IDX(sA, gA, 0); E0_LOAD(dA, pA, sA, 0);
        E0_IDX(sB, gB, (ntrip > 1 ? 1 : 0));
        for (int trip = 0; trip < ntrip; trip += 2) {
            E0_LOAD(dB, pB, sB, (trip + 1 < ntrip ? trip + 1 : ntrip - 1));
            E0_COMP(dA, pA, gA, trip);
            E0_IDX(sA, gA, (trip + 2 < ntrip ? trip + 2 : ntrip - 1));
            if (trip + 1 < ntrip) {
                E0_LOAD(dA, pA, sA, (trip + 2 < ntrip ? trip + 2 : ntrip - 1));
                E0_COMP(dB, pB, gB, trip + 1);
                E0_IDX(sB, gB, (trip + 3 < ntrip ? trip + 3 : ntrip - 1));
            }
        }
#undef E0_IDX
#undef E0_LOAD
#undef E0_COMP
    }
    GRID_BAR(11);
    if constexpr (IN(12)) {
        PH_IDS
        pg8::Gemm g{(const bf16_t*)(ws + WS_A2), wgate_t, T, D, D, nullptr}; pg8::StaticOrder S; S.init(T, D, G, bid);
        pg8::EpiGate E{(bf16_t*)(ws + WS_H3B), (const bf16_t*)(ws + WS_A2), peb, rstdg, rstde, P.ple_norm, part2};
        pg8::gemm_phase<pg8::EpiGate, pg8::StaticOrder, true, true>(ldsl, g, S, E);
    }
    GRID_BAR(12);
    if constexpr (IN(13)) {
        PH_IDS
        const bf16_t* h3b = (const bf16_t*)(ws + WS_H3B);
        for (int row0 = gw; row0 < T; row0 += 2 * NGW) {
            v4u hq[2][2]; float ssv[2];
#pragma unroll
            for (int u = 0; u < 2; ++u) { const int row = row0 + u * NGW; hq[u][0] = __builtin_nontemporal_load((const v4u*)(h3b + (size_t)row * D + 8 * lane)); hq[u][1] = __builtin_nontemporal_load((const v4u*)(h3b + (size_t)row * D + 8 * (lane + 64)));
                ssv[u] = lane < 16 ? part2[(size_t)row * 16 + lane] : 0.f; }
#pragma unroll
            for (int u = 0; u < 2; ++u) {
                const int row = row0 + u * NGW;
                const float rstd = 1.0f / sqrtf(wave_sum(ssv[u]) * (1.0f / D) + EPS);
#pragma unroll
                for (int j = 0; j < 2; ++j) { const int k0 = 8 * (lane + 64 * j); const v4u q = hq[u][j];
                    const f4v n0 = *(const f4v*)(P.final_norm + k0), n1 = *(const f4v*)(P.final_norm + k0 + 4);
                    f4v o0, o1; o0.x = blo(q.x) * rstd * n0.x; o0.y = bhi(q.x) * rstd * n0.y; o0.z = blo(q.y) * rstd * n0.z; o0.w = bhi(q.y) * rstd * n0.w;
                    o1.x = blo(q.z) * rstd * n1.x; o1.y = bhi(q.z) * rstd * n1.y; o1.z = blo(q.w) * rstd * n1.z; o1.w = bhi(q.w) * rstd * n1.w;
                    __builtin_nontemporal_store(o0, (f4v*)(out + (size_t)row * D + k0)); __builtin_nontemporal_store(o1, (f4v*)(out + (size_t)row * D + k0 + 4)); }
            }
        }
    }
    if (PROBE_PH >= 0) {
        if (PROBE_PH == NPHASES - 1) pt1 = __builtin_amdgcn_s_memrealtime();
        if (bid == 0 && threadIdx.x == 0) { const unsigned long long dt = (PROBE_PH >= 110 && PROBE_PH < 140) ? pseg : pt1 - pt0, te = __builtin_amdgcn_s_memrealtime(); while (__builtin_amdgcn_s_memrealtime() - te < 9ull * dt) __builtin_amdgcn_s_sleep(8); }
    }
#undef GRID_BAR
#undef PH_IDS
#undef IN
#undef SEG
#undef rstd1
#undef gates
#undef rstdg
#undef rstde
#undef eid
#undef posn
#undef gate
#undef mn
#undef ml
#undef mbl
#undef mm
#undef list
#undef cnt
#undef part
#undef part2
#undef win_t
#undef wout_t
#undef w13_t
#undef w2_t
#undef wgate_t
#undef wup_t
#undef proj
#undef hbuf
#undef xs
#undef ybuf
#undef peb
#undef yreg
#undef pb
#undef rst
#undef mst
}

template <int PH> static void launch_one(int grid, const Params& p, hipStream_t stream) {
    static bool attr_done = false;
    if (!attr_done) { (void)hipFuncSetAttribute((const void*)mk<PH, PH + 1>, hipFuncAttributeMaxDynamicSharedMemorySize, LDS_BYTES); attr_done = true; }
    hipLaunchKernelGGL((mk<PH, PH + 1>), dim3(grid), dim3(NTHREADS), LDS_BYTES, stream, p);
}
template <int PH> static void launch_all(int grid, const Params& p, hipStream_t stream) {
    if constexpr (PH < NPHASES) { launch_one<PH>(grid, p, stream); launch_all<PH + 1>(grid, p, stream); }
}
#ifndef MK_N_LAUNCHES
#define MK_N_LAUNCHES 1
#endif

extern "C" void kernel_launch(void* const* d_in, const int* in_sizes, int n_in, void* d_out, int out_size, void* d_ws, size_t ws_size, hipStream_t stream) {
    static int grid = 0;
    if (grid == 0) {
        if (n_in != 25 || in_sizes[0] != T * D || out_size != T * D || ws_size < WS_END) {
            fprintf(stderr, "kernel_launch: unexpected shapes: n_in %d in0 %d out %d ws %zu\n", n_in, n_in > 0 ? in_sizes[0] : -1, out_size, ws_size); grid = -1; return; }
        int dev = 0, cus = 0;
        (void)hipGetDevice(&dev); (void)hipDeviceGetAttribute(&cus, hipDeviceAttributeMultiprocessorCount, dev);
        (void)hipGetLastError();
        if (cus < 256) { fprintf(stderr, "kernel_launch: this kernel's phase maps are built for a 256-workgroup grid (one per CU of a 256-CU device); the device reports %d CUs; nothing launched\n", cus); grid = -1; return; }
        grid = 256;
        if (MK_N_LAUNCHES == 1) {
            int per_cu = 0;
            if (hipFuncSetAttribute((const void*)mk<0, NPHASES>, hipFuncAttributeMaxDynamicSharedMemorySize, LDS_BYTES) != hipSuccess) { fprintf(stderr, "kernel_launch: hipFuncSetAttribute failed\n"); grid = -1; return; }
            if (hipOccupancyMaxActiveBlocksPerMultiprocessor(&per_cu, (const void*)mk<0, NPHASES>, NTHREADS, LDS_BYTES) != hipSuccess || per_cu < 1) { fprintf(stderr, "kernel_launch: occupancy query reports %d workgroups per CU; the grid barrier needs one resident workgroup per CU; nothing launched\n", per_cu); grid = -1; return; }
            (void)hipGetLastError();
        }
    }
    if (grid < 0) return;
    (void)hipMemsetAsync((char*)d_ws + WS_CTL, 0, 1 * MiB, stream);
    Params p{};
    p.x = (const float*)d_in[0]; p.p = (const float*)d_in[1]; p.pos = (const int*)d_in[2];
    p.attn_norm = (const float*)d_in[3]; p.w_in = (const float*)d_in[4]; p.conv_w = (const float*)d_in[5]; p.conv_b = (const float*)d_in[6];
    p.b_ig = (const float*)d_in[7]; p.b_fg = (const float*)d_in[8]; p.ret_gn = (const float*)d_in[9]; p.ml_gn = (const float*)d_in[10];
    p.w_out = (const float*)d_in[11]; p.moe_norm = (const float*)d_in[12]; p.w_group = (const float*)d_in[13]; p.b_group = (const float*)d_in[14];
    p.w_router = (const float*)d_in[15]; p.b_router = (const float*)d_in[16]; p.w1 = (const float*)d_in[17]; p.w3 = (const float*)d_in[18]; p.w2 = (const float*)d_in[19];
    p.w_up = (const float*)d_in[20]; p.ple_norm = (const float*)d_in[21]; p.pg_norm = (const float*)d_in[22]; p.w_gate = (const float*)d_in[23]; p.final_norm = (const float*)d_in[24];
    p.out = (float*)d_out; p.ws = (unsigned char*)d_ws;
    if (MK_N_LAUNCHES == 1) hipLaunchKernelGGL((mk<0, NPHASES>), dim3(grid), dim3(NTHREADS), LDS_BYTES, stream, p);
    else launch_all<0>(grid, p, stream);
}
```

```cpp
#include <hip/hip_runtime.h>
#include <cstdio>
#include <cstdint>

constexpr int D = 1024, BATCH = 4, SEQ = 8192, T = BATCH * SEQ, PLE = 256;
constexpr int NPROJ = 4104, NP = 4096;
constexpr int CH = 128, NCH = SEQ / CH;
constexpr int RH = 8, RD = 64, MH = 4, MD = 128;
constexpr int NE = 32, DE = 512;
constexpr float EPS = 1e-6f;
constexpr int C_RQ = 0, C_RK = 512, C_RV = 1024, C_RG = 1536, C_MQ = 2048, C_MK = 2560, C_MV = 3072, C_MO = 3584;

constexpr size_t MiB = 1u << 20;
constexpr size_t WS_CTL = 0;
constexpr size_t WS_RSTD1 = 1 * MiB;
constexpr size_t WS_GATES = WS_RSTD1 + 256 * 1024;
constexpr size_t WS_SLOTR = 2560 * 1024;
constexpr size_t WS_RSTDG = 3 * MiB;
constexpr size_t WS_RSTDE = WS_RSTDG + 256 * 1024;
constexpr size_t WS_EID = 4 * MiB;
constexpr size_t WS_POS = WS_EID + 256 * 1024;
constexpr size_t WS_GATE = WS_POS + 256 * 1024;
constexpr size_t WS_MN = 5 * MiB;
constexpr size_t WS_ML = WS_MN + 512 * 1024;
constexpr size_t WS_MBL = WS_ML + 4096;
constexpr size_t WS_MM = WS_MBL + 4096;
constexpr size_t WS_WR = 6 * MiB;
constexpr size_t WS_LIST = 8 * MiB;
constexpr size_t WS_PART = 12 * MiB;
constexpr size_t WS_PART2 = 14 * MiB;
constexpr size_t WS_WIN = 16 * MiB;
constexpr size_t WS_WOUT = 24 * MiB;
constexpr size_t WS_W13 = 26 * MiB;
constexpr size_t WS_W2 = 90 * MiB;
constexpr size_t WS_WGATE = 122 * MiB;
constexpr size_t WS_WUP = 124 * MiB;
constexpr size_t WS_PROJ = 128 * MiB;
constexpr size_t WS_HBUF = 128 * MiB;
constexpr size_t WS_XS = 200 * MiB;
constexpr size_t WS_YBUF = 200 * MiB;
constexpr size_t WS_A2 = 128 * MiB;
constexpr size_t WS_H3B = 200 * MiB;
constexpr size_t WS_PEB = 344 * MiB;
constexpr size_t WS_YREG = 384 * MiB;
constexpr size_t WS_PB = 448 * MiB;
constexpr size_t WS_CS = 464 * MiB;
constexpr size_t WS_RSTB = 472 * MiB;
constexpr size_t WS_END = 488 * MiB;
constexpr size_t OUT_RST = 0;
constexpr size_t OUT_MST = 32 * MiB;
constexpr size_t OUT_HB = 0;
constexpr size_t OUT_MSTB = 96 * MiB;
constexpr int CW_CNT = 64;
constexpr int CW_BAR = 4096;

constexpr int NTHREADS = 512, NWAVES = 8;
constexpr int RING_BYTES = 131072;
constexpr int LDSX_OFF = 143360;
constexpr int LDS_BYTES = 147456;

__host__ __device__ __forceinline__ size_t pix(size_t t, int col) {
    const size_t bn = t >> 7; const int r = (int)(t & 127);
    return bn * (size_t)(CH * NP) + (col < 2048 ? (size_t)((col >> 6) * (CH * 64) + r * 64 + (col & 63)) : (size_t)(CH * 2048 + ((col - 2048) >> 7) * (CH * 128) + r * 128 + (col & 127)));
}
#define GAS __attribute__((address_space(1)))
#define LAS __attribute__((address_space(3)))
typedef unsigned short bf16_t;
typedef unsigned v4u __attribute__((ext_vector_type(4)));
typedef unsigned v2u __attribute__((ext_vector_type(2)));
__device__ __forceinline__ float bf2f(bf16_t h) { return __uint_as_float((unsigned)h << 16); }
__device__ __forceinline__ unsigned f2bf(float f) { unsigned u = __float_as_uint(f); return (u + 0x7fffu + ((u >> 16) & 1u)) >> 16; }
__device__ __forceinline__ unsigned pk2(float lo, float hi) { return f2bf(lo) | (f2bf(hi) << 16); }
__device__ __forceinline__ float wave_sum(float v) {
#pragma unroll
    for (int o = 1; o < 64; o <<= 1) v += __shfl_xor(v, o);
    return v;
}
__device__ __forceinline__ float sigmoidf_(float x) { return 1.0f / (1.0f + expf(-x)); }
__device__ __forceinline__ float siluf_(float x) { return x / (1.0f + expf(-x)); }
__device__ __forceinline__ float logsigmoidf_(float x) { return x >= 0.f ? -log1pf(expf(-x)) : x - log1pf(expf(x)); }
#define LDS_WAIT() asm volatile("s_waitcnt lgkmcnt(0)" ::: "memory")

namespace pg8 {
#define PG8_LAS __attribute__((address_space(3)))
typedef unsigned short bf16_t;
typedef short bf16x8 __attribute__((ext_vector_type(8)));
typedef float f32x4 __attribute__((ext_vector_type(4)));
typedef unsigned u32x4 __attribute__((ext_vector_type(4)));
constexpr int BM = 256, BK = 64, HALF = 128, HTB = HALF * BK * 2  , STAGE_BYTES = 8 * HTB, NXCD = 8, WGM = 8;

__host__ __device__ __forceinline__ int lds_byte(int r, int c) { const int st = (r >> 4) * 2 + (c >> 5), rr = r & 15, cc = c & 31, ob = rr * 64 + cc * 2; return st * 1024 + (ob ^ (((ob >> 9) & 1) << 5)); }
__host__ __device__ __forceinline__ void stage_rc(int b, int& R, int& C) { const int st = b / 1024, sb = b % 1024, swz = sb ^ (((sb >> 9) & 1) << 5); R = (st >> 1) * 16 + swz / 64; C = (st & 1) * 32 + (swz % 64) / 2; }
__host__ __device__ __forceinline__ int perm32(int rho) { const int n = rho >> 4, i = rho & 15; return 8 * (i >> 2) + 4 * n + (i & 3); }

struct Unit { int pm, pn, ord; };
struct Gemm { const bf16_t* A; const bf16_t* Bt; int M, N, K; const PG8_LAS int* gtok; };

struct StaticOrder {
    int nM, nN, nwg, G, c;
    __host__ __device__ __forceinline__ void init(int M, int N, int G_, int c_) { nM = M / BM; nN = N / BM; nwg = nM * nN; G = G_; c = c_; }
    __host__ __device__ __forceinline__ bool next(int i, Unit& u) const {
        const long L = (long)i * G + c; if (L >= nwg) return false;
        int wgid = (int)L; { const int q = nwg / NXCD, r = nwg % NXCD, xcd = wgid % NXCD, off = wgid / NXCD; wgid = (xcd < r ? xcd * (q + 1) : r * (q + 1) + (xcd - r) * q) + off; }
        const int nig = WGM * nN, gid = wgid / nig, fm = gid * WGM, gsz = (nM - fm) < WGM ? (nM - fm) : WGM;
        u.pm = fm + ((wgid % nig) % gsz); u.pn = (wgid % nig) / gsz; u.ord = i; return true;
    }
    __device__ __forceinline__ void a_ready(const Unit&) const {}
    __device__ __forceinline__ void done(const Unit&) const {}
};

__device__ __forceinline__ unsigned cvt_pk_bf16(float lo, float hi) { unsigned r; asm volatile("v_cvt_pk_bf16_f32 %0, %1, %2" : "=v"(r) : "v"(lo), "v"(hi)); return r; }
typedef float f32x2 __attribute__((ext_vector_type(2)));
struct GroupedOrder {
    int nM, nwg, G, c; const PG8_LAS int* t2e;
    __device__ __forceinline__ void init(int nM_, int G_, int c_, const PG8_LAS int* t2e_) { nM = nM_; nwg = nM_ * 4; G = G_; c = c_; t2e = t2e_; }
    __device__ __forceinline__ bool next(int i, Unit& u) const {
        const long L = (long)i * G + c; if (L >= nwg) return false;
        int wgid = (int)L; { const int q = nwg / NXCD, r = nwg % NXCD, xcd = wgid % NXCD, off = wgid / NXCD; wgid = (xcd < r ? xcd * (q + 1) : r * (q + 1) + (xcd - r) * q) + off; }
        const int nig = WGM * 4, gid = wgid / nig, fm = gid * WGM, gsz = (nM - fm) < WGM ? (nM - fm) : WGM;
        u.pm = fm + ((wgid % nig) % gsz); u.pn = (wgid % nig) / gsz + 4 * t2e[u.pm]; u.ord = i; return true;
    }
    __device__ __forceinline__ void a_ready(const Unit&) const {}
    __device__ __forceinline__ void done(const Unit&) const {}
};
struct SkewOrder {
    int nunits, stride, j;
    __device__ __forceinline__ void init(int nunits_, int G_, int c_, int skip_) { if (skip_ >= G_) skip_ = 0; nunits = nunits_; stride = G_ - skip_; j = c_ - skip_; }
    __device__ __forceinline__ bool next(int i, Unit& u) const { if (j < 0) return false; const int idx = j + i * stride; if (idx >= nunits) return false; u.pm = idx >> 2; u.pn = idx & 3; u.ord = i; return true; }
    __device__ __forceinline__ void a_ready(const Unit&) const {}
    __device__ __forceinline__ void done(const Unit&) const {}
};
__device__ __forceinline__ float fast_sigmoid(float x) { return __builtin_amdgcn_rcpf(1.0f + __builtin_amdgcn_exp2f(-1.4426950408889634f * x)); }
struct EpiStoreBf16 {
    static constexpr bool PERM = true, AFTER_DRAIN = false;
    bf16_t* O; int ldc; int pn_mask; float* part; int blocked;
    __device__ __forceinline__ void operator()(const f32x4 (&acc)[2][2][4][2], const Unit& u, int wr, int wc, int fr, int fq) const {
        const int pnl = u.pn & pn_mask; const int row0 = u.pm * BM + wr * 64 + fr, col0 = pnl * BM + wc * 32 + 8 * fq;
#pragma unroll
        for (int ai = 0; ai < 2; ++ai)
#pragma unroll
            for (int m = 0; m < 4; ++m) { const int row = row0 + ai * HALF + m * 16; bf16_t* rowp = O + (size_t)row * ldc + col0; bf16_t* rowq = rowp + HALF;
                if (blocked) { rowp = O + pix((size_t)row, col0); rowq = O + pix((size_t)row, col0 + HALF); }
                float s = 0.f;
#pragma unroll
                for (int bj = 0; bj < 2; ++bj) { const f32x4 v0 = acc[ai][bj][m][0], v1 = acc[ai][bj][m][1];
                    u32x4 w; w.x = cvt_pk_bf16(v0[0], v0[1]); w.y = cvt_pk_bf16(v0[2], v0[3]); w.z = cvt_pk_bf16(v1[0], v1[1]); w.w = cvt_pk_bf16(v1[2], v1[3]);
                    if (blocked) __builtin_nontemporal_store(w, (u32x4*)(bj ? rowq : rowp)); else *(u32x4*)(bj ? rowq : rowp) = w;
                    s += (v0[0] * v0[0] + v0[1] * v0[1]) + (v0[2] * v0[2] + v0[3] * v0[3]) + (v1[0] * v1[0] + v1[1] * v1[1]) + (v1[2] * v1[2] + v1[3] * v1[3]); }
                if (part) { s += __shfl_xor(s, 16); s += __shfl_xor(s, 32); if (fq == 0) part[(size_t)row * 16 + pnl * 4 + wc] = s; } }
    }
};
struct EpiSwiglu {
    static constexpr bool PERM = true, AFTER_DRAIN = false;
    bf16_t* H; const PG8_LAS float* rtab;
    __device__ __forceinline__ void operator()(const f32x4 (&acc)[2][2][4][2], const Unit& u, int wr, int wc, int fr, int fq) const {
        const int pnl = u.pn & 3; const int row0 = u.pm * BM + wr * 64 + fr, col0 = pnl * HALF + wc * 32 + 8 * fq;
#pragma unroll
        for (int ai = 0; ai < 2; ++ai)
#pragma unroll
            for (int m = 0; m < 4; ++m) { const int row = row0 + ai * HALF + m * 16; bf16_t* rowp = H + (size_t)row * 512 + col0; const float rs = rtab[u.ord * 256 + (row - u.pm * BM)];
                f32x4 h[2];
#pragma unroll
                for (int n = 0; n < 2; ++n) { const f32x4 a = acc[ai][0][m][n] * rs, b = acc[ai][1][m][n] * rs;
#pragma unroll
                    for (int j = 0; j < 4; ++j) h[n][j] = a[j] * fast_sigmoid(a[j]) * b[j]; }
                u32x4 w; w.x = cvt_pk_bf16(h[0][0], h[0][1]); w.y = cvt_pk_bf16(h[0][2], h[0][3]); w.z = cvt_pk_bf16(h[1][0], h[1][1]); w.w = cvt_pk_bf16(h[1][2], h[1][3]);
                *(u32x4*)rowp = w; }
    }
};
struct EpiRes {
    static constexpr bool PERM = true, AFTER_DRAIN = false;
    const float* base; bf16_t* hb;
    __device__ __forceinline__ void operator()(const f32x4 (&acc)[2][2][4][2], const Unit& u, int wr, int wc, int fr, int fq) const {
        const int row0 = u.pm * BM + wr * 64 + fr, col0 = u.pn * BM + wc * 32 + 8 * fq;
#pragma unroll
        for (int ai = 0; ai < 2; ++ai) {
            f32x4 xv[4][2][2];
#pragma unroll
            for (int m = 0; m < 4; ++m) { const size_t off = (size_t)(row0 + ai * HALF + m * 16) * 1024 + col0;
#pragma unroll
                for (int bj = 0; bj < 2; ++bj) { xv[m][bj][0] = __builtin_nontemporal_load((const f32x4*)(base + off + bj * HALF)); xv[m][bj][1] = __builtin_nontemporal_load((const f32x4*)(base + off + bj * HALF + 4)); } }
#pragma unroll
            for (int m = 0; m < 4; ++m) { const size_t off = (size_t)(row0 + ai * HALF + m * 16) * 1024 + col0;
#pragma unroll
                for (int bj = 0; bj < 2; ++bj) { const f32x4 v0 = xv[m][bj][0] + acc[ai][bj][m][0], v1 = xv[m][bj][1] + acc[ai][bj][m][1];
                    u32x4 w; w.x = cvt_pk_bf16(v0[0], v0[1]); w.y = cvt_pk_bf16(v0[2], v0[3]); w.z = cvt_pk_bf16(v1[0], v1[1]); w.w = cvt_pk_bf16(v1[2], v1[3]);
                    *(u32x4*)(hb + off + bj * HALF) = w; } }
            asm volatile("" ::: "memory");
        }
    }
};
struct EpiGate {
    static constexpr bool PERM = true, AFTER_DRAIN = false;
    bf16_t* h3; const bf16_t* a2; const bf16_t* peb; const float* rstdg; const float* rstde; const float* ple_norm; float* part;
    __device__ __forceinline__ void operator()(const f32x4 (&acc)[2][2][4][2], const Unit& u, int wr, int wc, int fr, int fq) const {
        const int row0 = u.pm * BM + wr * 64 + fr, col0 = u.pn * BM + wc * 32 + 8 * fq;
        f32x4 pn4[2][2];
#pragma unroll
        for (int bj = 0; bj < 2; ++bj)
#pragma unroll
            for (int n = 0; n < 2; ++n) pn4[bj][n] = *(const f32x4*)(ple_norm + col0 + bj * HALF + n * 4);
#pragma unroll
        for (int ap = 0; ap < 4; ++ap) { const int ai = ap >> 1, m0 = (ap & 1) * 2;
            u32x4 pev[4][2], hqv[4][2]; float rgv[4], rev[4];
#pragma unroll
            for (int m = m0; m < m0 + 2; ++m) { const int row = row0 + ai * HALF + m * 16; const size_t off = (size_t)row * 1024 + col0; rgv[m] = rstdg[row]; rev[m] = rstde[row];
#pragma unroll
                for (int bj = 0; bj < 2; ++bj) { pev[m][bj] = __builtin_nontemporal_load((const u32x4*)(peb + off + bj * HALF)); hqv[m][bj] = *(const u32x4*)(a2 + off + bj * HALF); } }
#pragma unroll
            for (int m = m0; m < m0 + 2; ++m) { const int row = row0 + ai * HALF + m * 16; const size_t off = (size_t)row * 1024 + col0; const float rg = rgv[m], re = rev[m]; float s = 0.f;
#pragma unroll
                for (int bj = 0; bj < 2; ++bj) { const size_t o = off + bj * HALF;
                    const u32x4 pe = pev[m][bj], hq = hqv[m][bj];
                    float hv[8];
#pragma unroll
                    for (int n = 0; n < 2; ++n) { const f32x4 a = acc[ai][bj][m][n]; const unsigned p0 = n ? pe.z : pe.x, p1 = n ? pe.w : pe.y, h0 = n ? hq.z : hq.x, h1 = n ? hq.w : hq.y;
                        const float e4[4] = {__uint_as_float(p0 << 16), __uint_as_float(p0 & 0xffff0000u), __uint_as_float(p1 << 16), __uint_as_float(p1 & 0xffff0000u)};
                        const float b4[4] = {__uint_as_float(h0 << 16), __uint_as_float(h0 & 0xffff0000u), __uint_as_float(h1 << 16), __uint_as_float(h1 & 0xffff0000u)};
#pragma unroll
                        for (int j = 0; j < 4; ++j) hv[4 * n + j] = b4[j] + fast_sigmoid(rg * a[j]) * (e4[j] * re * pn4[bj][n][j]); }
                    u32x4 w; w.x = cvt_pk_bf16(hv[0], hv[1]); w.y = cvt_pk_bf16(hv[2], hv[3]); w.z = cvt_pk_bf16(hv[4], hv[5]); w.w = cvt_pk_bf16(hv[6], hv[7]);
                    *(u32x4*)(h3 + o) = w;
                    const float r8[8] = {__uint_as_float(w.x << 16), __uint_as_float(w.x & 0xffff0000u), __uint_as_float(w.y << 16), __uint_as_float(w.y & 0xffff0000u), __uint_as_float(w.z << 16), __uint_as_float(w.z & 0xffff0000u), __uint_as_float(w.w << 16), __uint_as_float(w.w & 0xffff0000u)};
#pragma unroll
                    for (int j = 0; j < 8; ++j) s += r8[j] * r8[j]; }
                s += __shfl_xor(s, 16); s += __shfl_xor(s, 32); if (fq == 0) part[(size_t)row * 16 + u.pn * 4 + wc] = s; }
            asm volatile("" ::: "memory");
        }
    }
};

template <class Epi, class Sched, bool ALIGN_EPI = false, bool SP2 = false, bool GATHER = false>
__device__ __forceinline__ void gemm_phase(PG8_LAS unsigned char* lds, const Gemm g, const Sched& S, const Epi& E) {
    int tid_l = threadIdx.x; asm volatile("" : "+v"(tid_l));
    const int tid = tid_l, wid = __builtin_amdgcn_readfirstlane(tid >> 6), lane = tid & 63, wr = wid >> 2, wc = wid & 3, fr = lane & 15, fq = lane >> 4;
    const int K = g.K, nt = K / BK;
    unsigned voffA[2], voffB[2];
    int RAi[2]; unsigned CA2[2];
#pragma unroll
    for (int i = 0; i < 2; ++i) { int R, C; stage_rc(tid * 16 + i * 8192, R, C); const int Rb = Epi::PERM ? ((R & ~31) + perm32(R & 31)) : R;
        voffA[i] = (unsigned)(R * K + C) * 2u; voffB[i] = (unsigned)(Rb * K + C) * 2u; RAi[i] = R; CA2[i] = (unsigned)C * 2u; }
    unsigned gvc[2][2] = {{0u, 0u}, {0u, 0u}}, gvn[2][2] = {{0u, 0u}, {0u, 0u}};
#define PG8_GOFF(gv, ord_) do { _Pragma("unroll") for (int _h = 0; _h < 2; ++_h) _Pragma("unroll") for (int _i = 0; _i < 2; ++_i) \
        gv[_h][_i] = (unsigned)g.gtok[(ord_) * 256 + _h * HALF + RAi[_i]] * (unsigned)(K * 2) + CA2[_i]; } while (0)
    const size_t kstep = (size_t)(BK * 2);
    const size_t hstep = (size_t)HALF * K * 2;
    const size_t tstep = 2 * hstep;
    const unsigned ldsw = (unsigned)wid * 1024u;
    const int aoff = lds_byte(wr * 64 + fr, fq * 8), boff = lds_byte(wc * 32 + fr, fq * 8);
#define PG8_SA(b, h) (((b) * 2 + (h)) * HTB)
#define PG8_SB(b, h) ((4 + (b) * 2 + (h)) * HTB)
#define PG8_STAGE(bufoff, gbase, voff) do { _Pragma("unroll") for (int _i = 0; _i < 2; ++_i) \
        __builtin_amdgcn_global_load_lds((const unsigned*)((const char*)(gbase) + (voff)[_i]), (PG8_LAS unsigned*)(lds + (bufoff) + ldsw + _i * 8192), 16, 0, 0); } while (0)
#define PG8_STAGEA(bufoff, gbase, h, sel) do { _Pragma("unroll") for (int _i = 0; _i < 2; ++_i) { \
        const char* _p = GATHER ? (const char*)(gbase) + ((sel) ? gvn[h][_i] : gvc[h][_i]) : (const char*)(gbase) + (size_t)(h) * hstep + voffA[_i]; \
        __builtin_amdgcn_global_load_lds((const unsigned*)_p, (PG8_LAS unsigned*)(lds + (bufoff) + ldsw + _i * 8192), 16, 0, 0); } } while (0)
#define PG8_LDA(dst, b, h) do { _Pragma("unroll") for (int m = 0; m < 4; ++m) _Pragma("unroll") for (int k = 0; k < 2; ++k) dst[m][k] = *(const PG8_LAS bf16x8*)(lds + PG8_SA(b, h) + aoff + m * 2048 + k * 1024); } while (0)
#define PG8_LDB(dst, b, h) do { _Pragma("unroll") for (int n = 0; n < 2; ++n) _Pragma("unroll") for (int k = 0; k < 2; ++k) dst[n][k] = *(const PG8_LAS bf16x8*)(lds + PG8_SB(b, h) + boff + n * 2048 + k * 1024); } while (0)
#define PG8_MMA(ai, bj, At, Bt) do { __builtin_amdgcn_s_setprio(1); _Pragma("unroll") for (int m = 0; m < 4; ++m) _Pragma("unroll") for (int n = 0; n < 2; ++n) _Pragma("unroll") for (int k = 0; k < 2; ++k) \
        acc[ai][bj][m][n] = __builtin_amdgcn_mfma_f32_16x16x32_bf16(Bt[n][k], At[m][k], acc[ai][bj][m][n], 0, 0, 0); __builtin_amdgcn_s_setprio(0); } while (0)
#define PG8_WAIT_V(n) asm volatile("s_waitcnt vmcnt(" #n ")" ::: "memory")
#define PG8_WAIT_L(n) asm volatile("s_waitcnt lgkmcnt(" #n ")" ::: "memory")
#define PG8_BAR __builtin_amdgcn_s_barrier()
#define PG8_SCHED __builtin_amdgcn_sched_barrier(0)
    Unit cur, nxt; int ui = 0;
    if (!S.next(0, cur)) return;
    f32x4 acc[2][2][4][2];
#pragma unroll
    for (int a = 0; a < 2; ++a)
#pragma unroll
        for (int b = 0; b < 2; ++b)
#pragma unroll
            for (int m = 0; m < 4; ++m)
#pragma unroll
                for (int n = 0; n < 2; ++n) acc[a][b][m][n] = (f32x4){0.f, 0.f, 0.f, 0.f};
    bf16x8 At[4][2], B0[2][2], B1[2][2];
    const char* cA = GATHER ? (const char*)g.A : (const char*)g.A + (size_t)cur.pm * tstep; const char* cB = (const char*)g.Bt + (size_t)cur.pn * tstep;
    if constexpr (GATHER) PG8_GOFF(gvc, cur.ord);
    S.a_ready(cur);
    if constexpr (SP2) {
        PG8_STAGE(PG8_SB(0, 0), cB, voffB); PG8_STAGE(PG8_SB(0, 1), cB + hstep, voffB); PG8_STAGEA(PG8_SA(0, 0), cA, 0, false); PG8_STAGEA(PG8_SA(0, 1), cA, 1, false);
        if (wr == 1) PG8_BAR;
        PG8_WAIT_V(2); PG8_BAR;
        PG8_STAGE(PG8_SB(1, 0), cB + kstep, voffB); PG8_STAGEA(PG8_SA(1, 0), cA + kstep, 0, false); PG8_STAGE(PG8_SB(1, 1), cB + hstep + kstep, voffB);
        PG8_WAIT_V(6); PG8_BAR;
    } else {
        PG8_STAGE(PG8_SB(0, 0), cB, voffB); PG8_STAGEA(PG8_SA(0, 0), cA, 0, false); PG8_STAGE(PG8_SB(0, 1), cB + hstep, voffB); PG8_STAGEA(PG8_SA(0, 1), cA, 1, false);
        if (wr == 1) PG8_BAR;
        PG8_WAIT_V(4); PG8_BAR;
        PG8_STAGE(PG8_SB(1, 0), cB + kstep, voffB); PG8_STAGEA(PG8_SA(1, 0), cA + kstep, 0, false); PG8_STAGE(PG8_SB(1, 1), cB + hstep + kstep, voffB);
        PG8_WAIT_V(6); PG8_BAR;
    }
    for (;;) {
        const bool has_next = S.next(ui + 1, nxt);
        const char* nA = GATHER ? (const char*)g.A : (has_next ? (const char*)g.A + (size_t)nxt.pm * tstep : cA); const char* nB = has_next ? (const char*)g.Bt + (size_t)nxt.pn * tstep : cB;
        if constexpr (GATHER) { if (has_next) PG8_GOFF(gvn, nxt.ord); }
        for (int t = 0; t < nt; t += 2) {
            const bool last = (t == nt - 2); const bool seln = last && has_next; (void)seln;
            const char* a1 = cA + (size_t)(t + 1) * kstep;
            const char* a2 = last ? nA : cA + (size_t)(t + 2) * kstep; const char* b2 = last ? nB : cB + (size_t)(t + 2) * kstep;
            const char* a3 = a2 + kstep; const char* b3 = b2 + kstep;
            if (last && has_next) S.a_ready(nxt);
            if constexpr (SP2) {
            PG8_LDB(B0, 0, 0); PG8_LDB(B1, 0, 1); PG8_SCHED; PG8_LDA(At, 0, 0); PG8_STAGEA(PG8_SA(1, 1), a1, 1, false);
            PG8_WAIT_V(8); PG8_WAIT_L(0); PG8_BAR; PG8_MMA(0, 0, At, B0); PG8_MMA(0, 1, At, B1); PG8_BAR; PG8_SCHED;
            PG8_LDA(At, 0, 1); PG8_STAGE(PG8_SB(0, 0), b2, voffB); PG8_STAGE(PG8_SB(0, 1), b2 + hstep, voffB); PG8_STAGEA(PG8_SA(0, 0), a2, 0, seln);
            PG8_WAIT_V(8); PG8_WAIT_L(0); PG8_BAR; PG8_MMA(1, 0, At, B0); PG8_MMA(1, 1, At, B1); PG8_BAR; PG8_SCHED;
            PG8_LDB(B0, 1, 0); PG8_LDB(B1, 1, 1); PG8_SCHED; PG8_LDA(At, 1, 0); PG8_STAGEA(PG8_SA(0, 1), a2, 1, seln);
            PG8_WAIT_V(8); PG8_WAIT_L(0); PG8_BAR; PG8_MMA(0, 0, At, B0); PG8_MMA(0, 1, At, B1); PG8_BAR; PG8_SCHED;
            PG8_LDA(At, 1, 1); PG8_STAGE(PG8_SB(1, 0), b3, voffB); PG8_STAGE(PG8_SB(1, 1), b3 + hstep, voffB); PG8_STAGEA(PG8_SA(1, 0), a3, 0, seln);
            PG8_WAIT_V(8); PG8_WAIT_L(0); PG8_BAR; PG8_MMA(1, 0, At, B0); PG8_MMA(1, 1, At, B1); PG8_BAR; PG8_SCHED;
            } else {
            PG8_LDB(B0, 0, 0); PG8_SCHED; PG8_LDA(At, 0, 0); PG8_STAGEA(PG8_SA(1, 1), a1, 1, false);
            PG8_WAIT_L(8); PG8_BAR; PG8_WAIT_L(0); PG8_MMA(0, 0, At, B0); PG8_BAR; PG8_SCHED;
            PG8_LDB(B1, 0, 1); PG8_STAGE(PG8_SB(0, 0), b2, voffB);
            PG8_BAR; PG8_WAIT_L(0); PG8_MMA(0, 1, At, B1); PG8_BAR;
            PG8_LDA(At, 0, 1); PG8_STAGEA(PG8_SA(0, 0), a2, 0, seln);
            PG8_BAR; PG8_WAIT_L(0); PG8_MMA(1, 0, At, B0); PG8_BAR; PG8_SCHED;
            PG8_STAGE(PG8_SB(0, 1), b2 + hstep, voffB);
            PG8_WAIT_V(6); PG8_BAR; PG8_MMA(1, 1, At, B1); PG8_BAR;
            PG8_LDB(B0, 1, 0); PG8_SCHED; PG8_LDA(At, 1, 0); PG8_STAGEA(PG8_SA(0, 1), a2, 1, seln);
            PG8_WAIT_L(8); PG8_BAR; PG8_WAIT_L(0); PG8_MMA(0, 0, At, B0); PG8_BAR; PG8_SCHED;
            PG8_LDB(B1, 1, 1); PG8_STAGE(PG8_SB(1, 0), b3, voffB);
            PG8_BAR; PG8_WAIT_L(0); PG8_MMA(0, 1, At, B1); PG8_BAR;
            PG8_LDA(At, 1, 1); PG8_STAGEA(PG8_SA(1, 0), a3, 0, seln);
            PG8_BAR; PG8_WAIT_L(0); PG8_MMA(1, 0, At, B0); PG8_BAR; PG8_SCHED;
            PG8_STAGE(PG8_SB(1, 1), b3 + hstep, voffB);
            PG8_WAIT_V(6); PG8_BAR; PG8_MMA(1, 1, At, B1); PG8_BAR;
            }
        }
        if constexpr (ALIGN_EPI) { if (wr == 0) PG8_BAR; }
        if constexpr (!Epi::AFTER_DRAIN) { E(acc, cur, wr, wc, fr, fq); S.done(cur); }
        if (!has_next) break;
#pragma unroll
        for (int a = 0; a < 2; ++a)
#pragma unroll
            for (int b = 0; b < 2; ++b)
#pragma unroll
                for (int m = 0; m < 4; ++m)
#pragma unroll
                    for (int n = 0; n < 2; ++n) acc[a][b][m][n] = (f32x4){0.f, 0.f, 0.f, 0.f};
        cur = nxt; cA = nA; cB = nB; ++ui;
        if constexpr (GATHER) { gvc[0][0] = gvn[0][0]; gvc[0][1] = gvn[0][1]; gvc[1][0] = gvn[1][0]; gvc[1][1] = gvn[1][1]; }
        if constexpr (ALIGN_EPI) { if (wr == 1) PG8_BAR; }
    }
    PG8_WAIT_V(0);
    if constexpr (!ALIGN_EPI) { if (wr == 0) PG8_BAR; }
    PG8_BAR;
    if constexpr (Epi::AFTER_DRAIN) { E.fused(acc, cur, wr, wc, fr, fq, lds, wid, lane); S.done(cur); }
#undef PG8_SA
#undef PG8_SB
#undef PG8_STAGE
#undef PG8_STAGEA
#undef PG8_GOFF
#undef PG8_LDA
#undef PG8_LDB
#undef PG8_MMA
#undef PG8_WAIT_V
#undef PG8_WAIT_L
#undef PG8_BAR
#undef PG8_SCHED
}
}
#define XB_TMO      128
#define XB_XCNT(j)  (256  + 64 * (j))
#define XB_XSUB(j)  (1280 + 64 * (j))
#define XB_XGEN(j)  (2304 + 64 * (j))
#define XB_TOP      3328
#define XB_TOPGEN   3392
#define XCD_BAR_WORDS 3456
#define XB_SPIN_CAP (1u << 18)

__device__ __forceinline__ unsigned xb_ld(unsigned* p)              { return __hip_atomic_load(p, __ATOMIC_RELAXED, __HIP_MEMORY_SCOPE_AGENT); }
__device__ __forceinline__ unsigned xb_add(unsigned* p, unsigned v) { return __hip_atomic_fetch_add(p, v, __ATOMIC_RELAXED, __HIP_MEMORY_SCOPE_AGENT); }
__device__ __forceinline__ unsigned xb_xcc_id() { return (unsigned)__builtin_amdgcn_s_getreg((3 << 11) | 20) & 0xFu; }
#define XB_SPIN(cond, bar) do { unsigned _sp = 0; while (cond) { __builtin_amdgcn_s_sleep(1); \
    if ((++_sp & 255u) == 0u) { if (xb_ld(&(bar)[XB_TMO])) break; if (_sp > XB_SPIN_CAP) { atomicAdd(&(bar)[XB_TMO], 1u); break; } } } } while (0)

struct XcdBarrier {
    unsigned* bar; unsigned x;
    volatile LAS unsigned* st;
};

__device__ __forceinline__ XcdBarrier xcd_barrier_post(unsigned* bar, volatile LAS unsigned* st) {
    XcdBarrier b; b.bar = bar; b.x = xb_xcc_id(); b.st = st;
    if (threadIdx.x == 0) (void)xb_add(&bar[XB_XCNT(b.x)], 1u);
    return b;
}
__device__ __forceinline__ void xcd_barrier_complete(unsigned* bar, unsigned x, unsigned& nloc, unsigned& nx) {
    const unsigned G = gridDim.x * gridDim.y * gridDim.z;
    unsigned sum, cnt, mine, sp = 0u;
    for (;;) {
        sum = 0u; cnt = 0u; mine = 0u;
#pragma unroll
        for (unsigned j = 0; j < 16; ++j) { const unsigned c = xb_ld(&bar[XB_XCNT(j)]); sum += c; cnt += (c > 0u) ? 1u : 0u; mine = (j == x) ? c : mine; }
        if (sum == G) break;
        __builtin_amdgcn_s_sleep(1);
        if ((++sp & 255u) == 0u) { if (xb_ld(&bar[XB_TMO])) break; if (sp > XB_SPIN_CAP) { atomicAdd(&bar[XB_TMO], 1u); break; } }
    }
    nloc = mine > 0u ? mine : 1u; nx = cnt > 0u ? cnt : 1u;
}

__device__ __forceinline__ void xcd_barrier(const XcdBarrier& b) {
    asm volatile("s_waitcnt vmcnt(0)" ::: "memory");
    __syncthreads();
    if (threadIdx.x == 0) {
        unsigned* bar = b.bar;
        __builtin_amdgcn_s_waitcnt(0);
        unsigned nloc = b.st[0], nx = b.st[1];
        if (nloc == 0u) { xcd_barrier_complete(bar, b.x, nloc, nx); b.st[0] = nloc; b.st[1] = nx; }
        const unsigned old = xb_add(&bar[XB_XSUB(b.x)], 1u);
        const unsigned gen = old / nloc;
        if (old + 1u == (gen + 1u) * nloc) {
            __builtin_amdgcn_fence(__ATOMIC_RELEASE, "agent");
            asm volatile("s_waitcnt vmcnt(0)" ::: "memory");
            const unsigned og = xb_add(&bar[XB_TOP], 1u);
            const unsigned tg = og / nx;
            if (og + 1u == (tg + 1u) * nx) xb_add(&bar[XB_TOPGEN], 1u);
            else XB_SPIN(xb_ld(&bar[XB_TOPGEN]) == tg, bar);
            __builtin_amdgcn_fence(__ATOMIC_ACQUIRE, "agent");
            xb_add(&bar[XB_XGEN(b.x)], 1u);
            asm volatile("s_waitcnt vmcnt(0)" ::: "memory");
        } else {
            XB_SPIN(xb_ld(&bar[XB_XGEN(b.x)]) == gen, bar);
            __builtin_amdgcn_fence(__ATOMIC_ACQUIRE, "agent");
            asm volatile("s_waitcnt vmcnt(0)" ::: "memory");
        }
    }
    __syncthreads();
}
typedef short bf16x8 __attribute__((ext_vector_type(8)));
typedef short v4i16_t __attribute__((ext_vector_type(4)));
typedef float f32x16 __attribute__((ext_vector_type(16)));
typedef float f32x2_t __attribute__((ext_vector_type(2)));
typedef __bf16 bf16x2_t __attribute__((ext_vector_type(2)));
typedef float f4v __attribute__((ext_vector_type(4)));
__device__ __forceinline__ f32x16 MFMA32(const bf16x8 a, const bf16x8 b, const f32x16 c) { return __builtin_amdgcn_mfma_f32_32x32x16_bf16(a, b, c, 0, 0, 0); }
__device__ __forceinline__ unsigned cvtpk(float lo, float hi) { f32x2_t v = {lo, hi}; bf16x2_t b = __builtin_convertvector(v, bf16x2_t); return __builtin_bit_cast(unsigned, b); }
__device__ __forceinline__ int crow(int reg, int h) { return (reg & 3) + 8 * (reg >> 2) + 4 * h; }
__device__ __forceinline__ float blo(unsigned u) { return __uint_as_float(u << 16); }
__device__ __forceinline__ float bhi(unsigned u) { return __uint_as_float(u & 0xffff0000u); }
template <int W> __device__ __forceinline__ unsigned toff(unsigned row, unsigned ch) {
    if constexpr (W == 64) return row * 144u + ch * 16u;
    else return row * 272u + ch * 16u;
}
template <int W> __device__ __forceinline__ bf16x8 frag_row(const LAS unsigned char* tile, int R, int s, int h) { return *(const LAS bf16x8*)(tile + toff<W>(R, 2 * s + h)); }
template <int W, bool PERMK> __device__ __forceinline__ bf16x8 frag_tr(const LAS unsigned char* tile, int rbase, int cbase, int lane) {
    const int h = lane >> 5, blk = (lane >> 4) & 1, q = (lane & 15) >> 2, p = lane & 3;
    const int ch = (cbase >> 3) + 2 * blk + (p >> 1);
    const int r0 = rbase + (PERMK ? 4 * h : 8 * h) + q, r1 = r0 + (PERMK ? 8 : 4);
    const v4i16_t lo = __builtin_amdgcn_ds_read_tr16_b64_v4i16((LAS v4i16_t*)(tile + toff<W>(r0, ch) + 8 * (p & 1)));
    const v4i16_t hi = __builtin_amdgcn_ds_read_tr16_b64_v4i16((LAS v4i16_t*)(tile + toff<W>(r1, ch) + 8 * (p & 1)));
    return __builtin_shufflevector(lo, hi, 0, 1, 2, 3, 4, 5, 6, 7);
}
__device__ __forceinline__ bf16x8 pack_step(const f32x16& x, int s) {
    v4u p; p.x = cvtpk(x[8 * s], x[8 * s + 1]); p.y = cvtpk(x[8 * s + 2], x[8 * s + 3]); p.z = cvtpk(x[8 * s + 4], x[8 * s + 5]); p.w = cvtpk(x[8 * s + 6], x[8 * s + 7]);
    return __builtin_bit_cast(bf16x8, p);
}
__device__ __forceinline__ f32x16 zero16() { f32x16 z;
#pragma unroll
    for (int i = 0; i < 16; ++i) z[i] = 0.f; return z; }
__device__ __forceinline__ void wave_scan_sum2(float& x0, float& x1, int lane) {
    const float loc = x0 + x1; float s = loc;
#pragma unroll
    for (int o = 1; o < 64; o <<= 1) { const float t = __shfl_up(s, o); if (lane >= o) s += t; }
    const float ex = s - loc; x0 = ex + x0; x1 = x0 + x1;
}
__device__ __forceinline__ void wave_scan_max2(float& x0, float& x1, int lane) {
    const float loc = fmaxf(x0, x1); float s = loc;
#pragma unroll
    for (int o = 1; o < 64; o <<= 1) { const float t = __shfl_up(s, o); if (lane >= o) s = fmaxf(s, t); }
    float ex = __shfl_up(s, 1); if (lane == 0) ex = -INFINITY;
    x0 = fmaxf(ex, x0); x1 = fmaxf(x0, x1);
}
__device__ __forceinline__ float wave_max(float v) {
#pragma unroll
    for (int o = 1; o < 64; o <<= 1) v = fmaxf(v, __shfl_xor(v, o));
    return v;
}
__device__ __forceinline__ void rot8_store(LAS unsigned char* tile, int row, int j0, const v4u x1, const v4u x2, const float* cs, float scale) {
    float a[8], b[8];
    a[0] = blo(x1.x); a[1] = bhi(x1.x); a[2] = blo(x1.y); a[3] = bhi(x1.y); a[4] = blo(x1.z); a[5] = bhi(x1.z); a[6] = blo(x1.w); a[7] = bhi(x1.w);
    b[0] = blo(x2.x); b[1] = bhi(x2.x); b[2] = blo(x2.y); b[3] = bhi(x2.y); b[4] = blo(x2.z); b[5] = bhi(x2.z); b[6] = blo(x2.w); b[7] = bhi(x2.w);
    float o1[8], o2[8];
#pragma unroll
    for (int i = 0; i < 8; ++i) { const float c = cs[2 * i], s = cs[2 * i + 1]; o1[i] = (a[i] * c - b[i] * s) * scale; o2[i] = (a[i] * s + b[i] * c) * scale; }
    v4u w1, w2; w1.x = cvtpk(o1[0], o1[1]); w1.y = cvtpk(o1[2], o1[3]); w1.z = cvtpk(o1[4], o1[5]); w1.w = cvtpk(o1[6], o1[7]);
    w2.x = cvtpk(o2[0], o2[1]); w2.y = cvtpk(o2[2], o2[3]); w2.z = cvtpk(o2[4], o2[5]); w2.w = cvtpk(o2[6], o2[7]);
    *(LAS v4u*)(tile + toff<64>(row, j0 >> 3)) = w1; *(LAS v4u*)(tile + toff<64>(row, 4 + (j0 >> 3))) = w2;
}
__device__ __forceinline__ void conv8(const bf16_t* colp, int s, const float* cw, const float* cb, float* o) {
#pragma unroll
    for (int i = 0; i < 8; ++i) o[i] = cb[i];
#pragma unroll
    for (int w = 0; w < 4; ++w) { const int ss = s - 3 + w; if (ss >= 0) { const v4u x = *(const v4u*)(colp + (ptrdiff_t)(w - 3) * NP);
        o[0] += blo(x.x) * cw[w * 8 + 0]; o[1] += bhi(x.x) * cw[w * 8 + 1]; o[2] += blo(x.y) * cw[w * 8 + 2]; o[3] += bhi(x.y) * cw[w * 8 + 3];
        o[4] += blo(x.z) * cw[w * 8 + 4]; o[5] += bhi(x.z) * cw[w * 8 + 5]; o[6] += blo(x.w) * cw[w * 8 + 6]; o[7] += bhi(x.w) * cw[w * 8 + 7]; } }
#pragma unroll
    for (int i = 0; i < 8; ++i) o[i] = o[i] * __builtin_amdgcn_rcpf(1.0f + __builtin_amdgcn_exp2f(-1.4426950408889634f * o[i]));
}

__device__ __forceinline__ float fast_sig(float x) { return __builtin_amdgcn_rcpf(1.0f + __builtin_amdgcn_exp2f(-1.4426950408889634f * x)); }
__device__ __forceinline__ size_t ret_tile(int bn, int slot) { return (size_t)bn * (size_t)(CH * NP) + (size_t)slot * (CH * 64); }
__device__ __forceinline__ size_t ml_tile(int bn, int slot) { return (size_t)bn * (size_t)(CH * NP) + (size_t)(CH * 2048) + (size_t)slot * (CH * 128); }
struct RetPre { v4u q1, q2, k1, k2, v0, v1, rp; f4v cs[4]; };
__device__ __forceinline__ void ret_issue(RetPre& R, const bf16_t* projp, const float* cstab, const bf16_t* rstb, int ri, int tid) {
    const int h = ri & 7, bn = ri >> 3;
    const int c = tid >> 2, j0 = (tid & 3) * 8;
    const f4v* csp = (const f4v*)(cstab + ((size_t)bn * CH + c) * 64 + j0 * 2);
#pragma unroll
    for (int i = 0; i < 4; ++i) R.cs[i] = csp[i];
    const int qo = c * 64 + j0;
    const bf16_t* qp = projp + ret_tile(bn, h) + qo; const bf16_t* kp = projp + ret_tile(bn, 8 + h) + qo;
    R.q1 = __builtin_nontemporal_load((const v4u*)qp); R.q2 = __builtin_nontemporal_load((const v4u*)(qp + 32)); R.k1 = __builtin_nontemporal_load((const v4u*)kp); R.k2 = __builtin_nontemporal_load((const v4u*)(kp + 32));
    const bf16_t* vp = projp + ret_tile(bn, 16 + h) + tid * 8;
    R.v0 = __builtin_nontemporal_load((const v4u*)vp); R.v1 = __builtin_nontemporal_load((const v4u*)(vp + 64 * 64));
    R.rp = __builtin_nontemporal_load((const v4u*)(rstb + (size_t)ri * (RD * RD) + tid * 8));
}
__device__ __forceinline__ void ret_stage(const RetPre& R, LAS unsigned char* Qt, LAS unsigned char* Kt, LAS unsigned char* Vt, LAS unsigned char* Rpt, int tid) {
    const int c = tid >> 2, j0 = (tid & 3) * 8;
    float cs[16];
#pragma unroll
    for (int i = 0; i < 4; ++i) { cs[4 * i] = R.cs[i].x; cs[4 * i + 1] = R.cs[i].y; cs[4 * i + 2] = R.cs[i].z; cs[4 * i + 3] = R.cs[i].w; }
    rot8_store(Qt, c, j0, R.q1, R.q2, cs, 1.0f); rot8_store(Kt, c, j0, R.k1, R.k2, cs, 0.125f);
    const int row = tid >> 3, ch = tid & 7;
    *(LAS v4u*)(Vt + toff<64>(row, ch)) = R.v0; *(LAS v4u*)(Vt + toff<64>(row + 64, ch)) = R.v1; *(LAS v4u*)(Rpt + toff<64>(row, ch)) = R.rp;
}
struct MlPre { v4u raw[11]; v4u v[4]; v4u sp[4]; float gi0, gi1, gf0, gf1, np0, np1, mprev; };
__device__ __forceinline__ void ml_issue_a(MlPre& M, const bf16_t* projp, const float* gatesp, const bf16_t* mstb, const float* mnp, const float* mmp, int mi, int tid, int lane) {
    const int h = mi & 3, bn = mi >> 2;
    const bf16_t* vp = projp + ml_tile(bn, 8 + h) + tid * 8; const bf16_t* sp = mstb + (size_t)mi * (MD * MD) + tid * 8;
#pragma unroll
    for (int i = 0; i < 4; ++i) { M.v[i] = __builtin_nontemporal_load((const v4u*)(vp + i * (NTHREADS * 8))); M.sp[i] = __builtin_nontemporal_load((const v4u*)(sp + i * (NTHREADS * 8))); }
    const float* gp = gatesp + ((size_t)bn * CH + 2 * lane) * 8 + h;
    M.gi0 = gp[0]; M.gi1 = gp[8]; M.gf0 = gp[4]; M.gf1 = gp[12];
    M.np0 = mnp[(size_t)mi * MD + lane]; M.np1 = mnp[(size_t)mi * MD + lane + 64]; M.mprev = mmp[mi];
}
__device__ __forceinline__ void ml_issue_b(MlPre& M, const bf16_t* projp, int mi, int tid) {
    const int h = mi & 3, bn = mi >> 2, n = bn % NCH;
    const int which = tid >> 8, u = tid & 255, cg = u & 15, c0 = 8 * (u >> 4);
    const bf16_t* tp = projp + ml_tile(bn, which * 4 + h) + c0 * 128 + cg * 8;
#pragma unroll
    for (int rr = 0; rr < 11; ++rr) {
        v4u x = {0u, 0u, 0u, 0u};
        if (rr >= 3) x = *(const v4u*)(tp + (rr - 3) * 128);
        else if (c0 > 0) x = *(const v4u*)(tp + (rr - 3) * 128);
        else if (n > 0) x = *(const v4u*)(tp + (rr - 3) * 128 - (ptrdiff_t)(CH * NP) + CH * 128);
        M.raw[rr] = x; }
}
__device__ __forceinline__ void ml_stage(const MlPre& M, LAS unsigned char* Qt, LAS unsigned char* Kt, LAS unsigned char* Vt, LAS unsigned char* Spt, const float* conv_w, const float* conv_b, int h, int tid) {
    const int which = tid >> 8, u = tid & 255, cg = u & 15, c0 = 8 * (u >> 4);
    const int chn = which * 512 + h * MD + cg * 8;
    float cw[32], cb_[8];
#pragma unroll
    for (int w = 0; w < 4; ++w) { const f4v a = *(const f4v*)(conv_w + w * 1024 + chn), b = *(const f4v*)(conv_w + w * 1024 + chn + 4);
        cw[w * 8] = a.x; cw[w * 8 + 1] = a.y; cw[w * 8 + 2] = a.z; cw[w * 8 + 3] = a.w; cw[w * 8 + 4] = b.x; cw[w * 8 + 5] = b.y; cw[w * 8 + 6] = b.z; cw[w * 8 + 7] = b.w; }
    { const f4v a = *(const f4v*)(conv_b + chn), b = *(const f4v*)(conv_b + chn + 4); cb_[0] = a.x; cb_[1] = a.y; cb_[2] = a.z; cb_[3] = a.w; cb_[4] = b.x; cb_[5] = b.y; cb_[6] = b.z; cb_[7] = b.w; }
    LAS unsigned char* dst = which ? Kt : Qt; const float sc = which ? 0.08838834764831845f : 1.0f;
#pragma unroll
    for (int o = 0; o < 8; ++o) {
        float a[8];
#pragma unroll
        for (int i = 0; i < 8; ++i) a[i] = cb_[i];
#pragma unroll
        for (int w = 0; w < 4; ++w) { const v4u x = M.raw[o + w];
            a[0] += blo(x.x) * cw[w * 8 + 0]; a[1] += bhi(x.x) * cw[w * 8 + 1]; a[2] += blo(x.y) * cw[w * 8 + 2]; a[3] += bhi(x.y) * cw[w * 8 + 3];
            a[4] += blo(x.z) * cw[w * 8 + 4]; a[5] += bhi(x.z) * cw[w * 8 + 5]; a[6] += blo(x.w) * cw[w * 8 + 6]; a[7] += bhi(x.w) * cw[w * 8 + 7]; }
#pragma unroll
        for (int i = 0; i < 8; ++i) a[i] = a[i] * fast_sig(a[i]) * sc;
        v4u w; w.x = cvtpk(a[0], a[1]); w.y = cvtpk(a[2], a[3]); w.z = cvtpk(a[4], a[5]); w.w = cvtpk(a[6], a[7]);
        *(LAS v4u*)(dst + toff<128>(c0 + o, cg)) = w;
    }
#pragma unroll
    for (int i = 0; i < 4; ++i) { const int idx = tid + NTHREADS * i, row = idx >> 4, ch = idx & 15; *(LAS v4u*)(Vt + toff<128>(row, ch)) = M.v[i]; *(LAS v4u*)(Spt + toff<128>(row, ch)) = M.sp[i]; }
}
struct Params {
    const float *x, *p; const int* pos;
    const float *attn_norm, *w_in, *conv_w, *conv_b, *b_ig, *b_fg, *ret_gn, *ml_gn, *w_out, *moe_norm, *w_group, *b_group, *w_router, *b_router,
                *w1, *w3, *w2, *w_up, *ple_norm, *pg_norm, *w_gate, *final_norm;
    float* out; unsigned char* ws;
};

__device__ __forceinline__ void load4(const float* p, float (&o)[4]) { const float4 v = *(const float4*)p; o[0] = v.x; o[1] = v.y; o[2] = v.z; o[3] = v.w; }
__device__ __forceinline__ void load4(const bf16_t* p, float (&o)[4]) { const uint2 v = *(const uint2*)p; o[0] = __uint_as_float(v.x << 16); o[1] = __uint_as_float(v.x & 0xffff0000u); o[2] = __uint_as_float(v.y << 16); o[3] = __uint_as_float(v.y & 0xffff0000u); }

__device__ __forceinline__ void transpose_item(const float* W, int ldw, const float* gain, bf16_t* WT, int K, int kb, int n0, size_t drow0, LAS float* scr, int lane) {
    const int k0 = 64 * kb;
#pragma unroll 8
    for (int i = 0; i < 32; ++i) { const int kk = 2 * i + (lane >> 5); float w = W[(size_t)(k0 + kk) * ldw + n0 + (lane & 31)]; if (gain) w *= gain[k0 + kk]; scr[kk * 33 + (lane & 31)] = w; }
    LDS_WAIT(); asm volatile("" ::: "memory");
    const int c = lane & 7;
#pragma unroll
    for (int j = 0; j < 4; ++j) { const int n = (lane >> 3) + 8 * j; const LAS float* s = scr + (8 * c) * 33 + n;
        v4u o; o.x = pk2(s[0 * 33], s[1 * 33]); o.y = pk2(s[2 * 33], s[3 * 33]); o.z = pk2(s[4 * 33], s[5 * 33]); o.w = pk2(s[6 * 33], s[7 * 33]);
        *(GAS v4u*)(WT + (drow0 + n) * K + k0 + 8 * c) = o; }
    LDS_WAIT(); asm volatile("" ::: "memory");
}

constexpr int NPHASES = 14;
template <int LO, int HI>
__global__ void __launch_bounds__(NTHREADS, 2) mk(Params P) {
    extern __shared__ __attribute__((aligned(16))) unsigned char lds_raw[];
    float* ldsf = (float*)lds_raw;
    LAS unsigned char* ldsl = (LAS unsigned char*)lds_raw;
    const int G = gridDim.x, bid = blockIdx.x, NGW = G * NWAVES;
#define PH_IDS int tid = threadIdx.x; asm volatile("" : "+v"(tid)); const int lane = tid & 63, wave = __builtin_amdgcn_readfirstlane(tid >> 6), gw = bid * NWAVES + wave; (void)lane; (void)gw;
    unsigned char* const ws = P.ws;
#define rstd1 ((float*)(ws + WS_RSTD1))
#define gates ((float*)(ws + WS_GATES))
#define rstdg ((float*)(ws + WS_RSTDG))
#define rstde ((float*)(ws + WS_RSTDE))
#define eid ((int*)(ws + WS_EID))
#define posn ((int*)(ws + WS_POS))
#define gate ((float*)(ws + WS_GATE))
#define mn ((float*)(ws + WS_MN))
#define ml ((float*)(ws + WS_ML))
#define mbl ((float*)(ws + WS_MBL))
#define mm ((float*)(ws + WS_MM))
#define list ((int*)(ws + WS_LIST))
#define cnt ((int*)(ws + WS_CTL) + CW_CNT)
#define part ((float*)(ws + WS_PART))
#define part2 ((float*)(ws + WS_PART2))
#define win_t ((bf16_t*)(ws + WS_WIN))
#define wout_t ((bf16_t*)(ws + WS_WOUT))
#define w13_t ((bf16_t*)(ws + WS_W13))
#define w2_t ((bf16_t*)(ws + WS_W2))
#define wgate_t ((bf16_t*)(ws + WS_WGATE))
#define wup_t ((bf16_t*)(ws + WS_WUP))
#define proj ((bf16_t*)(ws + WS_PROJ))
#define hbuf ((bf16_t*)(ws + WS_HBUF))
#define xs ((bf16_t*)(ws + WS_XS))
#define ybuf ((bf16_t*)(ws + WS_YBUF))
#define peb ((bf16_t*)(ws + WS_PEB))
#define yreg ((bf16_t*)(ws + WS_YREG))
#define pb ((bf16_t*)(ws + WS_PB))
    float* const out = P.out;
#define rst ((float*)((unsigned char*)out + OUT_RST))
#define mst ((float*)((unsigned char*)out + OUT_MST))
    LAS int* s_off = (LAS int*)(ldsl + LDSX_OFF + 256);
    LAS int* s_cnt = s_off + 40;
    LAS int* s_t2e = s_off + 80;
#define IN(k) (LO <= (k) && (k) < HI)
#ifndef PROBE_PH
#define PROBE_PH (-1)
#endif
    unsigned long long pt0 = 0ull, pt1 = 0ull, pseg = 0ull, plast = 0ull; (void)pseg; (void)plast;
#define SEG(k) do { if (PROBE_PH >= 110 && PROBE_PH < 140) { const unsigned long long _n = __builtin_amdgcn_s_memrealtime(); if (PROBE_PH == 110 + (k)) pseg += _n - plast; plast = _n; } } while (0)
    if (PROBE_PH == 0) pt0 = __builtin_amdgcn_s_memrealtime();
#define GRID_BAR(k) do { if constexpr (IN(k) && IN((k) + 1)) xcd_barrier(bar); if (PROBE_PH == (k)) pt1 = __builtin_amdgcn_s_memrealtime(); if (PROBE_PH == (k) + 1) pt0 = __builtin_amdgcn_s_memrealtime(); } while (0)
    XcdBarrier bar; bar.bar = (unsigned*)(ws + WS_CTL) + CW_BAR; bar.x = 0; bar.st = nullptr;
    if constexpr (HI - LO > 1) {
        PH_IDS
        volatile LAS unsigned* st = (volatile LAS unsigned*)(ldsl + LDSX_OFF);
        if (tid == 0) { st[0] = 0u; st[1] = 0u; }
        __syncthreads();
        bar = xcd_barrier_post((unsigned*)(ws + WS_CTL) + CW_BAR, st);
    }

    if constexpr (IN(0)) {
        PH_IDS
        if (PROBE_PH >= 120 && PROBE_PH < 130) plast = __builtin_amdgcn_s_memrealtime();
        {
            constexpr int I0 = 8 * 16, I1 = 8 * 4, I2 = 0, I3 = 0, I4 = 8 * 4, I5 = 2 * 4;
#define P0_DECODE(it_, W, ldw, K, kb, n0, gain, WT, drow0, dsplit) do { int r = (it_); gain = nullptr; dsplit = 0; \
                if (r < I0) { W = P.w_in; ldw = NPROJ; K = D; kb = r >> 4; n0 = 256 * (r & 15); gain = P.attn_norm; WT = win_t; drow0 = n0; } \
                else if ((r -= I0) < I1) { W = P.w_out; ldw = D; K = D; kb = r >> 2; n0 = 256 * (r & 3); WT = wout_t; drow0 = n0; } \
                else if ((r -= I1) < I2) { const int mat = r >> 4, q = r & 15, e = mat >> 1, which = mat & 1; W = (which ? P.w3 : P.w1) + (size_t)e * D * DE; ldw = DE; K = D; kb = q >> 1; n0 = 256 * (q & 1); \
                    gain = P.moe_norm; WT = w13_t; drow0 = (size_t)e * 1024 + (size_t)((n0 >> 7) * 256 + which * 128); dsplit = 1; } \
                else if ((r -= I2) < I3) { const int e = r >> 4, q = r & 15; W = P.w2 + (size_t)e * DE * D; ldw = D; K = DE; kb = q >> 2; n0 = 256 * (q & 3); WT = w2_t; drow0 = (size_t)e * 1024 + n0; } \
                else if ((r -= I3) < I4) { W = P.w_gate; ldw = D; K = D; kb = r >> 2; n0 = 256 * (r & 3); gain = P.pg_norm; WT = wgate_t; drow0 = n0; } \
                else { r -= I4; W = P.w_up; ldw = D; K = PLE; kb = r >> 2; n0 = 256 * (r & 3); WT = wup_t; drow0 = n0; } } while (0)
            constexpr int NIT = I0 + I1 + I2 + I3 + I4 + I5;
            const int c4 = tid & 63, r0 = tid >> 6;
            f4v va[16], vb[16]; float ga[16], gb[16];
#define P0_LOAD(v_, g_, it_) do { if ((it_) < NIT) { const float* W; int ldw, K, kb, n0; const float* gain; bf16_t* WT; size_t drow0; int dsplit; \
                P0_DECODE((it_), W, ldw, K, kb, n0, gain, WT, drow0, dsplit); (void)K; (void)WT; (void)drow0; (void)dsplit; \
                _Pragma("unroll") for (int i = 0; i < 16; ++i) { v_[i] = __builtin_nontemporal_load((const f4v*)(W + (size_t)(128 * kb + r0 + 8 * i) * ldw + n0 + 4 * c4)); g_[i] = gain ? gain[128 * kb + r0 + 8 * i] : 1.0f; } } } while (0)
#define P0_PROCESS(v_, g_, it_, itn_) do { const float* W; int ldw, K, kb, n0; const float* gain; bf16_t* WT; size_t drow0; int dsplit; \
                P0_DECODE((it_), W, ldw, K, kb, n0, gain, WT, drow0, dsplit); (void)W; (void)ldw; (void)gain; const int k0 = 128 * kb; \
                __syncthreads(); \
                _Pragma("unroll") for (int i = 0; i < 16; ++i) { v2u o; o.x = cvtpk(v_[i].x * g_[i], v_[i].y * g_[i]); o.y = cvtpk(v_[i].z * g_[i], v_[i].w * g_[i]); \
                    *(LAS v2u*)(ldsl + (r0 + 8 * i) * 576 + c4 * 8) = o; } \
                P0_LOAD(v_, g_, (itn_)); \
                __syncthreads(); \
                { const int grp = lane >> 4, q = (lane & 15) >> 2, p = lane & 3, i16 = lane & 15; \
                    \
                  _Pragma("unroll") for (int cg = 0; cg < 2; ++cg) { const int nl = 32 * wave + 16 * cg + i16; \
                    const size_t drow = drow0 + (dsplit && nl >= 128 ? (size_t)(256 + nl - 128) : (size_t)nl); \
                    _Pragma("unroll") for (int cq = 0; cq < 4; ++cq) { \
                        const LAS unsigned char* src = ldsl + ((4 * cq + grp) * 8 + q) * 576 + (32 * wave + 16 * cg + 4 * p) * 2; \
                        const v4i16_t lo = __builtin_amdgcn_ds_read_tr16_b64_v4i16((LAS v4i16_t*)src); \
                        const v4i16_t hi = __builtin_amdgcn_ds_read_tr16_b64_v4i16((LAS v4i16_t*)(src + 4 * 576)); \
                        const bf16x8 o = __builtin_shufflevector(lo, hi, 0, 1, 2, 3, 4, 5, 6, 7); \
                        *(bf16x8*)(WT + drow * K + k0 + (4 * cq + grp) * 8) = o; } } } } while (0)
            P0_LOAD(va, ga, bid); P0_LOAD(vb, gb, bid + G);
            for (int it = bid; it < NIT; it += 2 * G) {
                P0_PROCESS(va, ga, it, it + 2 * G);
                if (it + G < NIT) P0_PROCESS(vb, gb, it + G, it + 3 * G);
            }
#undef P0_LOAD
#undef P0_PROCESS
#undef P0_DECODE
        }
        __syncthreads();
        SEG(10);
        {
            LAS float* gwl = (LAS float*)ldsl;
            for (int idx = tid; idx < D * 8; idx += NTHREADS) { const int k = idx >> 3, j = idx & 7; gwl[idx] = P.w_in[(size_t)k * NPROJ + NP + j] * P.attn_norm[k]; }
            __syncthreads();
            for (int row0 = gw; row0 < T; row0 += 2 * NGW) {
                float4 v[2][4];
#pragma unroll
                for (int u = 0; u < 2; ++u) { const float4* xr = (const float4*)(P.x + (size_t)(row0 + u * NGW) * D) + lane;
#pragma unroll
                    for (int j = 0; j < 4; ++j) { const f4v t_ = __builtin_nontemporal_load((const f4v*)(xr + 64 * j)); v[u][j] = make_float4(t_.x, t_.y, t_.z, t_.w); } }
#pragma unroll
                for (int u = 0; u < 2; ++u) {
                    const int row = row0 + u * NGW; float ss = 0.f;
#pragma unroll
                    for (int j = 0; j < 4; ++j) ss += v[u][j].x * v[u][j].x + v[u][j].y * v[u][j].y + v[u][j].z * v[u][j].z + v[u][j].w * v[u][j].w;
                    ss = wave_sum(ss);
                    const float rstd = 1.0f / sqrtf(ss * (1.0f / D) + EPS);
                    float g8[8];
#pragma unroll
                    for (int i = 0; i < 8; ++i) g8[i] = 0.f;
#pragma unroll
                    for (int j = 0; j < 4; ++j) {
                        const int k0 = 4 * (lane + 64 * j);
                        const float xs_[4] = {v[u][j].x * rstd, v[u][j].y * rstd, v[u][j].z * rstd, v[u][j].w * rstd};
                        uint2 o; o.x = cvtpk(xs_[0], xs_[1]); o.y = cvtpk(xs_[2], xs_[3]);
                        *(uint2*)(yreg + (size_t)row * D + k0) = o;
#pragma unroll
                        for (int i = 0; i < 4; ++i) {
                            const LAS f4v* wr = (const LAS f4v*)(gwl + (k0 + i) * 8);
                            const f4v w0 = wr[0], w1 = wr[1];
                            g8[0] += xs_[i] * w0.x; g8[1] += xs_[i] * w0.y; g8[2] += xs_[i] * w0.z; g8[3] += xs_[i] * w0.w;
                            g8[4] += xs_[i] * w1.x; g8[5] += xs_[i] * w1.y; g8[6] += xs_[i] * w1.z; g8[7] += xs_[i] * w1.w;
                        }
                    }
#pragma unroll
                    for (int i = 0; i < 8; ++i) g8[i] = wave_sum(g8[i]);
                    if (lane == 0) {
                        *(float4*)(gates + (size_t)row * 8) = make_float4(g8[0], g8[1], g8[2], g8[3]);
                        *(float4*)(gates + (size_t)row * 8 + 4) = make_float4(g8[4], g8[5], g8[6], g8[7]);
                    }
                }
            }
            SEG(11);
            {
                bf16_t* wrh = (bf16_t*)(ws + WS_WR); bf16_t* wrl = wrh + 48 * D;
                for (int idx = bid * NTHREADS + tid; idx < 48 * D; idx += G * NTHREADS) {
                    const int col = idx >> 10, k = idx & 1023;
                    float w = 0.f; if (col < 4) w = P.w_group[k * 4 + col] * P.moe_norm[k]; else if (col < 36) w = P.w_router[k * 32 + col - 4] * P.moe_norm[k];
                    const unsigned hi = f2bf(w); const float r = w - __uint_as_float(hi << 16);
                    wrh[idx] = (bf16_t)hi; wrl[idx] = (bf16_t)f2bf(r);
                }
            }
            {
                float* cstab = (float*)(ws + WS_CS);
                for (int idx = bid * NTHREADS + tid; idx < T * 32; idx += G * NTHREADS) {
                    const int t = idx >> 5, j = idx & 31;
                    const float ang = (float)P.pos[t] * powf(10000.0f, -(float)j / 32.0f);
                    float sn, cs; sincosf(ang, &sn, &cs);
                    *(float2*)(cstab + (size_t)idx * 2) = make_float2(cs, sn);
                }
            }
            SEG(12);
        }
        __syncthreads();
        SEG(13);
    }
    GRID_BAR(0);
#ifdef PROBE_XBAR
    xcd_barrier(bar); xcd_barrier(bar); xcd_barrier(bar); xcd_barrier(bar); xcd_barrier(bar);
#endif
    if constexpr (IN(1)) {
        PH_IDS
        pg8::Gemm g{yreg, win_t, T, NP, D, nullptr}; pg8::StaticOrder S; S.init(T, NP, G, bid);
        pg8::EpiStoreBf16 E{proj, NP, 0xffff, nullptr, 1};
        pg8::gemm_phase<pg8::EpiStoreBf16, pg8::StaticOrder, true, true>(ldsl, g, S, E);
    }
    GRID_BAR(1);
    if constexpr (IN(2)) {
        PH_IDS
        const float* cstab = (const float*)(ws + WS_CS);
#define BAR_LDS() do { asm volatile("s_waitcnt lgkmcnt(0)" ::: "memory"); __builtin_amdgcn_s_barrier(); asm volatile("" ::: "memory"); } while (0)
        LAS unsigned char* tl = ldsl + 73728;
        f4v tv[8]; float tg[8]; int tk = 0;
        const int tc4 = tid & 63, tr0 = tid >> 6;
#define MOE_DECODE(it_, W, ldw, K, kb, n0, gain, WT, drow0, dsplit) do { int r = (it_); dsplit = 0; gain = nullptr; \
            if (r < 2048) { const int mat = r >> 5, q = r & 31, e = mat >> 1, which = mat & 1; W = (which ? P.w3 : P.w1) + (size_t)e * D * DE; ldw = DE; K = D; kb = q >> 1; n0 = 256 * (q & 1); \
                gain = P.moe_norm; WT = w13_t; drow0 = (size_t)e * 1024 + (size_t)((n0 >> 7) * 256 + which * 128); dsplit = 1; } \
            else { r -= 2048; const int e = r >> 5, q = r & 31; W = P.w2 + (size_t)e * DE * D; ldw = D; K = DE; kb = q >> 2; n0 = 256 * (q & 3); WT = w2_t; drow0 = (size_t)e * 1024 + n0; } } while (0)
#define MOE_LOAD(k_) do { const int it_ = bid + G * (k_); if (it_ < 3072) { const float* W; int ldw, K, kb, n0; const float* gain; bf16_t* WT; size_t drow0; int dsplit; \
            MOE_DECODE(it_, W, ldw, K, kb, n0, gain, WT, drow0, dsplit); (void)K; (void)WT; (void)drow0; (void)dsplit; \
            _Pragma("unroll") for (int i = 0; i < 8; ++i) { tv[i] = __builtin_nontemporal_load((const f4v*)(W + (size_t)(64 * kb + tr0 + 8 * i) * ldw + n0 + 4 * tc4)); tg[i] = gain ? gain[64 * kb + tr0 + 8 * i] : 1.0f; } } } while (0)
#define MOE_PROCESS(k_) do { const int it_ = bid + G * (k_); if (it_ < 3072) { const float* W; int ldw, K, kb, n0; const float* gain; bf16_t* WT; size_t drow0; int dsplit; \
            MOE_DECODE(it_, W, ldw, K, kb, n0, gain, WT, drow0, dsplit); (void)W; (void)ldw; (void)gain; const int k0 = 64 * kb; \
            _Pragma("unroll") for (int i = 0; i < 8; ++i) { v2u o; o.x = cvtpk(tv[i].x * tg[i], tv[i].y * tg[i]); o.y = cvtpk(tv[i].z * tg[i], tv[i].w * tg[i]); \
                *(LAS v2u*)(tl + (tr0 + 8 * i) * 576 + tc4 * 8) = o; } \
            MOE_LOAD((k_) + 1); \
            BAR_LDS(); \
            { const int grp = lane >> 4, q = (lane & 15) >> 2, p = lane & 3, i16 = lane & 15; \
              _Pragma("unroll") for (int cg = 0; cg < 2; ++cg) { const int nl = 32 * wave + 16 * cg + i16; \
                const size_t drow = drow0 + (dsplit && nl >= 128 ? (size_t)(256 + nl - 128) : (size_t)nl); \
                _Pragma("unroll") for (int cq = 0; cq < 2; ++cq) { \
                    const LAS unsigned char* src = tl + ((4 * cq + grp) * 8 + q) * 576 + (32 * wave + 16 * cg + 4 * p) * 2; \
                    const v4i16_t lo = __builtin_amdgcn_ds_read_tr16_b64_v4i16((LAS v4i16_t*)src); \
                    const v4i16_t hi = __builtin_amdgcn_ds_read_tr16_b64_v4i16((LAS v4i16_t*)(src + 4 * 576)); \
                    const bf16x8 o = __builtin_shufflevector(lo, hi, 0, 1, 2, 3, 4, 5, 6, 7); \
                    *(bf16x8*)(WT + drow * K + k0 + (4 * cq + grp) * 8) = o; } } } } } while (0)
        MOE_LOAD(0);
        BAR_LDS();
        {
            LAS unsigned char* Kt = ldsl; LAS unsigned char* Vt = ldsl + 18432;
            v4u k1, k2, v0, v1; f4v csr[4];
#define RET1_ISSUE(ri_) do { const int h_ = (ri_) & 7, bn_ = (ri_) >> 3; const int c_ = tid >> 2, j0_ = (tid & 3) * 8; \
                const f4v* csp_ = (const f4v*)(cstab + ((size_t)bn_ * CH + c_) * 64 + j0_ * 2); csr[0] = csp_[0]; csr[1] = csp_[1]; csr[2] = csp_[2]; csr[3] = csp_[3]; \
                const bf16_t* kp_ = proj + ret_tile(bn_, 8 + h_) + c_ * 64 + j0_; k1 = *(const v4u*)kp_; k2 = *(const v4u*)(kp_ + 32); \
                const bf16_t* vp_ = proj + ret_tile(bn_, 16 + h_) + tid * 8; v0 = *(const v4u*)vp_; v1 = *(const v4u*)(vp_ + 64 * 64); } while (0)
            const int rpb = (BATCH * NCH * RH + G - 1) / G, ri0 = bid * rpb, ri1 = (ri0 + rpb < BATCH * NCH * RH) ? ri0 + rpb : BATCH * NCH * RH;
            if (ri0 < ri1) RET1_ISSUE(ri0);
            for (int ri = ri0; ri < ri1; ++ri) {
                const int h = ri & 7;
                const float lg2 = log1pf(-exp2f(-5.0f - (float)h)) * 1.4426950408889634f;
                BAR_LDS();
                {   const int c = tid >> 2, j0 = (tid & 3) * 8; float cs[16];
#pragma unroll
                    for (int i = 0; i < 4; ++i) { cs[4 * i] = csr[i].x; cs[4 * i + 1] = csr[i].y; cs[4 * i + 2] = csr[i].z; cs[4 * i + 3] = csr[i].w; }
                    rot8_store(Kt, c, j0, k1, k2, cs, 0.125f * __builtin_amdgcn_exp2f(lg2 * (float)(CH - 1 - c)));
                    const int row = tid >> 3, ch = tid & 7;
                    *(LAS v4u*)(Vt + toff<64>(row, ch)) = v0; *(LAS v4u*)(Vt + toff<64>(row + 64, ch)) = v1; }
                BAR_LDS();
                if (ri + 1 < ri1) RET1_ISSUE(ri + 1);
                if (wave < 4) {
                    const int db = wave >> 1, eb = wave & 1, r = lane & 31, hl = lane >> 5;
                    f32x16 acc = zero16();
#pragma unroll
                    for (int s = 0; s < 8; ++s) acc = MFMA32(frag_tr<64, false>(Kt, 16 * s, db * 32, lane), frag_tr<64, false>(Vt, 16 * s, eb * 32, lane), acc);
                    bf16_t* dst = (bf16_t*)rst + (size_t)ri * (RD * RD) + eb * 32 + r;
#pragma unroll
                    for (int reg = 0; reg < 16; ++reg) { const float o = __shfl_down(acc[reg], 1); if ((r & 1) == 0) *(unsigned*)(dst + (db * 32 + crow(reg, hl)) * RD) = cvtpk(acc[reg], o); }
                }
                MOE_PROCESS(tk); ++tk;
            }
#undef RET1_ISSUE
        }
        {
            LAS unsigned char* Kt = ldsl; LAS unsigned char* Vt = ldsl + 34816; LAS float* sw = (LAS float*)(ldsl + 69632);
            v4u raw[7], vv[4]; float gi0, gi1, gf0, gf1;
#define ML1_ISSUE(mi_) do { const int h_ = (mi_) & 3, bn_ = (mi_) >> 2, n_ = bn_ % NCH; const int cg_ = tid & 15, c0_ = 4 * (tid >> 4); \
                const bf16_t* tp_ = proj + ml_tile(bn_, 4 + h_) + c0_ * 128 + cg_ * 8; \
                _Pragma("unroll") for (int rr = 0; rr < 7; ++rr) { v4u x_ = {0u, 0u, 0u, 0u}; \
                    if (rr >= 3) x_ = *(const v4u*)(tp_ + (rr - 3) * 128); else if (c0_ > 0) x_ = *(const v4u*)(tp_ + (rr - 3) * 128); \
                    else if (n_ > 0) x_ = *(const v4u*)(tp_ + (rr - 3) * 128 - (ptrdiff_t)(CH * NP) + CH * 128); raw[rr] = x_; } \
                const bf16_t* vp_ = proj + ml_tile(bn_, 8 + h_) + tid * 8; \
                _Pragma("unroll") for (int i = 0; i < 4; ++i) vv[i] = *(const v4u*)(vp_ + i * (NTHREADS * 8)); \
                const float* gp_ = gates + ((size_t)bn_ * CH + 2 * lane) * 8 + h_; gi0 = gp_[0]; gi1 = gp_[8]; gf0 = gp_[4]; gf1 = gp_[12]; } while (0)
            const int mpb = (BATCH * NCH * MH + G - 1) / G, mi0 = bid * mpb, mi1 = (mi0 + mpb < BATCH * NCH * MH) ? mi0 + mpb : BATCH * NCH * MH;
            if (mi0 < mi1) ML1_ISSUE(mi0);
            for (int mi = mi0; mi < mi1; ++mi) {
                const int h = mi & 3;
                BAR_LDS();
                if (wave == 0) {
                    const float i0 = gi0 + P.b_ig[h], i1 = gi1 + P.b_ig[h];
                    float b0 = logsigmoidf_(gf0 + P.b_fg[h]), b1 = logsigmoidf_(gf1 + P.b_fg[h]);
                    wave_scan_sum2(b0, b1, lane);
                    const float bL = __shfl(b1, 63);
                    const float a0 = bL - b0 + i0, a1 = bL - b1 + i1;
                    const float mloc = wave_max(fmaxf(a0, a1));
                    sw[2 * lane] = expf(a0 - mloc); sw[2 * lane + 1] = expf(a1 - mloc);
                    if (lane == 0) { ml[mi] = mloc; mbl[mi] = bL; }
                }
#pragma unroll
                for (int i = 0; i < 4; ++i) { const int idx = tid + NTHREADS * i, row = idx >> 4, ch = idx & 15; *(LAS v4u*)(Vt + toff<128>(row, ch)) = vv[i]; }
                BAR_LDS();
                {   const int cg = tid & 15, c0 = 4 * (tid >> 4); const int chn = 512 + h * MD + cg * 8;
                    float cw[32], cb_[8];
#pragma unroll
                    for (int w = 0; w < 4; ++w) { const f4v a = *(const f4v*)(P.conv_w + w * 1024 + chn), b2 = *(const f4v*)(P.conv_w + w * 1024 + chn + 4);
                        cw[w * 8] = a.x; cw[w * 8 + 1] = a.y; cw[w * 8 + 2] = a.z; cw[w * 8 + 3] = a.w; cw[w * 8 + 4] = b2.x; cw[w * 8 + 5] = b2.y; cw[w * 8 + 6] = b2.z; cw[w * 8 + 7] = b2.w; }
                    { const f4v a = *(const f4v*)(P.conv_b + chn), b2 = *(const f4v*)(P.conv_b + chn + 4); cb_[0] = a.x; cb_[1] = a.y; cb_[2] = a.z; cb_[3] = a.w; cb_[4] = b2.x; cb_[5] = b2.y; cb_[6] = b2.z; cb_[7] = b2.w; }
#pragma unroll
                    for (int o = 0; o < 4; ++o) {
                        float a[8];
#pragma unroll
                        for (int i = 0; i < 8; ++i) a[i] = cb_[i];
#pragma unroll
                        for (int w = 0; w < 4; ++w) { const v4u x = raw[o + w];
                            a[0] += blo(x.x) * cw[w * 8 + 0]; a[1] += bhi(x.x) * cw[w * 8 + 1]; a[2] += blo(x.y) * cw[w * 8 + 2]; a[3] += bhi(x.y) * cw[w * 8 + 3];
                            a[4] += blo(x.z) * cw[w * 8 + 4]; a[5] += bhi(x.z) * cw[w * 8 + 5]; a[6] += blo(x.w) * cw[w * 8 + 6]; a[7] += bhi(x.w) * cw[w * 8 + 7]; }
                        const float sc = 0.08838834764831845f * sw[c0 + o];
#pragma unroll
                        for (int i = 0; i < 8; ++i) a[i] = a[i] * fast_sig(a[i]) * sc;
                        v4u w; w.x = cvtpk(a[0], a[1]); w.y = cvtpk(a[2], a[3]); w.z = cvtpk(a[4], a[5]); w.w = cvtpk(a[6], a[7]);
                        *(LAS v4u*)(Kt + toff<128>(c0 + o, cg)) = w;
                    }
                }
                BAR_LDS();
                if (mi + 1 < mi1) ML1_ISSUE(mi + 1);
                {
                    const int db = wave >> 1, ep = wave & 1, r = lane & 31, hl = lane >> 5;
                    f32x16 acc0 = zero16(), acc1 = zero16(), accn = zero16();
                    bf16x8 ones;
#pragma unroll
                    for (int i = 0; i < 8; ++i) ones[i] = (short)0x3F80;
#pragma unroll
                    for (int s = 0; s < 8; ++s) { const bf16x8 ka = frag_tr<128, false>(Kt, 16 * s, db * 32, lane);
                        acc0 = MFMA32(ka, frag_tr<128, false>(Vt, 16 * s, ep * 64, lane), acc0);
                        acc1 = MFMA32(ka, frag_tr<128, false>(Vt, 16 * s, ep * 64 + 32, lane), acc1);
                        if (ep == 0) accn = MFMA32(ka, ones, accn); }
                    bf16_t* dst = (bf16_t*)mst + (size_t)mi * (MD * MD) + ep * 64 + r;
#pragma unroll
                    for (int reg = 0; reg < 16; ++reg) { const int d = db * 32 + crow(reg, hl); const float o0 = __shfl_down(acc0[reg], 1), o1 = __shfl_down(acc1[reg], 1);
                        if ((r & 1) == 0) { *(unsigned*)(dst + d * MD) = cvtpk(acc0[reg], o0); *(unsigned*)(dst + d * MD + 32) = cvtpk(acc1[reg], o1); } }
                    if (ep == 0 && r == 0) {
#pragma unroll
                        for (int reg = 0; reg < 16; ++reg) mn[(size_t)mi * MD + db * 32 + crow(reg, hl)] = accn[reg];
                    }
                }
                MOE_PROCESS(tk); ++tk;
            }
#undef ML1_ISSUE
        }
        BAR_LDS();
        for (; tk < 12; ++tk) { MOE_PROCESS(tk); BAR_LDS(); }
#undef MOE_DECODE
#undef MOE_LOAD
#undef MOE_PROCESS
#undef BAR_LDS
    }
    GRID_BAR(2);
    if constexpr (IN(3)) {
        PH_IDS
        constexpr int NRT = BATCH * RH * (RD * RD / 4), NMT = BATCH * MH * (MD * MD / 4), NNT = BATCH * MH * (MD / 4);
        bf16_t* rstb = (bf16_t*)(ws + WS_RSTB); bf16_t* mstb = (bf16_t*)((unsigned char*)out + OUT_MSTB);
        for (int task = bid * NTHREADS + tid; task < NRT + NMT + NNT; task += G * NTHREADS) {
            if (task < NRT) {
                const int el = (task % (RD * RD / 4)) * 4, bh = task / (RD * RD / 4), b = bh / RH, h = bh % RH;
                const float dec = expf(log1pf(-exp2f(-5.0f - (float)h)) * (float)CH);
                const size_t base = (size_t)(b * NCH * RH + h) * (RD * RD) + el, nstride = (size_t)RH * RD * RD;
                f4v R = {0.f, 0.f, 0.f, 0.f};
#pragma unroll 1
                for (int n0 = 0; n0 < NCH; n0 += 8) {
                    f4v v[8];
#pragma unroll
                    for (int i = 0; i < 8; ++i) { const v2u q = __builtin_nontemporal_load((const v2u*)((const bf16_t*)rst + base + (size_t)(n0 + i) * nstride)); v[i].x = blo(q.x); v[i].y = bhi(q.x); v[i].z = blo(q.y); v[i].w = bhi(q.y); }
#pragma unroll
                    for (int i = 0; i < 8; ++i) { v2u o; o.x = cvtpk(R.x, R.y); o.y = cvtpk(R.z, R.w); *(v2u*)(rstb + base + (size_t)(n0 + i) * nstride) = o; R = R * dec + v[i]; }
                }
            } else {
                const int j = task - NRT; const bool isn = j >= NMT; const int jj = isn ? j - NMT : j, per = isn ? MD / 4 : MD * MD / 4;
                const int el = (jj % per) * 4, bh = jj / per, b = bh / MH, h = bh % MH;
                const int s0 = b * NCH * MH + h;
                f4v S = {0.f, 0.f, 0.f, 0.f}; float m = 0.f;
#pragma unroll 1
                for (int n0 = 0; n0 < NCH; n0 += 8) {
                    f4v v[8]; float bl[8], mlc[8];
#pragma unroll
                    for (int i = 0; i < 8; ++i) { const int sidx = s0 + (n0 + i) * MH; bl[i] = mbl[sidx]; mlc[i] = ml[sidx];
                        if (isn) v[i] = *(const f4v*)(mn + (size_t)sidx * MD + el);
                        else { const v2u q = __builtin_nontemporal_load((const v2u*)((const bf16_t*)mst + (size_t)sidx * (MD * MD) + el)); v[i].x = blo(q.x); v[i].y = bhi(q.x); v[i].z = blo(q.y); v[i].w = bhi(q.y); } }
#pragma unroll
                    for (int i = 0; i < 8; ++i) { const int sidx = s0 + (n0 + i) * MH;
                        const float mnew = fmaxf(bl[i] + m, mlc[i]);
                        const float dec = expf(bl[i] + m - mnew), sc = expf(mlc[i] - mnew);
                        if (isn) { *(f4v*)(mn + (size_t)sidx * MD + el) = S; if (el == 0) mm[sidx] = m; }
                        else { v2u o; o.x = cvtpk(S.x, S.y); o.y = cvtpk(S.z, S.w); *(v2u*)(mstb + (size_t)sidx * (MD * MD) + el) = o; }
                        S = S * dec + v[i] * sc; m = mnew; }
                }
            }
        }
    }
    GRID_BAR(3);
    if constexpr (IN(4)) {
        PH_IDS
        const float* cstab = (const float*)(ws + WS_CS);
        const bf16_t* rstb = (const bf16_t*)(ws + WS_RSTB); const bf16_t* mstb = (const bf16_t*)((unsigned char*)out + OUT_MSTB);
#define BAR_LDS() do { asm volatile("s_waitcnt lgkmcnt(0)" ::: "memory"); __builtin_amdgcn_s_barrier(); asm volatile("" ::: "memory"); } while (0)
        BAR_LDS();
        if (PROBE_PH == 100) pt0 = __builtin_amdgcn_s_memrealtime();
        {
            LAS unsigned char* Qt = ldsl; LAS unsigned char* Kt = ldsl + 18432; LAS unsigned char* Vt = ldsl + 36864; LAS unsigned char* Rpt = ldsl + 55296;
            LAS float* Zs = (LAS float*)(ldsl + 65536);
            LAS float* sgn = (LAS float*)(ldsl + 110592);
            sgn[tid] = P.ret_gn[tid];
            RetPre R;
            const int rpb = (BATCH * NCH * RH + G - 1) / G, ri0 = bid * rpb, ri1 = (ri0 + rpb < BATCH * NCH * RH) ? ri0 + rpb : BATCH * NCH * RH;
            if (ri0 < ri1) ret_issue(R, proj, cstab, rstb, ri0, tid);
            for (int ri = ri0; ri < ri1; ++ri) {
                int tid_i = threadIdx.x; asm volatile("" : "+v"(tid_i));
                const int tid = tid_i, lane = tid & 63;
                const int h = ri & 7; const size_t t0 = (size_t)(ri >> 3) * CH;
                const float lg2 = log1pf(-exp2f(-5.0f - (float)h)) * 1.4426950408889634f;
                ret_stage(R, Qt, Kt, Vt, Rpt, tid);
                BAR_LDS();
                const int ce = tid >> 2, e0 = (tid & 3) * 16; const size_t te = t0 + ce;
                const bf16_t* gp_ = proj + ret_tile(ri >> 3, 24 + h) + ce * 64 + e0; const v4u g0 = __builtin_nontemporal_load((const v4u*)gp_), g1 = __builtin_nontemporal_load((const v4u*)(gp_ + 8));
                asm volatile("" :: "v"(g0), "v"(g1));
                if (ri + 1 < ri1) ret_issue(R, proj, cstab, rstb, ri + 1, tid);
                const int prow = bid * (T / 256) + (ri - ri0) * 16 + wave * 2;
                const bool pdo = (ri - ri0) < 8 && G == 256;
                f4v pv0 = {0.f, 0.f, 0.f, 0.f}, pv1 = pv0;
                if (pdo) { pv0 = __builtin_nontemporal_load((const f4v*)(P.p + (size_t)prow * PLE) + lane); pv1 = __builtin_nontemporal_load((const f4v*)(P.p + (size_t)(prow + 1) * PLE) + lane); }
                {
                    const int cb = (0x1023 >> (4 * (wave >> 1))) & 3,     eb = wave & 1, r = lane & 31, hl = lane >> 5;
                    f32x16 Z = zero16();
                    const int c = cb * 32 + r;
                    for (int jb = 0; jb <= cb; ++jb) {
                        f32x16 X = zero16();
#pragma unroll
                        for (int s = 0; s < 4; ++s) X = MFMA32(frag_row<64>(Kt, jb * 32 + r, s, hl), frag_row<64>(Qt, cb * 32 + r, s, hl), X);
#pragma unroll
                        for (int reg = 0; reg < 16; ++reg) { const int dl = c - (jb * 32 + crow(reg, hl)); X[reg] = dl >= 0 ? X[reg] * __builtin_amdgcn_exp2f(lg2 * (float)dl) : 0.f; }
#pragma unroll
                        for (int s2 = 0; s2 < 2; ++s2) Z = MFMA32(pack_step(X, s2), frag_tr<64, true>(Vt, jb * 32 + 16 * s2, eb * 32, lane), Z);
                    }
                    f32x16 Zi = zero16();
#pragma unroll
                    for (int s = 0; s < 4; ++s) Zi = MFMA32(frag_row<64>(Qt, cb * 32 + r, s, hl), frag_tr<64, false>(Rpt, 16 * s, eb * 32, lane), Zi);
#pragma unroll
                    for (int reg = 0; reg < 16; ++reg) { const int cc = cb * 32 + crow(reg, hl); Z[reg] += __builtin_amdgcn_exp2f(lg2 * (float)(cc + 1)) * Zi[reg]; Zs[cc * 68 + eb * 32 + r] = Z[reg]; }
                }
                BAR_LDS();
                {
                    float z[16]; float ss = 0.f;
#pragma unroll
                    for (int i = 0; i < 4; ++i) { const f4v v = *(const LAS f4v*)(Zs + ce * 68 + e0 + 4 * i); z[4 * i] = v.x; z[4 * i + 1] = v.y; z[4 * i + 2] = v.z; z[4 * i + 3] = v.w; }
#pragma unroll
                    for (int i = 0; i < 16; ++i) ss += z[i] * z[i];
                    ss += __shfl_xor(ss, 1); ss += __shfl_xor(ss, 2);
                    const float rn = 1.0f / sqrtf(ss * (1.0f / RD) + EPS);
                    const float gg[16] = {blo(g0.x), bhi(g0.x), blo(g0.y), bhi(g0.y), blo(g0.z), bhi(g0.z), blo(g0.w), bhi(g0.w), blo(g1.x), bhi(g1.x), blo(g1.y), bhi(g1.y), blo(g1.z), bhi(g1.z), blo(g1.w), bhi(g1.w)};
                    float o[16];
#pragma unroll
                    for (int i = 0; i < 16; ++i) o[i] = gg[i] * fast_sig(gg[i]) * z[i] * rn * sgn[h * RD + e0 + i];
                    v4u w0, w1; w0.x = cvtpk(o[0], o[1]); w0.y = cvtpk(o[2], o[3]); w0.z = cvtpk(o[4], o[5]); w0.w = cvtpk(o[6], o[7]);
                    w1.x = cvtpk(o[8], o[9]); w1.y = cvtpk(o[10], o[11]); w1.z = cvtpk(o[12], o[13]); w1.w = cvtpk(o[14], o[15]);
                    *(v4u*)(yreg + te * D + h * RD + e0) = w0; *(v4u*)(yreg + te * D + h * RD + e0 + 8) = w1;
                }
                if (pdo) { v2u o0, o1; o0.x = cvtpk(pv0.x, pv0.y); o0.y = cvtpk(pv0.z, pv0.w); o1.x = cvtpk(pv1.x, pv1.y); o1.y = cvtpk(pv1.z, pv1.w);
                    ((v2u*)(pb + (size_t)prow * PLE))[lane] = o0; ((v2u*)(pb + (size_t)(prow + 1) * PLE))[lane] = o1; }
            }
        }
        BAR_LDS();
        if (PROBE_PH == 100) pt1 = __builtin_amdgcn_s_memrealtime();
        if (PROBE_PH == 101) pt0 = __builtin_amdgcn_s_memrealtime();
        {
            LAS unsigned char* Qt = ldsl; LAS unsigned char* Kt = ldsl + 34816; LAS unsigned char* Vt = ldsl + 69632; LAS unsigned char* Spt = ldsl + 104448;
            LAS float* sb = (LAS float*)(ldsl + 139264); LAS float* sg = sb + 128; LAS float* spm = sg + 128; LAS float* snp = spm + 128; LAS float* sden = snp + 128; LAS float* swi = sden + 128;
            LAS float* Zs = (LAS float*)(ldsl + 34816);
            MlPre M;
            const int mpb = (BATCH * NCH * MH + G - 1) / G, mi0 = bid * mpb, mi1 = (mi0 + mpb < BATCH * NCH * MH) ? mi0 + mpb : BATCH * NCH * MH;
            if (mi0 < mi1) { ml_issue_a(M, proj, gates, mstb, mn, mm, mi0, tid, lane); ml_issue_b(M, proj, mi0, tid); }
            if (PROBE_PH >= 110 && PROBE_PH < 120) plast = __builtin_amdgcn_s_memrealtime();
            for (int mi = mi0; mi < mi1; ++mi) {
                int tid_i = threadIdx.x; asm volatile("" : "+v"(tid_i));
                const int tid = tid_i, lane = tid & 63;
                const int h = mi & 3; const size_t t0 = (size_t)(mi >> 2) * CH;
                const float mprev = M.mprev;
                SEG(3);
                BAR_LDS();
                if (wave == 0) {
                    const float i0 = M.gi0 + P.b_ig[h], i1 = M.gi1 + P.b_ig[h];
                    float b0 = logsigmoidf_(M.gf0 + P.b_fg[h]), b1 = logsigmoidf_(M.gf1 + P.b_fg[h]);
                    wave_scan_sum2(b0, b1, lane);
                    const float g0 = i0 - b0, g1 = i1 - b1; float p0 = g0, p1 = g1;
                    wave_scan_max2(p0, p1, lane);
                    sb[2 * lane] = b0; sb[2 * lane + 1] = b1; sg[2 * lane] = g0; sg[2 * lane + 1] = g1; spm[2 * lane] = p0; spm[2 * lane + 1] = p1;
                    swi[2 * lane] = expf(mprev - fmaxf(p0, mprev)); swi[2 * lane + 1] = expf(mprev - fmaxf(p1, mprev));
                } else if (wave == 1) { snp[lane] = M.np0; snp[lane + 64] = M.np1; }
                ml_stage(M, Qt, Kt, Vt, Spt, P.conv_w, P.conv_b, h, tid);
                BAR_LDS();
                SEG(0);
                const int ce = tid >> 2, qd = tid & 3, e0 = qd * 32; const size_t te = t0 + ce;
                if (mi + 1 < mi1) ml_issue_a(M, proj, gates, mstb, mn, mm, mi + 1, tid, lane);
                const int cb = (0x1023 >> (4 * (wave >> 1))) & 3,     ep = wave & 1, r = lane & 31, hl = lane >> 5;
                f32x16 Z0 = zero16(), Z1 = zero16();
                {
                    const int c = cb * 32 + r;
#pragma unroll
                    for (int s = 0; s < 8; ++s) { const bf16x8 qa = frag_row<128>(Qt, cb * 32 + r, s, hl);
                        Z0 = MFMA32(qa, frag_tr<128, false>(Spt, 16 * s, ep * 64, lane), Z0);
                        Z1 = MFMA32(qa, frag_tr<128, false>(Spt, 16 * s, ep * 64 + 32, lane), Z1); }
#pragma unroll
                    for (int reg = 0; reg < 16; ++reg) { const float wi = swi[cb * 32 + crow(reg, hl)]; Z0[reg] *= wi; Z1[reg] *= wi; }
                    const float nc = -fmaxf(spm[c], mprev); float den = 0.f;
                    for (int jb = 0; jb <= cb; ++jb) {
                        f32x16 X = zero16();
#pragma unroll
                        for (int s = 0; s < 8; ++s) X = MFMA32(frag_row<128>(Kt, jb * 32 + r, s, hl), frag_row<128>(Qt, cb * 32 + r, s, hl), X);
                        {
                            f4v gq[4];
#pragma unroll
                            for (int g4 = 0; g4 < 4; ++g4) gq[g4] = *(const LAS f4v*)(sg + jb * 32 + 8 * g4 + 4 * hl);
#pragma unroll
                            for (int reg = 0; reg < 16; ++reg) { const int j = jb * 32 + crow(reg, hl);
                                const float f = __builtin_amdgcn_exp2f(1.4426950408889634f * (nc + gq[reg >> 2][reg & 3]));
                                const float xv = X[reg] * f; X[reg] = j <= c ? xv : 0.f; den += X[reg]; }
                        }
#pragma unroll
                        for (int s2 = 0; s2 < 2; ++s2) { const bf16x8 xs_ = pack_step(X, s2);
                            Z0 = MFMA32(xs_, frag_tr<128, true>(Vt, jb * 32 + 16 * s2, ep * 64, lane), Z0);
                            Z1 = MFMA32(xs_, frag_tr<128, true>(Vt, jb * 32 + 16 * s2, ep * 64 + 32, lane), Z1); }
                    }
                    den += __shfl_xor(den, 32);
                    if (ep == 0 && hl == 0) sden[c] = den;
                }
                BAR_LDS();
                SEG(1);
#pragma unroll
                for (int reg = 0; reg < 16; ++reg) { const int cc = cb * 32 + crow(reg, hl); Zs[cc * 132 + ep * 64 + r] = Z0[reg]; Zs[cc * 132 + ep * 64 + 32 + r] = Z1[reg]; }
                BAR_LDS();
                SEG(2);
                v4u ov[4];
#pragma unroll
                for (int i = 0; i < 4; ++i) ov[i] = __builtin_nontemporal_load((const v4u*)(proj + ml_tile(mi >> 2, 12 + h) + ce * 128 + e0 + 8 * i));
                f4v gnm[8];
#pragma unroll
                for (int i = 0; i < 8; ++i) gnm[i] = *(const f4v*)(P.ml_gn + h * MD + e0 + 4 * i);
                asm volatile("" :: "v"(ov[0]), "v"(ov[1]), "v"(ov[2]), "v"(ov[3]));
                asm volatile("" :: "v"(gnm[0]), "v"(gnm[1]), "v"(gnm[2]), "v"(gnm[3]), "v"(gnm[4]), "v"(gnm[5]), "v"(gnm[6]), "v"(gnm[7]));
                if (mi + 1 < mi1) ml_issue_b(M, proj, mi + 1, tid);
                {
                    float qn = 0.f;
#pragma unroll
                    for (int i = 0; i < 4; ++i) { const v4u qv = *(const LAS v4u*)(Qt + toff<128>(ce, 4 * qd + i)); const LAS float* np_ = snp + 32 * qd + 8 * i;
                        qn += blo(qv.x) * np_[0] + bhi(qv.x) * np_[1] + blo(qv.y) * np_[2] + bhi(qv.y) * np_[3] + blo(qv.z) * np_[4] + bhi(qv.z) * np_[5] + blo(qv.w) * np_[6] + bhi(qv.w) * np_[7]; }
                    qn += __shfl_xor(qn, 1); qn += __shfl_xor(qn, 2);
                    const float Mx = fmaxf(spm[ce], mprev), mrow = sb[ce] + Mx;
                    const float den = sden[ce] + swi[ce] * qn;
                    const float inv = 1.0f / fmaxf(fabsf(den), expf(-mrow));
                    float z[32]; float ss = 0.f;
#pragma unroll
                    for (int i = 0; i < 8; ++i) { const f4v v = *(const LAS f4v*)(Zs + ce * 132 + e0 + 4 * i); z[4 * i] = v.x; z[4 * i + 1] = v.y; z[4 * i + 2] = v.z; z[4 * i + 3] = v.w; }
#pragma unroll
                    for (int i = 0; i < 4; ++i) { const v4u ovi = ov[i];
                        const float oo[8] = {blo(ovi.x), bhi(ovi.x), blo(ovi.y), bhi(ovi.y), blo(ovi.z), bhi(ovi.z), blo(ovi.w), bhi(ovi.w)};
#pragma unroll
                        for (int k = 0; k < 8; ++k) { const float v = fast_sig(oo[k]) * z[8 * i + k] * inv; z[8 * i + k] = v; ss += v * v; } }
                    ss += __shfl_xor(ss, 1); ss += __shfl_xor(ss, 2);
                    const float rn = 1.0f / sqrtf(ss * (1.0f / MD) + EPS);
                    bf16_t* yp = yreg + te * D + 512 + h * MD + e0;
#pragma unroll
                    for (int i = 0; i < 4; ++i) { const f4v ga = gnm[2 * i], gb = gnm[2 * i + 1];
                        v4u w; w.x = cvtpk(z[8 * i] * rn * ga.x, z[8 * i + 1] * rn * ga.y); w.y = cvtpk(z[8 * i + 2] * rn * ga.z, z[8 * i + 3] * rn * ga.w);
                        w.z = cvtpk(z[8 * i + 4] * rn * gb.x, z[8 * i + 5] * rn * gb.y); w.w = cvtpk(z[8 * i + 6] * rn * gb.z, z[8 * i + 7] * rn * gb.w);
                        *(v4u*)(yp + 8 * i) = w; }
                }
            }
        }
        BAR_LDS();
        if (PROBE_PH == 101) pt1 = __builtin_amdgcn_s_memrealtime();
#undef BAR_LDS
    }
    GRID_BAR(4);
    if constexpr (IN(5)) {
        PH_IDS
        pg8::Gemm g{yreg, wout_t, T, D, D, nullptr}; pg8::StaticOrder S; S.init(T, D, G, bid);
        pg8::EpiRes E{P.x, (bf16_t*)((unsigned char*)out + OUT_HB)};
        pg8::gemm_phase<pg8::EpiRes, pg8::StaticOrder, true, true>(ldsl, g, S, E);
    }
    GRID_BAR(5);
    if constexpr (IN(6)) {
        PH_IDS
        LAS unsigned char* Bh = ldsl;
        LAS unsigned char* Bl = ldsl + 49920;
        LAS float* Ls = (LAS float*)(ldsl + 106496);
        LAS int* lcnt = (LAS int*)(ldsl + 131584); LAS int* lbase = lcnt + 32;
        const bf16_t* wrh = (const bf16_t*)(ws + WS_WR); const bf16_t* wrl = wrh + 48 * D;
        for (int unit = bid; unit < T / 128; unit += G) {
            const int tok0 = unit * 128 + wave * 16, row = lane & 15, kq = lane >> 4;
            const bf16_t* ap = (const bf16_t*)((unsigned char*)out + OUT_HB) + (size_t)(tok0 + row) * D + 8 * kq;
            pg8::f32x4 c0 = {0.f, 0.f, 0.f, 0.f}, c1 = c0, c2 = c0; float ss = 0.f;
            if (tid < 32) lcnt[tid] = 0;
#pragma unroll 1
            for (int kh = 0; kh < 2; ++kh) {
                __syncthreads();
                for (int idx = tid; idx < 48 * 64; idx += NTHREADS) { const int col = idx >> 6, ch = idx & 63;
                    *(LAS v4u*)(Bh + col * 1040 + ch * 16) = *(const v4u*)(wrh + col * D + kh * 512 + ch * 8);
                    *(LAS v4u*)(Bl + col * 1040 + ch * 16) = *(const v4u*)(wrl + col * D + kh * 512 + ch * 8); }
                __syncthreads();
#pragma unroll 4
                for (int st = 0; st < 16; ++st) {
                    const v4u hq = *(const v4u*)(ap + kh * 512 + st * 32);
                    const float a8[8] = {blo(hq.x), bhi(hq.x), blo(hq.y), bhi(hq.y), blo(hq.z), bhi(hq.z), blo(hq.w), bhi(hq.w)};
#pragma unroll
                    for (int i = 0; i < 8; ++i) ss += a8[i] * a8[i];
                    const bf16x8 af = __builtin_bit_cast(bf16x8, hq);
                    const int bo = row * 1040 + (st * 32 + 8 * kq) * 2;
                    c0 = __builtin_amdgcn_mfma_f32_16x16x32_bf16(af, *(const LAS bf16x8*)(Bh + bo), c0, 0, 0, 0);
                    c0 = __builtin_amdgcn_mfma_f32_16x16x32_bf16(af, *(const LAS bf16x8*)(Bl + bo), c0, 0, 0, 0);
                    c1 = __builtin_amdgcn_mfma_f32_16x16x32_bf16(af, *(const LAS bf16x8*)(Bh + bo + 16 * 1040), c1, 0, 0, 0);
                    c1 = __builtin_amdgcn_mfma_f32_16x16x32_bf16(af, *(const LAS bf16x8*)(Bl + bo + 16 * 1040), c1, 0, 0, 0);
                    c2 = __builtin_amdgcn_mfma_f32_16x16x32_bf16(af, *(const LAS bf16x8*)(Bh + bo + 32 * 1040), c2, 0, 0, 0);
                    c2 = __builtin_amdgcn_mfma_f32_16x16x32_bf16(af, *(const LAS bf16x8*)(Bl + bo + 32 * 1040), c2, 0, 0, 0);
                }
            }
            ss += __shfl_xor(ss, 16); ss += __shfl_xor(ss, 32);
            const float rstd = 1.0f / sqrtf(ss * (1.0f / D) + EPS);
#pragma unroll
            for (int reg = 0; reg < 4; ++reg) { LAS float* lp = Ls + (wave * 16 + 4 * kq + reg) * 49 + row; lp[0] = c0[reg]; lp[16] = c1[reg]; lp[32] = c2[reg]; }
            __syncthreads();
            const int tok = tok0 + row;
            const LAS float* lp = Ls + (wave * 16 + row) * 49;
            float gl[4];
#pragma unroll
            for (int i = 0; i < 4; ++i) gl[i] = lp[i] * rstd + P.b_group[i];
            int gs = 0; float gmax = gl[0];
#pragma unroll
            for (int i = 1; i < 4; ++i) if (gl[i] > gmax) { gmax = gl[i]; gs = i; }
            float gsum = 0.f;
#pragma unroll
            for (int i = 0; i < 4; ++i) gsum += expf(gl[i] - gmax);
            const float pg = 1.0f / gsum;
            float el[8];
#pragma unroll
            for (int i = 0; i < 8; ++i) el[i] = lp[4 + gs * 8 + i] * rstd + P.b_router[gs * 8 + i];
            int i0 = 0; float l0 = el[0];
#pragma unroll
            for (int i = 1; i < 8; ++i) if (el[i] > l0) { l0 = el[i]; i0 = i; }
            int i1 = -1; float l1 = -INFINITY;
#pragma unroll
            for (int i = 0; i < 8; ++i) if (i != i0 && el[i] > l1) { l1 = el[i]; i1 = i; }
            const float rr = expf(l1 - l0);
            const float g0 = pg / (1.0f + rr), g1 = pg * rr / (1.0f + rr);
            const int e0 = gs * 8 + i0, e1 = gs * 8 + i1;
            int lp0 = 0, lp1 = 0;
            if (lane < 16) { lp0 = __hip_atomic_fetch_add(&lcnt[e0], 1, __ATOMIC_RELAXED, __HIP_MEMORY_SCOPE_WORKGROUP); lp1 = __hip_atomic_fetch_add(&lcnt[e1], 1, __ATOMIC_RELAXED, __HIP_MEMORY_SCOPE_WORKGROUP); }
            __syncthreads();
            if (tid < 32) { const int c = lcnt[tid]; lbase[tid] = c ? atomicAdd(&cnt[tid], c) : 0; }
            __syncthreads();
            if (lane < 16) {
                const int p0 = lbase[e0] + lp0, p1 = lbase[e1] + lp1;
                list[(size_t)e0 * T + p0] = tok; list[(size_t)e1 * T + p1] = tok;
                *(int2*)(eid + tok * 2) = make_int2(e0, e1); *(int2*)(posn + tok * 2) = make_int2(p0, p1);
                *(float2*)(gate + tok * 2) = make_float2(g0, g1);
                rstd1[tok] = rstd;
            }
        }
        __syncthreads();
    }
    GRID_BAR(6);
    if constexpr (IN(8) || IN(9) || IN(11)) {
        PH_IDS
        __syncthreads();
        if (tid == 0) { int o = 0; for (int e = 0; e < NE; ++e) { const int c = cnt[e]; s_cnt[e] = c; s_off[e] = o; const int nt = (c + 255) >> 8; for (int i = 0; i < nt; ++i) s_t2e[(o >> 8) + i] = e; o += nt << 8; } s_off[NE] = o; }
        __syncthreads();
    }
    if constexpr (IN(8)) {
        PH_IDS
        const int NS = s_off[NE];
        LAS int* gtok = (LAS int*)(ldsl + RING_BYTES); LAS float* rtab = (LAS float*)(ldsl + RING_BYTES + 6144);
        pg8::GroupedOrder S; S.init(NS >> 8, G, bid, (const LAS int*)s_t2e);
        {   pg8::Unit u;
            for (int ui = 0; ui < 6 && S.next(ui, u); ++ui) {
                const int e = s_t2e[u.pm], base = s_off[e], c = s_cnt[e];
                if (tid < 256) { const int i = u.pm * 256 + tid - base; int tok = 0; float rs = 0.f; if (i < c) { tok = list[(size_t)e * T + i]; rs = rstd1[tok]; } gtok[ui * 256 + tid] = tok; rtab[ui * 256 + tid] = rs; }
            }
        }
        __syncthreads();
        pg8::Gemm g{(const bf16_t*)((unsigned char*)out + OUT_HB), w13_t, NS, NE * 1024, D, (const LAS int*)gtok};
        pg8::EpiSwiglu E{hbuf, (const LAS float*)rtab};
        pg8::gemm_phase<pg8::EpiSwiglu, pg8::GroupedOrder, true, true, true>(ldsl, g, S, E);
        {
            const int nwg8 = (NS >> 8) * 4, full = nwg8 / G, extra = nwg8 - full * G;
            pg8::Gemm g2{pb, wup_t, T, D, PLE, nullptr}; pg8::SkewOrder S2; S2.init((T / 256) * 4, G, bid, extra);
            pg8::EpiStoreBf16 E2{peb, D, 0xffff, part, 0};
            pg8::gemm_phase<pg8::EpiStoreBf16, pg8::SkewOrder, true, true>(ldsl, g2, S2, E2);
        }
    }
    GRID_BAR(8);
    if constexpr (IN(9)) {
        PH_IDS
        const int NS = s_off[NE];
        pg8::Gemm g{hbuf, w2_t, NS, NE * 1024, DE, nullptr}; pg8::GroupedOrder S; S.init(NS >> 8, G, bid, (const LAS int*)s_t2e);
        pg8::EpiStoreBf16 E{ybuf, D, 3, nullptr, 0};
        pg8::gemm_phase<pg8::EpiStoreBf16, pg8::GroupedOrder, true, true>(ldsl, g, S, E);
    }
    GRID_BAR(9);
    if constexpr (IN(11)) {
        PH_IDS
        const bf16_t* hb = (const bf16_t*)((unsigned char*)out + OUT_HB); bf16_t* a2b = (bf16_t*)(ws + WS_A2);
        const int ntrip = T / (2 * NGW);
        int sA[2][2], sB[2][2]; float gA[2][2], gB[2][2]; v4u dA[2][3][2], dB[2][3][2]; float pA[2], pB[2];
#define E0_IDX(s_, g_, trip_) do { _Pragma("unroll") for (int u = 0; u < 2; ++u) { const int row = gw + (2 * (trip_) + u) * NGW; \
            const int2 e2 = *(const int2*)(eid + row * 2), p2 = *(const int2*)(posn + row * 2); const float2 g2 = *(const float2*)(gate + row * 2); \
            s_[u][0] = s_off[e2.x] + p2.x; s_[u][1] = s_off[e2.y] + p2.y; g_[u][0] = g2.x; g_[u][1] = g2.y; } } while (0)
#define E0_LOAD(d_, p_, s_, trip_) do { _Pragma("unroll") for (int u = 0; u < 2; ++u) { const int row = gw + (2 * (trip_) + u) * NGW; \
            _Pragma("unroll") for (int j = 0; j < 2; ++j) { const int k0 = 8 * (lane + 64 * j); \
                d_[u][0][j] = __builtin_nontemporal_load((const v4u*)(hb + (size_t)row * D + k0)); d_[u][1][j] = __builtin_nontemporal_load((const v4u*)(ybuf + (size_t)s_[u][0] * D + k0)); d_[u][2][j] = __builtin_nontemporal_load((const v4u*)(ybuf + (size_t)s_[u][1] * D + k0)); } \
            p_[u] = lane < 16 ? part[(size_t)row * 16 + lane] : 0.f; } } while (0)
#define E0_COMP(d_, p_, g_, trip_) do { _Pragma("unroll") for (int u = 0; u < 2; ++u) { const int row = gw + (2 * (trip_) + u) * NGW; const float g0 = g_[u][0], g1 = g_[u][1]; float ss = 0.f; \
            _Pragma("unroll") for (int j = 0; j < 2; ++j) { const int k0 = 8 * (lane + 64 * j); const v4u hq = d_[u][0][j], y0 = d_[u][1][j], y1 = d_[u][2][j]; float hv[8]; \
                hv[0] = blo(hq.x) + g0 * blo(y0.x) + g1 * blo(y1.x); hv[1] = bhi(hq.x) + g0 * bhi(y0.x) + g1 * bhi(y1.x); \
                hv[2] = blo(hq.y) + g0 * blo(y0.y) + g1 * blo(y1.y); hv[3] = bhi(hq.y) + g0 * bhi(y0.y) + g1 * bhi(y1.y); \
                hv[4] = blo(hq.z) + g0 * blo(y0.z) + g1 * blo(y1.z); hv[5] = bhi(hq.z) + g0 * bhi(y0.z) + g1 * bhi(y1.z); \
                hv[6] = blo(hq.w) + g0 * blo(y0.w) + g1 * blo(y1.w); hv[7] = bhi(hq.w) + g0 * bhi(y0.w) + g1 * bhi(y1.w); \
                v4u o; o.x = cvtpk(hv[0], hv[1]); o.y = cvtpk(hv[2], hv[3]); o.z = cvtpk(hv[4], hv[5]); o.w = cvtpk(hv[6], hv[7]); \
                  \
                const float r8[8] = {blo(o.x), bhi(o.x), blo(o.y), bhi(o.y), blo(o.z), bhi(o.z), blo(o.w), bhi(o.w)}; \
                _Pragma("unroll") for (int i = 0; i < 8; ++i) ss += r8[i] * r8[i]; \
                *(v4u*)(a2b + (size_t)row * D + k0) = o; } \
            ss = wave_sum(ss); const float pe = wave_sum(p_[u]); \
            if (lane == 0) { rstdg[row] = 1.0f / sqrtf(ss * (1.0f / D) + EPS); rstde[row] = 1.0f / sqrtf(pe * (1.0f / D) + EPS); } } } while (0)
        E0_IDX(sA, gA, 0); E0_LOAD(dA, pA, sA, 0);
        if (ntrip > 1) E0_IDX(sB, gB, 1);
        for (int trip = 0; trip < ntrip; trip += 2) {
            if (trip + 1 < ntrip) E0_LOAD(dB, pB, sB, trip + 1);
            E0_COMP(dA, pA, gA, trip);
            if (trip + 2 < ntrip) E0_IDX(sA, gA, trip + 2);
            if (trip + 1 < ntrip) {
                if (trip + 2 < ntrip) E0_LOAD(dA, pA, sA, trip + 2);
                E0_COMP(dB, pB, gB, trip + 1);
                if (trip + 3 < ntrip) E0_IDX(sB, gB, trip + 3);
            }
        }
#undef E0_IDX
#undef E0_LOAD
#undef E0_COMP
    }
    GRID_BAR(11);
    if constexpr (IN(12)) {
        PH_IDS
        pg8::Gemm g{(const bf16_t*)(ws + WS_A2), wgate_t, T, D, D, nullptr}; pg8::StaticOrder S; S.init(T, D, G, bid);
        pg8::EpiGate E{(bf16_t*)(ws + WS_H3B), (const bf16_t*)(ws + WS_A2), peb, rstdg, rstde, P.ple_norm, part2};
        pg8::gemm_phase<pg8::EpiGate, pg8::StaticOrder, true, true>(ldsl, g, S, E);
    }
    GRID_BAR(12);
    if constexpr (IN(13)) {
        PH_IDS
        const bf16_t* h3b = (const bf16_t*)(ws + WS_H3B);
        for (int row0 = gw; row0 < T; row0 += 2 * NGW) {
            v4u hq[2][2]; float ssv[2];
#pragma unroll
            for (int u = 0; u < 2; ++u) { const int row = row0 + u * NGW; hq[u][0] = __builtin_nontemporal_load((const v4u*)(h3b + (size_t)row * D + 8 * lane)); hq[u][1] = __builtin_nontemporal_load((const v4u*)(h3b + (size_t)row * D + 8 * (lane + 64)));
                ssv[u] = lane < 16 ? part2[(size_t)row * 16 + lane] : 0.f; }
#pragma unroll
            for (int u = 0; u < 2; ++u) {
                const int row = row0 + u * NGW;
                const float rstd = 1.0f / sqrtf(wave_sum(ssv[u]) * (1.0f / D) + EPS);
#pragma unroll
                for (int j = 0; j < 2; ++j) { const int k0 = 8 * (lane + 64 * j); const v4u q = hq[u][j];
                    const f4v n0 = *(const f4v*)(P.final_norm + k0), n1 = *(const f4v*)(P.final_norm + k0 + 4);
                    f4v o0, o1; o0.x = blo(q.x) * rstd * n0.x; o0.y = bhi(q.x) * rstd * n0.y; o0.z = blo(q.y) * rstd * n0.z; o0.w = bhi(q.y) * rstd * n0.w;
                    o1.x = blo(q.z) * rstd * n1.x; o1.y = bhi(q.z) * rstd * n1.y; o1.z = blo(q.w) * rstd * n1.z; o1.w = bhi(q.w) * rstd * n1.w;
                    __builtin_nontemporal_store(o0, (f4v*)(out + (size_t)row * D + k0)); __builtin_nontemporal_store(o1, (f4v*)(out + (size_t)row * D + k0 + 4)); }
            }
        }
    }
    if (PROBE_PH >= 0) {
        if (PROBE_PH == NPHASES - 1) pt1 = __builtin_amdgcn_s_memrealtime();
        if (bid == 0 && threadIdx.x == 0) { const unsigned long long dt = (PROBE_PH >= 110 && PROBE_PH < 140) ? pseg : pt1 - pt0, te = __builtin_amdgcn_s_memrealtime(); while (__builtin_amdgcn_s_memrealtime() - te < 9ull * dt) __builtin_amdgcn_s_sleep(8); }
    }
#undef GRID_BAR
#undef PH_IDS
#undef IN
#undef SEG
#undef rstd1
#undef gates
#undef rstdg
#undef rstde
#undef eid
#undef posn
#undef gate
#undef mn
#undef ml
#undef mbl
#undef mm
#undef list
#undef cnt
#undef part
#undef part2
#undef win_t
#undef wout_t
#undef w13_t
#undef w2_t
#undef wgate_t
#undef wup_t
#undef proj
#undef hbuf
#undef xs
#undef ybuf
#undef peb
#undef yreg
#undef pb
#undef rst
#undef mst
}

template <int PH> static void launch_one(int grid, const Params& p, hipStream_t stream) {
    static bool attr_done = false;
    if (!attr_done) { (void)hipFuncSetAttribute((const void*)mk<PH, PH + 1>, hipFuncAttributeMaxDynamicSharedMemorySize, LDS_BYTES); attr_done = true; }
    hipLaunchKernelGGL((mk<PH, PH + 1>), dim3(grid), dim3(NTHREADS), LDS_BYTES, stream, p);
}
template <int PH> static void launch_all(int grid, const Params& p, hipStream_t stream) {
    if constexpr (PH < NPHASES) { launch_one<PH>(grid, p, stream); launch_all<PH + 1>(grid, p, stream); }
}
#ifndef MK_N_LAUNCHES
#define MK_N_LAUNCHES 1
#endif

extern "C" void kernel_launch(void* const* d_in, const int* in_sizes, int n_in, void* d_out, int out_size, void* d_ws, size_t ws_size, hipStream_t stream) {
    static int grid = 0;
    if (grid == 0) {
        if (n_in != 25 || in_sizes[0] != T * D || out_size != T * D || ws_size < WS_END) {
            fprintf(stderr, "kernel_launch: unexpected shapes: n_in %d in0 %d out %d ws %zu\n", n_in, n_in > 0 ? in_sizes[0] : -1, out_size, ws_size); grid = -1; return; }
        int dev = 0, cus = 0;
        (void)hipGetDevice(&dev); (void)hipDeviceGetAttribute(&cus, hipDeviceAttributeMultiprocessorCount, dev);
        (void)hipGetLastError();
        if (cus < 256) { fprintf(stderr, "kernel_launch: this kernel's phase maps are built for a 256-workgroup grid (one per CU of a 256-CU device); the device reports %d CUs; nothing launched\n", cus); grid = -1; return; }
        grid = 256;
        if (MK_N_LAUNCHES == 1) {
            int per_cu = 0;
            if (hipFuncSetAttribute((const void*)mk<0, NPHASES>, hipFuncAttributeMaxDynamicSharedMemorySize, LDS_BYTES) != hipSuccess) { fprintf(stderr, "kernel_launch: hipFuncSetAttribute failed\n"); grid = -1; return; }
            if (hipOccupancyMaxActiveBlocksPerMultiprocessor(&per_cu, (const void*)mk<0, NPHASES>, NTHREADS, LDS_BYTES) != hipSuccess || per_cu < 1) { fprintf(stderr, "kernel_launch: occupancy query reports %d workgroups per CU; the grid barrier needs one resident workgroup per CU; nothing launched\n", per_cu); grid = -1; return; }
            (void)hipGetLastError();
        }
    }
    if (grid < 0) return;
    (void)hipMemsetAsync((char*)d_ws + WS_CTL, 0, 1 * MiB, stream);
    Params p{};
    p.x = (const float*)d_in[0]; p.p = (const float*)d_in[1]; p.pos = (const int*)d_in[2];
    p.attn_norm = (const float*)d_in[3]; p.w_in = (const float*)d_in[4]; p.conv_w = (const float*)d_in[5]; p.conv_b = (const float*)d_in[6];
    p.b_ig = (const float*)d_in[7]; p.b_fg = (const float*)d_in[8]; p.ret_gn = (const float*)d_in[9]; p.ml_gn = (const float*)d_in[10];
    p.w_out = (const float*)d_in[11]; p.moe_norm = (const float*)d_in[12]; p.w_group = (const float*)d_in[13]; p.b_group = (const float*)d_in[14];
    p.w_router = (const float*)d_in[15]; p.b_router = (const float*)d_in[16]; p.w1 = (const float*)d_in[17]; p.w3 = (const float*)d_in[18]; p.w2 = (const float*)d_in[19];
    p.w_up = (const float*)d_in[20]; p.ple_norm = (const float*)d_in[21]; p.pg_norm = (const float*)d_in[22]; p.w_gate = (const float*)d_in[23]; p.final_norm = (const float*)d_in[24];
    p.out = (float*)d_out; p.ws = (unsigned char*)d_ws;
    if (MK_N_LAUNCHES == 1) hipLaunchKernelGGL((mk<0, NPHASES>), dim3(grid), dim3(NTHREADS), LDS_BYTES, stream, p);
    else launch_all<0>(grid, p, stream);
}
```

```cpp
#include <hip/hip_runtime.h>
#include <cstdio>
#include <cstdint>

constexpr int D = 1024, BATCH = 4, SEQ = 8192, T = BATCH * SEQ, PLE = 256;
constexpr int NPROJ = 4104, NP = 4096;
constexpr int CH = 128, NCH = SEQ / CH;
constexpr int RH = 8, RD = 64, MH = 4, MD = 128;
constexpr int NE = 32, DE = 512;
constexpr float EPS = 1e-6f;
constexpr int C_RQ = 0, C_RK = 512, C_RV = 1024, C_RG = 1536, C_MQ = 2048, C_MK = 2560, C_MV = 3072, C_MO = 3584;

constexpr size_t MiB = 1u << 20;
constexpr size_t WS_CTL = 0;
constexpr size_t WS_RSTD1 = 1 * MiB;
constexpr size_t WS_GATES = WS_RSTD1 + 256 * 1024;
constexpr size_t WS_SLOTR = 2560 * 1024;
constexpr size_t WS_RSTDG = 3 * MiB;
constexpr size_t WS_RSTDE = WS_RSTDG + 256 * 1024;
constexpr size_t WS_EID = 4 * MiB;
constexpr size_t WS_POS = WS_EID + 256 * 1024;
constexpr size_t WS_GATE = WS_POS + 256 * 1024;
constexpr size_t WS_MN = 5 * MiB;
constexpr size_t WS_ML = WS_MN + 512 * 1024;
constexpr size_t WS_MBL = WS_ML + 4096;
constexpr size_t WS_MM = WS_MBL + 4096;
constexpr size_t WS_WR = 6 * MiB;
constexpr size_t WS_LIST = 8 * MiB;
constexpr size_t WS_PART = 12 * MiB;
constexpr size_t WS_PART2 = 14 * MiB;
constexpr size_t WS_WIN = 16 * MiB;
constexpr size_t WS_WOUT = 24 * MiB;
constexpr size_t WS_W13 = 26 * MiB;
constexpr size_t WS_W2 = 90 * MiB;
constexpr size_t WS_WGATE = 122 * MiB;
constexpr size_t WS_WUP = 124 * MiB;
constexpr size_t WS_PROJ = 128 * MiB;
constexpr size_t WS_HBUF = 128 * MiB;
constexpr size_t WS_XS = 200 * MiB;
constexpr size_t WS_YBUF = 200 * MiB;
constexpr size_t WS_A2 = 128 * MiB;
constexpr size_t WS_H3B = 200 * MiB;
constexpr size_t WS_PEB = 344 * MiB;
constexpr size_t WS_YREG = 384 * MiB;
constexpr size_t WS_PB = 448 * MiB;
constexpr size_t WS_CS = 464 * MiB;
constexpr size_t WS_RSTB = 472 * MiB;
constexpr size_t WS_END = 488 * MiB;
constexpr size_t OUT_RST = 0;
constexpr size_t OUT_MST = 32 * MiB;
constexpr size_t OUT_HB = 0;
constexpr size_t OUT_MSTB = 96 * MiB;
constexpr int CW_CNT = 64;
constexpr int CW_BAR = 4096;

constexpr int NTHREADS = 512, NWAVES = 8;
constexpr int RING_BYTES = 131072;
constexpr int LDSX_OFF = 143360;
constexpr int LDS_BYTES = 147456;

__host__ __device__ __forceinline__ size_t pix(size_t t, int col) {
    const size_t bn = t >> 7; const int r = (int)(t & 127);
    return bn * (size_t)(CH * NP) + (col < 2048 ? (size_t)((col >> 6) * (CH * 64) + r * 64 + (col & 63)) : (size_t)(CH * 2048 + ((col - 2048) >> 7) * (CH * 128) + r * 128 + (col & 127)));
}
#define GAS __attribute__((address_space(1)))
#define LAS __attribute__((address_space(3)))
typedef unsigned short bf16_t;
typedef unsigned v4u __attribute__((ext_vector_type(4)));
typedef unsigned v2u __attribute__((ext_vector_type(2)));
__device__ __forceinline__ float bf2f(bf16_t h) { return __uint_as_float((unsigned)h << 16); }
__device__ __forceinline__ unsigned f2bf(float f) { unsigned u = __float_as_uint(f); return (u + 0x7fffu + ((u >> 16) & 1u)) >> 16; }
__device__ __forceinline__ unsigned pk2(float lo, float hi) { return f2bf(lo) | (f2bf(hi) << 16); }
__device__ __forceinline__ float wave_sum(float v) {
#pragma unroll
    for (int o = 1; o < 64; o <<= 1) v += __shfl_xor(v, o);
    return v;
}
__device__ __forceinline__ float sigmoidf_(float x) { return 1.0f / (1.0f + expf(-x)); }
__device__ __forceinline__ float siluf_(float x) { return x / (1.0f + expf(-x)); }
__device__ __forceinline__ float logsigmoidf_(float x) { return x >= 0.f ? -log1pf(expf(-x)) : x - log1pf(expf(x)); }
__device__ __forceinline__ float fexp_(float x) { return __builtin_amdgcn_exp2f(1.4426950408889634f * x); }
__device__ __forceinline__ float flogsig_(float x) { const float t = fexp_(-fabsf(x)); const float l = 0.6931471805599453f * __builtin_amdgcn_logf(1.0f + t); return x >= 0.f ? -l : x - l; }
#define LDS_WAIT() asm volatile("s_waitcnt lgkmcnt(0)" ::: "memory")

namespace pg8 {
#define PG8_LAS __attribute__((address_space(3)))
typedef unsigned short bf16_t;
typedef short bf16x8 __attribute__((ext_vector_type(8)));
typedef float f32x4 __attribute__((ext_vector_type(4)));
typedef unsigned u32x4 __attribute__((ext_vector_type(4)));
constexpr int BM = 256, BK = 64, HALF = 128, HTB = HALF * BK * 2  , STAGE_BYTES = 8 * HTB, NXCD = 8, WGM = 8;

__host__ __device__ __forceinline__ int lds_byte(int r, int c) { const int st = (r >> 4) * 2 + (c >> 5), rr = r & 15, cc = c & 31, ob = rr * 64 + cc * 2; return st * 1024 + (ob ^ (((ob >> 9) & 1) << 5)); }
__host__ __device__ __forceinline__ void stage_rc(int b, int& R, int& C) { const int st = b / 1024, sb = b % 1024, swz = sb ^ (((sb >> 9) & 1) << 5); R = (st >> 1) * 16 + swz / 64; C = (st & 1) * 32 + (swz % 64) / 2; }
__host__ __device__ __forceinline__ int perm32(int rho) { const int n = rho >> 4, i = rho & 15; return 8 * (i >> 2) + 4 * n + (i & 3); }

struct Unit { int pm, pn, ord; };
struct Gemm { const bf16_t* A; const bf16_t* Bt; int M, N, K; const PG8_LAS int* gtok; };

struct StaticOrder {
    int nM, nN, nwg, G, c;
    __host__ __device__ __forceinline__ void init(int M, int N, int G_, int c_) { nM = M / BM; nN = N / BM; nwg = nM * nN; G = G_; c = c_; }
    __host__ __device__ __forceinline__ bool next(int i, Unit& u) const {
        const long L = (long)i * G + c; if (L >= nwg) return false;
        int wgid = (int)L; { const int q = nwg / NXCD, r = nwg % NXCD, xcd = wgid % NXCD, off = wgid / NXCD; wgid = (xcd < r ? xcd * (q + 1) : r * (q + 1) + (xcd - r) * q) + off; }
        const int nig = WGM * nN, gid = wgid / nig, fm = gid * WGM, gsz = (nM - fm) < WGM ? (nM - fm) : WGM;
        u.pm = fm + ((wgid % nig) % gsz); u.pn = (wgid % nig) / gsz; u.ord = i; return true;
    }
    __device__ __forceinline__ void a_ready(const Unit&) const {}
    __device__ __forceinline__ void done(const Unit&) const {}
};

__device__ __forceinline__ unsigned cvt_pk_bf16(float lo, float hi) { unsigned r; asm volatile("v_cvt_pk_bf16_f32 %0, %1, %2" : "=v"(r) : "v"(lo), "v"(hi)); return r; }
typedef float f32x2 __attribute__((ext_vector_type(2)));
struct GroupedOrder {
    int nM, nwg, G, c; const PG8_LAS int* t2e;
    __device__ __forceinline__ void init(int nM_, int G_, int c_, const PG8_LAS int* t2e_) { nM = nM_; nwg = nM_ * 4; G = G_; c = c_; t2e = t2e_; }
    __device__ __forceinline__ bool next(int i, Unit& u) const {
        const long L = (long)i * G + c; if (L >= nwg) return false;
        int wgid = (int)L; { const int q = nwg / NXCD, r = nwg % NXCD, xcd = wgid % NXCD, off = wgid / NXCD; wgid = (xcd < r ? xcd * (q + 1) : r * (q + 1) + (xcd - r) * q) + off; }
        const int nig = WGM * 4, gid = wgid / nig, fm = gid * WGM, gsz = (nM - fm) < WGM ? (nM - fm) : WGM;
        u.pm = fm + ((wgid % nig) % gsz); u.pn = (wgid % nig) / gsz + 4 * t2e[u.pm]; u.ord = i; return true;
    }
    __device__ __forceinline__ void a_ready(const Unit&) const {}
    __device__ __forceinline__ void done(const Unit&) const {}
};
struct SkewOrder {
    int nunits, stride, j;
    __device__ __forceinline__ void init(int nunits_, int G_, int c_, int skip_) { if (skip_ >= G_) skip_ = 0; nunits = nunits_; stride = G_ - skip_; j = c_ - skip_; }
    __device__ __forceinline__ bool next(int i, Unit& u) const { if (j < 0) return false; const int idx = j + i * stride; if (idx >= nunits) return false; u.pm = idx >> 2; u.pn = idx & 3; u.ord = i; return true; }
    __device__ __forceinline__ void a_ready(const Unit&) const {}
    __device__ __forceinline__ void done(const Unit&) const {}
};
__device__ __forceinline__ float fast_sigmoid(float x) { return __builtin_amdgcn_rcpf(1.0f + __builtin_amdgcn_exp2f(-1.4426950408889634f * x)); }
struct EpiStoreBf16 {
    static constexpr bool PERM = true, AFTER_DRAIN = false;
    bf16_t* O; int ldc; int pn_mask; float* part; int blocked;
    __device__ __forceinline__ void operator()(const f32x4 (&acc)[2][2][4][2], const Unit& u, int wr, int wc, int fr, int fq) const {
        const int pnl = u.pn & pn_mask; const int row0 = u.pm * BM + wr * 64 + fr, col0 = pnl * BM + wc * 32 + 8 * fq;
#pragma unroll
        for (int ai = 0; ai < 2; ++ai)
#pragma unroll
            for (int m = 0; m < 4; ++m) { const int row = row0 + ai * HALF + m * 16; bf16_t* rowp = O + (size_t)row * ldc + col0; bf16_t* rowq = rowp + HALF;
                if (blocked) { rowp = O + pix((size_t)row, col0); rowq = O + pix((size_t)row, col0 + HALF); }
                float s = 0.f;
#pragma unroll
                for (int bj = 0; bj < 2; ++bj) { const f32x4 v0 = acc[ai][bj][m][0], v1 = acc[ai][bj][m][1];
                    u32x4 w; w.x = cvt_pk_bf16(v0[0], v0[1]); w.y = cvt_pk_bf16(v0[2], v0[3]); w.z = cvt_pk_bf16(v1[0], v1[1]); w.w = cvt_pk_bf16(v1[2], v1[3]);
                    if (blocked) __builtin_nontemporal_store(w, (u32x4*)(bj ? rowq : rowp)); else *(u32x4*)(bj ? rowq : rowp) = w;
                    s += (v0[0] * v0[0] + v0[1] * v0[1]) + (v0[2] * v0[2] + v0[3] * v0[3]) + (v1[0] * v1[0] + v1[1] * v1[1]) + (v1[2] * v1[2] + v1[3] * v1[3]); }
                if (part) { s += __shfl_xor(s, 16); s += __shfl_xor(s, 32); if (fq == 0) part[(size_t)row * 16 + pnl * 4 + wc] = s; } }
    }
};
struct EpiSwiglu {
    static constexpr bool PERM = true, AFTER_DRAIN = false;
    bf16_t* H; const PG8_LAS float* rtab;
    __device__ __forceinline__ void operator()(const f32x4 (&acc)[2][2][4][2], const Unit& u, int wr, int wc, int fr, int fq) const {
        const int pnl = u.pn & 3; const int row0 = u.pm * BM + wr * 64 + fr, col0 = pnl * HALF + wc * 32 + 8 * fq;
#pragma unroll
        for (int ai = 0; ai < 2; ++ai)
#pragma unroll
            for (int m = 0; m < 4; ++m) { const int row = row0 + ai * HALF + m * 16; bf16_t* rowp = H + (size_t)row * 512 + col0; const float rs = rtab[u.ord * 256 + (row - u.pm * BM)];
                f32x4 h[2];
#pragma unroll
                for (int n = 0; n < 2; ++n) { const f32x4 a = acc[ai][0][m][n] * rs, b = acc[ai][1][m][n] * rs;
#pragma unroll
                    for (int j = 0; j < 4; ++j) h[n][j] = a[j] * fast_sigmoid(a[j]) * b[j]; }
                u32x4 w; w.x = cvt_pk_bf16(h[0][0], h[0][1]); w.y = cvt_pk_bf16(h[0][2], h[0][3]); w.z = cvt_pk_bf16(h[1][0], h[1][1]); w.w = cvt_pk_bf16(h[1][2], h[1][3]);
                *(u32x4*)rowp = w; }
    }
};
struct EpiRes {
    static constexpr bool PERM = true, AFTER_DRAIN = false;
    const float* base; bf16_t* hb;
    __device__ __forceinline__ void operator()(const f32x4 (&acc)[2][2][4][2], const Unit& u, int wr, int wc, int fr, int fq) const {
        const int row0 = u.pm * BM + wr * 64 + fr, col0 = u.pn * BM + wc * 32 + 8 * fq;
#pragma unroll
        for (int ai = 0; ai < 2; ++ai) {
            f32x4 xv[4][2][2];
#pragma unroll
            for (int m = 0; m < 4; ++m) { const size_t off = (size_t)(row0 + ai * HALF + m * 16) * 1024 + col0;
#pragma unroll
                for (int bj = 0; bj < 2; ++bj) { xv[m][bj][0] = __builtin_nontemporal_load((const f32x4*)(base + off + bj * HALF)); xv[m][bj][1] = __builtin_nontemporal_load((const f32x4*)(base + off + bj * HALF + 4)); } }
#pragma unroll
            for (int m = 0; m < 4; ++m) { const size_t off = (size_t)(row0 + ai * HALF + m * 16) * 1024 + col0;
#pragma unroll
                for (int bj = 0; bj < 2; ++bj) { const f32x4 v0 = xv[m][bj][0] + acc[ai][bj][m][0], v1 = xv[m][bj][1] + acc[ai][bj][m][1];
                    u32x4 w; w.x = cvt_pk_bf16(v0[0], v0[1]); w.y = cvt_pk_bf16(v0[2], v0[3]); w.z = cvt_pk_bf16(v1[0], v1[1]); w.w = cvt_pk_bf16(v1[2], v1[3]);
                    *(u32x4*)(hb + off + bj * HALF) = w; } }
            asm volatile("" ::: "memory");
        }
    }
};
struct EpiGate {
    static constexpr bool PERM = true, AFTER_DRAIN = false;
    bf16_t* h3; const bf16_t* a2; const bf16_t* peb; const float* rstdg; const float* rstde; const float* ple_norm; float* part;
    __device__ __forceinline__ void operator()(const f32x4 (&acc)[2][2][4][2], const Unit& u, int wr, int wc, int fr, int fq) const {
        const int row0 = u.pm * BM + wr * 64 + fr, col0 = u.pn * BM + wc * 32 + 8 * fq;
        f32x4 pn4[2][2];
#pragma unroll
        for (int bj = 0; bj < 2; ++bj)
#pragma unroll
            for (int n = 0; n < 2; ++n) pn4[bj][n] = *(const f32x4*)(ple_norm + col0 + bj * HALF + n * 4);
#pragma unroll
        for (int ap = 0; ap < 4; ++ap) { const int ai = ap >> 1, m0 = (ap & 1) * 2;
            u32x4 pev[4][2], hqv[4][2]; float rgv[4], rev[4];
#pragma unroll
            for (int m = m0; m < m0 + 2; ++m) { const int row = row0 + ai * HALF + m * 16; const size_t off = (size_t)row * 1024 + col0; rgv[m] = rstdg[row]; rev[m] = rstde[row];
#pragma unroll
                for (int bj = 0; bj < 2; ++bj) { pev[m][bj] = __builtin_nontemporal_load((const u32x4*)(peb + off + bj * HALF)); hqv[m][bj] = *(const u32x4*)(a2 + off + bj * HALF); } }
#pragma unroll
            for (int m = m0; m < m0 + 2; ++m) { const int row = row0 + ai * HALF + m * 16; const size_t off = (size_t)row * 1024 + col0; const float rg = rgv[m], re = rev[m]; float s = 0.f;
#pragma unroll
                for (int bj = 0; bj < 2; ++bj) { const size_t o = off + bj * HALF;
                    const u32x4 pe = pev[m][bj], hq = hqv[m][bj];
                    float hv[8];
#pragma unroll
                    for (int n = 0; n < 2; ++n) { const f32x4 a = acc[ai][bj][m][n]; const unsigned p0 = n ? pe.z : pe.x, p1 = n ? pe.w : pe.y, h0 = n ? hq.z : hq.x, h1 = n ? hq.w : hq.y;
                        const float e4[4] = {__uint_as_float(p0 << 16), __uint_as_float(p0 & 0xffff0000u), __uint_as_float(p1 << 16), __uint_as_float(p1 & 0xffff0000u)};
                        const float b4[4] = {__uint_as_float(h0 << 16), __uint_as_float(h0 & 0xffff0000u), __uint_as_float(h1 << 16), __uint_as_float(h1 & 0xffff0000u)};
#pragma unroll
                        for (int j = 0; j < 4; ++j) hv[4 * n + j] = b4[j] + fast_sigmoid(rg * a[j]) * (e4[j] * re * pn4[bj][n][j]); }
                    u32x4 w; w.x = cvt_pk_bf16(hv[0], hv[1]); w.y = cvt_pk_bf16(hv[2], hv[3]); w.z = cvt_pk_bf16(hv[4], hv[5]); w.w = cvt_pk_bf16(hv[6], hv[7]);
                    *(u32x4*)(h3 + o) = w;
                    const float r8[8] = {__uint_as_float(w.x << 16), __uint_as_float(w.x & 0xffff0000u), __uint_as_float(w.y << 16), __uint_as_float(w.y & 0xffff0000u), __uint_as_float(w.z << 16), __uint_as_float(w.z & 0xffff0000u), __uint_as_float(w.w << 16), __uint_as_float(w.w & 0xffff0000u)};
#pragma unroll
                    for (int j = 0; j < 8; ++j) s += r8[j] * r8[j]; }
                s += __shfl_xor(s, 16); s += __shfl_xor(s, 32); if (fq == 0) part[(size_t)row * 16 + u.pn * 4 + wc] = s; }
            asm volatile("" ::: "memory");
        }
    }
};

template <class Epi, class Sched, bool ALIGN_EPI = false, bool SP2 = false, bool GATHER = false>
__device__ __forceinline__ void gemm_phase(PG8_LAS unsigned char* lds, const Gemm g, const Sched& S, const Epi& E) {
    int tid_l = threadIdx.x; asm volatile("" : "+v"(tid_l));
    const int tid = tid_l, wid = __builtin_amdgcn_readfirstlane(tid >> 6), lane = tid & 63, wr = wid >> 2, wc = wid & 3, fr = lane & 15, fq = lane >> 4;
    const int K = g.K, nt = K / BK;
    unsigned voffA[2], voffB[2];
    int RAi[2]; unsigned CA2[2];
#pragma unroll
    for (int i = 0; i < 2; ++i) { int R, C; stage_rc(tid * 16 + i * 8192, R, C); const int Rb = Epi::PERM ? ((R & ~31) + perm32(R & 31)) : R;
        voffA[i] = (unsigned)(R * K + C) * 2u; voffB[i] = (unsigned)(Rb * K + C) * 2u; RAi[i] = R; CA2[i] = (unsigned)C * 2u; }
    unsigned gvc[2][2] = {{0u, 0u}, {0u, 0u}}, gvn[2][2] = {{0u, 0u}, {0u, 0u}};
#define PG8_GOFF(gv, ord_) do { _Pragma("unroll") for (int _h = 0; _h < 2; ++_h) _Pragma("unroll") for (int _i = 0; _i < 2; ++_i) \
        gv[_h][_i] = (unsigned)g.gtok[(ord_) * 256 + _h * HALF + RAi[_i]] * (unsigned)(K * 2) + CA2[_i]; } while (0)
    const size_t kstep = (size_t)(BK * 2);
    const size_t hstep = (size_t)HALF * K * 2;
    const size_t tstep = 2 * hstep;
    const unsigned ldsw = (unsigned)wid * 1024u;
    const int aoff = lds_byte(wr * 64 + fr, fq * 8), boff = lds_byte(wc * 32 + fr, fq * 8);
#define PG8_SA(b, h) (((b) * 2 + (h)) * HTB)
#define PG8_SB(b, h) ((4 + (b) * 2 + (h)) * HTB)
#define PG8_STAGE(bufoff, gbase, voff) do { _Pragma("unroll") for (int _i = 0; _i < 2; ++_i) \
        __builtin_amdgcn_global_load_lds((const unsigned*)((const char*)(gbase) + (voff)[_i]), (PG8_LAS unsigned*)(lds + (bufoff) + ldsw + _i * 8192), 16, 0, 0); } while (0)
#define PG8_STAGEA(bufoff, gbase, h, sel) do { _Pragma("unroll") for (int _i = 0; _i < 2; ++_i) { \
        const char* _p = GATHER ? (const char*)(gbase) + ((sel) ? gvn[h][_i] : gvc[h][_i]) : (const char*)(gbase) + (size_t)(h) * hstep + voffA[_i]; \
        __builtin_amdgcn_global_load_lds((const unsigned*)_p, (PG8_LAS unsigned*)(lds + (bufoff) + ldsw + _i * 8192), 16, 0, 0); } } while (0)
#define PG8_LDA(dst, b, h) do { _Pragma("unroll") for (int m = 0; m < 4; ++m) _Pragma("unroll") for (int k = 0; k < 2; ++k) dst[m][k] = *(const PG8_LAS bf16x8*)(lds + PG8_SA(b, h) + aoff + m * 2048 + k * 1024); } while (0)
#define PG8_LDB(dst, b, h) do { _Pragma("unroll") for (int n = 0; n < 2; ++n) _Pragma("unroll") for (int k = 0; k < 2; ++k) dst[n][k] = *(const PG8_LAS bf16x8*)(lds + PG8_SB(b, h) + boff + n * 2048 + k * 1024); } while (0)
#define PG8_MMA(ai, bj, At, Bt) do { __builtin_amdgcn_s_setprio(1); _Pragma("unroll") for (int m = 0; m < 4; ++m) _Pragma("unroll") for (int n = 0; n < 2; ++n) _Pragma("unroll") for (int k = 0; k < 2; ++k) \
        acc[ai][bj][m][n] = __builtin_amdgcn_mfma_f32_16x16x32_bf16(Bt[n][k], At[m][k], acc[ai][bj][m][n], 0, 0, 0); __builtin_amdgcn_s_setprio(0); } while (0)
#define PG8_WAIT_V(n) asm volatile("s_waitcnt vmcnt(" #n ")" ::: "memory")
#define PG8_WAIT_L(n) asm volatile("s_waitcnt lgkmcnt(" #n ")" ::: "memory")
#define PG8_BAR __builtin_amdgcn_s_barrier()
#define PG8_SCHED __builtin_amdgcn_sched_barrier(0)
    Unit cur, nxt; int ui = 0;
    if (!S.next(0, cur)) return;
    f32x4 acc[2][2][4][2];
#pragma unroll
    for (int a = 0; a < 2; ++a)
#pragma unroll
        for (int b = 0; b < 2; ++b)
#pragma unroll
            for (int m = 0; m < 4; ++m)
#pragma unroll
                for (int n = 0; n < 2; ++n) acc[a][b][m][n] = (f32x4){0.f, 0.f, 0.f, 0.f};
    bf16x8 At[4][2], B0[2][2], B1[2][2];
    const char* cA = GATHER ? (const char*)g.A : (const char*)g.A + (size_t)cur.pm * tstep; const char* cB = (const char*)g.Bt + (size_t)cur.pn * tstep;
    if constexpr (GATHER) PG8_GOFF(gvc, cur.ord);
    S.a_ready(cur);
    if constexpr (SP2) {
        PG8_STAGE(PG8_SB(0, 0), cB, voffB); PG8_STAGE(PG8_SB(0, 1), cB + hstep, voffB); PG8_STAGEA(PG8_SA(0, 0), cA, 0, false); PG8_STAGEA(PG8_SA(0, 1), cA, 1, false);
        if (wr == 1) PG8_BAR;
        PG8_WAIT_V(2); PG8_BAR;
        PG8_STAGE(PG8_SB(1, 0), cB + kstep, voffB); PG8_STAGEA(PG8_SA(1, 0), cA + kstep, 0, false); PG8_STAGE(PG8_SB(1, 1), cB + hstep + kstep, voffB);
        PG8_WAIT_V(6); PG8_BAR;
    } else {
        PG8_STAGE(PG8_SB(0, 0), cB, voffB); PG8_STAGEA(PG8_SA(0, 0), cA, 0, false); PG8_STAGE(PG8_SB(0, 1), cB + hstep, voffB); PG8_STAGEA(PG8_SA(0, 1), cA, 1, false);
        if (wr == 1) PG8_BAR;
        PG8_WAIT_V(4); PG8_BAR;
        PG8_STAGE(PG8_SB(1, 0), cB + kstep, voffB); PG8_STAGEA(PG8_SA(1, 0), cA + kstep, 0, false); PG8_STAGE(PG8_SB(1, 1), cB + hstep + kstep, voffB);
        PG8_WAIT_V(6); PG8_BAR;
    }
    for (;;) {
        const bool has_next = S.next(ui + 1, nxt);
        const char* nA = GATHER ? (const char*)g.A : (has_next ? (const char*)g.A + (size_t)nxt.pm * tstep : cA); const char* nB = has_next ? (const char*)g.Bt + (size_t)nxt.pn * tstep : cB;
        if constexpr (GATHER) { if (has_next) PG8_GOFF(gvn, nxt.ord); }
        for (int t = 0; t < nt; t += 2) {
            const bool last = (t == nt - 2); const bool seln = last && has_next; (void)seln;
            const char* a1 = cA + (size_t)(t + 1) * kstep;
            const char* a2 = last ? nA : cA + (size_t)(t + 2) * kstep; const char* b2 = last ? nB : cB + (size_t)(t + 2) * kstep;
            const char* a3 = a2 + kstep; const char* b3 = b2 + kstep;
            if (last && has_next) S.a_ready(nxt);
            if constexpr (SP2) {
            PG8_LDB(B0, 0, 0); PG8_LDB(B1, 0, 1); PG8_SCHED; PG8_LDA(At, 0, 0); PG8_STAGEA(PG8_SA(1, 1), a1, 1, false);
            PG8_WAIT_V(8); PG8_WAIT_L(0); PG8_BAR; PG8_MMA(0, 0, At, B0); PG8_MMA(0, 1, At, B1); PG8_BAR; PG8_SCHED;
            PG8_LDA(At, 0, 1); PG8_STAGE(PG8_SB(0, 0), b2, voffB); PG8_STAGE(PG8_SB(0, 1), b2 + hstep, voffB); PG8_STAGEA(PG8_SA(0, 0), a2, 0, seln);
            PG8_WAIT_V(8); PG8_WAIT_L(0); PG8_BAR; PG8_MMA(1, 0, At, B0); PG8_MMA(1, 1, At, B1); PG8_BAR; PG8_SCHED;
            PG8_LDB(B0, 1, 0); PG8_LDB(B1, 1, 1); PG8_SCHED; PG8_LDA(At, 1, 0); PG8_STAGEA(PG8_SA(0, 1), a2, 1, seln);
            PG8_WAIT_V(8); PG8_WAIT_L(0); PG8_BAR; PG8_MMA(0, 0, At, B0); PG8_MMA(0, 1, At, B1); PG8_BAR; PG8_SCHED;
            PG8_LDA(At, 1, 1); PG8_STAGE(PG8_SB(1, 0), b3, voffB); PG8_STAGE(PG8_SB(1, 1), b3 + hstep, voffB); PG8_STAGEA(PG8_SA(1, 0), a3, 0, seln);
            PG8_WAIT_V(8); PG8_WAIT_L(0); PG8_BAR; PG8_MMA(1, 0, At, B0); PG8_MMA(1, 1, At, B1); PG8_BAR; PG8_SCHED;
            } else {
            PG8_LDB(B0, 0, 0); PG8_SCHED; PG8_LDA(At, 0, 0); PG8_STAGEA(PG8_SA(1, 1), a1, 1, false);
            PG8_WAIT_L(8); PG8_BAR; PG8_WAIT_L(0); PG8_MMA(0, 0, At, B0); PG8_BAR; PG8_SCHED;
            PG8_LDB(B1, 0, 1); PG8_STAGE(PG8_SB(0, 0), b2, voffB);
            PG8_BAR; PG8_WAIT_L(0); PG8_MMA(0, 1, At, B1); PG8_BAR;
            PG8_LDA(At, 0, 1); PG8_STAGEA(PG8_SA(0, 0), a2, 0, seln);
            PG8_BAR; PG8_WAIT_L(0); PG8_MMA(1, 0, At, B0); PG8_BAR; PG8_SCHED;
            PG8_STAGE(PG8_SB(0, 1), b2 + hstep, voffB);
            PG8_WAIT_V(6); PG8_BAR; PG8_MMA(1, 1, At, B1); PG8_BAR;
            PG8_LDB(B0, 1, 0); PG8_SCHED; PG8_LDA(At, 1, 0); PG8_STAGEA(PG8_SA(0, 1), a2, 1, seln);
            PG8_WAIT_L(8); PG8_BAR; PG8_WAIT_L(0); PG8_MMA(0, 0, At, B0); PG8_BAR; PG8_SCHED;
            PG8_LDB(B1, 1, 1); PG8_STAGE(PG8_SB(1, 0), b3, voffB);
            PG8_BAR; PG8_WAIT_L(0); PG8_MMA(0, 1, At, B1); PG8_BAR;
            PG8_LDA(At, 1, 1); PG8_STAGEA(PG8_SA(1, 0), a3, 0, seln);
            PG8_BAR; PG8_WAIT_L(0); PG8_MMA(1, 0, At, B0); PG8_BAR; PG8_SCHED;
            PG8_STAGE(PG8_SB(1, 1), b3 + hstep, voffB);
            PG8_WAIT_V(6); PG8_BAR; PG8_MMA(1, 1, At, B1); PG8_BAR;
            }
        }
        if constexpr (ALIGN_EPI) { if (wr == 0) PG8_BAR; }
        if constexpr (!Epi::AFTER_DRAIN) { E(acc, cur, wr, wc, fr, fq); S.done(cur); }
        if (!has_next) break;
#pragma unroll
        for (int a = 0; a < 2; ++a)
#pragma unroll
            for (int b = 0; b < 2; ++b)
#pragma unroll
                for (int m = 0; m < 4; ++m)
#pragma unroll
                    for (int n = 0; n < 2; ++n) acc[a][b][m][n] = (f32x4){0.f, 0.f, 0.f, 0.f};
        cur = nxt; cA = nA; cB = nB; ++ui;
        if constexpr (GATHER) { gvc[0][0] = gvn[0][0]; gvc[0][1] = gvn[0][1]; gvc[1][0] = gvn[1][0]; gvc[1][1] = gvn[1][1]; }
        if constexpr (ALIGN_EPI) { if (wr == 1) PG8_BAR; }
    }
    PG8_WAIT_V(0);
    if constexpr (!ALIGN_EPI) { if (wr == 0) PG8_BAR; }
    PG8_BAR;
    if constexpr (Epi::AFTER_DRAIN) { E.fused(acc, cur, wr, wc, fr, fq, lds, wid, lane); S.done(cur); }
#undef PG8_SA
#undef PG8_SB
#undef PG8_STAGE
#undef PG8_STAGEA
#undef PG8_GOFF
#undef PG8_LDA
#undef PG8_LDB
#undef PG8_MMA
#undef PG8_WAIT_V
#undef PG8_WAIT_L
#undef PG8_BAR
#undef PG8_SCHED
}
}
#define XB_TMO      128
#define XB_XCNT(j)  (256  + 64 * (j))
#define XB_XSUB(j)  (1280 + 64 * (j))
#define XB_XGEN(j)  (2304 + 64 * (j))
#define XB_TOP      3328
#define XB_TOPGEN   3392
#define XCD_BAR_WORDS 3456
#define XB_SPIN_CAP (1u << 18)

__device__ __forceinline__ unsigned xb_ld(unsigned* p)              { return __hip_atomic_load(p, __ATOMIC_RELAXED, __HIP_MEMORY_SCOPE_AGENT); }
__device__ __forceinline__ unsigned xb_add(unsigned* p, unsigned v) { return __hip_atomic_fetch_add(p, v, __ATOMIC_RELAXED, __HIP_MEMORY_SCOPE_AGENT); }
__device__ __forceinline__ unsigned xb_xcc_id() { return (unsigned)__builtin_amdgcn_s_getreg((3 << 11) | 20) & 0xFu; }
#define XB_SPIN(cond, bar) do { unsigned _sp = 0; while (cond) { __builtin_amdgcn_s_sleep(1); \
    if ((++_sp & 255u) == 0u) { if (xb_ld(&(bar)[XB_TMO])) break; if (_sp > XB_SPIN_CAP) { atomicAdd(&(bar)[XB_TMO], 1u); break; } } } } while (0)

struct XcdBarrier {
    unsigned* bar; unsigned x;
    volatile LAS unsigned* st;
};

__device__ __forceinline__ XcdBarrier xcd_barrier_post(unsigned* bar, volatile LAS unsigned* st) {
    XcdBarrier b; b.bar = bar; b.x = xb_xcc_id(); b.st = st;
    if (threadIdx.x == 0) (void)xb_add(&bar[XB_XCNT(b.x)], 1u);
    return b;
}
__device__ __forceinline__ void xcd_barrier_complete(unsigned* bar, unsigned x, unsigned& nloc, unsigned& nx) {
    const unsigned G = gridDim.x * gridDim.y * gridDim.z;
    unsigned sum, cnt, mine, sp = 0u;
    for (;;) {
        sum = 0u; cnt = 0u; mine = 0u;
#pragma unroll
        for (unsigned j = 0; j < 16; ++j) { const unsigned c = xb_ld(&bar[XB_XCNT(j)]); sum += c; cnt += (c > 0u) ? 1u : 0u; mine = (j == x) ? c : mine; }
        if (sum == G) break;
        __builtin_amdgcn_s_sleep(1);
        if ((++sp & 255u) == 0u) { if (xb_ld(&bar[XB_TMO])) break; if (sp > XB_SPIN_CAP) { atomicAdd(&bar[XB_TMO], 1u); break; } }
    }
    nloc = mine > 0u ? mine : 1u; nx = cnt > 0u ? cnt : 1u;
}

__device__ __forceinline__ void xcd_barrier(const XcdBarrier& b) {
    asm volatile("s_waitcnt vmcnt(0)" ::: "memory");
    __syncthreads();
    if (threadIdx.x == 0) {
        unsigned* bar = b.bar;
        __builtin_amdgcn_s_waitcnt(0);
        unsigned nloc = b.st[0], nx = b.st[1];
        if (nloc == 0u) { xcd_barrier_complete(bar, b.x, nloc, nx); b.st[0] = nloc; b.st[1] = nx; }
        const unsigned old = xb_add(&bar[XB_XSUB(b.x)], 1u);
        const unsigned gen = old / nloc;
        if (old + 1u == (gen + 1u) * nloc) {
            __builtin_amdgcn_fence(__ATOMIC_RELEASE, "agent");
            asm volatile("s_waitcnt vmcnt(0)" ::: "memory");
            const unsigned og = xb_add(&bar[XB_TOP], 1u);
            const unsigned tg = og / nx;
            if (og + 1u == (tg + 1u) * nx) xb_add(&bar[XB_TOPGEN], 1u);
            else XB_SPIN(xb_ld(&bar[XB_TOPGEN]) == tg, bar);
            __builtin_amdgcn_fence(__ATOMIC_ACQUIRE, "agent");
            xb_add(&bar[XB_XGEN(b.x)], 1u);
            asm volatile("s_waitcnt vmcnt(0)" ::: "memory");
        } else {
            XB_SPIN(xb_ld(&bar[XB_XGEN(b.x)]) == gen, bar);
            __builtin_amdgcn_fence(__ATOMIC_ACQUIRE, "agent");
            asm volatile("s_waitcnt vmcnt(0)" ::: "memory");
        }
    }
    __syncthreads();
}
typedef short bf16x8 __attribute__((ext_vector_type(8)));
typedef short v4i16_t __attribute__((ext_vector_type(4)));
typedef float f32x16 __attribute__((ext_vector_type(16)));
typedef float f32x2_t __attribute__((ext_vector_type(2)));
typedef __bf16 bf16x2_t __attribute__((ext_vector_type(2)));
typedef float f4v __attribute__((ext_vector_type(4)));
__device__ __forceinline__ f32x16 MFMA32(const bf16x8 a, const bf16x8 b, const f32x16 c) { return __builtin_amdgcn_mfma_f32_32x32x16_bf16(a, b, c, 0, 0, 0); }
__device__ __forceinline__ unsigned cvtpk(float lo, float hi) { f32x2_t v = {lo, hi}; bf16x2_t b = __builtin_convertvector(v, bf16x2_t); return __builtin_bit_cast(unsigned, b); }
__device__ __forceinline__ int crow(int reg, int h) { return (reg & 3) + 8 * (reg >> 2) + 4 * h; }
__device__ __forceinline__ float blo(unsigned u) { return __uint_as_float(u << 16); }
__device__ __forceinline__ float bhi(unsigned u) { return __uint_as_float(u & 0xffff0000u); }
template <int W> __device__ __forceinline__ unsigned toff(unsigned row, unsigned ch) {
    if constexpr (W == 64) return row * 144u + ch * 16u;
    else return row * 272u + ch * 16u;
}
template <int W> __device__ __forceinline__ bf16x8 frag_row(const LAS unsigned char* tile, int R, int s, int h) { return *(const LAS bf16x8*)(tile + toff<W>(R, 2 * s + h)); }
template <int W, bool PERMK> __device__ __forceinline__ bf16x8 frag_tr(const LAS unsigned char* tile, int rbase, int cbase, int lane) {
    const int h = lane >> 5, blk = (lane >> 4) & 1, q = (lane & 15) >> 2, p = lane & 3;
    const int ch = (cbase >> 3) + 2 * blk + (p >> 1);
    const int r0 = rbase + (PERMK ? 4 * h : 8 * h) + q, r1 = r0 + (PERMK ? 8 : 4);
    const v4i16_t lo = __builtin_amdgcn_ds_read_tr16_b64_v4i16((LAS v4i16_t*)(tile + toff<W>(r0, ch) + 8 * (p & 1)));
    const v4i16_t hi = __builtin_amdgcn_ds_read_tr16_b64_v4i16((LAS v4i16_t*)(tile + toff<W>(r1, ch) + 8 * (p & 1)));
    return __builtin_shufflevector(lo, hi, 0, 1, 2, 3, 4, 5, 6, 7);
}
__device__ __forceinline__ bf16x8 pack_step(const f32x16& x, int s) {
    v4u p; p.x = cvtpk(x[8 * s], x[8 * s + 1]); p.y = cvtpk(x[8 * s + 2], x[8 * s + 3]); p.z = cvtpk(x[8 * s + 4], x[8 * s + 5]); p.w = cvtpk(x[8 * s + 6], x[8 * s + 7]);
    return __builtin_bit_cast(bf16x8, p);
}
__device__ __forceinline__ f32x16 zero16() { f32x16 z;
#pragma unroll
    for (int i = 0; i < 16; ++i) z[i] = 0.f; return z; }
__device__ __forceinline__ void wave_scan_sum2(float& x0, float& x1, int lane) {
    const float loc = x0 + x1; float s = loc;
#pragma unroll
    for (int o = 1; o < 64; o <<= 1) { const float t = __shfl_up(s, o); if (lane >= o) s += t; }
    const float ex = s - loc; x0 = ex + x0; x1 = x0 + x1;
}
__device__ __forceinline__ void wave_scan_max2(float& x0, float& x1, int lane) {
    const float loc = fmaxf(x0, x1); float s = loc;
#pragma unroll
    for (int o = 1; o < 64; o <<= 1) { const float t = __shfl_up(s, o); if (lane >= o) s = fmaxf(s, t); }
    float ex = __shfl_up(s, 1); if (lane == 0) ex = -INFINITY;
    x0 = fmaxf(ex, x0); x1 = fmaxf(x0, x1);
}
__device__ __forceinline__ float wave_max(float v) {
#pragma unroll
    for (int o = 1; o < 64; o <<= 1) v = fmaxf(v, __shfl_xor(v, o));
    return v;
}
__device__ __forceinline__ void rot8_store(LAS unsigned char* tile, int row, int j0, const v4u x1, const v4u x2, const float* cs, float scale) {
    float a[8], b[8];
    a[0] = blo(x1.x); a[1] = bhi(x1.x); a[2] = blo(x1.y); a[3] = bhi(x1.y); a[4] = blo(x1.z); a[5] = bhi(x1.z); a[6] = blo(x1.w); a[7] = bhi(x1.w);
    b[0] = blo(x2.x); b[1] = bhi(x2.x); b[2] = blo(x2.y); b[3] = bhi(x2.y); b[4] = blo(x2.z); b[5] = bhi(x2.z); b[6] = blo(x2.w); b[7] = bhi(x2.w);
    float o1[8], o2[8];
#pragma unroll
    for (int i = 0; i < 8; ++i) { const float c = cs[2 * i], s = cs[2 * i + 1]; o1[i] = (a[i] * c - b[i] * s) * scale; o2[i] = (a[i] * s + b[i] * c) * scale; }
    v4u w1, w2; w1.x = cvtpk(o1[0], o1[1]); w1.y = cvtpk(o1[2], o1[3]); w1.z = cvtpk(o1[4], o1[5]); w1.w = cvtpk(o1[6], o1[7]);
    w2.x = cvtpk(o2[0], o2[1]); w2.y = cvtpk(o2[2], o2[3]); w2.z = cvtpk(o2[4], o2[5]); w2.w = cvtpk(o2[6], o2[7]);
    *(LAS v4u*)(tile + toff<64>(row, j0 >> 3)) = w1; *(LAS v4u*)(tile + toff<64>(row, 4 + (j0 >> 3))) = w2;
}
__device__ __forceinline__ void conv8(const bf16_t* colp, int s, const float* cw, const float* cb, float* o) {
#pragma unroll
    for (int i = 0; i < 8; ++i) o[i] = cb[i];
#pragma unroll
    for (int w = 0; w < 4; ++w) { const int ss = s - 3 + w; if (ss >= 0) { const v4u x = *(const v4u*)(colp + (ptrdiff_t)(w - 3) * NP);
        o[0] += blo(x.x) * cw[w * 8 + 0]; o[1] += bhi(x.x) * cw[w * 8 + 1]; o[2] += blo(x.y) * cw[w * 8 + 2]; o[3] += bhi(x.y) * cw[w * 8 + 3];
        o[4] += blo(x.z) * cw[w * 8 + 4]; o[5] += bhi(x.z) * cw[w * 8 + 5]; o[6] += blo(x.w) * cw[w * 8 + 6]; o[7] += bhi(x.w) * cw[w * 8 + 7]; } }
#pragma unroll
    for (int i = 0; i < 8; ++i) o[i] = o[i] * __builtin_amdgcn_rcpf(1.0f + __builtin_amdgcn_exp2f(-1.4426950408889634f * o[i]));
}

__device__ __forceinline__ float fast_sig(float x) { return __builtin_amdgcn_rcpf(1.0f + __builtin_amdgcn_exp2f(-1.4426950408889634f * x)); }
__device__ __forceinline__ size_t ret_tile(int bn, int slot) { return (size_t)bn * (size_t)(CH * NP) + (size_t)slot * (CH * 64); }
__device__ __forceinline__ size_t ml_tile(int bn, int slot) { return (size_t)bn * (size_t)(CH * NP) + (size_t)(CH * 2048) + (size_t)slot * (CH * 128); }
struct RetPre { v4u q1, q2, k1, k2, v0, v1, rp; f4v cs[4]; };
__device__ __forceinline__ void ret_issue(RetPre& R, const bf16_t* projp, const float* cstab, const bf16_t* rstb, int ri, int tid) {
    const int h = ri & 7, bn = ri >> 3;
    const int c = tid >> 2, j0 = (tid & 3) * 8;
    const f4v* csp = (const f4v*)(cstab + ((size_t)bn * CH + c) * 64 + j0 * 2);
#pragma unroll
    for (int i = 0; i < 4; ++i) R.cs[i] = csp[i];
    const int qo = c * 64 + j0;
    const bf16_t* qp = projp + ret_tile(bn, h) + qo; const bf16_t* kp = projp + ret_tile(bn, 8 + h) + qo;
    R.q1 = __builtin_nontemporal_load((const v4u*)qp); R.q2 = __builtin_nontemporal_load((const v4u*)(qp + 32)); R.k1 = __builtin_nontemporal_load((const v4u*)kp); R.k2 = __builtin_nontemporal_load((const v4u*)(kp + 32));
    const bf16_t* vp = projp + ret_tile(bn, 16 + h) + tid * 8;
    R.v0 = __builtin_nontemporal_load((const v4u*)vp); R.v1 = __builtin_nontemporal_load((const v4u*)(vp + 64 * 64));
    R.rp = __builtin_nontemporal_load((const v4u*)(rstb + (size_t)ri * (RD * RD) + tid * 8));
}
__device__ __forceinline__ void ret_stage(const RetPre& R, LAS unsigned char* Qt, LAS unsigned char* Kt, LAS unsigned char* Vt, LAS unsigned char* Rpt, int tid) {
    const int c = tid >> 2, j0 = (tid & 3) * 8;
    float cs[16];
#pragma unroll
    for (int i = 0; i < 4; ++i) { cs[4 * i] = R.cs[i].x; cs[4 * i + 1] = R.cs[i].y; cs[4 * i + 2] = R.cs[i].z; cs[4 * i + 3] = R.cs[i].w; }
    rot8_store(Qt, c, j0, R.q1, R.q2, cs, 1.0f); rot8_store(Kt, c, j0, R.k1, R.k2, cs, 0.125f);
    const int row = tid >> 3, ch = tid & 7;
    *(LAS v4u*)(Vt + toff<64>(row, ch)) = R.v0; *(LAS v4u*)(Vt + toff<64>(row + 64, ch)) = R.v1; *(LAS v4u*)(Rpt + toff<64>(row, ch)) = R.rp;
}
struct MlPre { v4u raw[11]; v4u v[4]; v4u sp[4]; float gi0, gi1, gf0, gf1, np0, np1, mprev; };
__device__ __forceinline__ void ml_issue_a(MlPre& M, const bf16_t* projp, const float* gatesp, const bf16_t* mstb, const float* mnp, const float* mmp, int mi, int tid, int lane) {
    const int h = mi & 3, bn = mi >> 2;
    const bf16_t* vp = projp + ml_tile(bn, 8 + h) + tid * 8; const bf16_t* sp = mstb + (size_t)mi * (MD * MD) + tid * 8;
#pragma unroll
    for (int i = 0; i < 4; ++i) { M.v[i] = __builtin_nontemporal_load((const v4u*)(vp + i * (NTHREADS * 8))); M.sp[i] = __builtin_nontemporal_load((const v4u*)(sp + i * (NTHREADS * 8))); }
    const float* gp = gatesp + ((size_t)bn * CH + 2 * lane) * 8 + h;
    M.gi0 = gp[0]; M.gi1 = gp[8]; M.gf0 = gp[4]; M.gf1 = gp[12];
    M.np0 = mnp[(size_t)mi * MD + lane]; M.np1 = mnp[(size_t)mi * MD + lane + 64]; M.mprev = mmp[mi];
}
__device__ __forceinline__ void ml_issue_b(MlPre& M, const bf16_t* projp, int mi, int tid) {
    const int h = mi & 3, bn = mi >> 2, n = bn % NCH;
    const int which = tid >> 8, u = tid & 255, cg = u & 15, c0 = 8 * (u >> 4);
    const bf16_t* tp = projp + ml_tile(bn, which * 4 + h) + c0 * 128 + cg * 8;
#pragma unroll
    for (int rr = 0; rr < 11; ++rr) {
        v4u x = {0u, 0u, 0u, 0u};
        if (rr >= 3) x = *(const v4u*)(tp + (rr - 3) * 128);
        else if (c0 > 0) x = *(const v4u*)(tp + (rr - 3) * 128);
        else if (n > 0) x = *(const v4u*)(tp + (rr - 3) * 128 - (ptrdiff_t)(CH * NP) + CH * 128);
        M.raw[rr] = x; }
}
__device__ __forceinline__ void ml_stage(const MlPre& M, LAS unsigned char* Qt, LAS unsigned char* Kt, LAS unsigned char* Vt, LAS unsigned char* Spt, const float* conv_w, const float* conv_b, int h, int tid) {
    const int which = tid >> 8, u = tid & 255, cg = u & 15, c0 = 8 * (u >> 4);
    const int chn = which * 512 + h * MD + cg * 8;
    float cw[32], cb_[8];
#pragma unroll
    for (int w = 0; w < 4; ++w) { const f4v a = *(const f4v*)(conv_w + w * 1024 + chn), b = *(const f4v*)(conv_w + w * 1024 + chn + 4);
        cw[w * 8] = a.x; cw[w * 8 + 1] = a.y; cw[w * 8 + 2] = a.z; cw[w * 8 + 3] = a.w; cw[w * 8 + 4] = b.x; cw[w * 8 + 5] = b.y; cw[w * 8 + 6] = b.z; cw[w * 8 + 7] = b.w; }
    { const f4v a = *(const f4v*)(conv_b + chn), b = *(const f4v*)(conv_b + chn + 4); cb_[0] = a.x; cb_[1] = a.y; cb_[2] = a.z; cb_[3] = a.w; cb_[4] = b.x; cb_[5] = b.y; cb_[6] = b.z; cb_[7] = b.w; }
    LAS unsigned char* dst = which ? Kt : Qt; const float sc = which ? 0.08838834764831845f : 1.0f;
#pragma unroll
    for (int o = 0; o < 8; ++o) {
        float a[8];
#pragma unroll
        for (int i = 0; i < 8; ++i) a[i] = cb_[i];
#pragma unroll
        for (int w = 0; w < 4; ++w) { const v4u x = M.raw[o + w];
            a[0] += blo(x.x) * cw[w * 8 + 0]; a[1] += bhi(x.x) * cw[w * 8 + 1]; a[2] += blo(x.y) * cw[w * 8 + 2]; a[3] += bhi(x.y) * cw[w * 8 + 3];
            a[4] += blo(x.z) * cw[w * 8 + 4]; a[5] += bhi(x.z) * cw[w * 8 + 5]; a[6] += blo(x.w) * cw[w * 8 + 6]; a[7] += bhi(x.w) * cw[w * 8 + 7]; }
#pragma unroll
        for (int i = 0; i < 8; ++i) a[i] = a[i] * fast_sig(a[i]) * sc;
        v4u w; w.x = cvtpk(a[0], a[1]); w.y = cvtpk(a[2], a[3]); w.z = cvtpk(a[4], a[5]); w.w = cvtpk(a[6], a[7]);
        *(LAS v4u*)(dst + toff<128>(c0 + o, cg)) = w;
    }
#pragma unroll
    for (int i = 0; i < 4; ++i) { const int idx = tid + NTHREADS * i, row = idx >> 4, ch = idx & 15; *(LAS v4u*)(Vt + toff<128>(row, ch)) = M.v[i]; *(LAS v4u*)(Spt + toff<128>(row, ch)) = M.sp[i]; }
}
struct Params {
    const float *x, *p; const int* pos;
    const float *attn_norm, *w_in, *conv_w, *conv_b, *b_ig, *b_fg, *ret_gn, *ml_gn, *w_out, *moe_norm, *w_group, *b_group, *w_router, *b_router,
                *w1, *w3, *w2, *w_up, *ple_norm, *pg_norm, *w_gate, *final_norm;
    float* out; unsigned char* ws;
};

__device__ __forceinline__ void load4(const float* p, float (&o)[4]) { const float4 v = *(const float4*)p; o[0] = v.x; o[1] = v.y; o[2] = v.z; o[3] = v.w; }
__device__ __forceinline__ void load4(const bf16_t* p, float (&o)[4]) { const uint2 v = *(const uint2*)p; o[0] = __uint_as_float(v.x << 16); o[1] = __uint_as_float(v.x & 0xffff0000u); o[2] = __uint_as_float(v.y << 16); o[3] = __uint_as_float(v.y & 0xffff0000u); }

__device__ __forceinline__ void transpose_item(const float* W, int ldw, const float* gain, bf16_t* WT, int K, int kb, int n0, size_t drow0, LAS float* scr, int lane) {
    const int k0 = 64 * kb;
#pragma unroll 8
    for (int i = 0; i < 32; ++i) { const int kk = 2 * i + (lane >> 5); float w = W[(size_t)(k0 + kk) * ldw + n0 + (lane & 31)]; if (gain) w *= gain[k0 + kk]; scr[kk * 33 + (lane & 31)] = w; }
    LDS_WAIT(); asm volatile("" ::: "memory");
    const int c = lane & 7;
#pragma unroll
    for (int j = 0; j < 4; ++j) { const int n = (lane >> 3) + 8 * j; const LAS float* s = scr + (8 * c) * 33 + n;
        v4u o; o.x = pk2(s[0 * 33], s[1 * 33]); o.y = pk2(s[2 * 33], s[3 * 33]); o.z = pk2(s[4 * 33], s[5 * 33]); o.w = pk2(s[6 * 33], s[7 * 33]);
        *(GAS v4u*)(WT + (drow0 + n) * K + k0 + 8 * c) = o; }
    LDS_WAIT(); asm volatile("" ::: "memory");
}

constexpr int NPHASES = 14;
template <int LO, int HI>
__global__ void __launch_bounds__(NTHREADS, 2) mk(Params P) {
    extern __shared__ __attribute__((aligned(16))) unsigned char lds_raw[];
    float* ldsf = (float*)lds_raw;
    LAS unsigned char* ldsl = (LAS unsigned char*)lds_raw;
    const int G = gridDim.x, bid = blockIdx.x, NGW = G * NWAVES;
#define PH_IDS int tid = threadIdx.x; asm volatile("" : "+v"(tid)); const int lane = tid & 63, wave = __builtin_amdgcn_readfirstlane(tid >> 6), gw = bid * NWAVES + wave; (void)lane; (void)gw;
    unsigned char* const ws = P.ws;
#define rstd1 ((float*)(ws + WS_RSTD1))
#define gates ((float*)(ws + WS_GATES))
#define rstdg ((float*)(ws + WS_RSTDG))
#define rstde ((float*)(ws + WS_RSTDE))
#define eid ((int*)(ws + WS_EID))
#define posn ((int*)(ws + WS_POS))
#define gate ((float*)(ws + WS_GATE))
#define mn ((float*)(ws + WS_MN))
#define ml ((float*)(ws + WS_ML))
#define mbl ((float*)(ws + WS_MBL))
#define mm ((float*)(ws + WS_MM))
#define list ((int*)(ws + WS_LIST))
#define cnt ((int*)(ws + WS_CTL) + CW_CNT)
#define part ((float*)(ws + WS_PART))
#define part2 ((float*)(ws + WS_PART2))
#define win_t ((bf16_t*)(ws + WS_WIN))
#define wout_t ((bf16_t*)(ws + WS_WOUT))
#define w13_t ((bf16_t*)(ws + WS_W13))
#define w2_t ((bf16_t*)(ws + WS_W2))
#define wgate_t ((bf16_t*)(ws + WS_WGATE))
#define wup_t ((bf16_t*)(ws + WS_WUP))
#define proj ((bf16_t*)(ws + WS_PROJ))
#define hbuf ((bf16_t*)(ws + WS_HBUF))
#define xs ((bf16_t*)(ws + WS_XS))
#define ybuf ((bf16_t*)(ws + WS_YBUF))
#define peb ((bf16_t*)(ws + WS_PEB))
#define yreg ((bf16_t*)(ws + WS_YREG))
#define pb ((bf16_t*)(ws + WS_PB))
    float* const out = P.out;
#define rst ((float*)((unsigned char*)out + OUT_RST))
#define mst ((float*)((unsigned char*)out + OUT_MST))
    LAS int* s_off = (LAS int*)(ldsl + LDSX_OFF + 256);
    LAS int* s_cnt = s_off + 40;
    LAS int* s_t2e = s_off + 80;
#define IN(k) (LO <= (k) && (k) < HI)
#ifndef PROBE_PH
#define PROBE_PH (-1)
#endif
    unsigned long long pt0 = 0ull, pt1 = 0ull, pseg = 0ull, plast = 0ull; (void)pseg; (void)plast;
#define SEG(k) do { if (PROBE_PH >= 110 && PROBE_PH < 140) { const unsigned long long _n = __builtin_amdgcn_s_memrealtime(); if (PROBE_PH == 110 + (k)) pseg += _n - plast; plast = _n; } } while (0)
    if (PROBE_PH == 0) pt0 = __builtin_amdgcn_s_memrealtime();
#define GRID_BAR(k) do { if constexpr (IN(k) && IN((k) + 1)) xcd_barrier(bar); if (PROBE_PH == (k)) pt1 = __builtin_amdgcn_s_memrealtime(); if (PROBE_PH == (k) + 1) pt0 = __builtin_amdgcn_s_memrealtime(); } while (0)
    XcdBarrier bar; bar.bar = (unsigned*)(ws + WS_CTL) + CW_BAR; bar.x = 0; bar.st = nullptr;
    if constexpr (HI - LO > 1) {
        PH_IDS
        volatile LAS unsigned* st = (volatile LAS unsigned*)(ldsl + LDSX_OFF);
        if (tid == 0) { st[0] = 0u; st[1] = 0u; }
        __syncthreads();
        bar = xcd_barrier_post((unsigned*)(ws + WS_CTL) + CW_BAR, st);
    }

    if constexpr (IN(0)) {
        PH_IDS
        if (PROBE_PH >= 120 && PROBE_PH < 130) plast = __builtin_amdgcn_s_memrealtime();
        {
            constexpr int I0 = 8 * 16, I1 = 8 * 4, I2 = 0, I3 = 0, I4 = 8 * 4, I5 = 2 * 4;
#define P0_DECODE(it_, W, ldw, K, kb, n0, gain, WT, drow0, dsplit) do { int r = (it_); gain = nullptr; dsplit = 0; \
                if (r < I0) { W = P.w_in; ldw = NPROJ; K = D; kb = r >> 4; n0 = 256 * (r & 15); gain = P.attn_norm; WT = win_t; drow0 = n0; } \
                else if ((r -= I0) < I1) { W = P.w_out; ldw = D; K = D; kb = r >> 2; n0 = 256 * (r & 3); WT = wout_t; drow0 = n0; } \
                else if ((r -= I1) < I2) { const int mat = r >> 4, q = r & 15, e = mat >> 1, which = mat & 1; W = (which ? P.w3 : P.w1) + (size_t)e * D * DE; ldw = DE; K = D; kb = q >> 1; n0 = 256 * (q & 1); \
                    gain = P.moe_norm; WT = w13_t; drow0 = (size_t)e * 1024 + (size_t)((n0 >> 7) * 256 + which * 128); dsplit = 1; } \
                else if ((r -= I2) < I3) { const int e = r >> 4, q = r & 15; W = P.w2 + (size_t)e * DE * D; ldw = D; K = DE; kb = q >> 2; n0 = 256 * (q & 3); WT = w2_t; drow0 = (size_t)e * 1024 + n0; } \
                else if ((r -= I3) < I4) { W = P.w_gate; ldw = D; K = D; kb = r >> 2; n0 = 256 * (r & 3); gain = P.pg_norm; WT = wgate_t; drow0 = n0; } \
                else { r -= I4; W = P.w_up; ldw = D; K = PLE; kb = r >> 2; n0 = 256 * (r & 3); WT = wup_t; drow0 = n0; } } while (0)
            constexpr int NIT = I0 + I1 + I2 + I3 + I4 + I5;
            const int c4 = tid & 63, r0 = tid >> 6;
            f4v va[16], vb[16]; float ga[16], gb[16];
#define P0_LOAD(v_, g_, it_) do { if ((it_) < NIT) { const float* W; int ldw, K, kb, n0; const float* gain; bf16_t* WT; size_t drow0; int dsplit; \
                P0_DECODE((it_), W, ldw, K, kb, n0, gain, WT, drow0, dsplit); (void)K; (void)WT; (void)drow0; (void)dsplit; \
                _Pragma("unroll") for (int i = 0; i < 16; ++i) { v_[i] = __builtin_nontemporal_load((const f4v*)(W + (size_t)(128 * kb + r0 + 8 * i) * ldw + n0 + 4 * c4)); g_[i] = gain ? gain[128 * kb + r0 + 8 * i] : 1.0f; } } } while (0)
#define P0_PROCESS(v_, g_, it_, itn_) do { const float* W; int ldw, K, kb, n0; const float* gain; bf16_t* WT; size_t drow0; int dsplit; \
                P0_DECODE((it_), W, ldw, K, kb, n0, gain, WT, drow0, dsplit); (void)W; (void)ldw; (void)gain; const int k0 = 128 * kb; \
                __syncthreads(); \
                _Pragma("unroll") for (int i = 0; i < 16; ++i) { v2u o; o.x = cvtpk(v_[i].x * g_[i], v_[i].y * g_[i]); o.y = cvtpk(v_[i].z * g_[i], v_[i].w * g_[i]); \
                    *(LAS v2u*)(ldsl + (r0 + 8 * i) * 576 + c4 * 8) = o; } \
                P0_LOAD(v_, g_, (itn_)); \
                __syncthreads(); \
                { const int grp = lane >> 4, q = (lane & 15) >> 2, p = lane & 3, i16 = lane & 15; \
                    \
                  _Pragma("unroll") for (int cg = 0; cg < 2; ++cg) { const int nl = 32 * wave + 16 * cg + i16; \
                    const size_t drow = drow0 + (dsplit && nl >= 128 ? (size_t)(256 + nl - 128) : (size_t)nl); \
                    _Pragma("unroll") for (int cq = 0; cq < 4; ++cq) { \
                        const LAS unsigned char* src = ldsl + ((4 * cq + grp) * 8 + q) * 576 + (32 * wave + 16 * cg + 4 * p) * 2; \
                        const v4i16_t lo = __builtin_amdgcn_ds_read_tr16_b64_v4i16((LAS v4i16_t*)src); \
                        const v4i16_t hi = __builtin_amdgcn_ds_read_tr16_b64_v4i16((LAS v4i16_t*)(src + 4 * 576)); \
                        const bf16x8 o = __builtin_shufflevector(lo, hi, 0, 1, 2, 3, 4, 5, 6, 7); \
                        *(bf16x8*)(WT + drow * K + k0 + (4 * cq + grp) * 8) = o; } } } } while (0)
            P0_LOAD(va, ga, bid); P0_LOAD(vb, gb, bid + G);
            for (int it = bid; it < NIT; it += 2 * G) {
                P0_PROCESS(va, ga, it, it + 2 * G);
                if (it + G < NIT) P0_PROCESS(vb, gb, it + G, it + 3 * G);
            }
#undef P0_LOAD
#undef P0_PROCESS
#undef P0_DECODE
        }
        __syncthreads();
        SEG(10);
        {
            LAS float* gwl = (LAS float*)ldsl;
            for (int idx = tid; idx < D * 8; idx += NTHREADS) { const int k = idx >> 3, j = idx & 7; gwl[idx] = P.w_in[(size_t)k * NPROJ + NP + j] * P.attn_norm[k]; }
            __syncthreads();
            for (int row0 = gw; row0 < T; row0 += 2 * NGW) {
                float4 v[2][4];
#pragma unroll
                for (int u = 0; u < 2; ++u) { const float4* xr = (const float4*)(P.x + (size_t)(row0 + u * NGW) * D) + lane;
#pragma unroll
                    for (int j = 0; j < 4; ++j) { const f4v t_ = __builtin_nontemporal_load((const f4v*)(xr + 64 * j)); v[u][j] = make_float4(t_.x, t_.y, t_.z, t_.w); } }
#pragma unroll
                for (int u = 0; u < 2; ++u) {
                    const int row = row0 + u * NGW; float ss = 0.f;
#pragma unroll
                    for (int j = 0; j < 4; ++j) ss += v[u][j].x * v[u][j].x + v[u][j].y * v[u][j].y + v[u][j].z * v[u][j].z + v[u][j].w * v[u][j].w;
                    ss = wave_sum(ss);
                    const float rstd = 1.0f / sqrtf(ss * (1.0f / D) + EPS);
                    float g8[8];
#pragma unroll
                    for (int i = 0; i < 8; ++i) g8[i] = 0.f;
#pragma unroll
                    for (int j = 0; j < 4; ++j) {
                        const int k0 = 4 * (lane + 64 * j);
                        const float xs_[4] = {v[u][j].x * rstd, v[u][j].y * rstd, v[u][j].z * rstd, v[u][j].w * rstd};
                        uint2 o; o.x = cvtpk(xs_[0], xs_[1]); o.y = cvtpk(xs_[2], xs_[3]);
                        *(uint2*)(yreg + (size_t)row * D + k0) = o;
#pragma unroll
                        for (int i = 0; i < 4; ++i) {
                            const LAS f4v* wr = (const LAS f4v*)(gwl + (k0 + i) * 8);
                            const f4v w0 = wr[0], w1 = wr[1];
                            g8[0] += xs_[i] * w0.x; g8[1] += xs_[i] * w0.y; g8[2] += xs_[i] * w0.z; g8[3] += xs_[i] * w0.w;
                            g8[4] += xs_[i] * w1.x; g8[5] += xs_[i] * w1.y; g8[6] += xs_[i] * w1.z; g8[7] += xs_[i] * w1.w;
                        }
                    }
#pragma unroll
                    for (int i = 0; i < 8; ++i) g8[i] = wave_sum(g8[i]);
                    if (lane == 0) {
                        *(float4*)(gates + (size_t)row * 8) = make_float4(g8[0], g8[1], g8[2], g8[3]);
                        *(float4*)(gates + (size_t)row * 8 + 4) = make_float4(g8[4], g8[5], g8[6], g8[7]);
                    }
                }
            }
            SEG(11);
            {
                bf16_t* wrh = (bf16_t*)(ws + WS_WR); bf16_t* wrl = wrh + 48 * D;
                for (int idx = bid * NTHREADS + tid; idx < 48 * D; idx += G * NTHREADS) {
                    const int col = idx >> 10, k = idx & 1023;
                    float w = 0.f; if (col < 4) w = P.w_group[k * 4 + col] * P.moe_norm[k]; else if (col < 36) w = P.w_router[k * 32 + col - 4] * P.moe_norm[k];
                    const unsigned hi = f2bf(w); const float r = w - __uint_as_float(hi << 16);
                    wrh[idx] = (bf16_t)hi; wrl[idx] = (bf16_t)f2bf(r);
                }
            }
            {
                float* cstab = (float*)(ws + WS_CS);
                for (int idx = bid * NTHREADS + tid; idx < T * 32; idx += G * NTHREADS) {
                    const int t = idx >> 5, j = idx & 31;
                    const float ang = (float)P.pos[t] * powf(10000.0f, -(float)j / 32.0f);
                    float sn, cs; sincosf(ang, &sn, &cs);
                    *(float2*)(cstab + (size_t)idx * 2) = make_float2(cs, sn);
                }
            }
            SEG(12);
        }
        __syncthreads();
        SEG(13);
    }
    GRID_BAR(0);
#ifdef PROBE_XBAR
    xcd_barrier(bar); xcd_barrier(bar); xcd_barrier(bar); xcd_barrier(bar); xcd_barrier(bar);
#endif
    if constexpr (IN(1)) {
        PH_IDS
        pg8::Gemm g{yreg, win_t, T, NP, D, nullptr}; pg8::StaticOrder S; S.init(T, NP, G, bid);
        pg8::EpiStoreBf16 E{proj, NP, 0xffff, nullptr, 1};
        pg8::gemm_phase<pg8::EpiStoreBf16, pg8::StaticOrder, true, true>(ldsl, g, S, E);
    }
    GRID_BAR(1);
    if constexpr (IN(2)) {
        PH_IDS
        const float* cstab = (const float*)(ws + WS_CS);
#define BAR_LDS() do { asm volatile("s_waitcnt lgkmcnt(0)" ::: "memory"); __builtin_amdgcn_s_barrier(); asm volatile("" ::: "memory"); } while (0)
        LAS unsigned char* tl = ldsl + 73728;
        f4v tv[8]; float tg[8]; int tk = 0;
        const int tc4 = tid & 63, tr0 = tid >> 6;
#define MOE_DECODE(it_, W, ldw, K, kb, n0, gain, WT, drow0, dsplit) do { int r = (it_); dsplit = 0; gain = nullptr; \
            if (r < 2048) { const int mat = r >> 5, q = r & 31, e = mat >> 1, which = mat & 1; W = (which ? P.w3 : P.w1) + (size_t)e * D * DE; ldw = DE; K = D; kb = q >> 1; n0 = 256 * (q & 1); \
                gain = P.moe_norm; WT = w13_t; drow0 = (size_t)e * 1024 + (size_t)((n0 >> 7) * 256 + which * 128); dsplit = 1; } \
            else { r -= 2048; const int e = r >> 5, q = r & 31; W = P.w2 + (size_t)e * DE * D; ldw = D; K = DE; kb = q >> 2; n0 = 256 * (q & 3); WT = w2_t; drow0 = (size_t)e * 1024 + n0; } } while (0)
#define MOE_LOAD(k_) do { const int it_ = bid + G * (k_); if (it_ < 3072) { const float* W; int ldw, K, kb, n0; const float* gain; bf16_t* WT; size_t drow0; int dsplit; \
            MOE_DECODE(it_, W, ldw, K, kb, n0, gain, WT, drow0, dsplit); (void)K; (void)WT; (void)drow0; (void)dsplit; \
            _Pragma("unroll") for (int i = 0; i < 8; ++i) { tv[i] = __builtin_nontemporal_load((const f4v*)(W + (size_t)(64 * kb + tr0 + 8 * i) * ldw + n0 + 4 * tc4)); tg[i] = gain ? gain[64 * kb + tr0 + 8 * i] : 1.0f; } } } while (0)
#define MOE_PROCESS(k_) do { const int it_ = bid + G * (k_); if (it_ < 3072) { const float* W; int ldw, K, kb, n0; const float* gain; bf16_t* WT; size_t drow0; int dsplit; \
            MOE_DECODE(it_, W, ldw, K, kb, n0, gain, WT, drow0, dsplit); (void)W; (void)ldw; (void)gain; const int k0 = 64 * kb; \
            _Pragma("unroll") for (int i = 0; i < 8; ++i) { v2u o; o.x = cvtpk(tv[i].x * tg[i], tv[i].y * tg[i]); o.y = cvtpk(tv[i].z * tg[i], tv[i].w * tg[i]); \
                *(LAS v2u*)(tl + (tr0 + 8 * i) * 576 + tc4 * 8) = o; } \
            MOE_LOAD((k_) + 1); \
            BAR_LDS(); \
            { const int grp = lane >> 4, q = (lane & 15) >> 2, p = lane & 3, i16 = lane & 15; \
              _Pragma("unroll") for (int cg = 0; cg < 2; ++cg) { const int nl = 32 * wave + 16 * cg + i16; \
                const size_t drow = drow0 + (dsplit && nl >= 128 ? (size_t)(256 + nl - 128) : (size_t)nl); \
                _Pragma("unroll") for (int cq = 0; cq < 2; ++cq) { \
                    const LAS unsigned char* src = tl + ((4 * cq + grp) * 8 + q) * 576 + (32 * wave + 16 * cg + 4 * p) * 2; \
                    const v4i16_t lo = __builtin_amdgcn_ds_read_tr16_b64_v4i16((LAS v4i16_t*)src); \
                    const v4i16_t hi = __builtin_amdgcn_ds_read_tr16_b64_v4i16((LAS v4i16_t*)(src + 4 * 576)); \
                    const bf16x8 o = __builtin_shufflevector(lo, hi, 0, 1, 2, 3, 4, 5, 6, 7); \
                    *(bf16x8*)(WT + drow * K + k0 + (4 * cq + grp) * 8) = o; } } } } } while (0)
        MOE_LOAD(0);
        BAR_LDS();
        {
            LAS unsigned char* Kt = ldsl; LAS unsigned char* Vt = ldsl + 18432;
            v4u k1, k2, v0, v1; f4v csr[4];
#define RET1_ISSUE(ri_) do { const int h_ = (ri_) & 7, bn_ = (ri_) >> 3; const int c_ = tid >> 2, j0_ = (tid & 3) * 8; \
                const f4v* csp_ = (const f4v*)(cstab + ((size_t)bn_ * CH + c_) * 64 + j0_ * 2); csr[0] = csp_[0]; csr[1] = csp_[1]; csr[2] = csp_[2]; csr[3] = csp_[3]; \
                const bf16_t* kp_ = proj + ret_tile(bn_, 8 + h_) + c_ * 64 + j0_; k1 = *(const v4u*)kp_; k2 = *(const v4u*)(kp_ + 32); \
                const bf16_t* vp_ = proj + ret_tile(bn_, 16 + h_) + tid * 8; v0 = *(const v4u*)vp_; v1 = *(const v4u*)(vp_ + 64 * 64); } while (0)
            const int rpb = (BATCH * NCH * RH + G - 1) / G, ri0 = bid * rpb, ri1 = (ri0 + rpb < BATCH * NCH * RH) ? ri0 + rpb : BATCH * NCH * RH;
            if (ri0 < ri1) RET1_ISSUE(ri0);
            for (int ri = ri0; ri < ri1; ++ri) {
                const int h = ri & 7;
                const float lg2 = log1pf(-exp2f(-5.0f - (float)h)) * 1.4426950408889634f;
                BAR_LDS();
                {   const int c = tid >> 2, j0 = (tid & 3) * 8; float cs[16];
#pragma unroll
                    for (int i = 0; i < 4; ++i) { cs[4 * i] = csr[i].x; cs[4 * i + 1] = csr[i].y; cs[4 * i + 2] = csr[i].z; cs[4 * i + 3] = csr[i].w; }
                    rot8_store(Kt, c, j0, k1, k2, cs, 0.125f * __builtin_amdgcn_exp2f(lg2 * (float)(CH - 1 - c)));
                    const int row = tid >> 3, ch = tid & 7;
                    *(LAS v4u*)(Vt + toff<64>(row, ch)) = v0; *(LAS v4u*)(Vt + toff<64>(row + 64, ch)) = v1; }
                BAR_LDS();
                if (ri + 1 < ri1) RET1_ISSUE(ri + 1);
                if (wave < 4) {
                    const int db = wave >> 1, eb = wave & 1, r = lane & 31, hl = lane >> 5;
                    f32x16 acc = zero16();
#pragma unroll
                    for (int s = 0; s < 8; ++s) acc = MFMA32(frag_tr<64, false>(Kt, 16 * s, db * 32, lane), frag_tr<64, false>(Vt, 16 * s, eb * 32, lane), acc);
                    bf16_t* dst = (bf16_t*)rst + (size_t)ri * (RD * RD) + eb * 32 + r;
#pragma unroll
                    for (int reg = 0; reg < 16; ++reg) { const float o = __shfl_down(acc[reg], 1); if ((r & 1) == 0) *(unsigned*)(dst + (db * 32 + crow(reg, hl)) * RD) = cvtpk(acc[reg], o); }
                }
                MOE_PROCESS(tk); ++tk;
            }
#undef RET1_ISSUE
        }
        {
            LAS unsigned char* Kt = ldsl; LAS unsigned char* Vt = ldsl + 34816; LAS float* sw = (LAS float*)(ldsl + 69632);
            v4u raw[7], vv[4]; float gi0, gi1, gf0, gf1;
#define ML1_ISSUE(mi_) do { const int h_ = (mi_) & 3, bn_ = (mi_) >> 2, n_ = bn_ % NCH; const int cg_ = tid & 15, c0_ = 4 * (tid >> 4); \
                const bf16_t* tp_ = proj + ml_tile(bn_, 4 + h_) + c0_ * 128 + cg_ * 8; \
                _Pragma("unroll") for (int rr = 0; rr < 7; ++rr) { v4u x_ = {0u, 0u, 0u, 0u}; \
                    if (rr >= 3) x_ = *(const v4u*)(tp_ + (rr - 3) * 128); else if (c0_ > 0) x_ = *(const v4u*)(tp_ + (rr - 3) * 128); \
                    else if (n_ > 0) x_ = *(const v4u*)(tp_ + (rr - 3) * 128 - (ptrdiff_t)(CH * NP) + CH * 128); raw[rr] = x_; } \
                const bf16_t* vp_ = proj + ml_tile(bn_, 8 + h_) + tid * 8; \
                _Pragma("unroll") for (int i = 0; i < 4; ++i) vv[i] = *(const v4u*)(vp_ + i * (NTHREADS * 8)); \
                const float* gp_ = gates + ((size_t)bn_ * CH + 2 * lane) * 8 + h_; gi0 = gp_[0]; gi1 = gp_[8]; gf0 = gp_[4]; gf1 = gp_[12]; } while (0)
            const int mpb = (BATCH * NCH * MH + G - 1) / G, mi0 = bid * mpb, mi1 = (mi0 + mpb < BATCH * NCH * MH) ? mi0 + mpb : BATCH * NCH * MH;
            if (mi0 < mi1) ML1_ISSUE(mi0);
            for (int mi = mi0; mi < mi1; ++mi) {
                const int h = mi & 3;
                BAR_LDS();
                if (wave == 0) {
                    const float i0 = gi0 + P.b_ig[h], i1 = gi1 + P.b_ig[h];
                    float b0 = flogsig_(gf0 + P.b_fg[h]), b1 = flogsig_(gf1 + P.b_fg[h]);
                    wave_scan_sum2(b0, b1, lane);
                    const float bL = __shfl(b1, 63);
                    const float a0 = bL - b0 + i0, a1 = bL - b1 + i1;
                    const float mloc = wave_max(fmaxf(a0, a1));
                    sw[2 * lane] = fexp_(a0 - mloc); sw[2 * lane + 1] = fexp_(a1 - mloc);
                    if (lane == 0) { ml[mi] = mloc; mbl[mi] = bL; }
                }
#pragma unroll
                for (int i = 0; i < 4; ++i) { const int idx = tid + NTHREADS * i, row = idx >> 4, ch = idx & 15; *(LAS v4u*)(Vt + toff<128>(row, ch)) = vv[i]; }
                BAR_LDS();
                {   const int cg = tid & 15, c0 = 4 * (tid >> 4); const int chn = 512 + h * MD + cg * 8;
                    float cw[32], cb_[8];
#pragma unroll
                    for (int w = 0; w < 4; ++w) { const f4v a = *(const f4v*)(P.conv_w + w * 1024 + chn), b2 = *(const f4v*)(P.conv_w + w * 1024 + chn + 4);
                        cw[w * 8] = a.x; cw[w * 8 + 1] = a.y; cw[w * 8 + 2] = a.z; cw[w * 8 + 3] = a.w; cw[w * 8 + 4] = b2.x; cw[w * 8 + 5] = b2.y; cw[w * 8 + 6] = b2.z; cw[w * 8 + 7] = b2.w; }
                    { const f4v a = *(const f4v*)(P.conv_b + chn), b2 = *(const f4v*)(P.conv_b + chn + 4); cb_[0] = a.x; cb_[1] = a.y; cb_[2] = a.z; cb_[3] = a.w; cb_[4] = b2.x; cb_[5] = b2.y; cb_[6] = b2.z; cb_[7] = b2.w; }
#pragma unroll
                    for (int o = 0; o < 4; ++o) {
                        float a[8];
#pragma unroll
                        for (int i = 0; i < 8; ++i) a[i] = cb_[i];
#pragma unroll
                        for (int w = 0; w < 4; ++w) { const v4u x = raw[o + w];
                            a[0] += blo(x.x) * cw[w * 8 + 0]; a[1] += bhi(x.x) * cw[w * 8 + 1]; a[2] += blo(x.y) * cw[w * 8 + 2]; a[3] += bhi(x.y) * cw[w * 8 + 3];
                            a[4] += blo(x.z) * cw[w * 8 + 4]; a[5] += bhi(x.z) * cw[w * 8 + 5]; a[6] += blo(x.w) * cw[w * 8 + 6]; a[7] += bhi(x.w) * cw[w * 8 + 7]; }
                        const float sc = 0.08838834764831845f * sw[c0 + o];
#pragma unroll
                        for (int i = 0; i < 8; ++i) a[i] = a[i] * fast_sig(a[i]) * sc;
                        v4u w; w.x = cvtpk(a[0], a[1]); w.y = cvtpk(a[2], a[3]); w.z = cvtpk(a[4], a[5]); w.w = cvtpk(a[6], a[7]);
                        *(LAS v4u*)(Kt + toff<128>(c0 + o, cg)) = w;
                    }
                }
                BAR_LDS();
                if (mi + 1 < mi1) ML1_ISSUE(mi + 1);
                {
                    const int db = wave >> 1, ep = wave & 1, r = lane & 31, hl = lane >> 5;
                    f32x16 acc0 = zero16(), acc1 = zero16(), accn = zero16();
                    bf16x8 ones;
#pragma unroll
                    for (int i = 0; i < 8; ++i) ones[i] = (short)0x3F80;
#pragma unroll
                    for (int s = 0; s < 8; ++s) { const bf16x8 ka = frag_tr<128, false>(Kt, 16 * s, db * 32, lane);
                        acc0 = MFMA32(ka, frag_tr<128, false>(Vt, 16 * s, ep * 64, lane), acc0);
                        acc1 = MFMA32(ka, frag_tr<128, false>(Vt, 16 * s, ep * 64 + 32, lane), acc1);
                        if (ep == 0) accn = MFMA32(ka, ones, accn); }
                    bf16_t* dst = (bf16_t*)mst + (size_t)mi * (MD * MD) + ep * 64 + r;
#pragma unroll
                    for (int reg = 0; reg < 16; ++reg) { const int d = db * 32 + crow(reg, hl); const float o0 = __shfl_down(acc0[reg], 1), o1 = __shfl_down(acc1[reg], 1);
                        if ((r & 1) == 0) { *(unsigned*)(dst + d * MD) = cvtpk(acc0[reg], o0); *(unsigned*)(dst + d * MD + 32) = cvtpk(acc1[reg], o1); } }
                    if (ep == 0 && r == 0) {
#pragma unroll
                        for (int reg = 0; reg < 16; ++reg) mn[(size_t)mi * MD + db * 32 + crow(reg, hl)] = accn[reg];
                    }
                }
                MOE_PROCESS(tk); ++tk;
            }
#undef ML1_ISSUE
        }
        BAR_LDS();
        for (; tk < 12; ++tk) { MOE_PROCESS(tk); BAR_LDS(); }
#undef MOE_DECODE
#undef MOE_LOAD
#undef MOE_PROCESS
#undef BAR_LDS
    }
    GRID_BAR(2);
    if constexpr (IN(3)) {
        PH_IDS
        constexpr int NRT = BATCH * RH * (RD * RD / 4), NMT = BATCH * MH * (MD * MD / 4), NNT = BATCH * MH * (MD / 4);
        bf16_t* rstb = (bf16_t*)(ws + WS_RSTB); bf16_t* mstb = (bf16_t*)((unsigned char*)out + OUT_MSTB);
        for (int task = bid * NTHREADS + tid; task < NRT + NMT + NNT; task += G * NTHREADS) {
            if (task < NRT) {
                const int el = (task % (RD * RD / 4)) * 4, bh = task / (RD * RD / 4), b = bh / RH, h = bh % RH;
                const float dec = expf(log1pf(-exp2f(-5.0f - (float)h)) * (float)CH);
                const size_t base = (size_t)(b * NCH * RH + h) * (RD * RD) + el, nstride = (size_t)RH * RD * RD;
                f4v R = {0.f, 0.f, 0.f, 0.f};
#pragma unroll 1
                for (int n0 = 0; n0 < NCH; n0 += 8) {
                    f4v v[8];
#pragma unroll
                    for (int i = 0; i < 8; ++i) { const v2u q = __builtin_nontemporal_load((const v2u*)((const bf16_t*)rst + base + (size_t)(n0 + i) * nstride)); v[i].x = blo(q.x); v[i].y = bhi(q.x); v[i].z = blo(q.y); v[i].w = bhi(q.y); }
#pragma unroll
                    for (int i = 0; i < 8; ++i) { v2u o; o.x = cvtpk(R.x, R.y); o.y = cvtpk(R.z, R.w); *(v2u*)(rstb + base + (size_t)(n0 + i) * nstride) = o; R = R * dec + v[i]; }
                }
            } else {
                const int j = task - NRT; const bool isn = j >= NMT; const int jj = isn ? j - NMT : j, per = isn ? MD / 4 : MD * MD / 4;
                const int el = (jj % per) * 4, bh = jj / per, b = bh / MH, h = bh % MH;
                const int s0 = b * NCH * MH + h;
                f4v S = {0.f, 0.f, 0.f, 0.f}; float m = 0.f;
#pragma unroll 1
                for (int n0 = 0; n0 < NCH; n0 += 8) {
                    f4v v[8]; float bl[8], mlc[8];
#pragma unroll
                    for (int i = 0; i < 8; ++i) { const int sidx = s0 + (n0 + i) * MH; bl[i] = mbl[sidx]; mlc[i] = ml[sidx];
                        if (isn) v[i] = *(const f4v*)(mn + (size_t)sidx * MD + el);
                        else { const v2u q = __builtin_nontemporal_load((const v2u*)((const bf16_t*)mst + (size_t)sidx * (MD * MD) + el)); v[i].x = blo(q.x); v[i].y = bhi(q.x); v[i].z = blo(q.y); v[i].w = bhi(q.y); } }
#pragma unroll
                    for (int i = 0; i < 8; ++i) { const int sidx = s0 + (n0 + i) * MH;
                        const float mnew = fmaxf(bl[i] + m, mlc[i]);
                        const float dec = expf(bl[i] + m - mnew), sc = expf(mlc[i] - mnew);
                        if (isn) { *(f4v*)(mn + (size_t)sidx * MD + el) = S; if (el == 0) mm[sidx] = m; }
                        else { v2u o; o.x = cvtpk(S.x, S.y); o.y = cvtpk(S.z, S.w); *(v2u*)(mstb + (size_t)sidx * (MD * MD) + el) = o; }
                        S = S * dec + v[i] * sc; m = mnew; }
                }
            }
        }
    }
    GRID_BAR(3);
    if constexpr (IN(4)) {
        PH_IDS
        const float* cstab = (const float*)(ws + WS_CS);
        const bf16_t* rstb = (const bf16_t*)(ws + WS_RSTB); const bf16_t* mstb = (const bf16_t*)((unsigned char*)out + OUT_MSTB);
#define BAR_LDS() do { asm volatile("s_waitcnt lgkmcnt(0)" ::: "memory"); __builtin_amdgcn_s_barrier(); asm volatile("" ::: "memory"); } while (0)
        BAR_LDS();
        if (PROBE_PH == 100) pt0 = __builtin_amdgcn_s_memrealtime();
        {
            LAS unsigned char* Qt = ldsl; LAS unsigned char* Kt = ldsl + 18432; LAS unsigned char* Vt = ldsl + 36864; LAS unsigned char* Rpt = ldsl + 55296;
            LAS float* Zs = (LAS float*)(ldsl + 65536);
            LAS float* sgn = (LAS float*)(ldsl + 110592);
            sgn[tid] = P.ret_gn[tid];
            RetPre R;
            const int rpb = (BATCH * NCH * RH + G - 1) / G, ri0 = bid * rpb, ri1 = (ri0 + rpb < BATCH * NCH * RH) ? ri0 + rpb : BATCH * NCH * RH;
            if (ri0 < ri1) ret_issue(R, proj, cstab, rstb, ri0, tid);
            for (int ri = ri0; ri < ri1; ++ri) {
                int tid_i = threadIdx.x; asm volatile("" : "+v"(tid_i));
                const int tid = tid_i, lane = tid & 63;
                const int h = ri & 7; const size_t t0 = (size_t)(ri >> 3) * CH;
                const float lg2 = log1pf(-exp2f(-5.0f - (float)h)) * 1.4426950408889634f;
                ret_stage(R, Qt, Kt, Vt, Rpt, tid);
                BAR_LDS();
                const int ce = tid >> 2, e0 = (tid & 3) * 16; const size_t te = t0 + ce;
                const bf16_t* gp_ = proj + ret_tile(ri >> 3, 24 + h) + ce * 64 + e0; const v4u g0 = __builtin_nontemporal_load((const v4u*)gp_), g1 = __builtin_nontemporal_load((const v4u*)(gp_ + 8));
                asm volatile("" :: "v"(g0), "v"(g1));
                if (ri + 1 < ri1) ret_issue(R, proj, cstab, rstb, ri + 1, tid);
                const int prow = bid * (T / 256) + (ri - ri0) * 16 + wave * 2;
                const bool pdo = (ri - ri0) < 8 && G == 256;
                f4v pv0 = {0.f, 0.f, 0.f, 0.f}, pv1 = pv0;
                if (pdo) { pv0 = __builtin_nontemporal_load((const f4v*)(P.p + (size_t)prow * PLE) + lane); pv1 = __builtin_nontemporal_load((const f4v*)(P.p + (size_t)(prow + 1) * PLE) + lane); }
                {
                    const int cb = (0x1023 >> (4 * (wave >> 1))) & 3,     eb = wave & 1, r = lane & 31, hl = lane >> 5;
                    f32x16 Z = zero16();
                    const int c = cb * 32 + r;
                    for (int jb = 0; jb <= cb; ++jb) {
                        f32x16 X = zero16();
#pragma unroll
                        for (int s = 0; s < 4; ++s) X = MFMA32(frag_row<64>(Kt, jb * 32 + r, s, hl), frag_row<64>(Qt, cb * 32 + r, s, hl), X);
#pragma unroll
                        for (int reg = 0; reg < 16; ++reg) { const int dl = c - (jb * 32 + crow(reg, hl)); X[reg] = dl >= 0 ? X[reg] * __builtin_amdgcn_exp2f(lg2 * (float)dl) : 0.f; }
#pragma unroll
                        for (int s2 = 0; s2 < 2; ++s2) Z = MFMA32(pack_step(X, s2), frag_tr<64, true>(Vt, jb * 32 + 16 * s2, eb * 32, lane), Z);
                    }
                    f32x16 Zi = zero16();
#pragma unroll
                    for (int s = 0; s < 4; ++s) Zi = MFMA32(frag_row<64>(Qt, cb * 32 + r, s, hl), frag_tr<64, false>(Rpt, 16 * s, eb * 32, lane), Zi);
#pragma unroll
                    for (int reg = 0; reg < 16; ++reg) { const int cc = cb * 32 + crow(reg, hl); Z[reg] += __builtin_amdgcn_exp2f(lg2 * (float)(cc + 1)) * Zi[reg]; Zs[cc * 68 + eb * 32 + r] = Z[reg]; }
                }
                BAR_LDS();
                {
                    float z[16]; float ss = 0.f;
#pragma unroll
                    for (int i = 0; i < 4; ++i) { const f4v v = *(const LAS f4v*)(Zs + ce * 68 + e0 + 4 * i); z[4 * i] = v.x; z[4 * i + 1] = v.y; z[4 * i + 2] = v.z; z[4 * i + 3] = v.w; }
#pragma unroll
                    for (int i = 0; i < 16; ++i) ss += z[i] * z[i];
                    ss += __shfl_xor(ss, 1); ss += __shfl_xor(ss, 2);
                    const float rn = 1.0f / sqrtf(ss * (1.0f / RD) + EPS);
                    const float gg[16] = {blo(g0.x), bhi(g0.x), blo(g0.y), bhi(g0.y), blo(g0.z), bhi(g0.z), blo(g0.w), bhi(g0.w), blo(g1.x), bhi(g1.x), blo(g1.y), bhi(g1.y), blo(g1.z), bhi(g1.z), blo(g1.w), bhi(g1.w)};
                    float o[16];
#pragma unroll
                    for (int i = 0; i < 16; ++i) o[i] = gg[i] * fast_sig(gg[i]) * z[i] * rn * sgn[h * RD + e0 + i];
                    v4u w0, w1; w0.x = cvtpk(o[0], o[1]); w0.y = cvtpk(o[2], o[3]); w0.z = cvtpk(o[4], o[5]); w0.w = cvtpk(o[6], o[7]);
                    w1.x = cvtpk(o[8], o[9]); w1.y = cvtpk(o[10], o[11]); w1.z = cvtpk(o[12], o[13]); w1.w = cvtpk(o[14], o[15]);
                    *(v4u*)(yreg + te * D + h * RD + e0) = w0; *(v4u*)(yreg + te * D + h * RD + e0 + 8) = w1;
                }
                if (pdo) { v2u o0, o1; o0.x = cvtpk(pv0.x, pv0.y); o0.y = cvtpk(pv0.z, pv0.w); o1.x = cvtpk(pv1.x, pv1.y); o1.y = cvtpk(pv1.z, pv1.w);
                    ((v2u*)(pb + (size_t)prow * PLE))[lane] = o0; ((v2u*)(pb + (size_t)(prow + 1) * PLE))[lane] = o1; }
            }
        }
        BAR_LDS();
        if (PROBE_PH == 100) pt1 = __builtin_amdgcn_s_memrealtime();
        if (PROBE_PH == 101) pt0 = __builtin_amdgcn_s_memrealtime();
        {
            LAS unsigned char* Qt = ldsl; LAS unsigned char* Kt = ldsl + 34816; LAS unsigned char* Vt = ldsl + 69632; LAS unsigned char* Spt = ldsl + 104448;
            LAS float* sb = (LAS float*)(ldsl + 139264); LAS float* sg = sb + 128; LAS float* spm = sg + 128; LAS float* snp = spm + 128; LAS float* sden = snp + 128; LAS float* swi = sden + 128;
            LAS float* Zs = (LAS float*)(ldsl + 34816);
            MlPre M;
            const int mpb = (BATCH * NCH * MH + G - 1) / G, mi0 = bid * mpb, mi1 = (mi0 + mpb < BATCH * NCH * MH) ? mi0 + mpb : BATCH * NCH * MH;
            if (mi0 < mi1) { ml_issue_a(M, proj, gates, mstb, mn, mm, mi0, tid, lane); ml_issue_b(M, proj, mi0, tid); }
            if (PROBE_PH >= 110 && PROBE_PH < 120) plast = __builtin_amdgcn_s_memrealtime();
            for (int mi = mi0; mi < mi1; ++mi) {
                int tid_i = threadIdx.x; asm volatile("" : "+v"(tid_i));
                const int tid = tid_i, lane = tid & 63;
                const int h = mi & 3; const size_t t0 = (size_t)(mi >> 2) * CH;
                const float mprev = M.mprev;
                SEG(3);
                BAR_LDS();
                if (wave == 0) {
                    const float i0 = M.gi0 + P.b_ig[h], i1 = M.gi1 + P.b_ig[h];
                    float b0 = flogsig_(M.gf0 + P.b_fg[h]), b1 = flogsig_(M.gf1 + P.b_fg[h]);
                    wave_scan_sum2(b0, b1, lane);
                    const float g0 = i0 - b0, g1 = i1 - b1; float p0 = g0, p1 = g1;
                    wave_scan_max2(p0, p1, lane);
                    sb[2 * lane] = b0; sb[2 * lane + 1] = b1; sg[2 * lane] = g0; sg[2 * lane + 1] = g1; spm[2 * lane] = p0; spm[2 * lane + 1] = p1;
                    swi[2 * lane] = fexp_(mprev - fmaxf(p0, mprev)); swi[2 * lane + 1] = fexp_(mprev - fmaxf(p1, mprev));
                } else if (wave == 1) { snp[lane] = M.np0; snp[lane + 64] = M.np1; }
                ml_stage(M, Qt, Kt, Vt, Spt, P.conv_w, P.conv_b, h, tid);
                BAR_LDS();
                SEG(0);
                const int ce = tid >> 2, qd = tid & 3, e0 = qd * 32; const size_t te = t0 + ce;
                if (mi + 1 < mi1) ml_issue_a(M, proj, gates, mstb, mn, mm, mi + 1, tid, lane);
                const int cb = (0x1023 >> (4 * (wave >> 1))) & 3,     ep = wave & 1, r = lane & 31, hl = lane >> 5;
                f32x16 Z0 = zero16(), Z1 = zero16();
                {
                    const int c = cb * 32 + r;
#pragma unroll
                    for (int s = 0; s < 8; ++s) { const bf16x8 qa = frag_row<128>(Qt, cb * 32 + r, s, hl);
                        Z0 = MFMA32(qa, frag_tr<128, false>(Spt, 16 * s, ep * 64, lane), Z0);
                        Z1 = MFMA32(qa, frag_tr<128, false>(Spt, 16 * s, ep * 64 + 32, lane), Z1); }
#pragma unroll
                    for (int reg = 0; reg < 16; ++reg) { const float wi = swi[cb * 32 + crow(reg, hl)]; Z0[reg] *= wi; Z1[reg] *= wi; }
                    const float nc = -fmaxf(spm[c], mprev); float den = 0.f;
                    for (int jb = 0; jb <= cb; ++jb) {
                        f32x16 X = zero16();
#pragma unroll
                        for (int s = 0; s < 8; ++s) X = MFMA32(frag_row<128>(Kt, jb * 32 + r, s, hl), frag_row<128>(Qt, cb * 32 + r, s, hl), X);
                        {
                            f4v gq[4];
#pragma unroll
                            for (int g4 = 0; g4 < 4; ++g4) gq[g4] = *(const LAS f4v*)(sg + jb * 32 + 8 * g4 + 4 * hl);
#pragma unroll
                            for (int reg = 0; reg < 16; ++reg) { const int j = jb * 32 + crow(reg, hl);
                                const float f = __builtin_amdgcn_exp2f(1.4426950408889634f * (nc + gq[reg >> 2][reg & 3]));
                                const float xv = X[reg] * f; X[reg] = j <= c ? xv : 0.f; den += X[reg]; }
                        }
#pragma unroll
                        for (int s2 = 0; s2 < 2; ++s2) { const bf16x8 xs_ = pack_step(X, s2);
                            Z0 = MFMA32(xs_, frag_tr<128, true>(Vt, jb * 32 + 16 * s2, ep * 64, lane), Z0);
                            Z1 = MFMA32(xs_, frag_tr<128, true>(Vt, jb * 32 + 16 * s2, ep * 64 + 32, lane), Z1); }
                    }
                    den += __shfl_xor(den, 32);
                    if (ep == 0 && hl == 0) sden[c] = den;
                }
                BAR_LDS();
                SEG(1);
#pragma unroll
                for (int reg = 0; reg < 16; ++reg) { const int cc = cb * 32 + crow(reg, hl); Zs[cc * 132 + ep * 64 + r] = Z0[reg]; Zs[cc * 132 + ep * 64 + 32 + r] = Z1[reg]; }
                BAR_LDS();
                SEG(2);
                v4u ov[4];
#pragma unroll
                for (int i = 0; i < 4; ++i) ov[i] = __builtin_nontemporal_load((const v4u*)(proj + ml_tile(mi >> 2, 12 + h) + ce * 128 + e0 + 8 * i));
                f4v gnm[8];
#pragma unroll
                for (int i = 0; i < 8; ++i) gnm[i] = *(const f4v*)(P.ml_gn + h * MD + e0 + 4 * i);
                asm volatile("" :: "v"(ov[0]), "v"(ov[1]), "v"(ov[2]), "v"(ov[3]));
                asm volatile("" :: "v"(gnm[0]), "v"(gnm[1]), "v"(gnm[2]), "v"(gnm[3]), "v"(gnm[4]), "v"(gnm[5]), "v"(gnm[6]), "v"(gnm[7]));
                if (mi + 1 < mi1) ml_issue_b(M, proj, mi + 1, tid);
                {
                    float qn = 0.f;
#pragma unroll
                    for (int i = 0; i < 4; ++i) { const v4u qv = *(const LAS v4u*)(Qt + toff<128>(ce, 4 * qd + i)); const LAS float* np_ = snp + 32 * qd + 8 * i;
                        qn += blo(qv.x) * np_[0] + bhi(qv.x) * np_[1] + blo(qv.y) * np_[2] + bhi(qv.y) * np_[3] + blo(qv.z) * np_[4] + bhi(qv.z) * np_[5] + blo(qv.w) * np_[6] + bhi(qv.w) * np_[7]; }
                    qn += __shfl_xor(qn, 1); qn += __shfl_xor(qn, 2);
                    const float Mx = fmaxf(spm[ce], mprev), mrow = sb[ce] + Mx;
                    const float den = sden[ce] + swi[ce] * qn;
                    const float inv = __builtin_amdgcn_rcpf(fmaxf(fabsf(den), fexp_(-mrow)));
                    float z[32]; float ss = 0.f;
#pragma unroll
                    for (int i = 0; i < 8; ++i) { const f4v v = *(const LAS f4v*)(Zs + ce * 132 + e0 + 4 * i); z[4 * i] = v.x; z[4 * i + 1] = v.y; z[4 * i + 2] = v.z; z[4 * i + 3] = v.w; }
#pragma unroll
                    for (int i = 0; i < 4; ++i) { const v4u ovi = ov[i];
                        const float oo[8] = {blo(ovi.x), bhi(ovi.x), blo(ovi.y), bhi(ovi.y), blo(ovi.z), bhi(ovi.z), blo(ovi.w), bhi(ovi.w)};
#pragma unroll
                        for (int k = 0; k < 8; ++k) { const float v = fast_sig(oo[k]) * z[8 * i + k] * inv; z[8 * i + k] = v; ss += v * v; } }
                    ss += __shfl_xor(ss, 1); ss += __shfl_xor(ss, 2);
                    const float rn = 1.0f / sqrtf(ss * (1.0f / MD) + EPS);
                    bf16_t* yp = yreg + te * D + 512 + h * MD + e0;
#pragma unroll
                    for (int i = 0; i < 4; ++i) { const f4v ga = gnm[2 * i], gb = gnm[2 * i + 1];
                        v4u w; w.x = cvtpk(z[8 * i] * rn * ga.x, z[8 * i + 1] * rn * ga.y); w.y = cvtpk(z[8 * i + 2] * rn * ga.z, z[8 * i + 3] * rn * ga.w);
                        w.z = cvtpk(z[8 * i + 4] * rn * gb.x, z[8 * i + 5] * rn * gb.y); w.w = cvtpk(z[8 * i + 6] * rn * gb.z, z[8 * i + 7] * rn * gb.w);
                        *(v4u*)(yp + 8 * i) = w; }
                }
            }
        }
        BAR_LDS();
        if (PROBE_PH == 101) pt1 = __builtin_amdgcn_s_memrealtime();
#undef BAR_LDS
    }
    GRID_BAR(4);
    if constexpr (IN(5)) {
        PH_IDS
        pg8::Gemm g{yreg, wout_t, T, D, D, nullptr}; pg8::StaticOrder S; S.init(T, D, G, bid);
        pg8::EpiRes E{P.x, (bf16_t*)((unsigned char*)out + OUT_HB)};
        pg8::gemm_phase<pg8::EpiRes, pg8::StaticOrder, true, true>(ldsl, g, S, E);
    }
    GRID_BAR(5);
    if constexpr (IN(6)) {
        PH_IDS
        LAS unsigned char* Bh = ldsl;
        LAS unsigned char* Bl = ldsl + 49920;
        LAS float* Ls = (LAS float*)(ldsl + 106496);
        LAS int* lcnt = (LAS int*)(ldsl + 131584); LAS int* lbase = lcnt + 32;
        const bf16_t* wrh = (const bf16_t*)(ws + WS_WR); const bf16_t* wrl = wrh + 48 * D;
        for (int unit = bid; unit < T / 128; unit += G) {
            const int tok0 = unit * 128 + wave * 16, row = lane & 15, kq = lane >> 4;
            const bf16_t* ap = (const bf16_t*)((unsigned char*)out + OUT_HB) + (size_t)(tok0 + row) * D + 8 * kq;
            pg8::f32x4 c0 = {0.f, 0.f, 0.f, 0.f}, c1 = c0, c2 = c0; float ss = 0.f;
            if (tid < 32) lcnt[tid] = 0;
#pragma unroll 1
            for (int kh = 0; kh < 2; ++kh) {
                __syncthreads();
                for (int idx = tid; idx < 48 * 64; idx += NTHREADS) { const int col = idx >> 6, ch = idx & 63;
                    *(LAS v4u*)(Bh + col * 1040 + ch * 16) = *(const v4u*)(wrh + col * D + kh * 512 + ch * 8);
                    *(LAS v4u*)(Bl + col * 1040 + ch * 16) = *(const v4u*)(wrl + col * D + kh * 512 + ch * 8); }
                __syncthreads();
#pragma unroll 4
                for (int st = 0; st < 16; ++st) {
                    const v4u hq = *(const v4u*)(ap + kh * 512 + st * 32);
                    const float a8[8] = {blo(hq.x), bhi(hq.x), blo(hq.y), bhi(hq.y), blo(hq.z), bhi(hq.z), blo(hq.w), bhi(hq.w)};
#pragma unroll
                    for (int i = 0; i < 8; ++i) ss += a8[i] * a8[i];
                    const bf16x8 af = __builtin_bit_cast(bf16x8, hq);
                    const int bo = row * 1040 + (st * 32 + 8 * kq) * 2;
                    c0 = __builtin_amdgcn_mfma_f32_16x16x32_bf16(af, *(const LAS bf16x8*)(Bh + bo), c0, 0, 0, 0);
                    c0 = __builtin_amdgcn_mfma_f32_16x16x32_bf16(af, *(const LAS bf16x8*)(Bl + bo), c0, 0, 0, 0);
                    c1 = __builtin_amdgcn_mfma_f32_16x16x32_bf16(af, *(const LAS bf16x8*)(Bh + bo + 16 * 1040), c1, 0, 0, 0);
                    c1 = __builtin_amdgcn_mfma_f32_16x16x32_bf16(af, *(const LAS bf16x8*)(Bl + bo + 16 * 1040), c1, 0, 0, 0);
                    c2 = __builtin_amdgcn_mfma_f32_16x16x32_bf16(af, *(const LAS bf16x8*)(Bh + bo + 32 * 1040), c2, 0, 0, 0);
                    c2 = __builtin_amdgcn_mfma_f32_16x16x32_bf16(af, *(const LAS bf16x8*)(Bl + bo + 32 * 1040), c2, 0, 0, 0);
                }
            }
            ss += __shfl_xor(ss, 16); ss += __shfl_xor(ss, 32);
            const float rstd = 1.0f / sqrtf(ss * (1.0f / D) + EPS);
#pragma unroll
            for (int reg = 0; reg < 4; ++reg) { LAS float* lp = Ls + (wave * 16 + 4 * kq + reg) * 49 + row; lp[0] = c0[reg]; lp[16] = c1[reg]; lp[32] = c2[reg]; }
            __syncthreads();
            const int tok = tok0 + row;
            const LAS float* lp = Ls + (wave * 16 + row) * 49;
            float gl[4];
#pragma unroll
            for (int i = 0; i < 4; ++i) gl[i] = lp[i] * rstd + P.b_group[i];
            int gs = 0; float gmax = gl[0];
#pragma unroll
            for (int i = 1; i < 4; ++i) if (gl[i] > gmax) { gmax = gl[i]; gs = i; }
            float gsum = 0.f;
#pragma unroll
            for (int i = 0; i < 4; ++i) gsum += expf(gl[i] - gmax);
            const float pg = 1.0f / gsum;
            float el[8];
#pragma unroll
            for (int i = 0; i < 8; ++i) el[i] = lp[4 + gs * 8 + i] * rstd + P.b_router[gs * 8 + i];
            int i0 = 0; float l0 = el[0];
#pragma unroll
            for (int i = 1; i < 8; ++i) if (el[i] > l0) { l0 = el[i]; i0 = i; }
            int i1 = -1; float l1 = -INFINITY;
#pragma unroll
            for (int i = 0; i < 8; ++i) if (i != i0 && el[i] > l1) { l1 = el[i]; i1 = i; }
            const float rr = expf(l1 - l0);
            const float g0 = pg / (1.0f + rr), g1 = pg * rr / (1.0f + rr);
            const int e0 = gs * 8 + i0, e1 = gs * 8 + i1;
            int lp0 = 0, lp1 = 0;
            if (lane < 16) { lp0 = __hip_atomic_fetch_add(&lcnt[e0], 1, __ATOMIC_RELAXED, __HIP_MEMORY_SCOPE_WORKGROUP); lp1 = __hip_atomic_fetch_add(&lcnt[e1], 1, __ATOMIC_RELAXED, __HIP_MEMORY_SCOPE_WORKGROUP); }
            __syncthreads();
            if (tid < 32) { const int c = lcnt[tid]; lbase[tid] = c ? atomicAdd(&cnt[tid], c) : 0; }
            __syncthreads();
            if (lane < 16) {
                const int p0 = lbase[e0] + lp0, p1 = lbase[e1] + lp1;
                list[(size_t)e0 * T + p0] = tok; list[(size_t)e1 * T + p1] = tok;
                *(int2*)(eid + tok * 2) = make_int2(e0, e1); *(int2*)(posn + tok * 2) = make_int2(p0, p1);
                *(float2*)(gate + tok * 2) = make_float2(g0, g1);
                rstd1[tok] = rstd;
            }
        }
        __syncthreads();
    }
    GRID_BAR(6);
    if constexpr (IN(8) || IN(9) || IN(11)) {
        PH_IDS
        __syncthreads();
        if (tid == 0) { int o = 0; for (int e = 0; e < NE; ++e) { const int c = cnt[e]; s_cnt[e] = c; s_off[e] = o; const int nt = (c + 255) >> 8; for (int i = 0; i < nt; ++i) s_t2e[(o >> 8) + i] = e; o += nt << 8; } s_off[NE] = o; }
        __syncthreads();
    }
    if constexpr (IN(8)) {
        PH_IDS
        const int NS = s_off[NE];
        LAS int* gtok = (LAS int*)(ldsl + RING_BYTES); LAS float* rtab = (LAS float*)(ldsl + RING_BYTES + 6144);
        pg8::GroupedOrder S; S.init(NS >> 8, G, bid, (const LAS int*)s_t2e);
        {   pg8::Unit u;
            for (int ui = 0; ui < 6 && S.next(ui, u); ++ui) {
                const int e = s_t2e[u.pm], base = s_off[e], c = s_cnt[e];
                if (tid < 256) { const int i = u.pm * 256 + tid - base; int tok = 0; float rs = 0.f; if (i < c) { tok = list[(size_t)e * T + i]; rs = rstd1[tok]; } gtok[ui * 256 + tid] = tok; rtab[ui * 256 + tid] = rs; }
            }
        }
        __syncthreads();
        pg8::Gemm g{(const bf16_t*)((unsigned char*)out + OUT_HB), w13_t, NS, NE * 1024, D, (const LAS int*)gtok};
        pg8::EpiSwiglu E{hbuf, (const LAS float*)rtab};
        pg8::gemm_phase<pg8::EpiSwiglu, pg8::GroupedOrder, true, true, true>(ldsl, g, S, E);
        {
            const int nwg8 = (NS >> 8) * 4, full = nwg8 / G, extra = nwg8 - full * G;
            pg8::Gemm g2{pb, wup_t, T, D, PLE, nullptr}; pg8::SkewOrder S2; S2.init((T / 256) * 4, G, bid, extra);
            pg8::EpiStoreBf16 E2{peb, D, 0xffff, part, 0};
            pg8::gemm_phase<pg8::EpiStoreBf16, pg8::SkewOrder, true, true>(ldsl, g2, S2, E2);
        }
    }
    GRID_BAR(8);
    if constexpr (IN(9)) {
        PH_IDS
        const int NS = s_off[NE];
        pg8::Gemm g{hbuf, w2_t, NS, NE * 1024, DE, nullptr}; pg8::GroupedOrder S; S.init(NS >> 8, G, bid, (const LAS int*)s_t2e);
        pg8::EpiStoreBf16 E{ybuf, D, 3, nullptr, 0};
        pg8::gemm_phase<pg8::EpiStoreBf16, pg8::GroupedOrder, true, true>(ldsl, g, S, E);
    }
    GRID_BAR(9);
    if constexpr (IN(11)) {
        PH_IDS
        const bf16_t* hb = (const bf16_t*)((unsigned char*)out + OUT_HB); bf16_t* a2b = (bf16_t*)(ws + WS_A2);
        const int ntrip = T / (2 * NGW);
        int sA[2][2], sB[2][2]; float gA[2][2], gB[2][2]; v4u dA[2][3][2], dB[2][3][2]; float pA[2], pB[2];
#define E0_IDX(s_, g_, trip_) do { _Pragma("unroll") for (int u = 0; u < 2; ++u) { const int row = gw + (2 * (trip_) + u) * NGW; \
            const int2 e2 = *(const int2*)(eid + row * 2), p2 = *(const int2*)(posn + row * 2); const float2 g2 = *(const float2*)(gate + row * 2); \
            s_[u][0] = s_off[e2.x] + p2.x; s_[u][1] = s_off[e2.y] + p2.y; g_[u][0] = g2.x; g_[u][1] = g2.y; } } while (0)
#define E0_LOAD(d_, p_, s_, trip_) do { _Pragma("unroll") for (int u = 0; u < 2; ++u) { const int row = gw + (2 * (trip_) + u) * NGW; \
            _Pragma("unroll") for (int j = 0; j < 2; ++j) { const int k0 = 8 * (lane + 64 * j); \
                d_[u][0][j] = __builtin_nontemporal_load((const v4u*)(hb + (size_t)row * D + k0)); d_[u][1][j] = __builtin_nontemporal_load((const v4u*)(ybuf + (size_t)s_[u][0] * D + k0)); d_[u][2][j] = __builtin_nontemporal_load((const v4u*)(ybuf + (size_t)s_[u][1] * D + k0)); } \
            p_[u] = lane < 16 ? part[(size_t)row * 16 + lane] : 0.f; } } while (0)
#define E0_COMP(d_, p_, g_, trip_) do { _Pragma("unroll") for (int u = 0; u < 2; ++u) { const int row = gw + (2 * (trip_) + u) * NGW; const float g0 = g_[u][0], g1 = g_[u][1]; float ss = 0.f; \
            _Pragma("unroll") for (int j = 0; j < 2; ++j) { const int k0 = 8 * (lane + 64 * j); const v4u hq = d_[u][0][j], y0 = d_[u][1][j], y1 = d_[u][2][j]; float hv[8]; \
                hv[0] = blo(hq.x) + g0 * blo(y0.x) + g1 * blo(y1.x); hv[1] = bhi(hq.x) + g0 * bhi(y0.x) + g1 * bhi(y1.x); \
                hv[2] = blo(hq.y) + g0 * blo(y0.y) + g1 * blo(y1.y); hv[3] = bhi(hq.y) + g0 * bhi(y0.y) + g1 * bhi(y1.y); \
                hv[4] = blo(hq.z) + g0 * blo(y0.z) + g1 * blo(y1.z); hv[5] = bhi(hq.z) + g0 * bhi(y0.z) + g1 * bhi(y1.z); \
                hv[6] = blo(hq.w) + g0 * blo(y0.w) + g1 * blo(y1.w); hv[7] = bhi(hq.w) + g0 * bhi(y0.w) + g1 * bhi(y1.w); \
                v4u o; o.x = cvtpk(hv[0], hv[1]); o.y = cvtpk(hv[2], hv[3]); o.z = cvtpk(hv[4], hv[5]); o.w = cvtpk(hv[6], hv[7]); \
                  \
                const float r8[8] = {blo(o.x), bhi(o.x), blo(o.y), bhi(o.y), blo(o.z), bhi(o.z), blo(o.w), bhi(o.w)}; \
                _Pragma("unroll") for (int i = 0; i < 8; ++i) ss += r8[i] * r8[i]; \
                *(v4u*)(a2b + (size_t)row * D + k0) = o; } \
            ss = wave_sum(ss); const float pe = wave_sum(p_[u]); \
            if (lane == 0) { rstdg[row] = 1.0f / sqrtf(ss * (1.0f / D) + EPS); rstde[row] = 1.0f / sqrtf(pe * (1.0f / D) + EPS); } } } while (0)
        E0_IDX(sA, gA, 0); E0_LOAD(dA, pA, sA, 0);
        if (ntrip > 1) E0_IDX(sB, gB, 1);
        for (int trip = 0; trip < ntrip; trip += 2) {
            if (trip + 1 < ntrip) E0_LOAD(dB, pB, sB, trip + 1);
            E0_COMP(dA, pA, gA, trip);
            if (trip + 2 < ntrip) E0_IDX(sA, gA, trip + 2);
            if (trip + 1 < ntrip) {
                if (trip + 2 < ntrip) E0_LOAD(dA, pA, sA, trip + 2);
                E0_COMP(dB, pB, gB, trip + 1);
                if (trip + 3 < ntrip) E0_IDX(sB, gB, trip + 3);
            }
        }
#undef E0_IDX
#undef E0_LOAD
#undef E0_COMP
    }
    GRID_BAR(11);
    if constexpr (IN(12)) {
        PH_IDS
        pg8::Gemm g{(const bf16_t*)(ws + WS_A2), wgate_t, T, D, D, nullptr}; pg8::StaticOrder S; S.init(T, D, G, bid);
        pg8::EpiGate E{(bf16_t*)(ws + WS_H3B), (const bf16_t*)(ws + WS_A2), peb, rstdg, rstde, P.ple_norm, part2};
        pg8::gemm_phase<pg8::EpiGate, pg8::StaticOrder, true, true>(ldsl, g, S, E);
    }
    GRID_BAR(12);
    if constexpr (IN(13)) {
        PH_IDS
        const bf16_t* h3b = (const bf16_t*)(ws + WS_H3B);
        for (int row0 = gw; row0 < T; row0 += 2 * NGW) {
            v4u hq[2][2]; float ssv[2];
#pragma unroll
            for (int u = 0; u < 2; ++u) { const int row = row0 + u * NGW; hq[u][0] = __builtin_nontemporal_load((const v4u*)(h3b + (size_t)row * D + 8 * lane)); hq[u][1] = __builtin_nontemporal_load((const v4u*)(h3b + (size_t)row * D + 8 * (lane + 64)));
                ssv[u] = lane < 16 ? part2[(size_t)row * 16 + lane] : 0.f; }
#pragma unroll
            for (int u = 0; u < 2; ++u) {
                const int row = row0 + u * NGW;
                const float rstd = 1.0f / sqrtf(wave_sum(ssv[u]) * (1.0f / D) + EPS);
#pragma unroll
                for (int j = 0; j < 2; ++j) { const int k0 = 8 * (lane + 64 * j); const v4u q = hq[u][j];
                    const f4v n0 = *(const f4v*)(P.final_norm + k0), n1 = *(const f4v*)(P.final_norm + k0 + 4);
                    f4v o0, o1; o0.x = blo(q.x) * rstd * n0.x; o0.y = bhi(q.x) * rstd * n0.y; o0.z = blo(q.y) * rstd * n0.z; o0.w = bhi(q.y) * rstd * n0.w;
                    o1.x = blo(q.z) * rstd * n1.x; o1.y = bhi(q.z) * rstd * n1.y; o1.z = blo(q.w) * rstd * n1.z; o1.w = bhi(q.w) * rstd * n1.w;
                    __builtin_nontemporal_store(o0, (f4v*)(out + (size_t)row * D + k0)); __builtin_nontemporal_store(o1, (f4v*)(out + (size_t)row * D + k0 + 4)); }
            }
        }
    }
    if (PROBE_PH >= 0) {
        if (PROBE_PH == NPHASES - 1) pt1 = __builtin_amdgcn_s_memrealtime();
        if (bid == 0 && threadIdx.x == 0) { const unsigned long long dt = (PROBE_PH >= 110 && PROBE_PH < 140) ? pseg : pt1 - pt0, te = __builtin_amdgcn_s_memrealtime(); while (__builtin_amdgcn_s_memrealtime() - te < 9ull * dt) __builtin_amdgcn_s_sleep(8); }
    }
#undef GRID_BAR
#undef PH_IDS
#undef IN
#undef SEG
#undef rstd1
#undef gates
#undef rstdg
#undef rstde
#undef eid
#undef posn
#undef gate
#undef mn
#undef ml
#undef mbl
#undef mm
#undef list
#undef cnt
#undef part
#undef part2
#undef win_t
#undef wout_t
#undef w13_t
#undef w2_t
#undef wgate_t
#undef wup_t
#undef proj
#undef hbuf
#undef xs
#undef ybuf
#undef peb
#undef yreg
#undef pb
#undef rst
#undef mst
}

template <int PH> static void launch_one(int grid, const Params& p, hipStream_t stream) {
    static bool attr_done = false;
    if (!attr_done) { (void)hipFuncSetAttribute((const void*)mk<PH, PH + 1>, hipFuncAttributeMaxDynamicSharedMemorySize, LDS_BYTES); attr_done = true; }
    hipLaunchKernelGGL((mk<PH, PH + 1>), dim3(grid), dim3(NTHREADS), LDS_BYTES, stream, p);
}
template <int PH> static void launch_all(int grid, const Params& p, hipStream_t stream) {
    if constexpr (PH < NPHASES) { launch_one<PH>(grid, p, stream); launch_all<PH + 1>(grid, p, stream); }
}
#ifndef MK_N_LAUNCHES
#define MK_N_LAUNCHES 1
#endif

extern "C" void kernel_launch(void* const* d_in, const int* in_sizes, int n_in, void* d_out, int out_size, void* d_ws, size_t ws_size, hipStream_t stream) {
    static int grid = 0;
    if (grid == 0) {
        if (n_in != 25 || in_sizes[0] != T * D || out_size != T * D || ws_size < WS_END) {
            fprintf(stderr, "kernel_launch: unexpected shapes: n_in %d in0 %d out %d ws %zu\n", n_in, n_in > 0 ? in_sizes[0] : -1, out_size, ws_size); grid = -1; return; }
        int dev = 0, cus = 0;
        (void)hipGetDevice(&dev); (void)hipDeviceGetAttribute(&cus, hipDeviceAttributeMultiprocessorCount, dev);
        (void)hipGetLastError();
        if (cus < 256) { fprintf(stderr, "kernel_launch: this kernel's phase maps are built for a 256-workgroup grid (one per CU of a 256-CU device); the device reports %d CUs; nothing launched\n", cus); grid = -1; return; }
        grid = 256;
        if (MK_N_LAUNCHES == 1) {
            int per_cu = 0;
            if (hipFuncSetAttribute((const void*)mk<0, NPHASES>, hipFuncAttributeMaxDynamicSharedMemorySize, LDS_BYTES) != hipSuccess) { fprintf(stderr, "kernel_launch: hipFuncSetAttribute failed\n"); grid = -1; return; }
            if (hipOccupancyMaxActiveBlocksPerMultiprocessor(&per_cu, (const void*)mk<0, NPHASES>, NTHREADS, LDS_BYTES) != hipSuccess || per_cu < 1) { fprintf(stderr, "kernel_launch: occupancy query reports %d workgroups per CU; the grid barrier needs one resident workgroup per CU; nothing launched\n", per_cu); grid = -1; return; }
            (void)hipGetLastError();
        }
    }
    if (grid < 0) return;
    (void)hipMemsetAsync((char*)d_ws + WS_CTL, 0, 1 * MiB, stream);
    Params p{};
    p.x = (const float*)d_in[0]; p.p = (const float*)d_in[1]; p.pos = (const int*)d_in[2];
    p.attn_norm = (const float*)d_in[3]; p.w_in = (const float*)d_in[4]; p.conv_w = (const float*)d_in[5]; p.conv_b = (const float*)d_in[6];
    p.b_ig = (const float*)d_in[7]; p.b_fg = (const float*)d_in[8]; p.ret_gn = (const float*)d_in[9]; p.ml_gn = (const float*)d_in[10];
    p.w_out = (const float*)d_in[11]; p.moe_norm = (const float*)d_in[12]; p.w_group = (const float*)d_in[13]; p.b_group = (const float*)d_in[14];
    p.w_router = (const float*)d_in[15]; p.b_router = (const float*)d_in[16]; p.w1 = (const float*)d_in[17]; p.w3 = (const float*)d_in[18]; p.w2 = (const float*)d_in[19];
    p.w_up = (const float*)d_in[20]; p.ple_norm = (const float*)d_in[21]; p.pg_norm = (const float*)d_in[22]; p.w_gate = (const float*)d_in[23]; p.final_norm = (const float*)d_in[24];
    p.out = (float*)d_out; p.ws = (unsigned char*)d_ws;
    if (MK_N_LAUNCHES == 1) hipLaunchKernelGGL((mk<0, NPHASES>), dim3(grid), dim3(NTHREADS), LDS_BYTES, stream, p);
    else launch_all<0>(grid, p, stream);
}
```
